# Optimizing an MI355X kernel written in HIP

```python
import jax
import jax.numpy as jnp
from jax import lax
import numpy as np

D_MODEL = 1024
BATCH = 16
SEQ = 256
DEPTH = 2
DEC_BATCH = 8
DEC_SEQ = 1024
PAST_LEN = 256

GRID_W = 64
NORM_EPS = 1e-6
D_FF = 4 * D_MODEL
N_EVEN = (DEPTH + 1) // 2
N_ODD = DEPTH // 2

HEAD_DIM = 64
A_HEADS = 8
A_KV_HEADS = 2
A_WIDTH = A_HEADS * HEAD_DIM
A_KV_WIDTH = A_KV_HEADS * HEAD_DIM
Q_BLOCK = 128
ROPE_THETA = 10000.0
ATTN_SCALE = HEAD_DIM ** -0.5

B_HEADS = 8
B_DK = 64
B_DV = 64
B_FDIM = B_HEADS * B_DK
B_VDIM = B_HEADS * B_DV
B_CHUNK = 64

AB_SIZES = (A_WIDTH, A_KV_WIDTH, A_KV_WIDTH, B_FDIM, B_FDIM, B_FDIM, B_VDIM, B_VDIM)
AB_IN = A_WIDTH + 2 * A_KV_WIDTH + 3 * B_FDIM + 2 * B_VDIM
AB_OUT = A_WIDTH + B_VDIM

C_N = 64
C_HEADS = D_MODEL // C_N
DECAY_LORA = 64
AAA_LORA = 64
GATE_LORA = 128
LN_X_EPS = 64e-5

kernel_name = 'hybrid_dit_gqa_hgrn2_rwkv7_step'


def rms_norm(x, w):
    xf = x.astype(jnp.float32)
    y = xf * lax.rsqrt(jnp.mean(xf * xf, axis=-1, keepdims=True) + NORM_EPS)
    return (y * w.astype(jnp.float32)).astype(x.dtype)


def adaln_vectors(cvec, w, b):
    m = jax.nn.silu(cvec) @ w + b
    return jnp.split(m[:, None, :], 6, axis=-1)


def modulate(h, shift, scale):
    return h * (1 + scale) + shift


def axial_rope_tables(n_tok):
    rows = n_tok // GRID_W
    row = jnp.repeat(jnp.arange(rows), GRID_W).astype(jnp.float32)
    col = jnp.tile(jnp.arange(GRID_W), rows).astype(jnp.float32)
    ax = HEAD_DIM // 2
    inv = ROPE_THETA ** (-jnp.arange(0, ax, 2, dtype=jnp.float32) / ax)
    ang = jnp.concatenate([row[:, None] * inv, col[:, None] * inv], axis=-1)
    return jnp.cos(ang), jnp.sin(ang)


def apply_rope(x, cos, sin):
    xf = x.astype(jnp.float32).reshape(x.shape[:-1] + (HEAD_DIM // 2, 2))
    x0, x1 = xf[..., 0], xf[..., 1]
    c = cos[None, :, None, :]
    s = sin[None, :, None, :]
    out = jnp.stack([x0 * c - x1 * s, x0 * s + x1 * c], axis=-1).reshape(x.shape)
    return out.astype(x.dtype)


def block_attention(q, k, v):
    bsz, n_q, n_h, hd = q.shape
    n_kv = k.shape[2]
    grp = n_h // n_kv
    n_blk = n_q // Q_BLOCK
    qb = jnp.moveaxis(q.reshape(bsz, n_blk, Q_BLOCK, n_kv, grp, hd), 1, 0)

    def one_block(q_blk):
        s = jnp.einsum('bqkgd,btkd->bkgqt', q_blk, k, preferred_element_type=jnp.float32) * ATTN_SCALE
        p = jax.nn.softmax(s, axis=-1).astype(v.dtype)
        return jnp.einsum('bkgqt,btkd->bqkgd', p, v)

    out = lax.map(one_block, qb)
    return jnp.moveaxis(out, 0, 1).reshape(bsz, n_q, n_h * hd)


def gla_chunkwise(q, log_f, k, v, s0):
    bsz, n_tok, n_h, dk = q.shape
    dv = v.shape[-1]
    n_c = n_tok // B_CHUNK
    q, log_f, k = (t.reshape(bsz, n_c, B_CHUNK, n_h, dk) for t in (q, log_f, k))
    v = v.reshape(bsz, n_c, B_CHUNK, n_h, dv)
    b = jnp.cumsum(log_f, axis=2)
    b_end = b[:, :, -1]
    q_dec = q * jnp.exp(b)
    k_inv = k * jnp.exp(-b)
    mask = jnp.tril(jnp.ones((B_CHUNK, B_CHUNK), dtype=bool))
    att = jnp.where(mask, jnp.einsum('bnchk,bnshk->bnhcs', q_dec, k_inv), 0.0)
    o_intra = jnp.einsum('bnhcs,bnshv->bnchv', att, v)
    k_end = k * jnp.exp(b_end[:, :, None] - b)
    ds = jnp.einsum('bnchk,bnchv->bnhkv', k_end, v)
    decay = jnp.exp(b_end)

    def step(s, inp):
        dec, d = inp
        return dec[..., None] * s + d, s

    s_final, s_start = lax.scan(step, s0.astype(jnp.float32), (jnp.moveaxis(decay, 1, 0), jnp.moveaxis(ds, 1, 0)))
    s_start = jnp.moveaxis(s_start, 0, 1)
    o_inter = jnp.einsum('bnchk,bnhkv->bnchv', q_dec, s_start)
    return (o_intra + o_inter).reshape(bsz, n_tok, n_h, dv), s_final


def even_mixer(h, w_in, w_out, q_norm, k_norm, lb, g_norm, ctx):
    bsz, n_tok, _ = h.shape
    offs = []
    acc = 0
    for size in AB_SIZES[:-1]:
        acc += size
        offs.append(acc)
    qa, ka, va, qb, fa, fb, vb, gb = jnp.split(h @ w_in, offs, axis=-1)
    qa = rms_norm(qa.reshape(bsz, n_tok, A_HEADS, HEAD_DIM), q_norm)
    ka = rms_norm(ka.reshape(bsz, n_tok, A_KV_HEADS, HEAD_DIM), k_norm)
    va = va.reshape(bsz, n_tok, A_KV_HEADS, HEAD_DIM)
    if ctx is None:
        keys, vals = ka, va
        s0_f = jnp.zeros((bsz, B_HEADS, B_DK, B_DV), jnp.float32)
        s0_b = s0_f
    else:
        ctx_k, ctx_v, s0_f, s0_b = ctx
        cos, sin = axial_rope_tables(n_tok)
        qa = apply_rope(qa, cos, sin)
        keys = jnp.concatenate([apply_rope(ka, cos, sin), ctx_k.astype(ka.dtype)], axis=1)
        vals = jnp.concatenate([va, ctx_v.astype(va.dtype)], axis=1)
    oa = block_attention(qa, keys, vals)
    lb = lb.reshape(B_HEADS, B_DK)

    def heads_b(t, d):
        return t.astype(jnp.float32).reshape(bsz, n_tok, B_HEADS, d)

    q = jax.nn.silu(heads_b(qb, B_DK))
    v = heads_b(vb, B_DV)
    f_f = lb + (1 - lb) * jax.nn.sigmoid(heads_b(fa, B_DK))
    f_b = lb + (1 - lb) * jax.nn.sigmoid(heads_b(fb, B_DK))
    o_f, s_f = gla_chunkwise(q, jnp.log(f_f), 1 - f_f, v, s0_f)
    o_b, s_b = gla_chunkwise(q[:, ::-1], jnp.log(f_b)[:, ::-1], (1 - f_b)[:, ::-1], v[:, ::-1], s0_b)
    o = rms_norm(o_f + o_b[:, ::-1], g_norm) * jax.nn.silu(heads_b(gb, B_DV))
    ob = o.reshape(bsz, n_tok, B_VDIM).astype(h.dtype)
    y = jnp.concatenate([oa, ob], axis=-1) @ w_out
    return y, (ka, va, s_f, s_b)


def token_shift(x):
    half = x.shape[-1] // 2
    xp = jnp.pad(x, ((0, 0), (1, 1), (0, 0)))
    shifted = jnp.concatenate([xp[:, :-2, :half], xp[:, 2:, half:]], axis=-1)
    return shifted - x


def rwkv7_scan(r, w, k, v, kk, a, s0):
    def step(s, inp):
        r_t, w_t, k_t, v_t, kk_t, a_t = inp
        sa = jnp.einsum('bhvk,bhk->bhv', s, -kk_t)
        s = s * w_t[:, :, None, :] + sa[..., None] * (kk_t * a_t)[:, :, None, :] + v_t[..., None] * k_t[:, :, None, :]
        return s, jnp.einsum('bhvk,bhk->bhv', s, r_t)

    xs = tuple(jnp.moveaxis(t, 1, 0) for t in (r, w, k, v, kk, a))
    s_fin, ys = lax.scan(step, s0.astype(jnp.float32), xs)
    return jnp.moveaxis(ys, 0, 1), s_fin


def odd_mixer(h, mix, wr, wk, wv, wo, w0, w1, w2, a0, a1, a2, g1, g2, k_k, k_a, r_k, ln_w, ln_b, ctx):
    bsz, n_tok, _ = h.shape

    def heads(t):
        return t.astype(jnp.float32).reshape(bsz, n_tok, C_HEADS, C_N)

    xx = token_shift(h)
    xr, xw, xk, xv, xa, xg = [h + xx * mix[i] for i in range(6)]
    r = heads(xr @ wr)
    k = heads(xk @ wk)
    v = heads(xv @ wv)
    g = jax.nn.sigmoid(xg @ g1) @ g2
    kk = k * k_k.astype(jnp.float32).reshape(C_HEADS, C_N)
    kk = kk * lax.rsqrt(jnp.maximum(jnp.sum(kk * kk, axis=-1, keepdims=True), 1e-24))
    k_a_h = k_a.astype(jnp.float32).reshape(C_HEADS, C_N)
    r_k_f = r_k.astype(jnp.float32)
    if ctx is None:
        s0_f = jnp.zeros((bsz, C_HEADS, C_N, C_N), jnp.float32)
        s0_b = s0_f
    else:
        s0_f, s0_b = ctx

    def direction(d, s0):
        w_log = -jax.nn.softplus(-(w0[d] + jnp.tanh(xw @ w1[d]) @ w2[d]).astype(jnp.float32)) - 0.5
        decay = heads(jnp.exp(-jnp.exp(w_log)))
        a = heads(jax.nn.sigmoid((a0[d] + (xa @ a1[d]) @ a2[d]).astype(jnp.float32)))
        kd = k * (1 + (a - 1) * k_a_h)
        seq = (r, decay, kd, v, kk, a)
        if d == 1:
            seq = tuple(t[:, ::-1] for t in seq)
        y, s_fin = rwkv7_scan(*seq, s0)
        if d == 1:
            y = y[:, ::-1]
        bonus = jnp.sum(r * kd * r_k_f, axis=-1, keepdims=True) * v
        return y, bonus, s_fin

    y_f, bonus_f, s_f = direction(0, s0_f)
    y_b, bonus_b, s_b = direction(1, s0_b)
    y = y_f + y_b
    mu = jnp.mean(y, axis=-1, keepdims=True)
    var = jnp.mean(jnp.square(y - mu), axis=-1, keepdims=True)
    yn = ((y - mu) * lax.rsqrt(var + LN_X_EPS)).reshape(bsz, n_tok, D_MODEL) * ln_w + ln_b
    out = (yn + (bonus_f + bonus_b).reshape(bsz, n_tok, D_MODEL)) * g
    return out.astype(h.dtype) @ wo, (s_f, s_b)


def sq_relu_mlp(h, w1, w2):
    return jnp.square(jax.nn.relu(h @ w1)) @ w2


def run_trunk(x, cvec, W, lb_all, cache):
    attn_k, attn_v, hg_f, hg_b, rw_f, rw_b = [], [], [], [], [], []
    for l in range(DEPTH):
        j = l // 2
        sh1, sc1, gt1, sh2, sc2, gt2 = adaln_vectors(cvec, W['ada_w'][l], W['ada_b'][l])
        h = modulate(rms_norm(x, W['norm1_w'][l]), sh1, sc1)
        if l % 2 == 0:
            ctx = None if cache is None else (cache['attn_k'][:, j], cache['attn_v'][:, j], cache['hgrn_fwd'][:, j], cache['hgrn_bwd'][:, j])
            y, (k_c, v_c, s_f, s_b) = even_mixer(h, W['ab_w_in'][j], W['ab_w_out'][j], W['attn_q_norm'][j], W['attn_k_norm'][j], lb_all[j], W['hgrn_g_norm'][j], ctx)
            attn_k.append(k_c)
            attn_v.append(v_c)
            hg_f.append(s_f)
            hg_b.append(s_b)
        else:
            ctx = None if cache is None else (cache['rwkv_fwd'][:, j], cache['rwkv_bwd'][:, j])
            y, (s_f, s_b) = odd_mixer(h, W['rwkv_mix'][j], W['rwkv_wr'][j], W['rwkv_wk'][j], W['rwkv_wv'][j], W['rwkv_wo'][j], W['rwkv_w0'][j], W['rwkv_w1'][j], W['rwkv_w2'][j], W['rwkv_a0'][j], W['rwkv_a1'][j], W['rwkv_a2'][j], W['rwkv_g1'][j], W['rwkv_g2'][j], W['rwkv_k_k'][j], W['rwkv_k_a'][j], W['rwkv_r_k'][j], W['rwkv_ln_w'][j], W['rwkv_ln_b'][j], ctx)
            rw_f.append(s_f)
            rw_b.append(s_b)
        x = x + gt1 * y
        h = modulate(rms_norm(x, W['norm2_w'][l]), sh2, sc2)
        x = x + gt2 * sq_relu_mlp(h, W['mlp_w1'][l], W['mlp_w2'][l])
    if cache is not None:
        return x, None
    return x, (jnp.stack(attn_k, axis=1), jnp.stack(attn_v, axis=1), jnp.stack(hg_f, axis=1), jnp.stack(hg_b, axis=1), jnp.stack(rw_f, axis=1), jnp.stack(rw_b, axis=1))


def setup_inputs(seed: int = 0) -> dict:
    key = jax.random.key(seed)
    keys = jax.random.split(key, 64)
    counter = [0]

    def nxt():
        kk = keys[counter[0]]
        counter[0] += 1
        return kk

    def nrm(shape, scale):
        return scale * jax.random.normal(nxt(), shape, jnp.float32)

    def unif(shape, lo, hi):
        return jax.random.uniform(nxt(), shape, jnp.float32, lo, hi)

    D = D_MODEL
    E, O, L = N_EVEN, N_ODD, DEPTH
    return {
        'x_prompt': nrm((BATCH, SEQ, D), 1.0),
        'x_sample': nrm((DEC_BATCH, DEC_SEQ, D), 1.0),
        'cache_attn_k': nrm((DEC_BATCH, E, PAST_LEN, A_KV_HEADS, HEAD_DIM), 1.0),
        'cache_attn_v': nrm((DEC_BATCH, E, PAST_LEN, A_KV_HEADS, HEAD_DIM), 1.0),
        'state_hgrn_fwd': nrm((DEC_BATCH, E, B_HEADS, B_DK, B_DV), 0.5),
        'state_hgrn_bwd': nrm((DEC_BATCH, E, B_HEADS, B_DK, B_DV), 0.5),
        'state_rwkv_fwd': nrm((DEC_BATCH, O, C_HEADS, C_N, C_N), 0.3),
        'state_rwkv_bwd': nrm((DEC_BATCH, O, C_HEADS, C_N, C_N), 0.3),
        'c': nrm((DEC_BATCH, D), 1.0),
        'c_ctx': nrm((D,), 1.0),
        'ada_w': nrm((L, D, 6 * D), 0.5 * D ** -0.5),
        'ada_b': nrm((L, 6 * D), 0.02),
        'norm1_w': 1.0 + nrm((L, D), 0.02),
        'norm2_w': 1.0 + nrm((L, D), 0.02),
        'ab_w_in': nrm((E, D, AB_IN), D ** -0.5),
        'ab_w_out': nrm((E, AB_OUT, D), AB_OUT ** -0.5),
        'attn_q_norm': 1.0 + nrm((E, HEAD_DIM), 0.02),
        'attn_k_norm': 1.0 + nrm((E, HEAD_DIM), 0.02),
        'hgrn_lb': nrm((E + 1, B_FDIM), 0.1),
        'hgrn_g_norm': 1.0 + nrm((E, B_DV), 0.02),
        'rwkv_mix': unif((O, 6, D), 0.0, 1.0),
        'rwkv_wr': nrm((O, D, D), D ** -0.5),
        'rwkv_wk': nrm((O, D, D), D ** -0.5),
        'rwkv_wv': nrm((O, D, D), D ** -0.5),
        'rwkv_wo': nrm((O, D, D), D ** -0.5),
        'rwkv_w0': unif((O, 2, D), -4.0, -1.0),
        'rwkv_w1': nrm((O, 2, D, DECAY_LORA), D ** -0.5),
        'rwkv_w2': nrm((O, 2, DECAY_LORA, D), 0.1 * DECAY_LORA ** -0.5),
        'rwkv_a0': nrm((O, 2, D), 0.1),
        'rwkv_a1': nrm((O, 2, D, AAA_LORA), D ** -0.5),
        'rwkv_a2': nrm((O, 2, AAA_LORA, D), AAA_LORA ** -0.5),
        'rwkv_g1': nrm((O, D, GATE_LORA), D ** -0.5),
        'rwkv_g2': nrm((O, GATE_LORA, D), GATE_LORA ** -0.5),
        'rwkv_k_k': 0.85 + nrm((O, D), 0.05),
        'rwkv_k_a': 1.0 + nrm((O, D), 0.05),
        'rwkv_r_k': nrm((O, C_HEADS, C_N), 0.1),
        'rwkv_ln_w': 1.0 + nrm((O, D), 0.02),
        'rwkv_ln_b': nrm((O, D), 0.02),
        'mlp_w1': nrm((L, D, D_FF), D ** -0.5),
        'mlp_w2': nrm((L, D_FF, D), D_FF ** -0.5),
    }


def reference(x_prompt, x_sample, cache_attn_k, cache_attn_v, state_hgrn_fwd, state_hgrn_bwd, state_rwkv_fwd, state_rwkv_bwd, c, c_ctx, ada_w, ada_b, norm1_w, norm2_w, ab_w_in, ab_w_out, attn_q_norm, attn_k_norm, hgrn_lb, hgrn_g_norm, rwkv_mix, rwkv_wr, rwkv_wk, rwkv_wv, rwkv_wo, rwkv_w0, rwkv_w1, rwkv_w2, rwkv_a0, rwkv_a1, rwkv_a2, rwkv_g1, rwkv_g2, rwkv_k_k, rwkv_k_a, rwkv_r_k, rwkv_ln_w, rwkv_ln_b, mlp_w1, mlp_w2):
    W = dict(ada_w=ada_w, ada_b=ada_b, norm1_w=norm1_w, norm2_w=norm2_w, ab_w_in=ab_w_in, ab_w_out=ab_w_out, attn_q_norm=attn_q_norm, attn_k_norm=attn_k_norm, hgrn_g_norm=hgrn_g_norm, rwkv_mix=rwkv_mix, rwkv_wr=rwkv_wr, rwkv_wk=rwkv_wk, rwkv_wv=rwkv_wv, rwkv_wo=rwkv_wo, rwkv_w0=rwkv_w0, rwkv_w1=rwkv_w1, rwkv_w2=rwkv_w2, rwkv_a0=rwkv_a0, rwkv_a1=rwkv_a1, rwkv_a2=rwkv_a2, rwkv_g1=rwkv_g1, rwkv_g2=rwkv_g2, rwkv_k_k=rwkv_k_k, rwkv_k_a=rwkv_k_a, rwkv_r_k=rwkv_r_k, rwkv_ln_w=rwkv_ln_w, rwkv_ln_b=rwkv_ln_b, mlp_w1=mlp_w1, mlp_w2=mlp_w2)
    lb_all = jnp.cumsum(jax.nn.softmax(hgrn_lb.astype(jnp.float32), axis=0), axis=0)
    y_prompt, ctx_new = run_trunk(x_prompt, c_ctx[None, :], W, lb_all, None)
    new_attn_k, new_attn_v, new_hgrn_fwd, new_hgrn_bwd, new_rwkv_fwd, new_rwkv_bwd = ctx_new
    cache = dict(attn_k=cache_attn_k, attn_v=cache_attn_v, hgrn_fwd=state_hgrn_fwd, hgrn_bwd=state_hgrn_bwd, rwkv_fwd=state_rwkv_fwd, rwkv_bwd=state_rwkv_bwd)
    y_sample, _ = run_trunk(x_sample, c, W, lb_all, cache)
    return (y_prompt, y_sample, new_attn_k, new_attn_v, new_hgrn_fwd, new_hgrn_bwd, new_rwkv_fwd, new_rwkv_bwd)
```

```cpp
#include <hip/hip_runtime.h>
#include <hip/hip_cooperative_groups.h>
#include <stdint.h>
#include <string.h>
#include <stdio.h>
namespace cg = cooperative_groups;

#ifndef ONE_LAUNCH
#define ONE_LAUNCH 1
#endif

typedef unsigned short bf16_t;
typedef short bf16x8 __attribute__((ext_vector_type(8)));
typedef float f32x4 __attribute__((ext_vector_type(4)));
typedef float f32x16 __attribute__((ext_vector_type(16)));

#define NT 256
#define NTOK 12288
#define NP 4096
#define NPHASES 18
#ifndef ONLY_PHASE
#define ONLY_PHASE -1
#endif

struct TJob { const float* src; bf16_t* dst; int K, N, tile0, pad; };

struct Params {
  const float *x_prompt, *x_sample, *cache_k, *cache_v, *hg_f0, *hg_b0, *rw_f0, *rw_b0, *c, *c_ctx;
  const float *ada_w, *ada_b, *norm1_w, *norm2_w, *q_norm, *k_norm, *hgrn_lb, *g_norm;
  const float *mix, *w0, *a0, *k_k, *k_a, *r_k, *ln_w, *ln_b;
  float *X, *out_k, *out_v, *out_hf, *out_hb, *out_rf, *out_rb;
  bf16_t *w_in_t, *w_out_t, *wr_t, *wk_t, *wv_t, *wo_t, *w1cat_t, *a1cat_t, *g1_t, *w2_t, *a2_t, *g2_t, *mlp1_t, *mlp2_t;
  float* MOD;
  bf16_t* H;
  bf16_t *Qbuf, *Kp, *Ks, *Vtp, *Vts, *HG, *AO, *U;
  float *OF, *OB;
  bf16_t *R, *Kx, *Vx, *LW, *LA, *LG, *E0, *E1, *A0, *A1, *ZO;
  float* BS;
  TJob jobs[20];
  int njobs, ntiles;
};

__device__ __forceinline__ unsigned pk_bf16(float lo, float hi) { unsigned r; asm("v_cvt_pk_bf16_f32 %0, %1, %2" : "=v"(r) : "v"(lo), "v"(hi)); return r; }
__device__ __forceinline__ bf16_t f2bf(float v) { return (bf16_t)(pk_bf16(v, 0.f) & 0xffffu); }
__device__ __forceinline__ float bf2f(bf16_t v) { return __uint_as_float(((unsigned)v) << 16); }
__device__ __forceinline__ float bflo(unsigned u) { return __uint_as_float(u << 16); }
__device__ __forceinline__ float bfhi(unsigned u) { return __uint_as_float(u & 0xffff0000u); }
__device__ __forceinline__ float sigmoidf_(float x) { return 1.f / (1.f + __expf(-x)); }
__device__ __forceinline__ float siluf_(float x) { return x / (1.f + __expf(-x)); }
__device__ __forceinline__ float wave_sum(float v) {
#pragma unroll
  for (int o = 32; o >= 1; o >>= 1) v += __shfl_xor(v, o);
  return v;
}
__device__ __forceinline__ float quad_sum(float v) {
  v += __int_as_float(__builtin_amdgcn_update_dpp(0, __float_as_int(v), 0xB1, 0xF, 0xF, true));
  v += __int_as_float(__builtin_amdgcn_update_dpp(0, __float_as_int(v), 0x4E, 0xF, 0xF, true));
  return v;
}
__device__ __forceinline__ int mod_index(int row) { return row < NP ? 0 : 1 + ((row - NP) >> 10); }

__device__ void ada_item(const Params& p, int it, char* smem) {
  const int tid = threadIdx.x;
  float* sil = (float*)smem;
  for (int i = tid; i < 9 * 1024; i += NT) {
    int n = i >> 10, k = i & 1023;
    float cv = n == 0 ? p.c_ctx[k] : p.c[(n - 1) * 1024 + k];
    sil[i] = siluf_(cv);
  }
  __syncthreads();
  const int gcol = it * 64, l = gcol / 6144, j = gcol % 6144;
  const int c4 = tid & 15, ks = tid >> 4;
  const float* wp = p.ada_w + (size_t)l * 1024 * 6144 + (size_t)(ks * 64) * 6144 + j + c4 * 4;
  float acc[9][4];
#pragma unroll
  for (int n = 0; n < 9; ++n) { acc[n][0] = 0.f; acc[n][1] = 0.f; acc[n][2] = 0.f; acc[n][3] = 0.f; }
#pragma unroll 4
  for (int k = 0; k < 64; ++k) {
    const float4 w = *(const float4*)(wp + (size_t)k * 6144);
#pragma unroll
    for (int n = 0; n < 9; ++n) {
      const float s = sil[n * 1024 + ks * 64 + k];
      acc[n][0] += s * w.x; acc[n][1] += s * w.y; acc[n][2] += s * w.z; acc[n][3] += s * w.w;
    }
  }
  __syncthreads();
  float* red = (float*)smem;
#pragma unroll
  for (int n = 0; n < 9; ++n)
#pragma unroll
    for (int q = 0; q < 4; ++q) red[(ks * 9 + n) * 64 + c4 * 4 + q] = acc[n][q];
  __syncthreads();
  for (int o = tid; o < 576; o += NT) {
    const int n = o >> 6, cc = o & 63;
    float s = 0.f;
#pragma unroll
    for (int k2 = 0; k2 < 16; ++k2) s += red[(k2 * 9 + n) * 64 + cc];
    s += p.ada_b[l * 6144 + j + cc];
    p.MOD[(size_t)(l * 9 + n) * 6144 + j + cc] = s;
  }
}

__device__ void transpose_item(const Params& p, int tix, char* smem) {
  const int tid = threadIdx.x;
  int j = 0;
  while (j + 1 < p.njobs && tix >= p.jobs[j + 1].tile0) ++j;
  const float* src = p.jobs[j].src; bf16_t* dst = p.jobs[j].dst;
  const int K = p.jobs[j].K, N = p.jobs[j].N, lt = tix - p.jobs[j].tile0;
  const int ntn = N >> 6, tk = lt / ntn, tn = lt % ntn;
  float* tile = (float*)smem;
#pragma unroll
  for (int i = 0; i < 4; ++i) {
    const int r = (tid >> 4) + 16 * i, c4 = tid & 15;
    const float4 v = *(const float4*)(src + (size_t)(tk * 64 + r) * N + tn * 64 + c4 * 4);
    float* t = tile + r * 65 + c4 * 4;
    t[0] = v.x; t[1] = v.y; t[2] = v.z; t[3] = v.w;
  }
  __syncthreads();
  const int n = tid >> 2, kc = (tid & 3) * 16;
  unsigned w[8];
#pragma unroll
  for (int i = 0; i < 8; ++i) w[i] = pk_bf16(tile[(kc + 2 * i) * 65 + n], tile[(kc + 2 * i + 1) * 65 + n]);
  uint4* d = (uint4*)(dst + (size_t)(tn * 64 + n) * K + tk * 64 + kc);
  d[0] = make_uint4(w[0], w[1], w[2], w[3]);
  d[1] = make_uint4(w[4], w[5], w[6], w[7]);
}

__device__ void cache_item(const Params& p, int ci) {
  const int tid = threadIdx.x;
  const int base = (ci & 31) * 8192;
  for (int e = tid; e < 8192; e += NT) {
    const int idx = base + e;
    const int d = idx & 63, kvh = (idx >> 6) & 1, pp = (idx >> 7) & 255, b = idx >> 15;
    if (ci < 32) p.Ks[((size_t)(b * 2 + kvh) * 1280 + 1024 + pp) * 64 + d] = f2bf(p.cache_k[idx]);
    else p.Vts[((size_t)(b * 2 + kvh) * 64 + d) * 1280 + 1024 + pp] = f2bf(p.cache_v[idx]);
  }
}

__device__ void phase0(const Params& p, char* smem) {
  const int n_ada = 192, n_tr = p.ntiles, n_cc = 64;
  const int total = n_ada + n_tr + n_cc;
  for (int it = blockIdx.x; it < total; it += gridDim.x) {
    if (it < n_ada) ada_item(p, it, smem);
    else if (it < n_ada + n_tr) transpose_item(p, it - n_ada, smem);
    else cache_item(p, it - n_ada - n_tr);
    __syncthreads();
  }
}

__device__ void prenorm_phase(const Params& p, int layer, int which, bool from_input) {
  const int wave = threadIdx.x >> 6, lane = threadIdx.x & 63;
  const float* nw = (which ? p.norm2_w : p.norm1_w) + layer * 1024;
  for (int row = blockIdx.x * 4 + wave; row < NTOK; row += gridDim.x * 4) {
    const float* xr = from_input ? (row < NP ? p.x_prompt + (size_t)row * 1024 : p.x_sample + (size_t)(row - NP) * 1024)
                                 : p.X + (size_t)row * 1024;
    float4 v[4]; float ss = 0.f;
#pragma unroll
    for (int i = 0; i < 4; ++i) { v[i] = *(const float4*)(xr + i * 256 + lane * 4); ss += v[i].x * v[i].x + v[i].y * v[i].y + v[i].z * v[i].z + v[i].w * v[i].w; }
    ss = wave_sum(ss);
    const float rstd = rsqrtf(ss * (1.f / 1024.f) + 1e-6f);
    const float* md = p.MOD + (size_t)(layer * 9 + mod_index(row)) * 6144;
    const float* sh = md + (which ? 3 : 0) * 1024; const float* sc = md + (which ? 4 : 1) * 1024;
#pragma unroll
    for (int i = 0; i < 4; ++i) {
      const int c = i * 256 + lane * 4;
      const float4 w4 = *(const float4*)(nw + c), s4 = *(const float4*)(sh + c), c4 = *(const float4*)(sc + c);
      const float h0 = v[i].x * rstd * w4.x * (1.f + c4.x) + s4.x, h1 = v[i].y * rstd * w4.y * (1.f + c4.y) + s4.y;
      const float h2 = v[i].z * rstd * w4.z * (1.f + c4.z) + s4.z, h3 = v[i].w * rstd * w4.w * (1.f + c4.w) + s4.w;
      *(uint2*)(p.H + (size_t)row * 1024 + c) = make_uint2(pk_bf16(h0, h1), pk_bf16(h2, h3));
    }
  }
}

struct ALoadPlain {
  const bf16_t* A; int lda;
  __device__ __forceinline__ uint4 operator()(int row, int k) const { return *(const uint4*)(A + (size_t)row * lda + k); }
};
struct ALoadShift {
  const bf16_t* H; const float* mix;
  __device__ __forceinline__ uint4 operator()(int row, int k) const {
    const uint4 h = *(const uint4*)(H + (size_t)row * 1024 + k);
    int tl, T;
    if (row < NP) { tl = row & 255; T = 256; } else { tl = (row - NP) & 1023; T = 1024; }
    uint4 s = make_uint4(0, 0, 0, 0);
    if (k < 512) { if (tl > 0) s = *(const uint4*)(H + (size_t)(row - 1) * 1024 + k); }
    else { if (tl < T - 1) s = *(const uint4*)(H + (size_t)(row + 1) * 1024 + k); }
    const float4 m0 = *(const float4*)(mix + k), m1 = *(const float4*)(mix + k + 4);
    uint4 o;
    { float a = bflo(h.x), b = bfhi(h.x); o.x = pk_bf16(a + (bflo(s.x) - a) * m0.x, b + (bfhi(s.x) - b) * m0.y); }
    { float a = bflo(h.y), b = bfhi(h.y); o.y = pk_bf16(a + (bflo(s.y) - a) * m0.z, b + (bfhi(s.y) - b) * m0.w); }
    { float a = bflo(h.z), b = bfhi(h.z); o.z = pk_bf16(a + (bflo(s.z) - a) * m1.x, b + (bfhi(s.z) - b) * m1.y); }
    { float a = bflo(h.w), b = bfhi(h.w); o.w = pk_bf16(a + (bflo(s.w) - a) * m1.z, b + (bfhi(s.w) - b) * m1.w); }
    return o;
  }
};

template <class AL, class EP>
__device__ __forceinline__ void gemm_tile(const AL& al, const bf16_t* __restrict__ Bt, int K, int tm, int tn, const EP& ep, char* smem) {
  const int tid = threadIdx.x, lane = tid & 63, wid = tid >> 6, wm = wid >> 1, wn = wid & 1;
  const int fr = lane & 15, fq = lane >> 4;
  char* sA = smem; char* sB = smem + 32768;
  f32x4 acc[4][4];
#pragma unroll
  for (int a = 0; a < 4; ++a)
#pragma unroll
    for (int b = 0; b < 4; ++b) acc[a][b] = (f32x4){0.f, 0.f, 0.f, 0.f};
  uint4 pa[4], pb[4];
  const int nk = K >> 6;
  const int cr0 = tid >> 3, cc = tid & 7;
  const int soff = cr0 * 128 + ((cc ^ ((cr0 >> 1) & 7)) << 4);
  const bf16_t* bp = Bt + (size_t)(tn * 128 + cr0) * K + cc * 8;
#define GLOAD(kt) do { _Pragma("unroll") for (int i = 0; i < 4; ++i) { pa[i] = al(tm * 128 + cr0 + 32 * i, (kt) * 64 + cc * 8); pb[i] = *(const uint4*)(bp + (size_t)(32 * i) * K + (kt) * 64); } } while (0)
#define SSTORE(buf) do { _Pragma("unroll") for (int i = 0; i < 4; ++i) { *(uint4*)(sA + (buf) * 16384 + soff + i * 4096) = pa[i]; *(uint4*)(sB + (buf) * 16384 + soff + i * 4096) = pb[i]; } } while (0)
  GLOAD(0); SSTORE(0); __syncthreads();
  for (int kt = 0; kt < nk; ++kt) {
    const int buf = kt & 1;
    if (kt + 1 < nk) GLOAD(kt + 1);
#pragma unroll
    for (int kk = 0; kk < 2; ++kk) {
      bf16x8 af[4], bfr[4];
#pragma unroll
      for (int mi = 0; mi < 4; ++mi) { const int r = wm * 64 + mi * 16 + fr, c = kk * 4 + fq; af[mi] = *(const bf16x8*)(sA + buf * 16384 + r * 128 + ((c ^ ((r >> 1) & 7)) << 4)); }
#pragma unroll
      for (int ni = 0; ni < 4; ++ni) { const int r = wn * 64 + ni * 16 + fr, c = kk * 4 + fq; bfr[ni] = *(const bf16x8*)(sB + buf * 16384 + r * 128 + ((c ^ ((r >> 1) & 7)) << 4)); }
#pragma unroll
      for (int mi = 0; mi < 4; ++mi)
#pragma unroll
        for (int ni = 0; ni < 4; ++ni) acc[mi][ni] = __builtin_amdgcn_mfma_f32_16x16x32_bf16(bfr[ni], af[mi], acc[mi][ni], 0, 0, 0);
    }
    if (kt + 1 < nk) SSTORE(buf ^ 1);
    __syncthreads();
  }
#undef GLOAD
#undef SSTORE
  ep(acc, tm * 128 + wm * 64, tn * 128 + wn * 64, lane);
}

struct EpiWin {
  const Params* pp;
  __device__ __forceinline__ void operator()(f32x4 (&acc)[4][4], int row0, int col0, int lane) const {
    const Params& p = *pp;
    const int fr = lane & 15, fq = lane >> 4;
    const bool sample = row0 >= NP;
    if (col0 < 640) {
      const bool isq = col0 < 512;
      const float* nw = isq ? p.q_norm : p.k_norm;
      float nwv[4][4];
#pragma unroll
      for (int ni = 0; ni < 4; ++ni)
#pragma unroll
        for (int j = 0; j < 4; ++j) nwv[ni][j] = nw[ni * 16 + fq * 4 + j];
#pragma unroll
      for (int mi = 0; mi < 4; ++mi) {
        const int row = row0 + mi * 16 + fr;
        float ss = 0.f;
#pragma unroll
        for (int ni = 0; ni < 4; ++ni)
#pragma unroll
          for (int j = 0; j < 4; ++j) ss += acc[mi][ni][j] * acc[mi][ni][j];
        ss += __shfl_xor(ss, 16); ss += __shfl_xor(ss, 32);
        const float rn = rsqrtf(ss * (1.f / 64.f) + 1e-6f);
        float y[4][4];
#pragma unroll
        for (int ni = 0; ni < 4; ++ni)
#pragma unroll
          for (int j = 0; j < 4; ++j) y[ni][j] = acc[mi][ni][j] * rn * nwv[ni][j];
        if (!sample && !isq) {
          const int kvh = (col0 - 512) >> 6;
#pragma unroll
          for (int ni = 0; ni < 4; ++ni) *(f32x4*)(p.out_k + (size_t)row * 128 + kvh * 64 + ni * 16 + fq * 4) = (f32x4){y[ni][0], y[ni][1], y[ni][2], y[ni][3]};
        }
        if (sample) {
          const int tl = (row - NP) & 1023;
          const float rp = (float)(tl >> 6), cp = (float)(tl & 63);
#pragma unroll
          for (int ni = 0; ni < 4; ++ni)
#pragma unroll
            for (int jp = 0; jp < 2; ++jp) {
              const int i = (ni * 16 + fq * 4 + jp * 2) >> 1;
              const float pos = i < 16 ? rp : cp;
              const float inv = exp2f(-(float)(i & 15) * 0.83048202372184058696f);
              const float ang = pos * inv;
              const float s = __sinf(ang), c = __cosf(ang);
              const float x0 = y[ni][2 * jp], x1 = y[ni][2 * jp + 1];
              y[ni][2 * jp] = x0 * c - x1 * s; y[ni][2 * jp + 1] = x0 * s + x1 * c;
            }
        }
        if (isq) {
          const float qs = 0.125f * 1.44269504088896f;
#pragma unroll
          for (int ni = 0; ni < 4; ++ni)
            *(uint2*)(p.Qbuf + (size_t)row * 512 + col0 + ni * 16 + fq * 4) = make_uint2(pk_bf16(y[ni][0] * qs, y[ni][1] * qs), pk_bf16(y[ni][2] * qs, y[ni][3] * qs));
        } else {
          const int kvh = (col0 - 512) >> 6;
          bf16_t* kd;
          if (!sample) kd = p.Kp + ((size_t)((row >> 8) * 2 + kvh) * 256 + (row & 255)) * 64;
          else kd = p.Ks + ((size_t)(((row - NP) >> 10) * 2 + kvh) * 1280 + ((row - NP) & 1023)) * 64;
#pragma unroll
          for (int ni = 0; ni < 4; ++ni)
            *(uint2*)(kd + ni * 16 + fq * 4) = make_uint2(pk_bf16(y[ni][0], y[ni][1]), pk_bf16(y[ni][2], y[ni][3]));
        }
      }
    } else if (col0 < 768) {
      const int kvh = (col0 - 640) >> 6;
#pragma unroll
      for (int mi = 0; mi < 4; ++mi) {
        const int row = row0 + mi * 16 + fr;
#pragma unroll
        for (int ni = 0; ni < 4; ++ni) {
          const int d0 = ni * 16 + fq * 4;
          if (!sample) {
            *(f32x4*)(p.out_v + (size_t)row * 128 + kvh * 64 + d0) = acc[mi][ni];
            bf16_t* vd = p.Vtp + ((size_t)((row >> 8) * 2 + kvh) * 64 + d0) * 256 + (row & 255);
#pragma unroll
            for (int j = 0; j < 4; ++j) vd[j * 256] = f2bf(acc[mi][ni][j]);
          } else {
            bf16_t* vd = p.Vts + ((size_t)(((row - NP) >> 10) * 2 + kvh) * 64 + d0) * 1280 + ((row - NP) & 1023);
#pragma unroll
            for (int j = 0; j < 4; ++j) vd[j * 1280] = f2bf(acc[mi][ni][j]);
          }
        }
      }
    } else {
      const int c0 = col0 - 768, seg = c0 >> 9;
      float oml[4][4];
      if (seg == 1 || seg == 2) {
#pragma unroll
        for (int ni = 0; ni < 4; ++ni)
#pragma unroll
          for (int j = 0; j < 4; ++j) { const int c = (c0 & 511) + ni * 16 + fq * 4 + j; oml[ni][j] = 1.f / (1.f + __expf(p.hgrn_lb[c] - p.hgrn_lb[512 + c])); }
      }
#pragma unroll
      for (int mi = 0; mi < 4; ++mi) {
        const int row = row0 + mi * 16 + fr;
#pragma unroll
        for (int ni = 0; ni < 4; ++ni) {
          float o[4];
#pragma unroll
          for (int j = 0; j < 4; ++j) {
            const float v = acc[mi][ni][j];
            if (seg == 0 || seg == 4) o[j] = siluf_(v);
            else if (seg == 3) o[j] = v;
            else o[j] = oml[ni][j] * sigmoidf_(-v);
          }
          *(uint2*)(p.HG + (size_t)row * 2560 + c0 + ni * 16 + fq * 4) = make_uint2(pk_bf16(o[0], o[1]), pk_bf16(o[2], o[3]));
        }
      }
    }
  }
};

struct EpiResid {
  const Params* pp; int layer, gidx; bool from_input;
  __device__ __forceinline__ void operator()(f32x4 (&acc)[4][4], int row0, int col0, int lane) const {
    const Params& p = *pp;
    const int fr = lane & 15, fq = lane >> 4;
    const float* gt = p.MOD + (size_t)(layer * 9 + mod_index(row0)) * 6144 + gidx * 1024;
#pragma unroll
    for (int mi = 0; mi < 4; ++mi) {
      const int row = row0 + mi * 16 + fr;
      const float* base = from_input ? (row < NP ? p.x_prompt + (size_t)row * 1024 : p.x_sample + (size_t)(row - NP) * 1024) : p.X + (size_t)row * 1024;
#pragma unroll
      for (int ni = 0; ni < 4; ++ni) {
        const int col = col0 + ni * 16 + fq * 4;
        const f32x4 b = *(const f32x4*)(base + col), g = *(const f32x4*)(gt + col);
        *(f32x4*)(p.X + (size_t)row * 1024 + col) = b + g * acc[mi][ni];
      }
    }
  }
};

template <int ACT>
struct EpiAct {
  bf16_t* O; int ldo; const float* bias;
  __device__ __forceinline__ void operator()(f32x4 (&acc)[4][4], int row0, int col0, int lane) const {
    const int fr = lane & 15, fq = lane >> 4;
#pragma unroll
    for (int ni = 0; ni < 4; ++ni) {
      const int col = col0 + ni * 16 + fq * 4;
      f32x4 bv = (f32x4){0.f, 0.f, 0.f, 0.f};
      if (ACT >= 4) bv = *(const f32x4*)(bias + col);
#pragma unroll
      for (int mi = 0; mi < 4; ++mi) {
        const int row = row0 + mi * 16 + fr;
        float o[4];
#pragma unroll
        for (int j = 0; j < 4; ++j) {
          const float v = acc[mi][ni][j] + bv[j];
          if (ACT == 0) o[j] = v;
          else if (ACT == 1) { const float r = fmaxf(v, 0.f); o[j] = r * r; }
          else if (ACT == 2) o[j] = 1.f - 2.f / (1.f + __expf(2.f * v));
          else if (ACT == 3 || ACT == 5) o[j] = sigmoidf_(v);
          else o[j] = 0.60653065971263342f * sigmoidf_(v);
        }
        *(uint2*)(O + (size_t)row * ldo + col) = make_uint2(pk_bf16(o[0], o[1]), pk_bf16(o[2], o[3]));
      }
    }
  }
};

struct EpiRwkvOut {
  const Params* pp;
  __device__ __forceinline__ void operator()(f32x4 (&acc)[4][4], int row0, int col0, int lane) const {
    const Params& p = *pp;
    const int fr = lane & 15, fq = lane >> 4, h = col0 >> 6;
#pragma unroll
    for (int mi = 0; mi < 4; ++mi) {
      const int row = row0 + mi * 16 + fr;
      float y[4][4]; float s = 0.f;
#pragma unroll
      for (int ni = 0; ni < 4; ++ni) {
        const size_t idx = (size_t)row * 1024 + col0 + ni * 16 + fq * 4;
        const uint2 a = *(const uint2*)(p.E0 + idx), b = *(const uint2*)(p.E1 + idx);
        y[ni][0] = bflo(a.x) + bflo(b.x); y[ni][1] = bfhi(a.x) + bfhi(b.x); y[ni][2] = bflo(a.y) + bflo(b.y); y[ni][3] = bfhi(a.y) + bfhi(b.y);
        s += (y[ni][0] + y[ni][1]) + (y[ni][2] + y[ni][3]);
      }
      s += __shfl_xor(s, 16); s += __shfl_xor(s, 32);
      const float mu = s * (1.f / 64.f);
      float q = 0.f;
#pragma unroll
      for (int ni = 0; ni < 4; ++ni)
#pragma unroll
        for (int j = 0; j < 4; ++j) { const float d = y[ni][j] - mu; q += d * d; }
      q += __shfl_xor(q, 16); q += __shfl_xor(q, 32);
      const float rs = rsqrtf(q * (1.f / 64.f) + 64e-5f);
      const float bs = p.BS[(size_t)row * 16 + h] + p.BS[(size_t)NTOK * 16 + (size_t)row * 16 + h];
#pragma unroll
      for (int ni = 0; ni < 4; ++ni) {
        const int col = col0 + ni * 16 + fq * 4;
        const size_t idx = (size_t)row * 1024 + col;
        const uint2 vv = *(const uint2*)(p.Vx + idx);
        const f32x4 lw = *(const f32x4*)(p.ln_w + col), lb = *(const f32x4*)(p.ln_b + col);
        const float v0 = bflo(vv.x), v1 = bfhi(vv.x), v2 = bflo(vv.y), v3 = bfhi(vv.y);
        const float o0 = ((y[ni][0] - mu) * rs * lw[0] + lb[0] + bs * v0) * acc[mi][ni][0];
        const float o1 = ((y[ni][1] - mu) * rs * lw[1] + lb[1] + bs * v1) * acc[mi][ni][1];
        const float o2 = ((y[ni][2] - mu) * rs * lw[2] + lb[2] + bs * v2) * acc[mi][ni][2];
        const float o3 = ((y[ni][3] - mu) * rs * lw[3] + lb[3] + bs * v3) * acc[mi][ni][3];
        *(uint2*)(p.ZO + idx) = make_uint2(pk_bf16(o0, o1), pk_bf16(o2, o3));
      }
    }
  }
};

template <class AL, class EP>
__device__ __forceinline__ void gemm_phase(const AL& al, const bf16_t* Bt, int K, int ntn, const EP& ep, char* smem) {
  const int nunits = (NTOK / 128) * ntn;
  for (int u = blockIdx.x; u < nunits; u += gridDim.x) gemm_tile(al, Bt, K, u / ntn, u % ntn, ep, smem);
}

__device__ void attn_item(const Params& p, int grp, int b, int h, int qb, char* smem) {
  const int tid = threadIdx.x, lane = tid & 63, wid = tid >> 6, qi = lane & 31, g = lane >> 5;
  const int Tk = grp ? 1280 : 256, kvh = h >> 2;
  const int rowbase = grp ? NP + b * 1024 + qb * 128 : b * 256 + qb * 128;
  const bf16_t* Kg = grp ? p.Ks + (size_t)(b * 2 + kvh) * 1280 * 64 : p.Kp + (size_t)(b * 2 + kvh) * 256 * 64;
  const bf16_t* Vg = grp ? p.Vts + (size_t)(b * 2 + kvh) * 64 * 1280 : p.Vtp + (size_t)(b * 2 + kvh) * 64 * 256;
  const int qrow = rowbase + wid * 32 + qi;
  bf16x8 Qf[4];
#pragma unroll
  for (int s = 0; s < 4; ++s) Qf[s] = *(const bf16x8*)(p.Qbuf + (size_t)qrow * 512 + h * 64 + s * 16 + g * 8);
  f32x16 O[2];
#pragma unroll
  for (int i = 0; i < 16; ++i) { O[0][i] = 0.f; O[1][i] = 0.f; }
  float m_run = -1e30f, l_run = 0.f;
  char* sK = smem; char* sV = smem + 16384;
  const int r0 = tid >> 3, c = tid & 7;
  uint4 pk[2], pv[2];
  const int ntile = Tk >> 6;
#define ALOAD(kt) do { _Pragma("unroll") for (int i = 0; i < 2; ++i) { const int r = r0 + 32 * i; pk[i] = *(const uint4*)(Kg + (size_t)((kt) * 64 + r) * 64 + c * 8); pv[i] = *(const uint4*)(Vg + (size_t)r * Tk + (kt) * 64 + c * 8); } } while (0)
#define ASTORE(buf) do { _Pragma("unroll") for (int i = 0; i < 2; ++i) { const int r = r0 + 32 * i; \
      *(uint4*)(sK + (buf) * 8192 + r * 128 + ((c ^ ((r >> 1) & 7)) << 4)) = pk[i]; \
      const int f = (r >> 1) & 15; \
      *(uint2*)(sV + (buf) * 8192 + r * 128 + (((2 * c) ^ f) << 3)) = make_uint2(pv[i].x, pv[i].y); \
      *(uint2*)(sV + (buf) * 8192 + r * 128 + (((2 * c + 1) ^ f) << 3)) = make_uint2(pv[i].z, pv[i].w); } } while (0)
  ALOAD(0); ASTORE(0); __syncthreads();
  for (int kt = 0; kt < ntile; ++kt) {
    const int buf = kt & 1;
    if (kt + 1 < ntile) ALOAD(kt + 1);
    f32x16 S[2];
#pragma unroll
    for (int t2 = 0; t2 < 2; ++t2) {
#pragma unroll
      for (int i = 0; i < 16; ++i) S[t2][i] = 0.f;
#pragma unroll
      for (int s = 0; s < 4; ++s) {
        const int r = t2 * 32 + qi, cc = 2 * s + g;
        const bf16x8 Kf = *(const bf16x8*)(sK + buf * 8192 + r * 128 + ((cc ^ ((r >> 1) & 7)) << 4));
        S[t2] = __builtin_amdgcn_mfma_f32_32x32x16_bf16(Kf, Qf[s], S[t2], 0, 0, 0);
      }
    }
    float mx = S[0][0];
#pragma unroll
    for (int i = 0; i < 16; ++i) { mx = fmaxf(mx, S[0][i]); mx = fmaxf(mx, S[1][i]); }
    mx = fmaxf(mx, __shfl_xor(mx, 32));
    const float m_new = fmaxf(m_run, mx);
    const float alpha = exp2f(m_run - m_new);
    float ls = 0.f;
#pragma unroll
    for (int i = 0; i < 16; ++i) { S[0][i] = exp2f(S[0][i] - m_new); S[1][i] = exp2f(S[1][i] - m_new); ls += S[0][i] + S[1][i]; }
    l_run = l_run * alpha + ls; m_run = m_new;
#pragma unroll
    for (int i = 0; i < 16; ++i) { O[0][i] *= alpha; O[1][i] *= alpha; }
#pragma unroll
    for (int t2 = 0; t2 < 2; ++t2)
#pragma unroll
      for (int sp = 0; sp < 2; ++sp) {
        union { bf16x8 v; unsigned u[4]; } Pf;
#pragma unroll
        for (int e = 0; e < 4; ++e) Pf.u[e] = pk_bf16(S[t2][8 * sp + 2 * e], S[t2][8 * sp + 2 * e + 1]);
#pragma unroll
        for (int ds = 0; ds < 2; ++ds) {
          const int d = ds * 32 + qi, f = (d >> 1) & 15, u1 = 8 * t2 + 4 * sp + g;
          union { bf16x8 v; uint2 u[2]; } Vf;
          Vf.u[0] = *(const uint2*)(sV + buf * 8192 + d * 128 + ((u1 ^ f) << 3));
          Vf.u[1] = *(const uint2*)(sV + buf * 8192 + d * 128 + (((u1 + 2) ^ f) << 3));
          O[ds] = __builtin_amdgcn_mfma_f32_32x32x16_bf16(Vf.v, Pf.v, O[ds], 0, 0, 0);
        }
      }
    if (kt + 1 < ntile) ASTORE(buf ^ 1);
    __syncthreads();
  }
#undef ALOAD
#undef ASTORE
  const float l = l_run + __shfl_xor(l_run, 32);
  const float inv = 1.f / l;
#pragma unroll
  for (int ds = 0; ds < 2; ++ds)
#pragma unroll
    for (int bq = 0; bq < 4; ++bq) {
      const int d0 = ds * 32 + 8 * bq + 4 * g;
      *(uint2*)(p.AO + (size_t)qrow * 1024 + h * 64 + d0) =
          make_uint2(pk_bf16(O[ds][4 * bq] * inv, O[ds][4 * bq + 1] * inv), pk_bf16(O[ds][4 * bq + 2] * inv, O[ds][4 * bq + 3] * inv));
    }
}

__device__ void hgrn_item(const Params& p, int grp, int b, int h, int dir, char* smem) {
  const int tid = threadIdx.x, v = tid >> 2, ks = tid & 3;
  const int T = grp ? 1024 : 256, rowbase = grp ? NP + b * 1024 : b * 256;
  float S[16];
  if (grp) {
    const float* s0 = (dir ? p.hg_b0 : p.hg_f0) + (size_t)(b * 8 + h) * 4096;
#pragma unroll
    for (int i = 0; i < 16; ++i) S[i] = s0[(ks * 16 + i) * 64 + v];
  } else {
#pragma unroll
    for (int i = 0; i < 16; ++i) S[i] = 0.f;
  }
  float* obuf = (float*)(smem + 32768);
  const int lt = tid >> 4, lc = (tid & 15) * 4;
  const int kfseg = dir ? 1024 : 512;
  uint2 rq, rk, rv;
  const int nch = T >> 4;
#define HLOAD(cix) do { const int ts = (cix) * 16 + lt; const int tok = dir ? T - 1 - ts : ts; const bf16_t* src = p.HG + (size_t)(rowbase + tok) * 2560 + h * 64 + lc; \
    rq = *(const uint2*)(src); rk = *(const uint2*)(src + kfseg); rv = *(const uint2*)(src + 1536); } while (0)
#define HSTORE(buf) do { float* B = (float*)(smem + (buf) * 16384) + lt * 64 + lc; \
    const float k0 = bflo(rk.x), k1 = bfhi(rk.x), k2 = bflo(rk.y), k3 = bfhi(rk.y); \
    *(float4*)(B) = make_float4(1.f - k0, 1.f - k1, 1.f - k2, 1.f - k3); *(float4*)(B + 1024) = make_float4(k0, k1, k2, k3); \
    *(float4*)(B + 2048) = make_float4(bflo(rq.x), bfhi(rq.x), bflo(rq.y), bfhi(rq.y)); *(float4*)(B + 3072) = make_float4(bflo(rv.x), bfhi(rv.x), bflo(rv.y), bfhi(rv.y)); } while (0)
  HLOAD(0); HSTORE(0); __syncthreads();
  float* OD = dir ? p.OB : p.OF;
  for (int cix = 0; cix < nch; ++cix) {
    const int buf = cix & 1;
    if (cix + 1 < nch) HLOAD(cix + 1);
    const float* B = (const float*)(smem + buf * 16384);
    float* ob = obuf + buf * 1024;
#pragma unroll 4
    for (int t = 0; t < 16; ++t) {
      const float* Bt = B + t * 64 + ks * 16;
      const float vv = B[3072 + t * 64 + v];
      float o = 0.f;
#pragma unroll
      for (int q = 0; q < 4; ++q) {
        const float4 f4 = *(const float4*)(Bt + q * 4), k4 = *(const float4*)(Bt + 1024 + q * 4), q4 = *(const float4*)(Bt + 2048 + q * 4);
        S[q * 4 + 0] = f4.x * S[q * 4 + 0] + k4.x * vv; o += S[q * 4 + 0] * q4.x;
        S[q * 4 + 1] = f4.y * S[q * 4 + 1] + k4.y * vv; o += S[q * 4 + 1] * q4.y;
        S[q * 4 + 2] = f4.z * S[q * 4 + 2] + k4.z * vv; o += S[q * 4 + 2] * q4.z;
        S[q * 4 + 3] = f4.w * S[q * 4 + 3] + k4.w * vv; o += S[q * 4 + 3] * q4.w;
      }
      o = quad_sum(o);
      if (ks == 0) ob[t * 64 + v] = o;
    }
    if (cix + 1 < nch) HSTORE(buf ^ 1);
    __syncthreads();
    {
      const int ts = cix * 16 + lt; const int tok = dir ? T - 1 - ts : ts;
      *(float4*)(OD + (size_t)(rowbase + tok) * 512 + h * 64 + lc) = *(const float4*)(ob + lt * 64 + lc);
    }
  }
#undef HLOAD
#undef HSTORE
  if (!grp) {
    float* so = (dir ? p.out_hb : p.out_hf) + (size_t)(b * 8 + h) * 4096;
#pragma unroll
    for (int i = 0; i < 16; ++i) so[(ks * 16 + i) * 64 + v] = S[i];
  }
}

__device__ void mix0_phase(const Params& p, char* smem) {
  for (int it = blockIdx.x; it < 1152; it += gridDim.x) {
    if (it < 128) { hgrn_item(p, 1, it >> 4, (it >> 1) & 7, it & 1, smem); }
    else if (it < 640) { const int a = it - 128; attn_item(p, 1, a >> 6, (a >> 3) & 7, a & 7, smem); }
    else if (it < 896) { const int a = it - 640; hgrn_item(p, 0, a >> 4, (a >> 1) & 7, a & 1, smem); }
    else { const int a = it - 896; attn_item(p, 0, a >> 4, (a >> 1) & 7, a & 1, smem); }
    __syncthreads();
  }
}

__device__ void hgrn_combine_phase(const Params& p) {
  const int gid = blockIdx.x * NT + threadIdx.x, l16 = gid & 15;
  const int ngroups = NTOK * 8;
  for (int grp = gid >> 4; grp < ngroups; grp += (gridDim.x * NT) >> 4) {
    const int row = grp >> 3, h = grp & 7;
    const size_t o = (size_t)row * 512 + h * 64 + l16 * 4;
    const float4 a = *(const float4*)(p.OF + o), b = *(const float4*)(p.OB + o);
    const float y0 = a.x + b.x, y1 = a.y + b.y, y2 = a.z + b.z, y3 = a.w + b.w;
    float ss = y0 * y0 + y1 * y1 + y2 * y2 + y3 * y3;
    ss += __shfl_xor(ss, 1); ss += __shfl_xor(ss, 2); ss += __shfl_xor(ss, 4); ss += __shfl_xor(ss, 8);
    const float rn = rsqrtf(ss * (1.f / 64.f) + 1e-6f);
    const float4 gn = *(const float4*)(p.g_norm + l16 * 4);
    const uint2 gt = *(const uint2*)(p.HG + (size_t)row * 2560 + 2048 + h * 64 + l16 * 4);
    *(uint2*)(p.AO + (size_t)row * 1024 + 512 + h * 64 + l16 * 4) =
        make_uint2(pk_bf16(y0 * rn * gn.x * bflo(gt.x), y1 * rn * gn.y * bfhi(gt.x)), pk_bf16(y2 * rn * gn.z * bflo(gt.y), y3 * rn * gn.w * bfhi(gt.y)));
  }
}

__device__ void rwkv_item(const Params& p, int grp, int b, int h, int dir, char* smem) {
  const int tid = threadIdx.x, lane = tid & 63, wid = tid >> 6, v = tid >> 2, ks = tid & 3;
  const int T = grp ? 1024 : 256, rowbase = grp ? NP + b * 1024 : b * 256;
  float S[16];
  if (grp) {
    const float* s0 = (dir ? p.rw_b0 : p.rw_f0) + ((size_t)(b * 16 + h) * 64 + v) * 64 + ks * 16;
#pragma unroll
    for (int q = 0; q < 4; ++q) { const float4 t = *(const float4*)(s0 + q * 4); S[q * 4] = t.x; S[q * 4 + 1] = t.y; S[q * 4 + 2] = t.z; S[q * 4 + 3] = t.w; }
  } else {
#pragma unroll
    for (int i = 0; i < 16; ++i) S[i] = 0.f;
  }
  const bf16_t* E = dir ? p.E1 : p.E0; const bf16_t* A = dir ? p.A1 : p.A0; bf16_t* Y = dir ? p.E1 : p.E0;
  const float kkc = p.k_k[h * 64 + lane], kac = p.k_a[h * 64 + lane], rkc = p.r_k[h * 64 + lane];
  float* BSd = p.BS + (size_t)dir * NTOK * 16;
  float* ybuf = (float*)(smem + 49152);
  float rg[4][5];
  const int nch = T >> 4;
  const int lt = tid >> 4, lc = (tid & 15) * 4;
#define RLOAD(cix) do { _Pragma("unroll") for (int i = 0; i < 4; ++i) { const int ts = (cix) * 16 + wid * 4 + i; const int tok = dir ? T - 1 - ts : ts; \
    const size_t idx = (size_t)(rowbase + tok) * 1024 + h * 64 + lane; \
    rg[i][0] = bf2f(p.R[idx]); rg[i][1] = bf2f(p.Kx[idx]); rg[i][2] = bf2f(p.Vx[idx]); rg[i][3] = bf2f(E[idx]); rg[i][4] = bf2f(A[idx]); } } while (0)
#define RSTORE(cix, buf) do { _Pragma("unroll") for (int i = 0; i < 4; ++i) { const int tl_ = wid * 4 + i; const int ts = (cix) * 16 + tl_; const int tok = dir ? T - 1 - ts : ts; \
    const float r_ = rg[i][0], k_ = rg[i][1], v_ = rg[i][2], e_ = rg[i][3], a_ = rg[i][4]; \
    const float kx = k_ * kkc; const float ssq = wave_sum(kx * kx); const float kk = kx * rsqrtf(fmaxf(ssq, 1e-24f)); \
    const float kd = k_ * (1.f + (a_ - 1.f) * kac); const float bsum = wave_sum(r_ * kd * rkc); \
    float* B = (float*)(smem + (buf) * 24576) + tl_ * 64 + lane; \
    B[0] = __expf(-e_); B[1024] = kk; B[2048] = kk * a_; B[3072] = kd; B[4096] = r_; B[5120] = v_; \
    if (lane == 0) BSd[(size_t)(rowbase + tok) * 16 + h] = bsum; } } while (0)
  RLOAD(0); RSTORE(0, 0); __syncthreads();
  for (int cix = 0; cix < nch; ++cix) {
    const int buf = cix & 1;
    if (cix + 1 < nch) RLOAD(cix + 1);
    const float* B = (const float*)(smem + buf * 24576);
    float* yb = ybuf + buf * 1024;
#pragma unroll 2
    for (int t = 0; t < 16; ++t) {
      const float* Bt = B + t * 64 + ks * 16;
      const float vv = B[5120 + t * 64 + v];
      float4 w4[4], kk4[4];
      float sa = 0.f;
#pragma unroll
      for (int q = 0; q < 4; ++q) {
        w4[q] = *(const float4*)(Bt + q * 4); kk4[q] = *(const float4*)(Bt + 1024 + q * 4);
        sa += S[q * 4] * kk4[q].x + S[q * 4 + 1] * kk4[q].y + S[q * 4 + 2] * kk4[q].z + S[q * 4 + 3] * kk4[q].w;
      }
      sa = -quad_sum(sa);
      float y = 0.f;
#pragma unroll
      for (int q = 0; q < 4; ++q) {
        const float4 ka = *(const float4*)(Bt + 2048 + q * 4), kd = *(const float4*)(Bt + 3072 + q * 4), r4 = *(const float4*)(Bt + 4096 + q * 4);
        S[q * 4 + 0] = S[q * 4 + 0] * w4[q].x + (sa * ka.x + vv * kd.x); y += S[q * 4 + 0] * r4.x;
        S[q * 4 + 1] = S[q * 4 + 1] * w4[q].y + (sa * ka.y + vv * kd.y); y += S[q * 4 + 1] * r4.y;
        S[q * 4 + 2] = S[q * 4 + 2] * w4[q].z + (sa * ka.z + vv * kd.z); y += S[q * 4 + 2] * r4.z;
        S[q * 4 + 3] = S[q * 4 + 3] * w4[q].w + (sa * ka.w + vv * kd.w); y += S[q * 4 + 3] * r4.w;
      }
      y = quad_sum(y);
      if (ks == 0) yb[t * 64 + v] = y;
    }
    if (cix + 1 < nch) RSTORE(cix + 1, buf ^ 1);
    __syncthreads();
    {
      const int ts = cix * 16 + lt; const int tok = dir ? T - 1 - ts : ts;
      const float4 yy = *(const float4*)(yb + lt * 64 + lc);
      *(uint2*)(Y + (size_t)(rowbase + tok) * 1024 + h * 64 + lc) = make_uint2(pk_bf16(yy.x, yy.y), pk_bf16(yy.z, yy.w));
    }
  }
#undef RLOAD
#undef RSTORE
  if (!grp) {
    float* so = (dir ? p.out_rb : p.out_rf) + ((size_t)(b * 16 + h) * 64 + v) * 64 + ks * 16;
#pragma unroll
    for (int q = 0; q < 4; ++q) *(float4*)(so + q * 4) = make_float4(S[q * 4], S[q * 4 + 1], S[q * 4 + 2], S[q * 4 + 3]);
  }
}

__device__ void rwkv_scan_phase(const Params& p, char* smem) {
  for (int it = blockIdx.x; it < 768; it += gridDim.x) {
    if (it < 256) rwkv_item(p, 1, it >> 5, (it >> 1) & 15, it & 1, smem);
    else { const int a = it - 256; rwkv_item(p, 0, a >> 5, (a >> 1) & 15, a & 1, smem); }
    __syncthreads();
  }
}

__device__ void rwkv_proj_phase(const Params& p, char* smem) {
  const int nunits = 96 * 27;
  for (int u = blockIdx.x; u < nunits; u += gridDim.x) {
    const int tm = u / 27, s = u % 27;
    if (s < 8) { ALoadShift al{p.H, p.mix + 0 * 1024}; EpiAct<0> ep{p.R, 1024, nullptr}; gemm_tile(al, p.wr_t, 1024, tm, s, ep, smem); }
    else if (s < 16) { ALoadShift al{p.H, p.mix + 2 * 1024}; EpiAct<0> ep{p.Kx, 1024, nullptr}; gemm_tile(al, p.wk_t, 1024, tm, s - 8, ep, smem); }
    else if (s < 24) { ALoadShift al{p.H, p.mix + 3 * 1024}; EpiAct<0> ep{p.Vx, 1024, nullptr}; gemm_tile(al, p.wv_t, 1024, tm, s - 16, ep, smem); }
    else if (s == 24) { ALoadShift al{p.H, p.mix + 1 * 1024}; EpiAct<2> ep{p.LW, 128, nullptr}; gemm_tile(al, p.w1cat_t, 1024, tm, 0, ep, smem); }
    else if (s == 25) { ALoadShift al{p.H, p.mix + 4 * 1024}; EpiAct<0> ep{p.LA, 128, nullptr}; gemm_tile(al, p.a1cat_t, 1024, tm, 0, ep, smem); }
    else { ALoadShift al{p.H, p.mix + 5 * 1024}; EpiAct<3> ep{p.LG, 128, nullptr}; gemm_tile(al, p.g1_t, 1024, tm, 0, ep, smem); }
  }
}
__device__ void rwkv_lora2_phase(const Params& p, char* smem) {
  const int nunits = 96 * 32;
  for (int u = blockIdx.x; u < nunits; u += gridDim.x) {
    const int tm = u >> 5, s = u & 31, which = s >> 3, tn = s & 7;
    const int d = which & 1;
    if (which < 2) { ALoadPlain al{p.LW + d * 64, 128}; EpiAct<4> ep{d ? p.E1 : p.E0, 1024, p.w0 + d * 1024}; gemm_tile(al, p.w2_t + (size_t)d * 65536, 64, tm, tn, ep, smem); }
    else { ALoadPlain al{p.LA + d * 64, 128}; EpiAct<5> ep{d ? p.A1 : p.A0, 1024, p.a0 + d * 1024}; gemm_tile(al, p.a2_t + (size_t)d * 65536, 64, tm, tn, ep, smem); }
  }
}

__device__ __forceinline__ void run_phase(const Params& p, int ph, char* smem) {
  switch (ph) {
    case 0: if (ONLY_PHASE < 0 || ONLY_PHASE == 0) phase0(p, smem); break;
    case 1: if (ONLY_PHASE < 0 || ONLY_PHASE == 1) prenorm_phase(p, 0, 0, true); break;
    case 2: if (ONLY_PHASE < 0 || ONLY_PHASE == 2) { ALoadPlain al{p.H, 1024}; EpiWin ep{&p}; gemm_phase(al, p.w_in_t, 1024, 26, ep, smem); } break;
    case 3: if (ONLY_PHASE < 0 || ONLY_PHASE == 3) mix0_phase(p, smem); break;
    case 4: if (ONLY_PHASE < 0 || ONLY_PHASE == 4) hgrn_combine_phase(p); break;
    case 5: if (ONLY_PHASE < 0 || ONLY_PHASE == 5) { ALoadPlain al{p.AO, 1024}; EpiResid ep{&p, 0, 2, true}; gemm_phase(al, p.w_out_t, 1024, 8, ep, smem); } break;
    case 6: if (ONLY_PHASE < 0 || ONLY_PHASE == 6) prenorm_phase(p, 0, 1, false); break;
    case 7: if (ONLY_PHASE < 0 || ONLY_PHASE == 7) { ALoadPlain al{p.H, 1024}; EpiAct<1> ep{p.U, 4096, nullptr}; gemm_phase(al, p.mlp1_t, 1024, 32, ep, smem); } break;
    case 8: if (ONLY_PHASE < 0 || ONLY_PHASE == 8) { ALoadPlain al{p.U, 4096}; EpiResid ep{&p, 0, 5, false}; gemm_phase(al, p.mlp2_t, 4096, 8, ep, smem); } break;
    case 9: if (ONLY_PHASE < 0 || ONLY_PHASE == 9) prenorm_phase(p, 1, 0, false); break;
    case 10: if (ONLY_PHASE < 0 || ONLY_PHASE == 10) rwkv_proj_phase(p, smem); break;
    case 11: if (ONLY_PHASE < 0 || ONLY_PHASE == 11) rwkv_lora2_phase(p, smem); break;
    case 12: if (ONLY_PHASE < 0 || ONLY_PHASE == 12) rwkv_scan_phase(p, smem); break;
    case 13: if (ONLY_PHASE < 0 || ONLY_PHASE == 13) { ALoadPlain al{p.LG, 128}; EpiRwkvOut ep{&p}; gemm_phase(al, p.g2_t, 128, 8, ep, smem); } break;
    case 14: if (ONLY_PHASE < 0 || ONLY_PHASE == 14) { ALoadPlain al{p.ZO, 1024}; EpiResid ep{&p, 1, 2, false}; gemm_phase(al, p.wo_t, 1024, 8, ep, smem); } break;
    case 15: if (ONLY_PHASE < 0 || ONLY_PHASE == 15) prenorm_phase(p, 1, 1, false); break;
    case 16: if (ONLY_PHASE < 0 || ONLY_PHASE == 16) { ALoadPlain al{p.H, 1024}; EpiAct<1> ep{p.U, 4096, nullptr}; gemm_phase(al, p.mlp1_t + (size_t)4096 * 1024, 1024, 32, ep, smem); } break;
    case 17: if (ONLY_PHASE < 0 || ONLY_PHASE == 17) { ALoadPlain al{p.U, 4096}; EpiResid ep{&p, 1, 5, false}; gemm_phase(al, p.mlp2_t + (size_t)4096 * 1024, 4096, 8, ep, smem); } break;
    default: break;
  }
}

__global__ void __launch_bounds__(NT, 2) fwd_kernel(const Params p, int ph_lo, int ph_hi) {
  __shared__ __attribute__((aligned(16))) char smem[65536];
#define PHASE(n) if (ph_lo <= n && n < ph_hi) { run_phase(p, n, smem); if (n + 1 < ph_hi) cg::this_grid().sync(); }
  PHASE(0) PHASE(1) PHASE(2) PHASE(3) PHASE(4) PHASE(5) PHASE(6) PHASE(7) PHASE(8) PHASE(9)
  PHASE(10) PHASE(11) PHASE(12) PHASE(13) PHASE(14) PHASE(15) PHASE(16) PHASE(17)
#undef PHASE
}

extern "C" void kernel_launch(void* const* d_in, const int* in_sizes, int n_in, void* d_out, int out_size, void* d_ws, size_t ws_size, hipStream_t stream) {
  Params p; memset(&p, 0, sizeof(p));
  auto F = [&](int i) { return (const float*)d_in[i]; };
  p.x_prompt = F(0); p.x_sample = F(1); p.cache_k = F(2); p.cache_v = F(3); p.hg_f0 = F(4); p.hg_b0 = F(5); p.rw_f0 = F(6); p.rw_b0 = F(7);
  p.c = F(8); p.c_ctx = F(9); p.ada_w = F(10); p.ada_b = F(11); p.norm1_w = F(12); p.norm2_w = F(13);
  p.q_norm = F(16); p.k_norm = F(17); p.hgrn_lb = F(18); p.g_norm = F(19); p.mix = F(20);
  p.w0 = F(25); p.a0 = F(28); p.k_k = F(33); p.k_a = F(34); p.r_k = F(35); p.ln_w = F(36); p.ln_b = F(37);
  float* out = (float*)d_out;
  p.X = out; p.out_k = out + 12582912; p.out_v = out + 13107200; p.out_hf = out + 13631488; p.out_hb = out + 14155776;
  p.out_rf = out + 14680064; p.out_rb = out + 15728640;
  char* ws = (char*)d_ws; size_t off = 4096;
  auto alloc = [&](size_t bytes) { char* r = ws + off; off += (bytes + 255) & ~(size_t)255; return r; };
  const size_t M1 = (size_t)1024 * 1024;
  p.w_in_t = (bf16_t*)alloc((size_t)3328 * 1024 * 2); p.w_out_t = (bf16_t*)alloc(M1 * 2);
  p.wr_t = (bf16_t*)alloc(M1 * 2); p.wk_t = (bf16_t*)alloc(M1 * 2); p.wv_t = (bf16_t*)alloc(M1 * 2); p.wo_t = (bf16_t*)alloc(M1 * 2);
  p.w1cat_t = (bf16_t*)alloc(128 * 1024 * 2); p.a1cat_t = (bf16_t*)alloc(128 * 1024 * 2); p.g1_t = (bf16_t*)alloc(128 * 1024 * 2);
  p.w2_t = (bf16_t*)alloc(2 * 1024 * 64 * 2); p.a2_t = (bf16_t*)alloc(2 * 1024 * 64 * 2); p.g2_t = (bf16_t*)alloc(1024 * 128 * 2);
  p.mlp1_t = (bf16_t*)alloc(2 * 4 * M1 * 2); p.mlp2_t = (bf16_t*)alloc(2 * 4 * M1 * 2);
  p.MOD = (float*)alloc((size_t)2 * 9 * 6144 * 4);
  const size_t TOKD = (size_t)NTOK * 1024;
  p.H = (bf16_t*)alloc(TOKD * 2);
  const size_t regL = off;
  p.Qbuf = (bf16_t*)alloc((size_t)NTOK * 512 * 2);
  p.Kp = (bf16_t*)alloc((size_t)32 * 256 * 64 * 2); p.Ks = (bf16_t*)alloc((size_t)16 * 1280 * 64 * 2);
  p.Vtp = (bf16_t*)alloc((size_t)32 * 64 * 256 * 2); p.Vts = (bf16_t*)alloc((size_t)16 * 64 * 1280 * 2);
  p.HG = (bf16_t*)alloc((size_t)NTOK * 2560 * 2);
  p.OF = (float*)alloc((size_t)NTOK * 512 * 4); p.OB = (float*)alloc((size_t)NTOK * 512 * 4);
  p.AO = (bf16_t*)alloc(TOKD * 2);
  size_t end0 = off;
  off = regL; p.U = (bf16_t*)alloc((size_t)NTOK * 4096 * 2);
  size_t endU = off;
  off = regL;
  p.R = (bf16_t*)alloc(TOKD * 2); p.Kx = (bf16_t*)alloc(TOKD * 2); p.Vx = (bf16_t*)alloc(TOKD * 2);
  p.LW = (bf16_t*)alloc((size_t)NTOK * 128 * 2); p.LA = (bf16_t*)alloc((size_t)NTOK * 128 * 2); p.LG = (bf16_t*)alloc((size_t)NTOK * 128 * 2);
  p.E0 = (bf16_t*)alloc(TOKD * 2); p.E1 = (bf16_t*)alloc(TOKD * 2); p.A1 = (bf16_t*)alloc(TOKD * 2);
  p.BS = (float*)alloc((size_t)2 * NTOK * 16 * 4);
  p.A0 = p.H; p.ZO = p.R;
  size_t end1 = off;
  size_t need = end0 > end1 ? end0 : end1; if (endU > need) need = endU;
  if (need > ws_size) fprintf(stderr, "workspace too small: need %zu have %zu\n", need, ws_size);
  int nj = 0, tiles = 0;
  auto job = [&](const float* src, bf16_t* dst, int K, int N) { p.jobs[nj].src = src; p.jobs[nj].dst = dst; p.jobs[nj].K = K; p.jobs[nj].N = N; p.jobs[nj].tile0 = tiles; p.jobs[nj].pad = 0; tiles += (K / 64) * (N / 64); ++nj; };
  job(F(38), p.mlp1_t, 1024, 4096); job(F(38) + 4 * M1, p.mlp1_t + 4 * M1, 1024, 4096);
  job(F(39), p.mlp2_t, 4096, 1024); job(F(39) + 4 * M1, p.mlp2_t + 4 * M1, 4096, 1024);
  job(F(14), p.w_in_t, 1024, 3328); job(F(15), p.w_out_t, 1024, 1024);
  job(F(21), p.wr_t, 1024, 1024); job(F(22), p.wk_t, 1024, 1024); job(F(23), p.wv_t, 1024, 1024); job(F(24), p.wo_t, 1024, 1024);
  job(F(26), p.w1cat_t, 1024, 64); job(F(26) + 65536, p.w1cat_t + 65536, 1024, 64);
  job(F(29), p.a1cat_t, 1024, 64); job(F(29) + 65536, p.a1cat_t + 65536, 1024, 64);
  job(F(31), p.g1_t, 1024, 128);
  job(F(27), p.w2_t, 64, 1024); job(F(27) + 65536, p.w2_t + 65536, 64, 1024);
  job(F(30), p.a2_t, 64, 1024); job(F(30) + 65536, p.a2_t + 65536, 64, 1024);
  job(F(32), p.g2_t, 128, 1024);
  p.njobs = nj; p.ntiles = tiles;

  static int grid_blocks = 0;
  if (!grid_blocks) {
    int dev = 0, cus = 0, per_cu = 0;
    hipGetDevice(&dev);
    hipDeviceGetAttribute(&cus, hipDeviceAttributeMultiprocessorCount, dev);
    hipOccupancyMaxActiveBlocksPerMultiprocessor(&per_cu, fwd_kernel, NT, 0);
    if (per_cu > 2) per_cu = 2;
    if (per_cu < 1) per_cu = 1;
    grid_blocks = cus * per_cu;
  }
#if ONE_LAUNCH
  int lo = 0, hi = NPHASES;
  void* args[] = {(void*)&p, (void*)&lo, (void*)&hi};
  hipError_t e = hipLaunchCooperativeKernel((void*)fwd_kernel, dim3(grid_blocks), dim3(NT), args, 0, stream);
  if (e != hipSuccess) fprintf(stderr, "cooperative launch failed: %s (grid %d)\n", hipGetErrorString(e), grid_blocks);
#else
  for (int ph = 0; ph < NPHASES; ++ph) hipLaunchKernelGGL(fwd_kernel, dim3(grid_blocks), dim3(NT), 0, stream, p, ph, ph + 1);
#endif
}
```

```cpp
#include <hip/hip_runtime.h>
#include <hip/hip_cooperative_groups.h>
#include <stdint.h>
#include <string.h>
#include <stdio.h>
namespace cg = cooperative_groups;

#ifndef ONE_LAUNCH
#define ONE_LAUNCH 1
#endif

typedef unsigned short bf16_t;
typedef short bf16x8 __attribute__((ext_vector_type(8)));
typedef float f32x4 __attribute__((ext_vector_type(4)));
typedef float f32x16 __attribute__((ext_vector_type(16)));

#define NT 256
#define NTOK 12288
#define NP 4096
#define NPHASES 18
#ifndef ONLY_PHASE
#define ONLY_PHASE -1
#endif

struct TJob { const float* src; bf16_t* dst; int K, N, tile0, pad; };

struct Params {
  const float *x_prompt, *x_sample, *cache_k, *cache_v, *hg_f0, *hg_b0, *rw_f0, *rw_b0, *c, *c_ctx;
  const float *ada_w, *ada_b, *norm1_w, *norm2_w, *q_norm, *k_norm, *hgrn_lb, *g_norm;
  const float *mix, *w0, *a0, *k_k, *k_a, *r_k, *ln_w, *ln_b;
  float *X, *out_k, *out_v, *out_hf, *out_hb, *out_rf, *out_rb;
  bf16_t *w_in_t, *w_out_t, *wr_t, *wk_t, *wv_t, *wo_t, *w1cat_t, *a1cat_t, *g1_t, *w2_t, *a2_t, *g2_t, *mlp1_t, *mlp2_t;
  float* MOD;
  bf16_t* H;
  bf16_t *Qbuf, *Kp, *Ks, *Vtp, *Vts, *HG, *AO, *U;
  float *OF, *OB;
  bf16_t *R, *Kx, *Vx, *LW, *LA, *LG, *E0, *E1, *A0, *A1, *ZO;
  float* BS;
  unsigned* bar;
  TJob jobs[20];
  int njobs, ntiles;
};

__device__ __forceinline__ unsigned pk_bf16(float lo, float hi) { unsigned r; asm("v_cvt_pk_bf16_f32 %0, %1, %2" : "=v"(r) : "v"(lo), "v"(hi)); return r; }
__device__ __forceinline__ bf16_t f2bf(float v) { return (bf16_t)(pk_bf16(v, 0.f) & 0xffffu); }
__device__ __forceinline__ float bf2f(bf16_t v) { return __uint_as_float(((unsigned)v) << 16); }
__device__ __forceinline__ float bflo(unsigned u) { return __uint_as_float(u << 16); }
__device__ __forceinline__ float bfhi(unsigned u) { return __uint_as_float(u & 0xffff0000u); }
__device__ __forceinline__ float sigmoidf_(float x) { return 1.f / (1.f + __expf(-x)); }
__device__ __forceinline__ float siluf_(float x) { return x / (1.f + __expf(-x)); }
__device__ __forceinline__ float wave_sum(float v) {
#pragma unroll
  for (int o = 32; o >= 1; o >>= 1) v += __shfl_xor(v, o);
  return v;
}
__device__ __forceinline__ float quad_sum(float v) {
  v += __int_as_float(__builtin_amdgcn_update_dpp(0, __float_as_int(v), 0xB1, 0xF, 0xF, true));
  v += __int_as_float(__builtin_amdgcn_update_dpp(0, __float_as_int(v), 0x4E, 0xF, 0xF, true));
  return v;
}
__device__ __forceinline__ int mod_index(int row) { return row < NP ? 0 : 1 + ((row - NP) >> 10); }

__device__ __forceinline__ void ada_item(const Params& p, int it, char* smem) {
  const int tid = threadIdx.x;
  float* sil = (float*)smem;
  for (int i = tid; i < 9 * 1024; i += NT) {
    int n = i >> 10, k = i & 1023;
    float cv = n == 0 ? p.c_ctx[k] : p.c[(n - 1) * 1024 + k];
    sil[i] = siluf_(cv);
  }
  __syncthreads();
  const int gcol = it * 64, l = gcol / 6144, j = gcol % 6144;
  const int c4 = tid & 15, ks = tid >> 4;
  const float* wp = p.ada_w + (size_t)l * 1024 * 6144 + (size_t)(ks * 64) * 6144 + j + c4 * 4;
  float acc[9][4];
#pragma unroll
  for (int n = 0; n < 9; ++n) { acc[n][0] = 0.f; acc[n][1] = 0.f; acc[n][2] = 0.f; acc[n][3] = 0.f; }
#pragma unroll 4
  for (int k = 0; k < 64; ++k) {
    const float4 w = *(const float4*)(wp + (size_t)k * 6144);
#pragma unroll
    for (int n = 0; n < 9; ++n) {
      const float s = sil[n * 1024 + ks * 64 + k];
      acc[n][0] += s * w.x; acc[n][1] += s * w.y; acc[n][2] += s * w.z; acc[n][3] += s * w.w;
    }
  }
  __syncthreads();
  float* red = (float*)smem;
#pragma unroll
  for (int n = 0; n < 9; ++n)
#pragma unroll
    for (int q = 0; q < 4; ++q) red[(ks * 9 + n) * 64 + c4 * 4 + q] = acc[n][q];
  __syncthreads();
  for (int o = tid; o < 576; o += NT) {
    const int n = o >> 6, cc = o & 63;
    float s = 0.f;
#pragma unroll
    for (int k2 = 0; k2 < 16; ++k2) s += red[(k2 * 9 + n) * 64 + cc];
    s += p.ada_b[l * 6144 + j + cc];
    p.MOD[(size_t)(l * 9 + n) * 6144 + j + cc] = s;
  }
}

__device__ __forceinline__ void transpose_item(const Params& p, int tix, char* smem) {
  const int tid = threadIdx.x;
  int j = 0;
  while (j + 1 < p.njobs && tix >= p.jobs[j + 1].tile0) ++j;
  const float* src = p.jobs[j].src; bf16_t* dst = p.jobs[j].dst;
  const int K = p.jobs[j].K, N = p.jobs[j].N, lt = tix - p.jobs[j].tile0;
  const int ntn = N >> 6, tk = lt / ntn, tn = lt % ntn;
  float* tile = (float*)smem;
#pragma unroll
  for (int i = 0; i < 4; ++i) {
    const int r = (tid >> 4) + 16 * i, c4 = tid & 15;
    const float4 v = *(const float4*)(src + (size_t)(tk * 64 + r) * N + tn * 64 + c4 * 4);
    float* t = tile + r * 65 + c4 * 4;
    t[0] = v.x; t[1] = v.y; t[2] = v.z; t[3] = v.w;
  }
  __syncthreads();
  const int n = tid >> 2, kc = (tid & 3) * 16;
  unsigned w[8];
#pragma unroll
  for (int i = 0; i < 8; ++i) w[i] = pk_bf16(tile[(kc + 2 * i) * 65 + n], tile[(kc + 2 * i + 1) * 65 + n]);
  uint4* d = (uint4*)(dst + (size_t)(tn * 64 + n) * K + tk * 64 + kc);
  d[0] = make_uint4(w[0], w[1], w[2], w[3]);
  d[1] = make_uint4(w[4], w[5], w[6], w[7]);
}

__device__ __forceinline__ void cache_item(const Params& p, int ci) {
  const int tid = threadIdx.x;
  const int base = (ci & 31) * 8192;
  for (int e = tid; e < 8192; e += NT) {
    const int idx = base + e;
    const int d = idx & 63, kvh = (idx >> 6) & 1, pp = (idx >> 7) & 255, b = idx >> 15;
    if (ci < 32) p.Ks[((size_t)(b * 2 + kvh) * 1280 + 1024 + pp) * 64 + d] = f2bf(p.cache_k[idx]);
    else p.Vts[((size_t)(b * 2 + kvh) * 64 + d) * 1280 + 1024 + pp] = f2bf(p.cache_v[idx]);
  }
}

__device__ __forceinline__ void phase0(const Params& p, char* smem) {
  const int n_ada = 192, n_tr = p.ntiles, n_cc = 64;
  const int total = n_ada + n_tr + n_cc;
  for (int it = blockIdx.x; it < total; it += gridDim.x) {
    if (it < n_ada) ada_item(p, it, smem);
    else if (it < n_ada + n_tr) transpose_item(p, it - n_ada, smem);
    else cache_item(p, it - n_ada - n_tr);
    __syncthreads();
  }
}

__device__ __forceinline__ void prenorm_phase(const Params& p, int layer, int which, bool from_input) {
  const int wave = threadIdx.x >> 6, lane = threadIdx.x & 63;
  const float* nw = (which ? p.norm2_w : p.norm1_w) + layer * 1024;
  for (int row = blockIdx.x * 4 + wave; row < NTOK; row += gridDim.x * 4) {
    const float* xr = from_input ? (row < NP ? p.x_prompt + (size_t)row * 1024 : p.x_sample + (size_t)(row - NP) * 1024)
                                 : p.X + (size_t)row * 1024;
    float4 v[4]; float ss = 0.f;
#pragma unroll
    for (int i = 0; i < 4; ++i) { v[i] = *(const float4*)(xr + i * 256 + lane * 4); ss += v[i].x * v[i].x + v[i].y * v[i].y + v[i].z * v[i].z + v[i].w * v[i].w; }
    ss = wave_sum(ss);
    const float rstd = rsqrtf(ss * (1.f / 1024.f) + 1e-6f);
    const float* md = p.MOD + (size_t)(layer * 9 + mod_index(row)) * 6144;
    const float* sh = md + (which ? 3 : 0) * 1024; const float* sc = md + (which ? 4 : 1) * 1024;
#pragma unroll
    for (int i = 0; i < 4; ++i) {
      const int c = i * 256 + lane * 4;
      const float4 w4 = *(const float4*)(nw + c), s4 = *(const float4*)(sh + c), c4 = *(const float4*)(sc + c);
      const float h0 = v[i].x * rstd * w4.x * (1.f + c4.x) + s4.x, h1 = v[i].y * rstd * w4.y * (1.f + c4.y) + s4.y;
      const float h2 = v[i].z * rstd * w4.z * (1.f + c4.z) + s4.z, h3 = v[i].w * rstd * w4.w * (1.f + c4.w) + s4.w;
      *(uint2*)(p.H + (size_t)row * 1024 + c) = make_uint2(pk_bf16(h0, h1), pk_bf16(h2, h3));
    }
  }
}

struct ALoadPlain {
  const bf16_t* A; int lda;
  __device__ __forceinline__ uint4 operator()(int row, int k) const { return *(const uint4*)(A + (size_t)row * lda + k); }
};
struct ALoadShift {
  const bf16_t* H; const float* mix;
  __device__ __forceinline__ uint4 operator()(int row, int k) const {
    const uint4 h = *(const uint4*)(H + (size_t)row * 1024 + k);
    int tl, T;
    if (row < NP) { tl = row & 255; T = 256; } else { tl = (row - NP) & 1023; T = 1024; }
    uint4 s = make_uint4(0, 0, 0, 0);
    if (k < 512) { if (tl > 0) s = *(const uint4*)(H + (size_t)(row - 1) * 1024 + k); }
    else { if (tl < T - 1) s = *(const uint4*)(H + (size_t)(row + 1) * 1024 + k); }
    const float4 m0 = *(const float4*)(mix + k), m1 = *(const float4*)(mix + k + 4);
    uint4 o;
    { float a = bflo(h.x), b = bfhi(h.x); o.x = pk_bf16(a + (bflo(s.x) - a) * m0.x, b + (bfhi(s.x) - b) * m0.y); }
    { float a = bflo(h.y), b = bfhi(h.y); o.y = pk_bf16(a + (bflo(s.y) - a) * m0.z, b + (bfhi(s.y) - b) * m0.w); }
    { float a = bflo(h.z), b = bfhi(h.z); o.z = pk_bf16(a + (bflo(s.z) - a) * m1.x, b + (bfhi(s.z) - b) * m1.y); }
    { float a = bflo(h.w), b = bfhi(h.w); o.w = pk_bf16(a + (bflo(s.w) - a) * m1.z, b + (bfhi(s.w) - b) * m1.w); }
    return o;
  }
};

template <class AL, class EP>
__device__ __forceinline__ void gemm_tile(const AL& al, const bf16_t* __restrict__ Bt, int K, int tm, int tn, const EP& ep, char* smem) {
  const int tid = threadIdx.x, lane = tid & 63, wid = tid >> 6, wm = wid >> 1, wn = wid & 1;
  const int fr = lane & 15, fq = lane >> 4;
  char* sA = smem; char* sB = smem + 32768;
  f32x4 acc[4][4];
#pragma unroll
  for (int a = 0; a < 4; ++a)
#pragma unroll
    for (int b = 0; b < 4; ++b) acc[a][b] = (f32x4){0.f, 0.f, 0.f, 0.f};
  uint4 pa[4], pb[4];
  const int nk = K >> 6;
  const int cr0 = tid >> 3, cc = tid & 7;
  const int soff = cr0 * 128 + ((cc ^ ((cr0 >> 1) & 7)) << 4);
  const bf16_t* bp = Bt + (size_t)(tn * 128 + cr0) * K + cc * 8;
#define GLOAD(kt) do { _Pragma("unroll") for (int i = 0; i < 4; ++i) { pa[i] = al(tm * 128 + cr0 + 32 * i, (kt) * 64 + cc * 8); pb[i] = *(const uint4*)(bp + (size_t)(32 * i) * K + (kt) * 64); } } while (0)
#define SSTORE(buf) do { _Pragma("unroll") for (int i = 0; i < 4; ++i) { *(uint4*)(sA + (buf) * 16384 + soff + i * 4096) = pa[i]; *(uint4*)(sB + (buf) * 16384 + soff + i * 4096) = pb[i]; } } while (0)
  GLOAD(0); SSTORE(0); __syncthreads();
  for (int kt = 0; kt < nk; ++kt) {
    const int buf = kt & 1;
    if (kt + 1 < nk) GLOAD(kt + 1);
#pragma unroll
    for (int kk = 0; kk < 2; ++kk) {
      bf16x8 af[4], bfr[4];
#pragma unroll
      for (int mi = 0; mi < 4; ++mi) { const int r = wm * 64 + mi * 16 + fr, c = kk * 4 + fq; af[mi] = *(const bf16x8*)(sA + buf * 16384 + r * 128 + ((c ^ ((r >> 1) & 7)) << 4)); }
#pragma unroll
      for (int ni = 0; ni < 4; ++ni) { const int r = wn * 64 + ni * 16 + fr, c = kk * 4 + fq; bfr[ni] = *(const bf16x8*)(sB + buf * 16384 + r * 128 + ((c ^ ((r >> 1) & 7)) << 4)); }
#pragma unroll
      for (int mi = 0; mi < 4; ++mi)
#pragma unroll
        for (int ni = 0; ni < 4; ++ni) acc[mi][ni] = __builtin_amdgcn_mfma_f32_16x16x32_bf16(bfr[ni], af[mi], acc[mi][ni], 0, 0, 0);
    }
    if (kt + 1 < nk) SSTORE(buf ^ 1);
    __syncthreads();
  }
#undef GLOAD
#undef SSTORE
  ep(acc, tm * 128 + wm * 64, tn * 128 + wn * 64, lane);
}

struct EpiWin {
  const Params* pp;
  __device__ __forceinline__ void operator()(f32x4 (&acc)[4][4], int row0, int col0, int lane) const {
    const Params& p = *pp;
    const int fr = lane & 15, fq = lane >> 4;
    const bool sample = row0 >= NP;
    if (col0 < 640) {
      const bool isq = col0 < 512;
      const float* nw = isq ? p.q_norm : p.k_norm;
      float nwv[4][4];
#pragma unroll
      for (int ni = 0; ni < 4; ++ni)
#pragma unroll
        for (int j = 0; j < 4; ++j) nwv[ni][j] = nw[ni * 16 + fq * 4 + j];
#pragma unroll
      for (int mi = 0; mi < 4; ++mi) {
        const int row = row0 + mi * 16 + fr;
        float ss = 0.f;
#pragma unroll
        for (int ni = 0; ni < 4; ++ni)
#pragma unroll
          for (int j = 0; j < 4; ++j) ss += acc[mi][ni][j] * acc[mi][ni][j];
        ss += __shfl_xor(ss, 16); ss += __shfl_xor(ss, 32);
        const float rn = rsqrtf(ss * (1.f / 64.f) + 1e-6f);
        float y[4][4];
#pragma unroll
        for (int ni = 0; ni < 4; ++ni)
#pragma unroll
          for (int j = 0; j < 4; ++j) y[ni][j] = acc[mi][ni][j] * rn * nwv[ni][j];
        if (!sample && !isq) {
          const int kvh = (col0 - 512) >> 6;
#pragma unroll
          for (int ni = 0; ni < 4; ++ni) *(f32x4*)(p.out_k + (size_t)row * 128 + kvh * 64 + ni * 16 + fq * 4) = (f32x4){y[ni][0], y[ni][1], y[ni][2], y[ni][3]};
        }
        if (sample) {
          const int tl = (row - NP) & 1023;
          const float rp = (float)(tl >> 6), cp = (float)(tl & 63);
#pragma unroll
          for (int ni = 0; ni < 4; ++ni)
#pragma unroll
            for (int jp = 0; jp < 2; ++jp) {
              const int i = (ni * 16 + fq * 4 + jp * 2) >> 1;
              const float pos = i < 16 ? rp : cp;
              const float inv = exp2f(-(float)(i & 15) * 0.83048202372184058696f);
              const float ang = pos * inv;
              const float s = __sinf(ang), c = __cosf(ang);
              const float x0 = y[ni][2 * jp], x1 = y[ni][2 * jp + 1];
              y[ni][2 * jp] = x0 * c - x1 * s; y[ni][2 * jp + 1] = x0 * s + x1 * c;
            }
        }
        if (isq) {
          const float qs = 0.125f * 1.44269504088896f;
#pragma unroll
          for (int ni = 0; ni < 4; ++ni)
            *(uint2*)(p.Qbuf + (size_t)row * 512 + col0 + ni * 16 + fq * 4) = make_uint2(pk_bf16(y[ni][0] * qs, y[ni][1] * qs), pk_bf16(y[ni][2] * qs, y[ni][3] * qs));
        } else {
          const int kvh = (col0 - 512) >> 6;
          bf16_t* kd;
          if (!sample) kd = p.Kp + ((size_t)((row >> 8) * 2 + kvh) * 256 + (row & 255)) * 64;
          else kd = p.Ks + ((size_t)(((row - NP) >> 10) * 2 + kvh) * 1280 + ((row - NP) & 1023)) * 64;
#pragma unroll
          for (int ni = 0; ni < 4; ++ni)
            *(uint2*)(kd + ni * 16 + fq * 4) = make_uint2(pk_bf16(y[ni][0], y[ni][1]), pk_bf16(y[ni][2], y[ni][3]));
        }
      }
    } else if (col0 < 768) {
      const int kvh = (col0 - 640) >> 6;
#pragma unroll
      for (int mi = 0; mi < 4; ++mi) {
        const int row = row0 + mi * 16 + fr;
#pragma unroll
        for (int ni = 0; ni < 4; ++ni) {
          const int d0 = ni * 16 + fq * 4;
          if (!sample) {
            *(f32x4*)(p.out_v + (size_t)row * 128 + kvh * 64 + d0) = acc[mi][ni];
            bf16_t* vd = p.Vtp + ((size_t)((row >> 8) * 2 + kvh) * 64 + d0) * 256 + (row & 255);
#pragma unroll
            for (int j = 0; j < 4; ++j) vd[j * 256] = f2bf(acc[mi][ni][j]);
          } else {
            bf16_t* vd = p.Vts + ((size_t)(((row - NP) >> 10) * 2 + kvh) * 64 + d0) * 1280 + ((row - NP) & 1023);
#pragma unroll
            for (int j = 0; j < 4; ++j) vd[j * 1280] = f2bf(acc[mi][ni][j]);
          }
        }
      }
    } else {
      const int c0 = col0 - 768, seg = c0 >> 9;
      float oml[4][4];
      if (seg == 1 || seg == 2) {
#pragma unroll
        for (int ni = 0; ni < 4; ++ni)
#pragma unroll
          for (int j = 0; j < 4; ++j) { const int c = (c0 & 511) + ni * 16 + fq * 4 + j; oml[ni][j] = 1.f / (1.f + __expf(p.hgrn_lb[c] - p.hgrn_lb[512 + c])); }
      }
#pragma unroll
      for (int mi = 0; mi < 4; ++mi) {
        const int row = row0 + mi * 16 + fr;
#pragma unroll
        for (int ni = 0; ni < 4; ++ni) {
          float o[4];
#pragma unroll
          for (int j = 0; j < 4; ++j) {
            const float v = acc[mi][ni][j];
            if (seg == 0 || seg == 4) o[j] = siluf_(v);
            else if (seg == 3) o[j] = v;
            else o[j] = oml[ni][j] * sigmoidf_(-v);
          }
          *(uint2*)(p.HG + (size_t)row * 2560 + c0 + ni * 16 + fq * 4) = make_uint2(pk_bf16(o[0], o[1]), pk_bf16(o[2], o[3]));
        }
      }
    }
  }
};

struct EpiResid {
  const Params* pp; int layer, gidx; bool from_input;
  __device__ __forceinline__ void operator()(f32x4 (&acc)[4][4], int row0, int col0, int lane) const {
    const Params& p = *pp;
    const int fr = lane & 15, fq = lane >> 4;
    const float* gt = p.MOD + (size_t)(layer * 9 + mod_index(row0)) * 6144 + gidx * 1024;
#pragma unroll
    for (int mi = 0; mi < 4; ++mi) {
      const int row = row0 + mi * 16 + fr;
      const float* base = from_input ? (row < NP ? p.x_prompt + (size_t)row * 1024 : p.x_sample + (size_t)(row - NP) * 1024) : p.X + (size_t)row * 1024;
#pragma unroll
      for (int ni = 0; ni < 4; ++ni) {
        const int col = col0 + ni * 16 + fq * 4;
        const f32x4 b = *(const f32x4*)(base + col), g = *(const f32x4*)(gt + col);
        *(f32x4*)(p.X + (size_t)row * 1024 + col) = b + g * acc[mi][ni];
      }
    }
  }
};

template <int ACT>
struct EpiAct {
  bf16_t* O; int ldo; const float* bias;
  __device__ __forceinline__ void operator()(f32x4 (&acc)[4][4], int row0, int col0, int lane) const {
    const int fr = lane & 15, fq = lane >> 4;
#pragma unroll
    for (int ni = 0; ni < 4; ++ni) {
      const int col = col0 + ni * 16 + fq * 4;
      f32x4 bv = (f32x4){0.f, 0.f, 0.f, 0.f};
      if (ACT >= 4) bv = *(const f32x4*)(bias + col);
#pragma unroll
      for (int mi = 0; mi < 4; ++mi) {
        const int row = row0 + mi * 16 + fr;
        float o[4];
#pragma unroll
        for (int j = 0; j < 4; ++j) {
          const float v = acc[mi][ni][j] + bv[j];
          if (ACT == 0) o[j] = v;
          else if (ACT == 1) { const float r = fmaxf(v, 0.f); o[j] = r * r; }
          else if (ACT == 2) o[j] = 1.f - 2.f / (1.f + __expf(2.f * v));
          else if (ACT == 3 || ACT == 5) o[j] = sigmoidf_(v);
          else o[j] = 0.60653065971263342f * sigmoidf_(v);
        }
        *(uint2*)(O + (size_t)row * ldo + col) = make_uint2(pk_bf16(o[0], o[1]), pk_bf16(o[2], o[3]));
      }
    }
  }
};

struct EpiRwkvOut {
  const Params* pp;
  __device__ __forceinline__ void operator()(f32x4 (&acc)[4][4], int row0, int col0, int lane) const {
    const Params& p = *pp;
    const int fr = lane & 15, fq = lane >> 4, h = col0 >> 6;
#pragma unroll
    for (int mi = 0; mi < 4; ++mi) {
      const int row = row0 + mi * 16 + fr;
      float y[4][4]; float s = 0.f;
#pragma unroll
      for (int ni = 0; ni < 4; ++ni) {
        const size_t idx = (size_t)row * 1024 + col0 + ni * 16 + fq * 4;
        const uint2 a = *(const uint2*)(p.E0 + idx), b = *(const uint2*)(p.E1 + idx);
        y[ni][0] = bflo(a.x) + bflo(b.x); y[ni][1] = bfhi(a.x) + bfhi(b.x); y[ni][2] = bflo(a.y) + bflo(b.y); y[ni][3] = bfhi(a.y) + bfhi(b.y);
        s += (y[ni][0] + y[ni][1]) + (y[ni][2] + y[ni][3]);
      }
      s += __shfl_xor(s, 16); s += __shfl_xor(s, 32);
      const float mu = s * (1.f / 64.f);
      float q = 0.f;
#pragma unroll
      for (int ni = 0; ni < 4; ++ni)
#pragma unroll
        for (int j = 0; j < 4; ++j) { const float d = y[ni][j] - mu; q += d * d; }
      q += __shfl_xor(q, 16); q += __shfl_xor(q, 32);
      const float rs = rsqrtf(q * (1.f / 64.f) + 64e-5f);
      const float bs = p.BS[(size_t)row * 16 + h] + p.BS[(size_t)NTOK * 16 + (size_t)row * 16 + h];
#pragma unroll
      for (int ni = 0; ni < 4; ++ni) {
        const int col = col0 + ni * 16 + fq * 4;
        const size_t idx = (size_t)row * 1024 + col;
        const uint2 vv = *(const uint2*)(p.Vx + idx);
        const f32x4 lw = *(const f32x4*)(p.ln_w + col), lb = *(const f32x4*)(p.ln_b + col);
        const float v0 = bflo(vv.x), v1 = bfhi(vv.x), v2 = bflo(vv.y), v3 = bfhi(vv.y);
        const float o0 = ((y[ni][0] - mu) * rs * lw[0] + lb[0] + bs * v0) * acc[mi][ni][0];
        const float o1 = ((y[ni][1] - mu) * rs * lw[1] + lb[1] + bs * v1) * acc[mi][ni][1];
        const float o2 = ((y[ni][2] - mu) * rs * lw[2] + lb[2] + bs * v2) * acc[mi][ni][2];
        const float o3 = ((y[ni][3] - mu) * rs * lw[3] + lb[3] + bs * v3) * acc[mi][ni][3];
        *(uint2*)(p.ZO + idx) = make_uint2(pk_bf16(o0, o1), pk_bf16(o2, o3));
      }
    }
  }
};

template <class AL, class EP>
__device__ __forceinline__ void gemm_phase(const AL& al, const bf16_t* Bt, int K, int ntn, const EP& ep, char* smem) {
  const int nunits = (NTOK / 128) * ntn;
  for (int u = blockIdx.x; u < nunits; u += gridDim.x) gemm_tile(al, Bt, K, u / ntn, u % ntn, ep, smem);
}

__device__ __forceinline__ void attn_item(const Params& p, int grp, int b, int h, int qb, char* smem) {
  const int tid = threadIdx.x, lane = tid & 63, wid = tid >> 6, qi = lane & 31, g = lane >> 5;
  const int Tk = grp ? 1280 : 256, kvh = h >> 2;
  const int rowbase = grp ? NP + b * 1024 + qb * 128 : b * 256 + qb * 128;
  const bf16_t* Kg = grp ? p.Ks + (size_t)(b * 2 + kvh) * 1280 * 64 : p.Kp + (size_t)(b * 2 + kvh) * 256 * 64;
  const bf16_t* Vg = grp ? p.Vts + (size_t)(b * 2 + kvh) * 64 * 1280 : p.Vtp + (size_t)(b * 2 + kvh) * 64 * 256;
  const int qrow = rowbase + wid * 32 + qi;
  bf16x8 Qf[4];
#pragma unroll
  for (int s = 0; s < 4; ++s) Qf[s] = *(const bf16x8*)(p.Qbuf + (size_t)qrow * 512 + h * 64 + s * 16 + g * 8);
  f32x16 O[2];
#pragma unroll
  for (int i = 0; i < 16; ++i) { O[0][i] = 0.f; O[1][i] = 0.f; }
  float m_run = -1e30f, l_run = 0.f;
  char* sK = smem; char* sV = smem + 16384;
  const int r0 = tid >> 3, c = tid & 7;
  uint4 pk[2], pv[2];
  const int ntile = Tk >> 6;
#define ALOAD(kt) do { _Pragma("unroll") for (int i = 0; i < 2; ++i) { const int r = r0 + 32 * i; pk[i] = *(const uint4*)(Kg + (size_t)((kt) * 64 + r) * 64 + c * 8); pv[i] = *(const uint4*)(Vg + (size_t)r * Tk + (kt) * 64 + c * 8); } } while (0)
#define ASTORE(buf) do { _Pragma("unroll") for (int i = 0; i < 2; ++i) { const int r = r0 + 32 * i; \
      *(uint4*)(sK + (buf) * 8192 + r * 128 + ((c ^ ((r >> 1) & 7)) << 4)) = pk[i]; \
      const int f = (r >> 1) & 15; \
      *(uint2*)(sV + (buf) * 8192 + r * 128 + (((2 * c) ^ f) << 3)) = make_uint2(pv[i].x, pv[i].y); \
      *(uint2*)(sV + (buf) * 8192 + r * 128 + (((2 * c + 1) ^ f) << 3)) = make_uint2(pv[i].z, pv[i].w); } } while (0)
  ALOAD(0); ASTORE(0); __syncthreads();
  for (int kt = 0; kt < ntile; ++kt) {
    const int buf = kt & 1;
    if (kt + 1 < ntile) ALOAD(kt + 1);
    f32x16 S[2];
#pragma unroll
    for (int t2 = 0; t2 < 2; ++t2) {
#pragma unroll
      for (int i = 0; i < 16; ++i) S[t2][i] = 0.f;
#pragma unroll
      for (int s = 0; s < 4; ++s) {
        const int r = t2 * 32 + qi, cc = 2 * s + g;
        const bf16x8 Kf = *(const bf16x8*)(sK + buf * 8192 + r * 128 + ((cc ^ ((r >> 1) & 7)) << 4));
        S[t2] = __builtin_amdgcn_mfma_f32_32x32x16_bf16(Kf, Qf[s], S[t2], 0, 0, 0);
      }
    }
    float mx = S[0][0];
#pragma unroll
    for (int i = 0; i < 16; ++i) { mx = fmaxf(mx, S[0][i]); mx = fmaxf(mx, S[1][i]); }
    mx = fmaxf(mx, __shfl_xor(mx, 32));
    const float m_new = fmaxf(m_run, mx);
    const float alpha = exp2f(m_run - m_new);
    float ls = 0.f;
#pragma unroll
    for (int i = 0; i < 16; ++i) { S[0][i] = exp2f(S[0][i] - m_new); S[1][i] = exp2f(S[1][i] - m_new); ls += S[0][i] + S[1][i]; }
    l_run = l_run * alpha + ls; m_run = m_new;
#pragma unroll
    for (int i = 0; i < 16; ++i) { O[0][i] *= alpha; O[1][i] *= alpha; }
#pragma unroll
    for (int t2 = 0; t2 < 2; ++t2)
#pragma unroll
      for (int sp = 0; sp < 2; ++sp) {
        union { bf16x8 v; unsigned u[4]; } Pf;
#pragma unroll
        for (int e = 0; e < 4; ++e) Pf.u[e] = pk_bf16(S[t2][8 * sp + 2 * e], S[t2][8 * sp + 2 * e + 1]);
#pragma unroll
        for (int ds = 0; ds < 2; ++ds) {
          const int d = ds * 32 + qi, f = (d >> 1) & 15, u1 = 8 * t2 + 4 * sp + g;
          union { bf16x8 v; uint2 u[2]; } Vf;
          Vf.u[0] = *(const uint2*)(sV + buf * 8192 + d * 128 + ((u1 ^ f) << 3));
          Vf.u[1] = *(const uint2*)(sV + buf * 8192 + d * 128 + (((u1 + 2) ^ f) << 3));
          O[ds] = __builtin_amdgcn_mfma_f32_32x32x16_bf16(Vf.v, Pf.v, O[ds], 0, 0, 0);
        }
      }
    if (kt + 1 < ntile) ASTORE(buf ^ 1);
    __syncthreads();
  }
#undef ALOAD
#undef ASTORE
  const float l = l_run + __shfl_xor(l_run, 32);
  const float inv = 1.f / l;
#pragma unroll
  for (int ds = 0; ds < 2; ++ds)
#pragma unroll
    for (int bq = 0; bq < 4; ++bq) {
      const int d0 = ds * 32 + 8 * bq + 4 * g;
      *(uint2*)(p.AO + (size_t)qrow * 1024 + h * 64 + d0) =
          make_uint2(pk_bf16(O[ds][4 * bq] * inv, O[ds][4 * bq + 1] * inv), pk_bf16(O[ds][4 * bq + 2] * inv, O[ds][4 * bq + 3] * inv));
    }
}

__device__ __forceinline__ void hgrn_item(const Params& p, int grp, int b, int h, int dir, char* smem) {
  const int tid = threadIdx.x, v = tid >> 2, ks = tid & 3;
  const int T = grp ? 1024 : 256, rowbase = grp ? NP + b * 1024 : b * 256;
  float S[16];
  if (grp) {
    const float* s0 = (dir ? p.hg_b0 : p.hg_f0) + (size_t)(b * 8 + h) * 4096;
#pragma unroll
    for (int i = 0; i < 16; ++i) S[i] = s0[(ks * 16 + i) * 64 + v];
  } else {
#pragma unroll
    for (int i = 0; i < 16; ++i) S[i] = 0.f;
  }
  float* obuf = (float*)(smem + 32768);
  const int lt = tid >> 4, lc = (tid & 15) * 4;
  const int kfseg = dir ? 1024 : 512;
  uint2 rq, rk, rv;
  const int nch = T >> 4;
#define HLOAD(cix) do { const int ts = (cix) * 16 + lt; const int tok = dir ? T - 1 - ts : ts; const bf16_t* src = p.HG + (size_t)(rowbase + tok) * 2560 + h * 64 + lc; \
    rq = *(const uint2*)(src); rk = *(const uint2*)(src + kfseg); rv = *(const uint2*)(src + 1536); } while (0)
#define HSTORE(buf) do { float* B = (float*)(smem + (buf) * 16384) + lt * 64 + lc; \
    const float k0 = bflo(rk.x), k1 = bfhi(rk.x), k2 = bflo(rk.y), k3 = bfhi(rk.y); \
    *(float4*)(B) = make_float4(1.f - k0, 1.f - k1, 1.f - k2, 1.f - k3); *(float4*)(B + 1024) = make_float4(k0, k1, k2, k3); \
    *(float4*)(B + 2048) = make_float4(bflo(rq.x), bfhi(rq.x), bflo(rq.y), bfhi(rq.y)); *(float4*)(B + 3072) = make_float4(bflo(rv.x), bfhi(rv.x), bflo(rv.y), bfhi(rv.y)); } while (0)
  HLOAD(0); HSTORE(0); __syncthreads();
  float* OD = dir ? p.OB : p.OF;
  for (int cix = 0; cix < nch; ++cix) {
    const int buf = cix & 1;
    if (cix + 1 < nch) HLOAD(cix + 1);
    const float* B = (const float*)(smem + buf * 16384);
    float* ob = obuf + buf * 1024;
#pragma unroll 4
    for (int t = 0; t < 16; ++t) {
      const float* Bt = B + t * 64 + ks * 16;
      const float vv = B[3072 + t * 64 + v];
      float o = 0.f;
#pragma unroll
      for (int q = 0; q < 4; ++q) {
        const float4 f4 = *(const float4*)(Bt + q * 4), k4 = *(const float4*)(Bt + 1024 + q * 4), q4 = *(const float4*)(Bt + 2048 + q * 4);
        S[q * 4 + 0] = f4.x * S[q * 4 + 0] + k4.x * vv; o += S[q * 4 + 0] * q4.x;
        S[q * 4 + 1] = f4.y * S[q * 4 + 1] + k4.y * vv; o += S[q * 4 + 1] * q4.y;
        S[q * 4 + 2] = f4.z * S[q * 4 + 2] + k4.z * vv; o += S[q * 4 + 2] * q4.z;
        S[q * 4 + 3] = f4.w * S[q * 4 + 3] + k4.w * vv; o += S[q * 4 + 3] * q4.w;
      }
      o = quad_sum(o);
      if (ks == 0) ob[t * 64 + v] = o;
    }
    if (cix + 1 < nch) HSTORE(buf ^ 1);
    __syncthreads();
    {
      const int ts = cix * 16 + lt; const int tok = dir ? T - 1 - ts : ts;
      *(float4*)(OD + (size_t)(rowbase + tok) * 512 + h * 64 + lc) = *(const float4*)(ob + lt * 64 + lc);
    }
  }
#undef HLOAD
#undef HSTORE
  if (!grp) {
    float* so = (dir ? p.out_hb : p.out_hf) + (size_t)(b * 8 + h) * 4096;
#pragma unroll
    for (int i = 0; i < 16; ++i) so[(ks * 16 + i) * 64 + v] = S[i];
  }
}

__device__ __forceinline__ void mix0_phase(const Params& p, char* smem) {
  for (int it = blockIdx.x; it < 1152; it += gridDim.x) {
    const bool is_h = it < 128 || (it >= 640 && it < 896);
    if (is_h) {
      const int grp = it < 128 ? 1 : 0, a = grp ? it : it - 640;
      hgrn_item(p, grp, a >> 4, (a >> 1) & 7, a & 1, smem);
    } else {
      const int grp = it < 640 ? 1 : 0, a = grp ? it - 128 : it - 896;
      const int b = grp ? a >> 6 : a >> 4, h = grp ? (a >> 3) & 7 : (a >> 1) & 7, qb = grp ? a & 7 : a & 1;
      attn_item(p, grp, b, h, qb, smem);
    }
    __syncthreads();
  }
}

__device__ __forceinline__ void hgrn_combine_phase(const Params& p) {
  const int gid = blockIdx.x * NT + threadIdx.x, l16 = gid & 15;
  const int ngroups = NTOK * 8;
  for (int grp = gid >> 4; grp < ngroups; grp += (gridDim.x * NT) >> 4) {
    const int row = grp >> 3, h = grp & 7;
    const size_t o = (size_t)row * 512 + h * 64 + l16 * 4;
    const float4 a = *(const float4*)(p.OF + o), b = *(const float4*)(p.OB + o);
    const float y0 = a.x + b.x, y1 = a.y + b.y, y2 = a.z + b.z, y3 = a.w + b.w;
    float ss = y0 * y0 + y1 * y1 + y2 * y2 + y3 * y3;
    ss += __shfl_xor(ss, 1); ss += __shfl_xor(ss, 2); ss += __shfl_xor(ss, 4); ss += __shfl_xor(ss, 8);
    const float rn = rsqrtf(ss * (1.f / 64.f) + 1e-6f);
    const float4 gn = *(const float4*)(p.g_norm + l16 * 4);
    const uint2 gt = *(const uint2*)(p.HG + (size_t)row * 2560 + 2048 + h * 64 + l16 * 4);
    *(uint2*)(p.AO + (size_t)row * 1024 + 512 + h * 64 + l16 * 4) =
        make_uint2(pk_bf16(y0 * rn * gn.x * bflo(gt.x), y1 * rn * gn.y * bfhi(gt.x)), pk_bf16(y2 * rn * gn.z * bflo(gt.y), y3 * rn * gn.w * bfhi(gt.y)));
  }
}

__device__ __forceinline__ void rwkv_item(const Params& p, int grp, int b, int h, int dir, char* smem) {
  const int tid = threadIdx.x, lane = tid & 63, wid = tid >> 6, v = tid >> 2, ks = tid & 3;
  const int T = grp ? 1024 : 256, rowbase = grp ? NP + b * 1024 : b * 256;
  float S[16];
  if (grp) {
    const float* s0 = (dir ? p.rw_b0 : p.rw_f0) + ((size_t)(b * 16 + h) * 64 + v) * 64 + ks * 16;
#pragma unroll
    for (int q = 0; q < 4; ++q) { const float4 t = *(const float4*)(s0 + q * 4); S[q * 4] = t.x; S[q * 4 + 1] = t.y; S[q * 4 + 2] = t.z; S[q * 4 + 3] = t.w; }
  } else {
#pragma unroll
    for (int i = 0; i < 16; ++i) S[i] = 0.f;
  }
  const bf16_t* E = dir ? p.E1 : p.E0; const bf16_t* A = dir ? p.A1 : p.A0; bf16_t* Y = dir ? p.E1 : p.E0;
  const float kkc = p.k_k[h * 64 + lane], kac = p.k_a[h * 64 + lane], rkc = p.r_k[h * 64 + lane];
  float* BSd = p.BS + (size_t)dir * NTOK * 16;
  float* ybuf = (float*)(smem + 49152);
  float rg[4][5];
  const int nch = T >> 4;
  const int lt = tid >> 4, lc = (tid & 15) * 4;
#define RLOAD(cix) do { _Pragma("unroll") for (int i = 0; i < 4; ++i) { const int ts = (cix) * 16 + wid * 4 + i; const int tok = dir ? T - 1 - ts : ts; \
    const size_t idx = (size_t)(rowbase + tok) * 1024 + h * 64 + lane; \
    rg[i][0] = bf2f(p.R[idx]); rg[i][1] = bf2f(p.Kx[idx]); rg[i][2] = bf2f(p.Vx[idx]); rg[i][3] = bf2f(E[idx]); rg[i][4] = bf2f(A[idx]); } } while (0)
#define RSTORE(cix, buf) do { _Pragma("unroll") for (int i = 0; i < 4; ++i) { const int tl_ = wid * 4 + i; const int ts = (cix) * 16 + tl_; const int tok = dir ? T - 1 - ts : ts; \
    const float r_ = rg[i][0], k_ = rg[i][1], v_ = rg[i][2], e_ = rg[i][3], a_ = rg[i][4]; \
    const float kx = k_ * kkc; const float ssq = wave_sum(kx * kx); const float kk = kx * rsqrtf(fmaxf(ssq, 1e-24f)); \
    const float kd = k_ * (1.f + (a_ - 1.f) * kac); const float bsum = wave_sum(r_ * kd * rkc); \
    float* B = (float*)(smem + (buf) * 24576) + tl_ * 64 + lane; \
    B[0] = __expf(-e_); B[1024] = kk; B[2048] = kk * a_; B[3072] = kd; B[4096] = r_; B[5120] = v_; \
    if (lane == 0) BSd[(size_t)(rowbase + tok) * 16 + h] = bsum; } } while (0)
  RLOAD(0); RSTORE(0, 0); __syncthreads();
  for (int cix = 0; cix < nch; ++cix) {
    const int buf = cix & 1;
    if (cix + 1 < nch) RLOAD(cix + 1);
    const float* B = (const float*)(smem + buf * 24576);
    float* yb = ybuf + buf * 1024;
#pragma unroll 2
    for (int t = 0; t < 16; ++t) {
      const float* Bt = B + t * 64 + ks * 16;
      const float vv = B[5120 + t * 64 + v];
      float4 w4[4], kk4[4];
      float sa = 0.f;
#pragma unroll
      for (int q = 0; q < 4; ++q) {
        w4[q] = *(const float4*)(Bt + q * 4); kk4[q] = *(const float4*)(Bt + 1024 + q * 4);
        sa += S[q * 4] * kk4[q].x + S[q * 4 + 1] * kk4[q].y + S[q * 4 + 2] * kk4[q].z + S[q * 4 + 3] * kk4[q].w;
      }
      sa = -quad_sum(sa);
      float y = 0.f;
#pragma unroll
      for (int q = 0; q < 4; ++q) {
        const float4 ka = *(const float4*)(Bt + 2048 + q * 4), kd = *(const float4*)(Bt + 3072 + q * 4), r4 = *(const float4*)(Bt + 4096 + q * 4);
        S[q * 4 + 0] = S[q * 4 + 0] * w4[q].x + (sa * ka.x + vv * kd.x); y += S[q * 4 + 0] * r4.x;
        S[q * 4 + 1] = S[q * 4 + 1] * w4[q].y + (sa * ka.y + vv * kd.y); y += S[q * 4 + 1] * r4.y;
        S[q * 4 + 2] = S[q * 4 + 2] * w4[q].z + (sa * ka.z + vv * kd.z); y += S[q * 4 + 2] * r4.z;
        S[q * 4 + 3] = S[q * 4 + 3] * w4[q].w + (sa * ka.w + vv * kd.w); y += S[q * 4 + 3] * r4.w;
      }
      y = quad_sum(y);
      if (ks == 0) yb[t * 64 + v] = y;
    }
    if (cix + 1 < nch) RSTORE(cix + 1, buf ^ 1);
    __syncthreads();
    {
      const int ts = cix * 16 + lt; const int tok = dir ? T - 1 - ts : ts;
      const float4 yy = *(const float4*)(yb + lt * 64 + lc);
      *(uint2*)(Y + (size_t)(rowbase + tok) * 1024 + h * 64 + lc) = make_uint2(pk_bf16(yy.x, yy.y), pk_bf16(yy.z, yy.w));
    }
  }
#undef RLOAD
#undef RSTORE
  if (!grp) {
    float* so = (dir ? p.out_rb : p.out_rf) + ((size_t)(b * 16 + h) * 64 + v) * 64 + ks * 16;
#pragma unroll
    for (int q = 0; q < 4; ++q) *(float4*)(so + q * 4) = make_float4(S[q * 4], S[q * 4 + 1], S[q * 4 + 2], S[q * 4 + 3]);
  }
}

__device__ __forceinline__ void rwkv_scan_phase(const Params& p, char* smem) {
  for (int it = blockIdx.x; it < 768; it += gridDim.x) {
    const int grp = it < 256 ? 1 : 0, a = grp ? it : it - 256;
    rwkv_item(p, grp, a >> 5, (a >> 1) & 15, a & 1, smem);
    __syncthreads();
  }
}

__device__ __forceinline__ void rwkv_proj_phase(const Params& p, char* smem) {
  const int nunits = 96 * 27;
  for (int u = blockIdx.x; u < nunits; u += gridDim.x) {
    const int tm = u / 27, s = u % 27;
    if (s < 8) { ALoadShift al{p.H, p.mix + 0 * 1024}; EpiAct<0> ep{p.R, 1024, nullptr}; gemm_tile(al, p.wr_t, 1024, tm, s, ep, smem); }
    else if (s < 16) { ALoadShift al{p.H, p.mix + 2 * 1024}; EpiAct<0> ep{p.Kx, 1024, nullptr}; gemm_tile(al, p.wk_t, 1024, tm, s - 8, ep, smem); }
    else if (s < 24) { ALoadShift al{p.H, p.mix + 3 * 1024}; EpiAct<0> ep{p.Vx, 1024, nullptr}; gemm_tile(al, p.wv_t, 1024, tm, s - 16, ep, smem); }
    else if (s == 24) { ALoadShift al{p.H, p.mix + 1 * 1024}; EpiAct<2> ep{p.LW, 128, nullptr}; gemm_tile(al, p.w1cat_t, 1024, tm, 0, ep, smem); }
    else if (s == 25) { ALoadShift al{p.H, p.mix + 4 * 1024}; EpiAct<0> ep{p.LA, 128, nullptr}; gemm_tile(al, p.a1cat_t, 1024, tm, 0, ep, smem); }
    else { ALoadShift al{p.H, p.mix + 5 * 1024}; EpiAct<3> ep{p.LG, 128, nullptr}; gemm_tile(al, p.g1_t, 1024, tm, 0, ep, smem); }
  }
}
__device__ __forceinline__ void rwkv_lora2_phase(const Params& p, char* smem) {
  const int nunits = 96 * 32;
  for (int u = blockIdx.x; u < nunits; u += gridDim.x) {
    const int tm = u >> 5, s = u & 31, which = s >> 3, tn = s & 7;
    const int d = which & 1;
    if (which < 2) { ALoadPlain al{p.LW + d * 64, 128}; EpiAct<4> ep{d ? p.E1 : p.E0, 1024, p.w0 + d * 1024}; gemm_tile(al, p.w2_t + (size_t)d * 65536, 64, tm, tn, ep, smem); }
    else { ALoadPlain al{p.LA + d * 64, 128}; EpiAct<5> ep{d ? p.A1 : p.A0, 1024, p.a0 + d * 1024}; gemm_tile(al, p.a2_t + (size_t)d * 65536, 64, tm, tn, ep, smem); }
  }
}


#define XB_TMO      128
#define XB_XCNT(j)  (256  + 64 * (j))
#define XB_XSUB(j)  (1280 + 64 * (j))
#define XB_XGEN(j)  (2304 + 64 * (j))
#define XB_TOP      3328
#define XB_TOPGEN   3392
#define XCD_BAR_WORDS 3456
#define XB_SPIN_CAP (1u << 22)
#define LAS __attribute__((address_space(3)))
__device__ __forceinline__ unsigned xb_ld(unsigned* p)              { return __hip_atomic_load(p, __ATOMIC_RELAXED, __HIP_MEMORY_SCOPE_AGENT); }
__device__ __forceinline__ unsigned xb_add(unsigned* p, unsigned v) { return __hip_atomic_fetch_add(p, v, __ATOMIC_RELAXED, __HIP_MEMORY_SCOPE_AGENT); }
__device__ __forceinline__ unsigned xb_xcc_id() { return (unsigned)__builtin_amdgcn_s_getreg((3 << 11) | 20) & 0xFu; }
#define XB_SPIN(cond, bar) do { unsigned _sp = 0; while (cond) { __builtin_amdgcn_s_sleep(1); \
    if ((++_sp & 255u) == 0u) { if (xb_ld(&(bar)[XB_TMO])) break; if (_sp > XB_SPIN_CAP) { atomicAdd(&(bar)[XB_TMO], 1u); break; } } } } while (0)
struct XcdBarrier { unsigned* bar; unsigned x; volatile LAS unsigned* st; };
__device__ __forceinline__ XcdBarrier xcd_barrier_post(unsigned* bar, volatile LAS unsigned* st) {
    XcdBarrier b; b.bar = bar; b.x = xb_xcc_id(); b.st = st;
    if (threadIdx.x == 0) (void)xb_add(&bar[XB_XCNT(b.x)], 1u);
    return b;
}
__device__ __forceinline__ void xcd_barrier_complete(unsigned* bar, unsigned x, unsigned& nloc, unsigned& nx) {
    const unsigned G = gridDim.x * gridDim.y * gridDim.z;
    unsigned sum, cnt, mine, sp = 0u;
    for (;;) {
        sum = 0u; cnt = 0u; mine = 0u;
#pragma unroll
        for (unsigned j = 0; j < 16; ++j) { const unsigned c = xb_ld(&bar[XB_XCNT(j)]); sum += c; cnt += (c > 0u) ? 1u : 0u; mine = (j == x) ? c : mine; }
        if (sum == G) break;
        __builtin_amdgcn_s_sleep(1);
        if ((++sp & 255u) == 0u) { if (xb_ld(&bar[XB_TMO])) break; if (sp > XB_SPIN_CAP) { atomicAdd(&bar[XB_TMO], 1u); break; } }
    }
    nloc = mine > 0u ? mine : 1u; nx = cnt > 0u ? cnt : 1u;
}
__device__ __forceinline__ void xcd_barrier(const XcdBarrier& b) {
    asm volatile("s_waitcnt vmcnt(0)" ::: "memory");
    __syncthreads();
    if (threadIdx.x == 0) {
        unsigned* bar = b.bar;
        __builtin_amdgcn_s_waitcnt(0);
        unsigned nloc = b.st[0], nx = b.st[1];
        if (nloc == 0u) { xcd_barrier_complete(bar, b.x, nloc, nx); b.st[0] = nloc; b.st[1] = nx; }
        const unsigned old = xb_add(&bar[XB_XSUB(b.x)], 1u);
        const unsigned gen = old / nloc;
        if (old + 1u == (gen + 1u) * nloc) {
            __builtin_amdgcn_fence(__ATOMIC_RELEASE, "agent");
            asm volatile("s_waitcnt vmcnt(0)" ::: "memory");
            const unsigned og = xb_add(&bar[XB_TOP], 1u);
            const unsigned tg = og / nx;
            if (og + 1u == (tg + 1u) * nx) xb_add(&bar[XB_TOPGEN], 1u);
            else XB_SPIN(xb_ld(&bar[XB_TOPGEN]) == tg, bar);
            __builtin_amdgcn_fence(__ATOMIC_ACQUIRE, "agent");
            xb_add(&bar[XB_XGEN(b.x)], 1u);
            asm volatile("s_waitcnt vmcnt(0)" ::: "memory");
        } else {
            XB_SPIN(xb_ld(&bar[XB_XGEN(b.x)]) == gen, bar);
            __builtin_amdgcn_fence(__ATOMIC_ACQUIRE, "agent");
            asm volatile("s_waitcnt vmcnt(0)" ::: "memory");
        }
    }
    __syncthreads();
}

__device__ __forceinline__ void run_phase(const Params& p, int ph, char* smem) {
  switch (ph) {
    case 0: if (ONLY_PHASE < 0 || ONLY_PHASE == 0) phase0(p, smem); break;
    case 1: if (ONLY_PHASE < 0 || ONLY_PHASE == 1) prenorm_phase(p, 0, 0, true); break;
    case 2: if (ONLY_PHASE < 0 || ONLY_PHASE == 2) { ALoadPlain al{p.H, 1024}; EpiWin ep{&p}; gemm_phase(al, p.w_in_t, 1024, 26, ep, smem); } break;
    case 3: if (ONLY_PHASE < 0 || ONLY_PHASE == 3) mix0_phase(p, smem); break;
    case 4: if (ONLY_PHASE < 0 || ONLY_PHASE == 4) hgrn_combine_phase(p); break;
    case 5: if (ONLY_PHASE < 0 || ONLY_PHASE == 5) { ALoadPlain al{p.AO, 1024}; EpiResid ep{&p, 0, 2, true}; gemm_phase(al, p.w_out_t, 1024, 8, ep, smem); } break;
    case 6: if (ONLY_PHASE < 0 || ONLY_PHASE == 6) prenorm_phase(p, 0, 1, false); break;
    case 7: if (ONLY_PHASE < 0 || ONLY_PHASE == 7) { ALoadPlain al{p.H, 1024}; EpiAct<1> ep{p.U, 4096, nullptr}; gemm_phase(al, p.mlp1_t, 1024, 32, ep, smem); } break;
    case 8: if (ONLY_PHASE < 0 || ONLY_PHASE == 8) { ALoadPlain al{p.U, 4096}; EpiResid ep{&p, 0, 5, false}; gemm_phase(al, p.mlp2_t, 4096, 8, ep, smem); } break;
    case 9: if (ONLY_PHASE < 0 || ONLY_PHASE == 9) prenorm_phase(p, 1, 0, false); break;
    case 10: if (ONLY_PHASE < 0 || ONLY_PHASE == 10) rwkv_proj_phase(p, smem); break;
    case 11: if (ONLY_PHASE < 0 || ONLY_PHASE == 11) rwkv_lora2_phase(p, smem); break;
    case 12: if (ONLY_PHASE < 0 || ONLY_PHASE == 12) rwkv_scan_phase(p, smem); break;
    case 13: if (ONLY_PHASE < 0 || ONLY_PHASE == 13) { ALoadPlain al{p.LG, 128}; EpiRwkvOut ep{&p}; gemm_phase(al, p.g2_t, 128, 8, ep, smem); } break;
    case 14: if (ONLY_PHASE < 0 || ONLY_PHASE == 14) { ALoadPlain al{p.ZO, 1024}; EpiResid ep{&p, 1, 2, false}; gemm_phase(al, p.wo_t, 1024, 8, ep, smem); } break;
    case 15: if (ONLY_PHASE < 0 || ONLY_PHASE == 15) prenorm_phase(p, 1, 1, false); break;
    case 16: if (ONLY_PHASE < 0 || ONLY_PHASE == 16) { ALoadPlain al{p.H, 1024}; EpiAct<1> ep{p.U, 4096, nullptr}; gemm_phase(al, p.mlp1_t + (size_t)4096 * 1024, 1024, 32, ep, smem); } break;
    case 17: if (ONLY_PHASE < 0 || ONLY_PHASE == 17) { ALoadPlain al{p.U, 4096}; EpiResid ep{&p, 1, 5, false}; gemm_phase(al, p.mlp2_t + (size_t)4096 * 1024, 4096, 8, ep, smem); } break;
    default: break;
  }
}

__global__ void __launch_bounds__(NT, 2) fwd_kernel(const Params p_unused, int ph_lo, int ph_hi) {
  const Params& p = *(const Params*)__builtin_amdgcn_kernarg_segment_ptr();
  __shared__ __attribute__((aligned(16))) char smem[65536];
  __shared__ uint4 xb_words;
  if (threadIdx.x == 0) xb_words = make_uint4(0u, 0u, 0u, 0u);
  __syncthreads();
  XcdBarrier xb = xcd_barrier_post(p.bar, (volatile LAS unsigned*)&xb_words);
  if (ph_hi < 0) cg::this_grid().sync();
#define PHASE(n) if (ph_lo <= n && n < ph_hi) { run_phase(p, n, smem); if (n + 1 < ph_hi) xcd_barrier(xb); }
  PHASE(0) PHASE(1) PHASE(2) PHASE(3) PHASE(4) PHASE(5) PHASE(6) PHASE(7) PHASE(8) PHASE(9)
  PHASE(10) PHASE(11) PHASE(12) PHASE(13) PHASE(14) PHASE(15) PHASE(16) PHASE(17)
#undef PHASE
}

extern "C" void kernel_launch(void* const* d_in, const int* in_sizes, int n_in, void* d_out, int out_size, void* d_ws, size_t ws_size, hipStream_t stream) {
  Params p; memset(&p, 0, sizeof(p));
  auto F = [&](int i) { return (const float*)d_in[i]; };
  p.x_prompt = F(0); p.x_sample = F(1); p.cache_k = F(2); p.cache_v = F(3); p.hg_f0 = F(4); p.hg_b0 = F(5); p.rw_f0 = F(6); p.rw_b0 = F(7);
  p.c = F(8); p.c_ctx = F(9); p.ada_w = F(10); p.ada_b = F(11); p.norm1_w = F(12); p.norm2_w = F(13);
  p.q_norm = F(16); p.k_norm = F(17); p.hgrn_lb = F(18); p.g_norm = F(19); p.mix = F(20);
  p.w0 = F(25); p.a0 = F(28); p.k_k = F(33); p.k_a = F(34); p.r_k = F(35); p.ln_w = F(36); p.ln_b = F(37);
  float* out = (float*)d_out;
  p.X = out; p.out_k = out + 12582912; p.out_v = out + 13107200; p.out_hf = out + 13631488; p.out_hb = out + 14155776;
  p.out_rf = out + 14680064; p.out_rb = out + 15728640;
  char* ws = (char*)d_ws; size_t off = 16384;
  p.bar = (unsigned*)ws;
  auto alloc = [&](size_t bytes) { char* r = ws + off; off += (bytes + 255) & ~(size_t)255; return r; };
  const size_t M1 = (size_t)1024 * 1024;
  p.w_in_t = (bf16_t*)alloc((size_t)3328 * 1024 * 2); p.w_out_t = (bf16_t*)alloc(M1 * 2);
  p.wr_t = (bf16_t*)alloc(M1 * 2); p.wk_t = (bf16_t*)alloc(M1 * 2); p.wv_t = (bf16_t*)alloc(M1 * 2); p.wo_t = (bf16_t*)alloc(M1 * 2);
  p.w1cat_t = (bf16_t*)alloc(128 * 1024 * 2); p.a1cat_t = (bf16_t*)alloc(128 * 1024 * 2); p.g1_t = (bf16_t*)alloc(128 * 1024 * 2);
  p.w2_t = (bf16_t*)alloc(2 * 1024 * 64 * 2); p.a2_t = (bf16_t*)alloc(2 * 1024 * 64 * 2); p.g2_t = (bf16_t*)alloc(1024 * 128 * 2);
  p.mlp1_t = (bf16_t*)alloc(2 * 4 * M1 * 2); p.mlp2_t = (bf16_t*)alloc(2 * 4 * M1 * 2);
  p.MOD = (float*)alloc((size_t)2 * 9 * 6144 * 4);
  const size_t TOKD = (size_t)NTOK * 1024;
  p.H = (bf16_t*)alloc(TOKD * 2);
  const size_t regL = off;
  p.Qbuf = (bf16_t*)alloc((size_t)NTOK * 512 * 2);
  p.Kp = (bf16_t*)alloc((size_t)32 * 256 * 64 * 2); p.Ks = (bf16_t*)alloc((size_t)16 * 1280 * 64 * 2);
  p.Vtp = (bf16_t*)alloc((size_t)32 * 64 * 256 * 2); p.Vts = (bf16_t*)alloc((size_t)16 * 64 * 1280 * 2);
  p.HG = (bf16_t*)alloc((size_t)NTOK * 2560 * 2);
  p.OF = (float*)alloc((size_t)NTOK * 512 * 4); p.OB = (float*)alloc((size_t)NTOK * 512 * 4);
  p.AO = (bf16_t*)alloc(TOKD * 2);
  size_t end0 = off;
  off = regL; p.U = (bf16_t*)alloc((size_t)NTOK * 4096 * 2);
  size_t endU = off;
  off = regL;
  p.R = (bf16_t*)alloc(TOKD * 2); p.Kx = (bf16_t*)alloc(TOKD * 2); p.Vx = (bf16_t*)alloc(TOKD * 2);
  p.LW = (bf16_t*)alloc((size_t)NTOK * 128 * 2); p.LA = (bf16_t*)alloc((size_t)NTOK * 128 * 2); p.LG = (bf16_t*)alloc((size_t)NTOK * 128 * 2);
  p.E0 = (bf16_t*)alloc(TOKD * 2); p.E1 = (bf16_t*)alloc(TOKD * 2); p.A1 = (bf16_t*)alloc(TOKD * 2);
  p.BS = (float*)alloc((size_t)2 * NTOK * 16 * 4);
  p.A0 = p.H; p.ZO = p.R;
  size_t end1 = off;
  size_t need = end0 > end1 ? end0 : end1; if (endU > need) need = endU;
  if (need > ws_size) fprintf(stderr, "workspace too small: need %zu have %zu\n", need, ws_size);
  int nj = 0, tiles = 0;
  auto job = [&](const float* src, bf16_t* dst, int K, int N) { p.jobs[nj].src = src; p.jobs[nj].dst = dst; p.jobs[nj].K = K; p.jobs[nj].N = N; p.jobs[nj].tile0 = tiles; p.jobs[nj].pad = 0; tiles += (K / 64) * (N / 64); ++nj; };
  job(F(38), p.mlp1_t, 1024, 4096); job(F(38) + 4 * M1, p.mlp1_t + 4 * M1, 1024, 4096);
  job(F(39), p.mlp2_t, 4096, 1024); job(F(39) + 4 * M1, p.mlp2_t + 4 * M1, 4096, 1024);
  job(F(14), p.w_in_t, 1024, 3328); job(F(15), p.w_out_t, 1024, 1024);
  job(F(21), p.wr_t, 1024, 1024); job(F(22), p.wk_t, 1024, 1024); job(F(23), p.wv_t, 1024, 1024); job(F(24), p.wo_t, 1024, 1024);
  job(F(26), p.w1cat_t, 1024, 64); job(F(26) + 65536, p.w1cat_t + 65536, 1024, 64);
  job(F(29), p.a1cat_t, 1024, 64); job(F(29) + 65536, p.a1cat_t + 65536, 1024, 64);
  job(F(31), p.g1_t, 1024, 128);
  job(F(27), p.w2_t, 64, 1024); job(F(27) + 65536, p.w2_t + 65536, 64, 1024);
  job(F(30), p.a2_t, 64, 1024); job(F(30) + 65536, p.a2_t + 65536, 64, 1024);
  job(F(32), p.g2_t, 128, 1024);
  p.njobs = nj; p.ntiles = tiles;

  static int grid_blocks = 0;
  if (!grid_blocks) {
    int dev = 0, cus = 0, per_cu = 0;
    hipGetDevice(&dev);
    hipDeviceGetAttribute(&cus, hipDeviceAttributeMultiprocessorCount, dev);
    hipOccupancyMaxActiveBlocksPerMultiprocessor(&per_cu, fwd_kernel, NT, 0);
    if (per_cu > 2) per_cu = 2;
    if (per_cu < 1) per_cu = 1;
    grid_blocks = cus * per_cu;
  }
  hipMemsetAsync(d_ws, 0, 16384, stream);
#if ONE_LAUNCH
  int lo = 0, hi = NPHASES;
  void* args[] = {(void*)&p, (void*)&lo, (void*)&hi};
  hipError_t e = hipLaunchCooperativeKernel((void*)fwd_kernel, dim3(grid_blocks), dim3(NT), args, 0, stream);
  if (e != hipSuccess) fprintf(stderr, "cooperative launch failed: %s (grid %d)\n", hipGetErrorString(e), grid_blocks);
#else
  for (int ph = 0; ph < NPHASES; ++ph) hipLaunchKernelGGL(fwd_kernel, dim3(grid_blocks), dim3(NT), 0, stream, p, ph, ph + 1);
#endif
}
```

```cpp
#include <hip/hip_runtime.h>
#include <hip/hip_cooperative_groups.h>
#include <stdint.h>
#include <string.h>
#include <stdio.h>
namespace cg = cooperative_groups;

#ifndef ONE_LAUNCH
#define ONE_LAUNCH 1
#endif

typedef unsigned short bf16_t;
typedef short bf16x8 __attribute__((ext_vector_type(8)));
typedef float f32x4 __attribute__((ext_vector_type(4)));
typedef float f32x16 __attribute__((ext_vector_type(16)));
typedef float f32x2 __attribute__((ext_vector_type(2)));

#define NT 256
#define NTOK 12288
#define NP 4096
#define NPHASES 18
#ifndef ONLY_PHASE
#define ONLY_PHASE -1
#endif

struct TJob { const float* src; bf16_t* dst; int K, N, tile0, pad; };

struct Params {
  const float *x_prompt, *x_sample, *cache_k, *cache_v, *hg_f0, *hg_b0, *rw_f0, *rw_b0, *c, *c_ctx;
  const float *ada_w, *ada_b, *norm1_w, *norm2_w, *q_norm, *k_norm, *hgrn_lb, *g_norm;
  const float *mix, *w0, *a0, *k_k, *k_a, *r_k, *ln_w, *ln_b;
  float *X, *out_k, *out_v, *out_hf, *out_hb, *out_rf, *out_rb;
  bf16_t *w_in_t, *w_out_t, *wr_t, *wk_t, *wv_t, *wo_t, *w1cat_t, *a1cat_t, *g1_t, *w2_t, *a2_t, *g2_t, *mlp1_t, *mlp2_t;
  float* MOD;
  bf16_t* H;
  bf16_t *Qbuf, *Kp, *Ks, *Vtp, *Vts, *HG, *AO, *U;
  float *OF, *OB;
  bf16_t *R, *Kx, *Vx, *LW, *LA, *LG, *E0, *E1, *A0, *A1, *ZO;
  float* BS;
  unsigned* bar;
  TJob jobs[20];
  int njobs, ntiles;
};

__device__ __forceinline__ unsigned pk_bf16(float lo, float hi) { unsigned r; asm("v_cvt_pk_bf16_f32 %0, %1, %2" : "=v"(r) : "v"(lo), "v"(hi)); return r; }
__device__ __forceinline__ bf16_t f2bf(float v) { return (bf16_t)(pk_bf16(v, 0.f) & 0xffffu); }
__device__ __forceinline__ float bf2f(bf16_t v) { return __uint_as_float(((unsigned)v) << 16); }
__device__ __forceinline__ float bflo(unsigned u) { return __uint_as_float(u << 16); }
__device__ __forceinline__ float bfhi(unsigned u) { return __uint_as_float(u & 0xffff0000u); }
__device__ __forceinline__ float sigmoidf_(float x) { return 1.f / (1.f + __expf(-x)); }
__device__ __forceinline__ float siluf_(float x) { return x / (1.f + __expf(-x)); }
__device__ __forceinline__ float wave_sum(float v) {
#pragma unroll
  for (int o = 32; o >= 1; o >>= 1) v += __shfl_xor(v, o);
  return v;
}
__device__ __forceinline__ float quad_sum(float v) {
  v += __int_as_float(__builtin_amdgcn_update_dpp(0, __float_as_int(v), 0xB1, 0xF, 0xF, true));
  v += __int_as_float(__builtin_amdgcn_update_dpp(0, __float_as_int(v), 0x4E, 0xF, 0xF, true));
  return v;
}
__device__ __forceinline__ float oct_sum(float v) {
  v += __int_as_float(__builtin_amdgcn_update_dpp(0, __float_as_int(v), 0xB1, 0xF, 0xF, true));
  v += __int_as_float(__builtin_amdgcn_update_dpp(0, __float_as_int(v), 0x4E, 0xF, 0xF, true));
  v += __int_as_float(__builtin_amdgcn_update_dpp(0, __float_as_int(v), 0x141, 0xF, 0xF, true));
  return v;
}
__device__ __forceinline__ int mod_index(int row) { return row < NP ? 0 : 1 + ((row - NP) >> 10); }

__device__ __forceinline__ void ada_item(const Params& p, int it, char* smem) {
  const int tid = threadIdx.x;
  float* sil = (float*)smem;
  for (int i = tid; i < 9 * 1024; i += NT) {
    int n = i >> 10, k = i & 1023;
    float cv = n == 0 ? p.c_ctx[k] : p.c[(n - 1) * 1024 + k];
    sil[i] = siluf_(cv);
  }
  __syncthreads();
  const int gcol = it * 64, l = gcol / 6144, j = gcol % 6144;
  const int c4 = tid & 15, ks = tid >> 4;
  const float* wp = p.ada_w + (size_t)l * 1024 * 6144 + (size_t)(ks * 64) * 6144 + j + c4 * 4;
  float acc[9][4];
#pragma unroll
  for (int n = 0; n < 9; ++n) { acc[n][0] = 0.f; acc[n][1] = 0.f; acc[n][2] = 0.f; acc[n][3] = 0.f; }
#pragma unroll 4
  for (int k = 0; k < 64; ++k) {
    const float4 w = *(const float4*)(wp + (size_t)k * 6144);
#pragma unroll
    for (int n = 0; n < 9; ++n) {
      const float s = sil[n * 1024 + ks * 64 + k];
      acc[n][0] += s * w.x; acc[n][1] += s * w.y; acc[n][2] += s * w.z; acc[n][3] += s * w.w;
    }
  }
  __syncthreads();
  float* red = (float*)smem;
#pragma unroll
  for (int n = 0; n < 9; ++n)
#pragma unroll
    for (int q = 0; q < 4; ++q) red[(ks * 9 + n) * 64 + c4 * 4 + q] = acc[n][q];
  __syncthreads();
  for (int o = tid; o < 576; o += NT) {
    const int n = o >> 6, cc = o & 63;
    float s = 0.f;
#pragma unroll
    for (int k2 = 0; k2 < 16; ++k2) s += red[(k2 * 9 + n) * 64 + cc];
    s += p.ada_b[l * 6144 + j + cc];
    p.MOD[(size_t)(l * 9 + n) * 6144 + j + cc] = s;
  }
}

__device__ __forceinline__ void transpose_item(const Params& p, int tix, char* smem) {
  const int tid = threadIdx.x;
  int j = 0;
  while (j + 1 < p.njobs && tix >= p.jobs[j + 1].tile0) ++j;
  const float* src = p.jobs[j].src; bf16_t* dst = p.jobs[j].dst;
  const int K = p.jobs[j].K, N = p.jobs[j].N, lt = tix - p.jobs[j].tile0;
  const int ntn = N >> 6, tk = lt / ntn, tn = lt % ntn;
  float* tile = (float*)smem;
#pragma unroll
  for (int i = 0; i < 4; ++i) {
    const int r = (tid >> 4) + 16 * i, c4 = tid & 15;
    const float4 v = *(const float4*)(src + (size_t)(tk * 64 + r) * N + tn * 64 + c4 * 4);
    float* t = tile + r * 65 + c4 * 4;
    t[0] = v.x; t[1] = v.y; t[2] = v.z; t[3] = v.w;
  }
  __syncthreads();
  const int n = tid >> 2, kc = (tid & 3) * 16;
  unsigned w[8];
#pragma unroll
  for (int i = 0; i < 8; ++i) w[i] = pk_bf16(tile[(kc + 2 * i) * 65 + n], tile[(kc + 2 * i + 1) * 65 + n]);
  uint4* d = (uint4*)(dst + (size_t)(tn * 64 + n) * K + tk * 64 + kc);
  d[0] = make_uint4(w[0], w[1], w[2], w[3]);
  d[1] = make_uint4(w[4], w[5], w[6], w[7]);
}

__device__ __forceinline__ void cache_item(const Params& p, int ci) {
  const int tid = threadIdx.x;
  const int base = (ci & 31) * 8192;
  for (int e = tid; e < 8192; e += NT) {
    const int idx = base + e;
    const int d = idx & 63, kvh = (idx >> 6) & 1, pp = (idx >> 7) & 255, b = idx >> 15;
    if (ci < 32) p.Ks[((size_t)(b * 2 + kvh) * 1280 + 1024 + pp) * 64 + d] = f2bf(p.cache_k[idx]);
    else p.Vts[((size_t)(b * 2 + kvh) * 64 + d) * 1280 + 1024 + pp] = f2bf(p.cache_v[idx]);
  }
}

__device__ __forceinline__ void phase0(const Params& p, char* smem) {
  const int n_ada = 192, n_tr = p.ntiles, n_cc = 64;
  const int total = n_ada + n_tr + n_cc;
  for (int it = blockIdx.x; it < total; it += gridDim.x) {
    if (it < n_ada) ada_item(p, it, smem);
    else if (it < n_ada + n_tr) transpose_item(p, it - n_ada, smem);
    else cache_item(p, it - n_ada - n_tr);
    __syncthreads();
  }
}

__device__ __forceinline__ void prenorm_phase(const Params& p, int layer, int which, bool from_input) {
  const int wave = threadIdx.x >> 6, lane = threadIdx.x & 63;
  const float* nw = (which ? p.norm2_w : p.norm1_w) + layer * 1024;
  for (int row = blockIdx.x * 4 + wave; row < NTOK; row += gridDim.x * 4) {
    const float* xr = from_input ? (row < NP ? p.x_prompt + (size_t)row * 1024 : p.x_sample + (size_t)(row - NP) * 1024)
                                 : p.X + (size_t)row * 1024;
    float4 v[4]; float ss = 0.f;
#pragma unroll
    for (int i = 0; i < 4; ++i) { v[i] = *(const float4*)(xr + i * 256 + lane * 4); ss += v[i].x * v[i].x + v[i].y * v[i].y + v[i].z * v[i].z + v[i].w * v[i].w; }
    ss = wave_sum(ss);
    const float rstd = rsqrtf(ss * (1.f / 1024.f) + 1e-6f);
    const float* md = p.MOD + (size_t)(layer * 9 + mod_index(row)) * 6144;
    const float* sh = md + (which ? 3 : 0) * 1024; const float* sc = md + (which ? 4 : 1) * 1024;
#pragma unroll
    for (int i = 0; i < 4; ++i) {
      const int c = i * 256 + lane * 4;
      const float4 w4 = *(const float4*)(nw + c), s4 = *(const float4*)(sh + c), c4 = *(const float4*)(sc + c);
      const float h0 = v[i].x * rstd * w4.x * (1.f + c4.x) + s4.x, h1 = v[i].y * rstd * w4.y * (1.f + c4.y) + s4.y;
      const float h2 = v[i].z * rstd * w4.z * (1.f + c4.z) + s4.z, h3 = v[i].w * rstd * w4.w * (1.f + c4.w) + s4.w;
      *(uint2*)(p.H + (size_t)row * 1024 + c) = make_uint2(pk_bf16(h0, h1), pk_bf16(h2, h3));
    }
  }
}

struct ALoadPlain {
  const bf16_t* A; int lda;
  __device__ __forceinline__ uint4 operator()(int row, int k) const { return *(const uint4*)(A + (size_t)row * lda + k); }
};
struct ALoadShift {
  const bf16_t* H; const float* mix;
  __device__ __forceinline__ uint4 operator()(int row, int k) const {
    const uint4 h = *(const uint4*)(H + (size_t)row * 1024 + k);
    int tl, T;
    if (row < NP) { tl = row & 255; T = 256; } else { tl = (row - NP) & 1023; T = 1024; }
    uint4 s = make_uint4(0, 0, 0, 0);
    if (k < 512) { if (tl > 0) s = *(const uint4*)(H + (size_t)(row - 1) * 1024 + k); }
    else { if (tl < T - 1) s = *(const uint4*)(H + (size_t)(row + 1) * 1024 + k); }
    const float4 m0 = *(const float4*)(mix + k), m1 = *(const float4*)(mix + k + 4);
    uint4 o;
    { float a = bflo(h.x), b = bfhi(h.x); o.x = pk_bf16(a + (bflo(s.x) - a) * m0.x, b + (bfhi(s.x) - b) * m0.y); }
    { float a = bflo(h.y), b = bfhi(h.y); o.y = pk_bf16(a + (bflo(s.y) - a) * m0.z, b + (bfhi(s.y) - b) * m0.w); }
    { float a = bflo(h.z), b = bfhi(h.z); o.z = pk_bf16(a + (bflo(s.z) - a) * m1.x, b + (bfhi(s.z) - b) * m1.y); }
    { float a = bflo(h.w), b = bfhi(h.w); o.w = pk_bf16(a + (bflo(s.w) - a) * m1.z, b + (bfhi(s.w) - b) * m1.w); }
    return o;
  }
};

template <class AL, class EP>
__device__ __forceinline__ void gemm_tile(const AL& al, const bf16_t* __restrict__ Bt, int K, int tm, int tn, const EP& ep, char* smem) {
  const int tid = threadIdx.x, lane = tid & 63, wid = tid >> 6, wm = wid >> 1, wn = wid & 1;
  const int fr = lane & 15, fq = lane >> 4;
  char* sA = smem; char* sB = smem + 32768;
  f32x4 acc[4][4];
#pragma unroll
  for (int a = 0; a < 4; ++a)
#pragma unroll
    for (int b = 0; b < 4; ++b) acc[a][b] = (f32x4){0.f, 0.f, 0.f, 0.f};
  uint4 pa[4], pb[4];
  const int nk = K >> 6;
  const int cr0 = tid >> 3, cc = tid & 7;
  const int soff = cr0 * 128 + ((cc ^ ((cr0 >> 1) & 7)) << 4);
  const bf16_t* bp = Bt + (size_t)(tn * 128 + cr0) * K + cc * 8;
#define GLOAD(kt) do { _Pragma("unroll") for (int i = 0; i < 4; ++i) { pa[i] = al(tm * 128 + cr0 + 32 * i, (kt) * 64 + cc * 8); pb[i] = *(const uint4*)(bp + (size_t)(32 * i) * K + (kt) * 64); } } while (0)
#define SSTORE(buf) do { _Pragma("unroll") for (int i = 0; i < 4; ++i) { *(uint4*)(sA + (buf) * 16384 + soff + i * 4096) = pa[i]; *(uint4*)(sB + (buf) * 16384 + soff + i * 4096) = pb[i]; } } while (0)
  GLOAD(0); SSTORE(0); __syncthreads();
  for (int kt = 0; kt < nk; ++kt) {
    const int buf = kt & 1;
    if (kt + 1 < nk) GLOAD(kt + 1);
#pragma unroll
    for (int kk = 0; kk < 2; ++kk) {
      bf16x8 af[4], bfr[4];
#pragma unroll
      for (int mi = 0; mi < 4; ++mi) { const int r = wm * 64 + mi * 16 + fr, c = kk * 4 + fq; af[mi] = *(const bf16x8*)(sA + buf * 16384 + r * 128 + ((c ^ ((r >> 1) & 7)) << 4)); }
#pragma unroll
      for (int ni = 0; ni < 4; ++ni) { const int r = wn * 64 + ni * 16 + fr, c = kk * 4 + fq; bfr[ni] = *(const bf16x8*)(sB + buf * 16384 + r * 128 + ((c ^ ((r >> 1) & 7)) << 4)); }
#pragma unroll
      for (int mi = 0; mi < 4; ++mi)
#pragma unroll
        for (int ni = 0; ni < 4; ++ni) acc[mi][ni] = __builtin_amdgcn_mfma_f32_16x16x32_bf16(bfr[ni], af[mi], acc[mi][ni], 0, 0, 0);
    }
    if (kt + 1 < nk) SSTORE(buf ^ 1);
    __syncthreads();
  }
#undef GLOAD
#undef SSTORE
  ep(acc, tm * 128 + wm * 64, tn * 128 + wn * 64, lane);
}

#define LAS3 __attribute__((address_space(3)))
template <class EP>
__device__ __forceinline__ void gemm_tile_glds(const bf16_t* __restrict__ A, int lda, const bf16_t* __restrict__ Bt, int K, int tm, int tn, const EP& ep, char* smem) {
  const int tid = threadIdx.x, lane = tid & 63, wid = __builtin_amdgcn_readfirstlane(tid >> 6), wm = wid >> 1, wn = wid & 1;
  const int fr = lane & 15, fq = lane >> 4;
  f32x4 acc[4][4];
#pragma unroll
  for (int a = 0; a < 4; ++a)
#pragma unroll
    for (int b = 0; b < 4; ++b) acc[a][b] = (f32x4){0.f, 0.f, 0.f, 0.f};
  const int nk = K >> 6;
  const int lr = lane >> 3, c0 = (lane & 7) ^ (lr >> 1);
  const bf16_t* pa = A + (size_t)(tm * 128 + wid * 32 + lr) * lda;
  const bf16_t* pb = Bt + (size_t)(tn * 128 + wid * 32 + lr) * K;
#define GLDS(kt, buf) do { _Pragma("unroll") for (int i = 0; i < 4; ++i) { const int cc_ = (c0 ^ ((i & 1) << 2)) * 8 + (kt) * 64; \
    __builtin_amdgcn_global_load_lds((const unsigned*)(pa + (size_t)(i * 8) * lda + cc_), (LAS3 unsigned*)(smem + (buf) * 16384 + (wid * 4 + i) * 1024), 16, 0, 0); \
    __builtin_amdgcn_global_load_lds((const unsigned*)(pb + (size_t)(i * 8) * K + cc_), (LAS3 unsigned*)(smem + 32768 + (buf) * 16384 + (wid * 4 + i) * 1024), 16, 0, 0); } } while (0)
  GLDS(0, 0);
  asm volatile("s_waitcnt vmcnt(0)" ::: "memory");
  __syncthreads();
  for (int kt = 0; kt < nk; ++kt) {
    const int buf = kt & 1;
    bf16x8 af[2][4], bfr[2][4];
#pragma unroll
    for (int kk = 0; kk < 2; ++kk) {
#pragma unroll
      for (int mi = 0; mi < 4; ++mi) { const int r = wm * 64 + mi * 16 + fr, c = kk * 4 + fq; af[kk][mi] = *(const bf16x8*)(smem + buf * 16384 + r * 128 + ((c ^ ((r >> 1) & 7)) << 4)); }
#pragma unroll
      for (int ni = 0; ni < 4; ++ni) { const int r = wn * 64 + ni * 16 + fr, c = kk * 4 + fq; bfr[kk][ni] = *(const bf16x8*)(smem + 32768 + buf * 16384 + r * 128 + ((c ^ ((r >> 1) & 7)) << 4)); }
    }
    asm volatile("s_waitcnt lgkmcnt(0)" ::: "memory");
    if (kt + 1 < nk) GLDS(kt + 1, buf ^ 1);
#pragma unroll
    for (int kk = 0; kk < 2; ++kk)
#pragma unroll
      for (int mi = 0; mi < 4; ++mi)
#pragma unroll
        for (int ni = 0; ni < 4; ++ni) acc[mi][ni] = __builtin_amdgcn_mfma_f32_16x16x32_bf16(bfr[kk][ni], af[kk][mi], acc[mi][ni], 0, 0, 0);
    asm volatile("s_waitcnt vmcnt(0)" ::: "memory");
    __syncthreads();
  }
#undef GLDS
  ep(acc, tm * 128 + wm * 64, tn * 128 + wn * 64, lane);
}

struct EpiWin {
  const Params* pp;
  __device__ __forceinline__ void operator()(f32x4 (&acc)[4][4], int row0, int col0, int lane) const {
    const Params& p = *pp;
    const int fr = lane & 15, fq = lane >> 4;
    const bool sample = row0 >= NP;
    if (col0 < 640) {
      const bool isq = col0 < 512;
      const float* nw = isq ? p.q_norm : p.k_norm;
      float nwv[4][4];
#pragma unroll
      for (int ni = 0; ni < 4; ++ni)
#pragma unroll
        for (int j = 0; j < 4; ++j) nwv[ni][j] = nw[ni * 16 + fq * 4 + j];
#pragma unroll
      for (int mi = 0; mi < 4; ++mi) {
        const int row = row0 + mi * 16 + fr;
        float ss = 0.f;
#pragma unroll
        for (int ni = 0; ni < 4; ++ni)
#pragma unroll
          for (int j = 0; j < 4; ++j) ss += acc[mi][ni][j] * acc[mi][ni][j];
        ss += __shfl_xor(ss, 16); ss += __shfl_xor(ss, 32);
        const float rn = rsqrtf(ss * (1.f / 64.f) + 1e-6f);
        float y[4][4];
#pragma unroll
        for (int ni = 0; ni < 4; ++ni)
#pragma unroll
          for (int j = 0; j < 4; ++j) y[ni][j] = acc[mi][ni][j] * rn * nwv[ni][j];
        if (!sample && !isq) {
          const int kvh = (col0 - 512) >> 6;
#pragma unroll
          for (int ni = 0; ni < 4; ++ni) *(f32x4*)(p.out_k + (size_t)row * 128 + kvh * 64 + ni * 16 + fq * 4) = (f32x4){y[ni][0], y[ni][1], y[ni][2], y[ni][3]};
        }
        if (sample) {
          const int tl = (row - NP) & 1023;
          const float rp = (float)(tl >> 6), cp = (float)(tl & 63);
#pragma unroll
          for (int ni = 0; ni < 4; ++ni)
#pragma unroll
            for (int jp = 0; jp < 2; ++jp) {
              const int i = (ni * 16 + fq * 4 + jp * 2) >> 1;
              const float pos = i < 16 ? rp : cp;
              const float inv = exp2f(-(float)(i & 15) * 0.83048202372184058696f);
              const float ang = pos * inv;
              const float s = __sinf(ang), c = __cosf(ang);
              const float x0 = y[ni][2 * jp], x1 = y[ni][2 * jp + 1];
              y[ni][2 * jp] = x0 * c - x1 * s; y[ni][2 * jp + 1] = x0 * s + x1 * c;
            }
        }
        if (isq) {
          const float qs = 0.125f * 1.44269504088896f;
#pragma unroll
          for (int ni = 0; ni < 4; ++ni)
            *(uint2*)(p.Qbuf + (size_t)row * 512 + col0 + ni * 16 + fq * 4) = make_uint2(pk_bf16(y[ni][0] * qs, y[ni][1] * qs), pk_bf16(y[ni][2] * qs, y[ni][3] * qs));
        } else {
          const int kvh = (col0 - 512) >> 6;
          bf16_t* kd;
          if (!sample) kd = p.Kp + ((size_t)((row >> 8) * 2 + kvh) * 256 + (row & 255)) * 64;
          else kd = p.Ks + ((size_t)(((row - NP) >> 10) * 2 + kvh) * 1280 + ((row - NP) & 1023)) * 64;
#pragma unroll
          for (int ni = 0; ni < 4; ++ni)
            *(uint2*)(kd + ni * 16 + fq * 4) = make_uint2(pk_bf16(y[ni][0], y[ni][1]), pk_bf16(y[ni][2], y[ni][3]));
        }
      }
    } else if (col0 < 768) {
      const int kvh = (col0 - 640) >> 6;
#pragma unroll
      for (int mi = 0; mi < 4; ++mi) {
        const int row = row0 + mi * 16 + fr;
#pragma unroll
        for (int ni = 0; ni < 4; ++ni) {
          const int d0 = ni * 16 + fq * 4;
          if (!sample) {
            *(f32x4*)(p.out_v + (size_t)row * 128 + kvh * 64 + d0) = acc[mi][ni];
            bf16_t* vd = p.Vtp + ((size_t)((row >> 8) * 2 + kvh) * 64 + d0) * 256 + (row & 255);
#pragma unroll
            for (int j = 0; j < 4; ++j) vd[j * 256] = f2bf(acc[mi][ni][j]);
          } else {
            bf16_t* vd = p.Vts + ((size_t)(((row - NP) >> 10) * 2 + kvh) * 64 + d0) * 1280 + ((row - NP) & 1023);
#pragma unroll
            for (int j = 0; j < 4; ++j) vd[j * 1280] = f2bf(acc[mi][ni][j]);
          }
        }
      }
    } else {
      const int c0 = col0 - 768, seg = c0 >> 9;
      float oml[4][4];
      if (seg == 1 || seg == 2) {
#pragma unroll
        for (int ni = 0; ni < 4; ++ni)
#pragma unroll
          for (int j = 0; j < 4; ++j) { const int c = (c0 & 511) + ni * 16 + fq * 4 + j; oml[ni][j] = 1.f / (1.f + __expf(p.hgrn_lb[c] - p.hgrn_lb[512 + c])); }
      }
#pragma unroll
      for (int mi = 0; mi < 4; ++mi) {
        const int row = row0 + mi * 16 + fr;
#pragma unroll
        for (int ni = 0; ni < 4; ++ni) {
          float o[4];
#pragma unroll
          for (int j = 0; j < 4; ++j) {
            const float v = acc[mi][ni][j];
            if (seg == 0 || seg == 4) o[j] = siluf_(v);
            else if (seg == 3) o[j] = v;
            else o[j] = oml[ni][j] * sigmoidf_(-v);
          }
          *(uint2*)(p.HG + (size_t)row * 2560 + c0 + ni * 16 + fq * 4) = make_uint2(pk_bf16(o[0], o[1]), pk_bf16(o[2], o[3]));
        }
      }
    }
  }
};

struct EpiResid {
  const Params* pp; int layer, gidx; bool from_input; bool dry = false;
  __device__ __forceinline__ void operator()(f32x4 (&acc)[4][4], int row0, int col0, int lane) const {
    const Params& p = *pp;
    if (dry && p.njobs >= 0) return;
    const int fr = lane & 15, fq = lane >> 4;
    const float* gt = p.MOD + (size_t)(layer * 9 + mod_index(row0)) * 6144 + gidx * 1024;
#pragma unroll
    for (int mi = 0; mi < 4; ++mi) {
      const int row = row0 + mi * 16 + fr;
      const float* base = from_input ? (row < NP ? p.x_prompt + (size_t)row * 1024 : p.x_sample + (size_t)(row - NP) * 1024) : p.X + (size_t)row * 1024;
#pragma unroll
      for (int ni = 0; ni < 4; ++ni) {
        const int col = col0 + ni * 16 + fq * 4;
        const f32x4 b = *(const f32x4*)(base + col), g = *(const f32x4*)(gt + col);
        *(f32x4*)(p.X + (size_t)row * 1024 + col) = b + g * acc[mi][ni];
      }
    }
  }
};

template <int ACT>
struct EpiAct {
  bf16_t* O; int ldo; const float* bias;
  __device__ __forceinline__ void operator()(f32x4 (&acc)[4][4], int row0, int col0, int lane) const {
    const int fr = lane & 15, fq = lane >> 4;
#pragma unroll
    for (int ni = 0; ni < 4; ++ni) {
      const int col = col0 + ni * 16 + fq * 4;
      f32x4 bv = (f32x4){0.f, 0.f, 0.f, 0.f};
      if (ACT >= 4) bv = *(const f32x4*)(bias + col);
#pragma unroll
      for (int mi = 0; mi < 4; ++mi) {
        const int row = row0 + mi * 16 + fr;
        float o[4];
#pragma unroll
        for (int j = 0; j < 4; ++j) {
          const float v = acc[mi][ni][j] + bv[j];
          if (ACT == 0) o[j] = v;
          else if (ACT == 1) { const float r = fmaxf(v, 0.f); o[j] = r * r; }
          else if (ACT == 2) o[j] = 1.f - 2.f / (1.f + __expf(2.f * v));
          else if (ACT == 3 || ACT == 5) o[j] = sigmoidf_(v);
          else o[j] = 0.60653065971263342f * sigmoidf_(v);
        }
        *(uint2*)(O + (size_t)row * ldo + col) = make_uint2(pk_bf16(o[0], o[1]), pk_bf16(o[2], o[3]));
      }
    }
  }
};

struct EpiRwkvOut {
  const Params* pp;
  __device__ __forceinline__ void operator()(f32x4 (&acc)[4][4], int row0, int col0, int lane) const {
    const Params& p = *pp;
    const int fr = lane & 15, fq = lane >> 4, h = col0 >> 6;
#pragma unroll
    for (int mi = 0; mi < 4; ++mi) {
      const int row = row0 + mi * 16 + fr;
      float y[4][4]; float s = 0.f;
#pragma unroll
      for (int ni = 0; ni < 4; ++ni) {
        const size_t idx = (size_t)row * 1024 + col0 + ni * 16 + fq * 4;
        const uint2 a = *(const uint2*)(p.E0 + idx), b = *(const uint2*)(p.E1 + idx);
        y[ni][0] = bflo(a.x) + bflo(b.x); y[ni][1] = bfhi(a.x) + bfhi(b.x); y[ni][2] = bflo(a.y) + bflo(b.y); y[ni][3] = bfhi(a.y) + bfhi(b.y);
        s += (y[ni][0] + y[ni][1]) + (y[ni][2] + y[ni][3]);
      }
      s += __shfl_xor(s, 16); s += __shfl_xor(s, 32);
      const float mu = s * (1.f / 64.f);
      float q = 0.f;
#pragma unroll
      for (int ni = 0; ni < 4; ++ni)
#pragma unroll
        for (int j = 0; j < 4; ++j) { const float d = y[ni][j] - mu; q += d * d; }
      q += __shfl_xor(q, 16); q += __shfl_xor(q, 32);
      const float rs = rsqrtf(q * (1.f / 64.f) + 64e-5f);
      const float bs = p.BS[(size_t)row * 16 + h] + p.BS[(size_t)NTOK * 16 + (size_t)row * 16 + h];
#pragma unroll
      for (int ni = 0; ni < 4; ++ni) {
        const int col = col0 + ni * 16 + fq * 4;
        const size_t idx = (size_t)row * 1024 + col;
        const uint2 vv = *(const uint2*)(p.Vx + idx);
        const f32x4 lw = *(const f32x4*)(p.ln_w + col), lb = *(const f32x4*)(p.ln_b + col);
        const float v0 = bflo(vv.x), v1 = bfhi(vv.x), v2 = bflo(vv.y), v3 = bfhi(vv.y);
        const float o0 = ((y[ni][0] - mu) * rs * lw[0] + lb[0] + bs * v0) * acc[mi][ni][0];
        const float o1 = ((y[ni][1] - mu) * rs * lw[1] + lb[1] + bs * v1) * acc[mi][ni][1];
        const float o2 = ((y[ni][2] - mu) * rs * lw[2] + lb[2] + bs * v2) * acc[mi][ni][2];
        const float o3 = ((y[ni][3] - mu) * rs * lw[3] + lb[3] + bs * v3) * acc[mi][ni][3];
        *(uint2*)(p.ZO + idx) = make_uint2(pk_bf16(o0, o1), pk_bf16(o2, o3));
      }
    }
  }
};

template <class EP>
__device__ __forceinline__ void gemm_phase(const ALoadPlain& al, const bf16_t* Bt, int K, int ntn, const EP& ep, char* smem) {
  const int nunits = (NTOK / 128) * ntn;
  for (int u = blockIdx.x; u < nunits; u += gridDim.x) gemm_tile_glds(al.A, al.lda, Bt, K, u / ntn, u % ntn, ep, smem);
}

__device__ __forceinline__ void attn_item(const Params& p, int grp, int b, int h, int qb, char* smem) {
  const int tid = threadIdx.x, lane = tid & 63, wid = tid >> 6, qi = lane & 31, g = lane >> 5;
  const int Tk = grp ? 1280 : 256, kvh = h >> 2;
  const int rowbase = grp ? NP + b * 1024 + qb * 128 : b * 256 + qb * 128;
  const bf16_t* Kg = grp ? p.Ks + (size_t)(b * 2 + kvh) * 1280 * 64 : p.Kp + (size_t)(b * 2 + kvh) * 256 * 64;
  const bf16_t* Vg = grp ? p.Vts + (size_t)(b * 2 + kvh) * 64 * 1280 : p.Vtp + (size_t)(b * 2 + kvh) * 64 * 256;
  const int qrow = rowbase + wid * 32 + qi;
  bf16x8 Qf[4];
#pragma unroll
  for (int s = 0; s < 4; ++s) Qf[s] = *(const bf16x8*)(p.Qbuf + (size_t)qrow * 512 + h * 64 + s * 16 + g * 8);
  f32x16 O[2];
#pragma unroll
  for (int i = 0; i < 16; ++i) { O[0][i] = 0.f; O[1][i] = 0.f; }
  float m_run = -1e30f, l_run = 0.f;
  char* sK = smem; char* sV = smem + 16384;
  const int r0 = tid >> 3, c = tid & 7;
  uint4 pk[2], pv[2];
  const int ntile = Tk >> 6;
#define ALOAD(kt) do { _Pragma("unroll") for (int i = 0; i < 2; ++i) { const int r = r0 + 32 * i; pk[i] = *(const uint4*)(Kg + (size_t)((kt) * 64 + r) * 64 + c * 8); pv[i] = *(const uint4*)(Vg + (size_t)r * Tk + (kt) * 64 + c * 8); } } while (0)
#define ASTORE(buf) do { _Pragma("unroll") for (int i = 0; i < 2; ++i) { const int r = r0 + 32 * i; \
      *(uint4*)(sK + (buf) * 8192 + r * 128 + ((c ^ ((r >> 1) & 7)) << 4)) = pk[i]; \
      const int f = (r >> 1) & 15; \
      *(uint2*)(sV + (buf) * 8192 + r * 128 + (((2 * c) ^ f) << 3)) = make_uint2(pv[i].x, pv[i].y); \
      *(uint2*)(sV + (buf) * 8192 + r * 128 + (((2 * c + 1) ^ f) << 3)) = make_uint2(pv[i].z, pv[i].w); } } while (0)
  ALOAD(0); ASTORE(0); __syncthreads();
  for (int kt = 0; kt < ntile; ++kt) {
    const int buf = kt & 1;
    if (kt + 1 < ntile) ALOAD(kt + 1);
    f32x16 S[2];
#pragma unroll
    for (int t2 = 0; t2 < 2; ++t2) {
#pragma unroll
      for (int i = 0; i < 16; ++i) S[t2][i] = 0.f;
#pragma unroll
      for (int s = 0; s < 4; ++s) {
        const int r = t2 * 32 + qi, cc = 2 * s + g;
        const bf16x8 Kf = *(const bf16x8*)(sK + buf * 8192 + r * 128 + ((cc ^ ((r >> 1) & 7)) << 4));
        S[t2] = __builtin_amdgcn_mfma_f32_32x32x16_bf16(Kf, Qf[s], S[t2], 0, 0, 0);
      }
    }
    float mx = S[0][0];
#pragma unroll
    for (int i = 0; i < 16; ++i) { mx = fmaxf(mx, S[0][i]); mx = fmaxf(mx, S[1][i]); }
    mx = fmaxf(mx, __shfl_xor(mx, 32));
    const float m_new = fmaxf(m_run, mx);
    const float alpha = exp2f(m_run - m_new);
    float ls = 0.f;
#pragma unroll
    for (int i = 0; i < 16; ++i) { S[0][i] = exp2f(S[0][i] - m_new); S[1][i] = exp2f(S[1][i] - m_new); ls += S[0][i] + S[1][i]; }
    l_run = l_run * alpha + ls; m_run = m_new;
#pragma unroll
    for (int i = 0; i < 16; ++i) { O[0][i] *= alpha; O[1][i] *= alpha; }
#pragma unroll
    for (int t2 = 0; t2 < 2; ++t2)
#pragma unroll
      for (int sp = 0; sp < 2; ++sp) {
        union { bf16x8 v; unsigned u[4]; } Pf;
#pragma unroll
        for (int e = 0; e < 4; ++e) Pf.u[e] = pk_bf16(S[t2][8 * sp + 2 * e], S[t2][8 * sp + 2 * e + 1]);
#pragma unroll
        for (int ds = 0; ds < 2; ++ds) {
          const int d = ds * 32 + qi, f = (d >> 1) & 15, u1 = 8 * t2 + 4 * sp + g;
          union { bf16x8 v; uint2 u[2]; } Vf;
          Vf.u[0] = *(const uint2*)(sV + buf * 8192 + d * 128 + ((u1 ^ f) << 3));
          Vf.u[1] = *(const uint2*)(sV + buf * 8192 + d * 128 + (((u1 + 2) ^ f) << 3));
          O[ds] = __builtin_amdgcn_mfma_f32_32x32x16_bf16(Vf.v, Pf.v, O[ds], 0, 0, 0);
        }
      }
    if (kt + 1 < ntile) ASTORE(buf ^ 1);
    __syncthreads();
  }
#undef ALOAD
#undef ASTORE
  const float l = l_run + __shfl_xor(l_run, 32);
  const float inv = 1.f / l;
#pragma unroll
  for (int ds = 0; ds < 2; ++ds)
#pragma unroll
    for (int bq = 0; bq < 4; ++bq) {
      const int d0 = ds * 32 + 8 * bq + 4 * g;
      *(uint2*)(p.AO + (size_t)qrow * 1024 + h * 64 + d0) =
          make_uint2(pk_bf16(O[ds][4 * bq] * inv, O[ds][4 * bq + 1] * inv), pk_bf16(O[ds][4 * bq + 2] * inv, O[ds][4 * bq + 3] * inv));
    }
}

__device__ __forceinline__ void hgrn_item(const Params& p, int grp, int b, int h, int dir, int half, char* smem) {
  const int tid = threadIdx.x, v = half * 32 + (tid >> 3), ks = tid & 7;
  const int T = grp ? 1024 : 256, rowbase = grp ? NP + b * 1024 : b * 256;
  f32x2 S2[4];
  if (grp) {
    const float* s0 = (dir ? p.hg_b0 : p.hg_f0) + (size_t)(b * 8 + h) * 4096;
#pragma unroll
    for (int i = 0; i < 4; ++i) S2[i] = (f32x2){s0[(ks * 8 + 2 * i) * 64 + v], s0[(ks * 8 + 2 * i + 1) * 64 + v]};
  } else {
#pragma unroll
    for (int i = 0; i < 4; ++i) S2[i] = (f32x2){0.f, 0.f};
  }
  float* obuf = (float*)(smem + 32768);
  const int lt = tid >> 4, lc = (tid & 15) * 4;
  const int kfseg = dir ? 1024 : 512;
  uint2 rq, rk, rv;
  const int nch = T >> 4;
#define HLOAD(cix) do { const int ts = (cix) * 16 + lt; const int tok = dir ? T - 1 - ts : ts; const bf16_t* src = p.HG + (size_t)(rowbase + tok) * 2560 + h * 64 + lc; \
    rq = *(const uint2*)(src); rk = *(const uint2*)(src + kfseg); rv = *(const uint2*)(src + 1536); } while (0)
#define HSTORE(buf) do { float* B = (float*)(smem + (buf) * 16384) + lt * 64 + lc; \
    const float k0 = bflo(rk.x), k1 = bfhi(rk.x), k2 = bflo(rk.y), k3 = bfhi(rk.y); \
    *(float4*)(B) = make_float4(1.f - k0, 1.f - k1, 1.f - k2, 1.f - k3); *(float4*)(B + 1024) = make_float4(k0, k1, k2, k3); \
    *(float4*)(B + 2048) = make_float4(bflo(rq.x), bfhi(rq.x), bflo(rq.y), bfhi(rq.y)); *(float4*)(B + 3072) = make_float4(bflo(rv.x), bfhi(rv.x), bflo(rv.y), bfhi(rv.y)); } while (0)
  HLOAD(0); HSTORE(0); __syncthreads();
  float* OD = dir ? p.OB : p.OF;
  for (int cix = 0; cix < nch; ++cix) {
    const int buf = cix & 1;
    if (cix + 1 < nch) HLOAD(cix + 1);
    const float* B = (const float*)(smem + buf * 16384);
    float* ob = obuf + buf * 512;
#pragma unroll 4
    for (int t = 0; t < 16; ++t) {
      const float* Bt = B + t * 64 + ks * 8;
      const float vv = B[3072 + t * 64 + v];
      const f32x2 vvv = (f32x2){vv, vv};
      f32x2 o0 = (f32x2){0.f, 0.f}, o1 = (f32x2){0.f, 0.f};
#pragma unroll
      for (int q = 0; q < 2; ++q) {
        const float4 f4 = *(const float4*)(Bt + q * 4), k4 = *(const float4*)(Bt + 1024 + q * 4), q4 = *(const float4*)(Bt + 2048 + q * 4);
        S2[2 * q] = S2[2 * q] * (f32x2){f4.x, f4.y} + vvv * (f32x2){k4.x, k4.y};
        S2[2 * q + 1] = S2[2 * q + 1] * (f32x2){f4.z, f4.w} + vvv * (f32x2){k4.z, k4.w};
        o0 = S2[2 * q] * (f32x2){q4.x, q4.y} + o0; o1 = S2[2 * q + 1] * (f32x2){q4.z, q4.w} + o1;
      }
      const f32x2 os = o0 + o1;
      const float o = oct_sum(os.x + os.y);
      if (ks == 0) ob[t * 32 + (tid >> 3)] = o;
    }
    if (cix + 1 < nch) HSTORE(buf ^ 1);
    __syncthreads();
    if (tid < 128) {
      const int ft = tid >> 3, fc = (tid & 7) * 4;
      const int ts = cix * 16 + ft; const int tok = dir ? T - 1 - ts : ts;
      *(float4*)(OD + (size_t)(rowbase + tok) * 512 + h * 64 + half * 32 + fc) = *(const float4*)(ob + ft * 32 + fc);
    }
  }
#undef HLOAD
#undef HSTORE
  if (!grp) {
    float* so = (dir ? p.out_hb : p.out_hf) + (size_t)(b * 8 + h) * 4096;
#pragma unroll
    for (int i = 0; i < 4; ++i) { so[(ks * 8 + 2 * i) * 64 + v] = S2[i].x; so[(ks * 8 + 2 * i + 1) * 64 + v] = S2[i].y; }
  }
}

__device__ __forceinline__ void mix0_phase(const Params& p, char* smem) {
  for (int it = blockIdx.x; it < 1536; it += gridDim.x) {
    const bool is_h = it < 256 || (it >= 768 && it < 1280);
    if (is_h) {
      const int grp = it < 256 ? 1 : 0, a = grp ? it : it - 768;
      hgrn_item(p, grp, a >> 5, (a >> 2) & 7, (a >> 1) & 1, a & 1, smem);
    } else {
      const int grp = it < 768 ? 1 : 0, a = grp ? it - 256 : it - 1280;
      const int b = grp ? a >> 6 : a >> 4, h = grp ? (a >> 3) & 7 : (a >> 1) & 7, qb = grp ? a & 7 : a & 1;
      attn_item(p, grp, b, h, qb, smem);
    }
    __syncthreads();
  }
}

__device__ __forceinline__ void hgrn_combine_phase(const Params& p) {
  const int gid = blockIdx.x * NT + threadIdx.x, l16 = gid & 15;
  const int ngroups = NTOK * 8;
  for (int grp = gid >> 4; grp < ngroups; grp += (gridDim.x * NT) >> 4) {
    const int row = grp >> 3, h = grp & 7;
    const size_t o = (size_t)row * 512 + h * 64 + l16 * 4;
    const float4 a = *(const float4*)(p.OF + o), b = *(const float4*)(p.OB + o);
    const float y0 = a.x + b.x, y1 = a.y + b.y, y2 = a.z + b.z, y3 = a.w + b.w;
    float ss = y0 * y0 + y1 * y1 + y2 * y2 + y3 * y3;
    ss += __shfl_xor(ss, 1); ss += __shfl_xor(ss, 2); ss += __shfl_xor(ss, 4); ss += __shfl_xor(ss, 8);
    const float rn = rsqrtf(ss * (1.f / 64.f) + 1e-6f);
    const float4 gn = *(const float4*)(p.g_norm + l16 * 4);
    const uint2 gt = *(const uint2*)(p.HG + (size_t)row * 2560 + 2048 + h * 64 + l16 * 4);
    *(uint2*)(p.AO + (size_t)row * 1024 + 512 + h * 64 + l16 * 4) =
        make_uint2(pk_bf16(y0 * rn * gn.x * bflo(gt.x), y1 * rn * gn.y * bfhi(gt.x)), pk_bf16(y2 * rn * gn.z * bflo(gt.y), y3 * rn * gn.w * bfhi(gt.y)));
  }
}

__device__ __forceinline__ void rwkv_item(const Params& p, int grp, int b, int h, int dir, char* smem, bool dry = false) {
  const bool wr = !(dry && p.njobs >= 0);
  const int tid = threadIdx.x, lane = tid & 63, wid = tid >> 6, v = tid >> 2, ks = tid & 3;
  const int T = grp ? 1024 : 256, rowbase = grp ? NP + b * 1024 : b * 256;
  const int vp = tid >> 3, k8 = tid & 7;
  f32x2 Sa[4], Sb[4];
  if (grp) {
    const float* s0 = (dir ? p.rw_b0 : p.rw_f0) + ((size_t)(b * 16 + h) * 64 + vp) * 64 + k8 * 8;
#pragma unroll
    for (int q = 0; q < 2; ++q) {
      const float4 t = *(const float4*)(s0 + q * 4), u = *(const float4*)(s0 + 2048 + q * 4);
      Sa[2 * q] = (f32x2){t.x, t.y}; Sa[2 * q + 1] = (f32x2){t.z, t.w}; Sb[2 * q] = (f32x2){u.x, u.y}; Sb[2 * q + 1] = (f32x2){u.z, u.w};
    }
  } else {
#pragma unroll
    for (int i = 0; i < 4; ++i) { Sa[i] = (f32x2){0.f, 0.f}; Sb[i] = (f32x2){0.f, 0.f}; }
  }
  const bf16_t* E = dir ? p.E1 : p.E0; const bf16_t* A = dir ? p.A1 : p.A0; bf16_t* Y = dir ? p.E1 : p.E0;
  const float kkc = p.k_k[h * 64 + lane], kac = p.k_a[h * 64 + lane], rkc = p.r_k[h * 64 + lane];
  float* BSd = p.BS + (size_t)dir * NTOK * 16;
  float* ybuf = (float*)(smem + 49152);
  float rg[4][5];
  const int nch = T >> 4;
  const int lt = tid >> 4, lc = (tid & 15) * 4;
#define RLOAD(cix) do { _Pragma("unroll") for (int i = 0; i < 4; ++i) { const int ts = (cix) * 16 + wid * 4 + i; const int tok = dir ? T - 1 - ts : ts; \
    const size_t idx = (size_t)(rowbase + tok) * 1024 + h * 64 + lane; \
    rg[i][0] = bf2f(p.R[idx]); rg[i][1] = bf2f(p.Kx[idx]); rg[i][2] = bf2f(p.Vx[idx]); rg[i][3] = bf2f(E[idx]); rg[i][4] = bf2f(A[idx]); } } while (0)
#define RSTORE(cix, buf) do { _Pragma("unroll") for (int i = 0; i < 4; ++i) { const int tl_ = wid * 4 + i; const int ts = (cix) * 16 + tl_; const int tok = dir ? T - 1 - ts : ts; \
    const float r_ = rg[i][0], k_ = rg[i][1], v_ = rg[i][2], e_ = rg[i][3], a_ = rg[i][4]; \
    const float kx = k_ * kkc; const float ssq = wave_sum(kx * kx); const float kk = kx * rsqrtf(fmaxf(ssq, 1e-24f)); \
    const float kd = k_ * (1.f + (a_ - 1.f) * kac); const float bsum = wave_sum(r_ * kd * rkc); \
    float* B = (float*)(smem + (buf) * 24576) + tl_ * 64 + lane; \
    B[0] = __expf(-e_); B[1024] = kk; B[2048] = kk * a_; B[3072] = kd; B[4096] = r_; B[5120] = v_; \
    if (lane == 0 && wr) BSd[(size_t)(rowbase + tok) * 16 + h] = bsum; } } while (0)
  RLOAD(0); RSTORE(0, 0); __syncthreads();
  for (int cix = 0; cix < nch; ++cix) {
    const int buf = cix & 1;
    if (cix + 1 < nch) RLOAD(cix + 1);
    const float* B = (const float*)(smem + buf * 24576);
    float* yb = ybuf + buf * 1024;
#pragma unroll 4
    for (int t = 0; t < 16; ++t) {
      const float* Bt = B + t * 64 + k8 * 8;
      const float va = B[5120 + t * 64 + vp], vb = B[5120 + t * 64 + vp + 32];
      f32x2 w2[4], kk2[4];
#pragma unroll
      for (int q = 0; q < 2; ++q) {
        const float4 w4 = *(const float4*)(Bt + q * 4), k4 = *(const float4*)(Bt + 1024 + q * 4);
        w2[2 * q] = (f32x2){w4.x, w4.y}; w2[2 * q + 1] = (f32x2){w4.z, w4.w};
        kk2[2 * q] = (f32x2){k4.x, k4.y}; kk2[2 * q + 1] = (f32x2){k4.z, k4.w};
      }
      const f32x2 sa_a = (Sa[0] * kk2[0] + Sa[1] * kk2[1]) + (Sa[2] * kk2[2] + Sa[3] * kk2[3]);
      const f32x2 sa_b = (Sb[0] * kk2[0] + Sb[1] * kk2[1]) + (Sb[2] * kk2[2] + Sb[3] * kk2[3]);
      const float saa = -oct_sum(sa_a.x + sa_a.y), sab = -oct_sum(sa_b.x + sa_b.y);
      const f32x2 saav = (f32x2){saa, saa}, sabv = (f32x2){sab, sab}, vav = (f32x2){va, va}, vbv = (f32x2){vb, vb};
      f32x2 ya = (f32x2){0.f, 0.f}, yb2 = (f32x2){0.f, 0.f};
#pragma unroll
      for (int q = 0; q < 2; ++q) {
        const float4 ka = *(const float4*)(Bt + 2048 + q * 4), kd = *(const float4*)(Bt + 3072 + q * 4), r4 = *(const float4*)(Bt + 4096 + q * 4);
        const f32x2 ka0 = (f32x2){ka.x, ka.y}, ka1 = (f32x2){ka.z, ka.w}, kd0 = (f32x2){kd.x, kd.y}, kd1 = (f32x2){kd.z, kd.w};
        const f32x2 r0 = (f32x2){r4.x, r4.y}, r1 = (f32x2){r4.z, r4.w};
        Sa[2 * q] = Sa[2 * q] * w2[2 * q] + (vav * kd0 + saav * ka0); Sa[2 * q + 1] = Sa[2 * q + 1] * w2[2 * q + 1] + (vav * kd1 + saav * ka1);
        Sb[2 * q] = Sb[2 * q] * w2[2 * q] + (vbv * kd0 + sabv * ka0); Sb[2 * q + 1] = Sb[2 * q + 1] * w2[2 * q + 1] + (vbv * kd1 + sabv * ka1);
        ya = Sa[2 * q] * r0 + ya; ya = Sa[2 * q + 1] * r1 + ya;
        yb2 = Sb[2 * q] * r0 + yb2; yb2 = Sb[2 * q + 1] * r1 + yb2;
      }
      const float y_a = oct_sum(ya.x + ya.y), y_b = oct_sum(yb2.x + yb2.y);
      if (k8 == 0) { yb[t * 64 + vp] = y_a; yb[t * 64 + vp + 32] = y_b; }
    }
    if (cix + 1 < nch) RSTORE(cix + 1, buf ^ 1);
    __syncthreads();
    {
      const int ts = cix * 16 + lt; const int tok = dir ? T - 1 - ts : ts;
      const float4 yy = *(const float4*)(yb + lt * 64 + lc);
      if (wr) *(uint2*)(Y + (size_t)(rowbase + tok) * 1024 + h * 64 + lc) = make_uint2(pk_bf16(yy.x, yy.y), pk_bf16(yy.z, yy.w));
    }
  }
#undef RLOAD
#undef RSTORE
  if (!grp && wr) {
    float* so = (dir ? p.out_rb : p.out_rf) + ((size_t)(b * 16 + h) * 64 + vp) * 64 + k8 * 8;
#pragma unroll
    for (int q = 0; q < 2; ++q) {
      *(float4*)(so + q * 4) = make_float4(Sa[2 * q].x, Sa[2 * q].y, Sa[2 * q + 1].x, Sa[2 * q + 1].y);
      *(float4*)(so + 2048 + q * 4) = make_float4(Sb[2 * q].x, Sb[2 * q].y, Sb[2 * q + 1].x, Sb[2 * q + 1].y);
    }
  }
}

__device__ __forceinline__ void rwkv_scan_phase(const Params& p, char* smem, bool dry = false) {
  const int G = gridDim.x;
  if (G >= 512) {
    if (blockIdx.x < 256) { const int a = blockIdx.x; rwkv_item(p, 1, a >> 5, (a >> 1) & 15, a & 1, smem, dry); }
    else for (int a = blockIdx.x - 256; a < 512; a += G - 256) { rwkv_item(p, 0, a >> 5, (a >> 1) & 15, a & 1, smem, dry); __syncthreads(); }
  } else {
    for (int it = blockIdx.x; it < 768; it += G) {
      const int grp = it < 256 ? 1 : 0, a = grp ? it : it - 256;
      rwkv_item(p, grp, a >> 5, (a >> 1) & 15, a & 1, smem, dry);
      __syncthreads();
    }
  }
}

__device__ __forceinline__ void rwkv_proj_phase(const Params& p, char* smem) {
  const int nunits = 96 * 27;
  for (int u = blockIdx.x; u < nunits; u += gridDim.x) {
    const int tm = u / 27, s = u % 27;
    if (s < 8) { ALoadShift al{p.H, p.mix + 0 * 1024}; EpiAct<0> ep{p.R, 1024, nullptr}; gemm_tile(al, p.wr_t, 1024, tm, s, ep, smem); }
    else if (s < 16) { ALoadShift al{p.H, p.mix + 2 * 1024}; EpiAct<0> ep{p.Kx, 1024, nullptr}; gemm_tile(al, p.wk_t, 1024, tm, s - 8, ep, smem); }
    else if (s < 24) { ALoadShift al{p.H, p.mix + 3 * 1024}; EpiAct<0> ep{p.Vx, 1024, nullptr}; gemm_tile(al, p.wv_t, 1024, tm, s - 16, ep, smem); }
    else if (s == 24) { ALoadShift al{p.H, p.mix + 1 * 1024}; EpiAct<2> ep{p.LW, 128, nullptr}; gemm_tile(al, p.w1cat_t, 1024, tm, 0, ep, smem); }
    else if (s == 25) { ALoadShift al{p.H, p.mix + 4 * 1024}; EpiAct<0> ep{p.LA, 128, nullptr}; gemm_tile(al, p.a1cat_t, 1024, tm, 0, ep, smem); }
    else { ALoadShift al{p.H, p.mix + 5 * 1024}; EpiAct<3> ep{p.LG, 128, nullptr}; gemm_tile(al, p.g1_t, 1024, tm, 0, ep, smem); }
  }
}
__device__ __forceinline__ void rwkv_lora2_phase(const Params& p, char* smem) {
  const int nunits = 96 * 32;
  for (int u = blockIdx.x; u < nunits; u += gridDim.x) {
    const int tm = u >> 5, s = u & 31, which = s >> 3, tn = s & 7;
    const int d = which & 1;
    if (which < 2) { ALoadPlain al{p.LW + d * 64, 128}; EpiAct<4> ep{d ? p.E1 : p.E0, 1024, p.w0 + d * 1024}; gemm_tile_glds(al.A, al.lda, p.w2_t + (size_t)d * 65536, 64, tm, tn, ep, smem); }
    else { ALoadPlain al{p.LA + d * 64, 128}; EpiAct<5> ep{d ? p.A1 : p.A0, 1024, p.a0 + d * 1024}; gemm_tile_glds(al.A, al.lda, p.a2_t + (size_t)d * 65536, 64, tm, tn, ep, smem); }
  }
}


#define XB_TMO      128
#define XB_XCNT(j)  (256  + 64 * (j))
#define XB_XSUB(j)  (1280 + 64 * (j))
#define XB_XGEN(j)  (2304 + 64 * (j))
#define XB_TOP      3328
#define XB_TOPGEN   3392
#define XCD_BAR_WORDS 3456
#define XB_SPIN_CAP (1u << 22)
#define LAS __attribute__((address_space(3)))
__device__ __forceinline__ unsigned xb_ld(unsigned* p)              { return __hip_atomic_load(p, __ATOMIC_RELAXED, __HIP_MEMORY_SCOPE_AGENT); }
__device__ __forceinline__ unsigned xb_add(unsigned* p, unsigned v) { return __hip_atomic_fetch_add(p, v, __ATOMIC_RELAXED, __HIP_MEMORY_SCOPE_AGENT); }
__device__ __forceinline__ unsigned xb_xcc_id() { return (unsigned)__builtin_amdgcn_s_getreg((3 << 11) | 20) & 0xFu; }
#define XB_SPIN(cond, bar) do { unsigned _sp = 0; while (cond) { __builtin_amdgcn_s_sleep(1); \
    if ((++_sp & 255u) == 0u) { if (xb_ld(&(bar)[XB_TMO])) break; if (_sp > XB_SPIN_CAP) { atomicAdd(&(bar)[XB_TMO], 1u); break; } } } } while (0)
struct XcdBarrier { unsigned* bar; unsigned x; volatile LAS unsigned* st; };
__device__ __forceinline__ XcdBarrier xcd_barrier_post(unsigned* bar, volatile LAS unsigned* st) {
    XcdBarrier b; b.bar = bar; b.x = xb_xcc_id(); b.st = st;
    if (threadIdx.x == 0) (void)xb_add(&bar[XB_XCNT(b.x)], 1u);
    return b;
}
__device__ __forceinline__ void xcd_barrier_complete(unsigned* bar, unsigned x, unsigned& nloc, unsigned& nx) {
    const unsigned G = gridDim.x * gridDim.y * gridDim.z;
    unsigned sum, cnt, mine, sp = 0u;
    for (;;) {
        sum = 0u; cnt = 0u; mine = 0u;
#pragma unroll
        for (unsigned j = 0; j < 16; ++j) { const unsigned c = xb_ld(&bar[XB_XCNT(j)]); sum += c; cnt += (c > 0u) ? 1u : 0u; mine = (j == x) ? c : mine; }
        if (sum == G) break;
        __builtin_amdgcn_s_sleep(1);
        if ((++sp & 255u) == 0u) { if (xb_ld(&bar[XB_TMO])) break; if (sp > XB_SPIN_CAP) { atomicAdd(&bar[XB_TMO], 1u); break; } }
    }
    nloc = mine > 0u ? mine : 1u; nx = cnt > 0u ? cnt : 1u;
}
__device__ __forceinline__ void xcd_barrier(const XcdBarrier& b) {
    asm volatile("s_waitcnt vmcnt(0)" ::: "memory");
    __syncthreads();
    if (threadIdx.x == 0) {
        unsigned* bar = b.bar;
        __builtin_amdgcn_s_waitcnt(0);
        unsigned nloc = b.st[0], nx = b.st[1];
        if (nloc == 0u) { xcd_barrier_complete(bar, b.x, nloc, nx); b.st[0] = nloc; b.st[1] = nx; }
        const unsigned old = xb_add(&bar[XB_XSUB(b.x)], 1u);
        const unsigned gen = old / nloc;
        if (old + 1u == (gen + 1u) * nloc) {
            __builtin_amdgcn_fence(__ATOMIC_RELEASE, "agent");
            asm volatile("s_waitcnt vmcnt(0)" ::: "memory");
            const unsigned og = xb_add(&bar[XB_TOP], 1u);
            const unsigned tg = og / nx;
            if (og + 1u == (tg + 1u) * nx) xb_add(&bar[XB_TOPGEN], 1u);
            else XB_SPIN(xb_ld(&bar[XB_TOPGEN]) == tg, bar);
            __builtin_amdgcn_fence(__ATOMIC_ACQUIRE, "agent");
            xb_add(&bar[XB_XGEN(b.x)], 1u);
            asm volatile("s_waitcnt vmcnt(0)" ::: "memory");
        } else {
            XB_SPIN(xb_ld(&bar[XB_XGEN(b.x)]) == gen, bar);
            __builtin_amdgcn_fence(__ATOMIC_ACQUIRE, "agent");
            asm volatile("s_waitcnt vmcnt(0)" ::: "memory");
        }
    }
    __syncthreads();
}

__device__ __forceinline__ void run_phase(const Params& p, int ph, char* smem, bool dry = false) {
  switch (ph) {
    case 0: if (ONLY_PHASE < 0 || ONLY_PHASE == 0) phase0(p, smem); break;
    case 1: if (ONLY_PHASE < 0 || ONLY_PHASE == 1) prenorm_phase(p, 0, 0, true); break;
    case 2: if (ONLY_PHASE < 0 || ONLY_PHASE == 2) { ALoadPlain al{p.H, 1024}; EpiWin ep{&p}; gemm_phase(al, p.w_in_t, 1024, 26, ep, smem); } break;
    case 3: if (ONLY_PHASE < 0 || ONLY_PHASE == 3) mix0_phase(p, smem); break;
    case 4: if (ONLY_PHASE < 0 || ONLY_PHASE == 4) hgrn_combine_phase(p); break;
    case 5: if (ONLY_PHASE < 0 || ONLY_PHASE == 5) { ALoadPlain al{p.AO, 1024}; EpiResid ep{&p, 0, 2, true}; gemm_phase(al, p.w_out_t, 1024, 8, ep, smem); } break;
    case 6: if (ONLY_PHASE < 0 || ONLY_PHASE == 6) prenorm_phase(p, 0, 1, false); break;
    case 7: if (ONLY_PHASE < 0 || ONLY_PHASE == 7) { ALoadPlain al{p.H, 1024}; EpiAct<1> ep{p.U, 4096, nullptr}; gemm_phase(al, p.mlp1_t, 1024, 32, ep, smem); } break;
    case 8: if (ONLY_PHASE < 0 || ONLY_PHASE == 8) { ALoadPlain al{p.U, 4096}; EpiResid ep{&p, 0, 5, false, dry}; gemm_phase(al, p.mlp2_t, 4096, 8, ep, smem); } break;
    case 9: if (ONLY_PHASE < 0 || ONLY_PHASE == 9) prenorm_phase(p, 1, 0, false); break;
    case 10: if (ONLY_PHASE < 0 || ONLY_PHASE == 10) rwkv_proj_phase(p, smem); break;
    case 11: if (ONLY_PHASE < 0 || ONLY_PHASE == 11) rwkv_lora2_phase(p, smem); break;
    case 12: if (ONLY_PHASE < 0 || ONLY_PHASE == 12) rwkv_scan_phase(p, smem, dry); break;
    case 13: if (ONLY_PHASE < 0 || ONLY_PHASE == 13) { ALoadPlain al{p.LG, 128}; EpiRwkvOut ep{&p}; gemm_phase(al, p.g2_t, 128, 8, ep, smem); } break;
    case 14: if (ONLY_PHASE < 0 || ONLY_PHASE == 14) { ALoadPlain al{p.ZO, 1024}; EpiResid ep{&p, 1, 2, false, dry}; gemm_phase(al, p.wo_t, 1024, 8, ep, smem); } break;
    case 15: if (ONLY_PHASE < 0 || ONLY_PHASE == 15) prenorm_phase(p, 1, 1, false); break;
    case 16: if (ONLY_PHASE < 0 || ONLY_PHASE == 16) { ALoadPlain al{p.H, 1024}; EpiAct<1> ep{p.U, 4096, nullptr}; gemm_phase(al, p.mlp1_t + (size_t)4096 * 1024, 1024, 32, ep, smem); } break;
    case 17: if (ONLY_PHASE < 0 || ONLY_PHASE == 17) { ALoadPlain al{p.U, 4096}; EpiResid ep{&p, 1, 5, false, dry}; gemm_phase(al, p.mlp2_t + (size_t)4096 * 1024, 4096, 8, ep, smem); } break;
    default: break;
  }
}

__global__ void __launch_bounds__(NT, 2) fwd_kernel(const Params p_unused, int ph_lo, int ph_hi) {
  const Params& p = *(const Params*)__builtin_amdgcn_kernarg_segment_ptr();
  __shared__ __attribute__((aligned(16))) char smem[65536];
  __shared__ uint4 xb_words;
  if (threadIdx.x == 0) xb_words = make_uint4(0u, 0u, 0u, 0u);
  __syncthreads();
  XcdBarrier xb = xcd_barrier_post(p.bar, (volatile LAS unsigned*)&xb_words);
  if (ph_hi < 0) cg::this_grid().sync();
#ifndef PROBE_MASK
#define PROBE_MASK 0
#endif
#ifndef PROBE_DRY
#define PROBE_DRY 0
#endif
#define PHASE(n) if (ph_lo <= n && n < ph_hi) { if ((PROBE_MASK >> n) & 1) { run_phase(p, n, smem); xcd_barrier(xb); } if ((PROBE_DRY >> n) & 1) { run_phase(p, n, smem, true); xcd_barrier(xb); } run_phase(p, n, smem); if (n + 1 < ph_hi) xcd_barrier(xb); }
  PHASE(0) PHASE(1) PHASE(2) PHASE(3) PHASE(4) PHASE(5) PHASE(6) PHASE(7) PHASE(8) PHASE(9)
  PHASE(10) PHASE(11) PHASE(12) PHASE(13) PHASE(14) PHASE(15) PHASE(16) PHASE(17)
#undef PHASE
}

extern "C" void kernel_launch(void* const* d_in, const int* in_sizes, int n_in, void* d_out, int out_size, void* d_ws, size_t ws_size, hipStream_t stream) {
  Params p; memset(&p, 0, sizeof(p));
  auto F = [&](int i) { return (const float*)d_in[i]; };
  p.x_prompt = F(0); p.x_sample = F(1); p.cache_k = F(2); p.cache_v = F(3); p.hg_f0 = F(4); p.hg_b0 = F(5); p.rw_f0 = F(6); p.rw_b0 = F(7);
  p.c = F(8); p.c_ctx = F(9); p.ada_w = F(10); p.ada_b = F(11); p.norm1_w = F(12); p.norm2_w = F(13);
  p.q_norm = F(16); p.k_norm = F(17); p.hgrn_lb = F(18); p.g_norm = F(19); p.mix = F(20);
  p.w0 = F(25); p.a0 = F(28); p.k_k = F(33); p.k_a = F(34); p.r_k = F(35); p.ln_w = F(36); p.ln_b = F(37);
  float* out = (float*)d_out;
  p.X = out; p.out_k = out + 12582912; p.out_v = out + 13107200; p.out_hf = out + 13631488; p.out_hb = out + 14155776;
  p.out_rf = out + 14680064; p.out_rb = out + 15728640;
  char* ws = (char*)d_ws; size_t off = 16384;
  p.bar = (unsigned*)ws;
  auto alloc = [&](size_t bytes) { char* r = ws + off; off += (bytes + 255) & ~(size_t)255; return r; };
  const size_t M1 = (size_t)1024 * 1024;
  p.w_in_t = (bf16_t*)alloc((size_t)3328 * 1024 * 2); p.w_out_t = (bf16_t*)alloc(M1 * 2);
  p.wr_t = (bf16_t*)alloc(M1 * 2); p.wk_t = (bf16_t*)alloc(M1 * 2); p.wv_t = (bf16_t*)alloc(M1 * 2); p.wo_t = (bf16_t*)alloc(M1 * 2);
  p.w1cat_t = (bf16_t*)alloc(128 * 1024 * 2); p.a1cat_t = (bf16_t*)alloc(128 * 1024 * 2); p.g1_t = (bf16_t*)alloc(128 * 1024 * 2);
  p.w2_t = (bf16_t*)alloc(2 * 1024 * 64 * 2); p.a2_t = (bf16_t*)alloc(2 * 1024 * 64 * 2); p.g2_t = (bf16_t*)alloc(1024 * 128 * 2);
  p.mlp1_t = (bf16_t*)alloc(2 * 4 * M1 * 2); p.mlp2_t = (bf16_t*)alloc(2 * 4 * M1 * 2);
  p.MOD = (float*)alloc((size_t)2 * 9 * 6144 * 4);
  const size_t TOKD = (size_t)NTOK * 1024;
  p.H = (bf16_t*)alloc(TOKD * 2);
  const size_t regL = off;
  p.Qbuf = (bf16_t*)alloc((size_t)NTOK * 512 * 2);
  p.Kp = (bf16_t*)alloc((size_t)32 * 256 * 64 * 2); p.Ks = (bf16_t*)alloc((size_t)16 * 1280 * 64 * 2);
  p.Vtp = (bf16_t*)alloc((size_t)32 * 64 * 256 * 2); p.Vts = (bf16_t*)alloc((size_t)16 * 64 * 1280 * 2);
  p.HG = (bf16_t*)alloc((size_t)NTOK * 2560 * 2);
  p.OF = (float*)alloc((size_t)NTOK * 512 * 4); p.OB = (float*)alloc((size_t)NTOK * 512 * 4);
  p.AO = (bf16_t*)alloc(TOKD * 2);
  size_t end0 = off;
  off = regL; p.U = (bf16_t*)alloc((size_t)NTOK * 4096 * 2);
  size_t endU = off;
  off = regL;
  p.R = (bf16_t*)alloc(TOKD * 2); p.Kx = (bf16_t*)alloc(TOKD * 2); p.Vx = (bf16_t*)alloc(TOKD * 2);
  p.LW = (bf16_t*)alloc((size_t)NTOK * 128 * 2); p.LA = (bf16_t*)alloc((size_t)NTOK * 128 * 2); p.LG = (bf16_t*)alloc((size_t)NTOK * 128 * 2);
  p.E0 = (bf16_t*)alloc(TOKD * 2); p.E1 = (bf16_t*)alloc(TOKD * 2); p.A1 = (bf16_t*)alloc(TOKD * 2);
  p.BS = (float*)alloc((size_t)2 * NTOK * 16 * 4);
  p.A0 = p.H; p.ZO = p.R;
  size_t end1 = off;
  size_t need = end0 > end1 ? end0 : end1; if (endU > need) need = endU;
  if (need > ws_size) fprintf(stderr, "workspace too small: need %zu have %zu\n", need, ws_size);
  int nj = 0, tiles = 0;
  auto job = [&](const float* src, bf16_t* dst, int K, int N) { p.jobs[nj].src = src; p.jobs[nj].dst = dst; p.jobs[nj].K = K; p.jobs[nj].N = N; p.jobs[nj].tile0 = tiles; p.jobs[nj].pad = 0; tiles += (K / 64) * (N / 64); ++nj; };
  job(F(38), p.mlp1_t, 1024, 4096); job(F(38) + 4 * M1, p.mlp1_t + 4 * M1, 1024, 4096);
  job(F(39), p.mlp2_t, 4096, 1024); job(F(39) + 4 * M1, p.mlp2_t + 4 * M1, 4096, 1024);
  job(F(14), p.w_in_t, 1024, 3328); job(F(15), p.w_out_t, 1024, 1024);
  job(F(21), p.wr_t, 1024, 1024); job(F(22), p.wk_t, 1024, 1024); job(F(23), p.wv_t, 1024, 1024); job(F(24), p.wo_t, 1024, 1024);
  job(F(26), p.w1cat_t, 1024, 64); job(F(26) + 65536, p.w1cat_t + 65536, 1024, 64);
  job(F(29), p.a1cat_t, 1024, 64); job(F(29) + 65536, p.a1cat_t + 65536, 1024, 64);
  job(F(31), p.g1_t, 1024, 128);
  job(F(27), p.w2_t, 64, 1024); job(F(27) + 65536, p.w2_t + 65536, 64, 1024);
  job(F(30), p.a2_t, 64, 1024); job(F(30) + 65536, p.a2_t + 65536, 64, 1024);
  job(F(32), p.g2_t, 128, 1024);
  p.njobs = nj; p.ntiles = tiles;

  static int grid_blocks = 0;
  if (!grid_blocks) {
    int dev = 0, cus = 0, per_cu = 0;
    hipGetDevice(&dev);
    hipDeviceGetAttribute(&cus, hipDeviceAttributeMultiprocessorCount, dev);
    hipOccupancyMaxActiveBlocksPerMultiprocessor(&per_cu, fwd_kernel, NT, 0);
    if (per_cu > 2) per_cu = 2;
    if (per_cu < 1) per_cu = 1;
    grid_blocks = cus * per_cu;
  }
  hipMemsetAsync(d_ws, 0, 16384, stream);
#if ONE_LAUNCH
  int lo = 0, hi = NPHASES;
  void* args[] = {(void*)&p, (void*)&lo, (void*)&hi};
  hipError_t e = hipLaunchCooperativeKernel((void*)fwd_kernel, dim3(grid_blocks), dim3(NT), args, 0, stream);
  if (e != hipSuccess) fprintf(stderr, "cooperative launch failed: %s (grid %d)\n", hipGetErrorString(e), grid_blocks);
#else
  for (int ph = 0; ph < NPHASES; ++ph) hipLaunchKernelGGL(fwd_kernel, dim3(grid_blocks), dim3(NT), 0, stream, p, ph, ph + 1);
#endif
}
```

```cpp
#include <hip/hip_runtime.h>
#include <hip/hip_cooperative_groups.h>
#include <stdint.h>
#include <string.h>
#include <stdio.h>
namespace cg = cooperative_groups;

#ifndef ONE_LAUNCH
#define ONE_LAUNCH 1
#endif

typedef unsigned short bf16_t;
typedef short bf16x8 __attribute__((ext_vector_type(8)));
typedef float f32x4 __attribute__((ext_vector_type(4)));
typedef float f32x16 __attribute__((ext_vector_type(16)));
typedef float f32x2 __attribute__((ext_vector_type(2)));

#define NT 256
#define NTOK 12288
#define NP 4096
#define NPHASES 18
#ifndef ONLY_PHASE
#define ONLY_PHASE -1
#endif

struct TJob { const float* src; bf16_t* dst; int K, N, tile0, pad; };

struct Params {
  const float *x_prompt, *x_sample, *cache_k, *cache_v, *hg_f0, *hg_b0, *rw_f0, *rw_b0, *c, *c_ctx;
  const float *ada_w, *ada_b, *norm1_w, *norm2_w, *q_norm, *k_norm, *hgrn_lb, *g_norm;
  const float *mix, *w0, *a0, *k_k, *k_a, *r_k, *ln_w, *ln_b;
  float *X, *out_k, *out_v, *out_hf, *out_hb, *out_rf, *out_rb;
  bf16_t *w_in_t, *w_out_t, *wr_t, *wk_t, *wv_t, *wo_t, *w1cat_t, *a1cat_t, *g1_t, *w2_t, *a2_t, *g2_t, *mlp1_t, *mlp2_t;
  float* MOD;
  bf16_t* H;
  bf16_t *Qbuf, *Kp, *Ks, *Vtp, *Vts, *HG, *AO, *U;
  float *OF, *OB;
  bf16_t *R, *Kx, *Vx, *LW, *LA, *LG, *E0, *E1, *A0, *A1, *ZO;
  float* BS;
  unsigned* bar;
  TJob jobs[20];
  int njobs, ntiles;
};

__device__ __forceinline__ unsigned pk_bf16(float lo, float hi) { unsigned r; asm("v_cvt_pk_bf16_f32 %0, %1, %2" : "=v"(r) : "v"(lo), "v"(hi)); return r; }
__device__ __forceinline__ bf16_t f2bf(float v) { return (bf16_t)(pk_bf16(v, 0.f) & 0xffffu); }
__device__ __forceinline__ float bf2f(bf16_t v) { return __uint_as_float(((unsigned)v) << 16); }
__device__ __forceinline__ float bflo(unsigned u) { return __uint_as_float(u << 16); }
__device__ __forceinline__ float bfhi(unsigned u) { return __uint_as_float(u & 0xffff0000u); }
__device__ __forceinline__ float sigmoidf_(float x) { return 1.f / (1.f + __expf(-x)); }
__device__ __forceinline__ float siluf_(float x) { return x / (1.f + __expf(-x)); }
__device__ __forceinline__ float wave_sum(float v) {
#pragma unroll
  for (int o = 32; o >= 1; o >>= 1) v += __shfl_xor(v, o);
  return v;
}
__device__ __forceinline__ float quad_sum(float v) {
  v += __int_as_float(__builtin_amdgcn_update_dpp(0, __float_as_int(v), 0xB1, 0xF, 0xF, true));
  v += __int_as_float(__builtin_amdgcn_update_dpp(0, __float_as_int(v), 0x4E, 0xF, 0xF, true));
  return v;
}
__device__ __forceinline__ float oct_sum(float v) {
  v += __int_as_float(__builtin_amdgcn_update_dpp(0, __float_as_int(v), 0xB1, 0xF, 0xF, true));
  v += __int_as_float(__builtin_amdgcn_update_dpp(0, __float_as_int(v), 0x4E, 0xF, 0xF, true));
  v += __int_as_float(__builtin_amdgcn_update_dpp(0, __float_as_int(v), 0x141, 0xF, 0xF, true));
  return v;
}
__device__ __forceinline__ float hex_sum(float v) {
  v = oct_sum(v);
  v += __int_as_float(__builtin_amdgcn_update_dpp(0, __float_as_int(v), 0x140, 0xF, 0xF, true));
  return v;
}
__device__ __forceinline__ int mod_index(int row) { return row < NP ? 0 : 1 + ((row - NP) >> 10); }

__device__ __forceinline__ void ada_item(const Params& p, int it, char* smem) {
  const int tid = threadIdx.x;
  float* sil = (float*)smem;
  for (int i = tid; i < 9 * 1024; i += NT) {
    int n = i >> 10, k = i & 1023;
    float cv = n == 0 ? p.c_ctx[k] : p.c[(n - 1) * 1024 + k];
    sil[i] = siluf_(cv);
  }
  __syncthreads();
  const int gcol = it * 64, l = gcol / 6144, j = gcol % 6144;
  const int c4 = tid & 15, ks = tid >> 4;
  const float* wp = p.ada_w + (size_t)l * 1024 * 6144 + (size_t)(ks * 64) * 6144 + j + c4 * 4;
  float acc[9][4];
#pragma unroll
  for (int n = 0; n < 9; ++n) { acc[n][0] = 0.f; acc[n][1] = 0.f; acc[n][2] = 0.f; acc[n][3] = 0.f; }
#pragma unroll 4
  for (int k = 0; k < 64; ++k) {
    const float4 w = *(const float4*)(wp + (size_t)k * 6144);
#pragma unroll
    for (int n = 0; n < 9; ++n) {
      const float s = sil[n * 1024 + ks * 64 + k];
      acc[n][0] += s * w.x; acc[n][1] += s * w.y; acc[n][2] += s * w.z; acc[n][3] += s * w.w;
    }
  }
  __syncthreads();
  float* red = (float*)smem;
#pragma unroll
  for (int n = 0; n < 9; ++n)
#pragma unroll
    for (int q = 0; q < 4; ++q) red[(ks * 9 + n) * 64 + c4 * 4 + q] = acc[n][q];
  __syncthreads();
  for (int o = tid; o < 576; o += NT) {
    const int n = o >> 6, cc = o & 63;
    float s = 0.f;
#pragma unroll
    for (int k2 = 0; k2 < 16; ++k2) s += red[(k2 * 9 + n) * 64 + cc];
    s += p.ada_b[l * 6144 + j + cc];
    p.MOD[(size_t)(l * 9 + n) * 6144 + j + cc] = s;
  }
}

__device__ __forceinline__ void transpose_item(const Params& p, int tix, char* smem) {
  const int tid = threadIdx.x;
  int j = 0;
  while (j + 1 < p.njobs && tix >= p.jobs[j + 1].tile0) ++j;
  const float* src = p.jobs[j].src; bf16_t* dst = p.jobs[j].dst;
  const int K = p.jobs[j].K, N = p.jobs[j].N, lt = tix - p.jobs[j].tile0;
  const int ntn = N >> 6, tk = lt / ntn, tn = lt % ntn;
  float* tile = (float*)smem;
#pragma unroll
  for (int i = 0; i < 4; ++i) {
    const int r = (tid >> 4) + 16 * i, c4 = tid & 15;
    const float4 v = *(const float4*)(src + (size_t)(tk * 64 + r) * N + tn * 64 + c4 * 4);
    float* t = tile + r * 65 + c4 * 4;
    t[0] = v.x; t[1] = v.y; t[2] = v.z; t[3] = v.w;
  }
  __syncthreads();
  const int n = tid >> 2, kc = (tid & 3) * 16;
  unsigned w[8];
#pragma unroll
  for (int i = 0; i < 8; ++i) w[i] = pk_bf16(tile[(kc + 2 * i) * 65 + n], tile[(kc + 2 * i + 1) * 65 + n]);
  uint4* d = (uint4*)(dst + (size_t)(tn * 64 + n) * K + tk * 64 + kc);
  d[0] = make_uint4(w[0], w[1], w[2], w[3]);
  d[1] = make_uint4(w[4], w[5], w[6], w[7]);
}

__device__ __forceinline__ void cache_item(const Params& p, int ci) {
  const int tid = threadIdx.x;
  const int base = (ci & 31) * 8192;
  for (int e = tid; e < 8192; e += NT) {
    const int idx = base + e;
    const int d = idx & 63, kvh = (idx >> 6) & 1, pp = (idx >> 7) & 255, b = idx >> 15;
    if (ci < 32) p.Ks[((size_t)(b * 2 + kvh) * 1280 + 1024 + pp) * 64 + d] = f2bf(p.cache_k[idx]);
    else p.Vts[((size_t)(b * 2 + kvh) * 64 + d) * 1280 + 1024 + pp] = f2bf(p.cache_v[idx]);
  }
}

__device__ __forceinline__ void phase0(const Params& p, char* smem) {
  const int n_ada = 192, n_tr = p.ntiles, n_cc = 64;
  const int total = n_ada + n_tr + n_cc;
  for (int it = blockIdx.x; it < total; it += gridDim.x) {
    if (it < n_ada) ada_item(p, it, smem);
    else if (it < n_ada + n_tr) transpose_item(p, it - n_ada, smem);
    else cache_item(p, it - n_ada - n_tr);
    __syncthreads();
  }
}

__device__ __forceinline__ void prenorm_phase(const Params& p, int layer, int which, bool from_input) {
  const int wave = threadIdx.x >> 6, lane = threadIdx.x & 63;
  const float* nw = (which ? p.norm2_w : p.norm1_w) + layer * 1024;
  for (int row = blockIdx.x * 4 + wave; row < NTOK; row += gridDim.x * 4) {
    const float* xr = from_input ? (row < NP ? p.x_prompt + (size_t)row * 1024 : p.x_sample + (size_t)(row - NP) * 1024)
                                 : p.X + (size_t)row * 1024;
    float4 v[4]; float ss = 0.f;
#pragma unroll
    for (int i = 0; i < 4; ++i) { v[i] = *(const float4*)(xr + i * 256 + lane * 4); ss += v[i].x * v[i].x + v[i].y * v[i].y + v[i].z * v[i].z + v[i].w * v[i].w; }
    ss = wave_sum(ss);
    const float rstd = rsqrtf(ss * (1.f / 1024.f) + 1e-6f);
    const float* md = p.MOD + (size_t)(layer * 9 + mod_index(row)) * 6144;
    const float* sh = md + (which ? 3 : 0) * 1024; const float* sc = md + (which ? 4 : 1) * 1024;
#pragma unroll
    for (int i = 0; i < 4; ++i) {
      const int c = i * 256 + lane * 4;
      const float4 w4 = *(const float4*)(nw + c), s4 = *(const float4*)(sh + c), c4 = *(const float4*)(sc + c);
      const float h0 = v[i].x * rstd * w4.x * (1.f + c4.x) + s4.x, h1 = v[i].y * rstd * w4.y * (1.f + c4.y) + s4.y;
      const float h2 = v[i].z * rstd * w4.z * (1.f + c4.z) + s4.z, h3 = v[i].w * rstd * w4.w * (1.f + c4.w) + s4.w;
      *(uint2*)(p.H + (size_t)row * 1024 + c) = make_uint2(pk_bf16(h0, h1), pk_bf16(h2, h3));
    }
  }
}

struct ALoadPlain {
  const bf16_t* A; int lda;
  __device__ __forceinline__ uint4 operator()(int row, int k) const { return *(const uint4*)(A + (size_t)row * lda + k); }
};
struct ALoadShift {
  const bf16_t* H; const float* mix;
  __device__ __forceinline__ uint4 operator()(int row, int k) const {
    const uint4 h = *(const uint4*)(H + (size_t)row * 1024 + k);
    int tl, T;
    if (row < NP) { tl = row & 255; T = 256; } else { tl = (row - NP) & 1023; T = 1024; }
    uint4 s = make_uint4(0, 0, 0, 0);
    if (k < 512) { if (tl > 0) s = *(const uint4*)(H + (size_t)(row - 1) * 1024 + k); }
    else { if (tl < T - 1) s = *(const uint4*)(H + (size_t)(row + 1) * 1024 + k); }
    const float4 m0 = *(const float4*)(mix + k), m1 = *(const float4*)(mix + k + 4);
    uint4 o;
    { float a = bflo(h.x), b = bfhi(h.x); o.x = pk_bf16(a + (bflo(s.x) - a) * m0.x, b + (bfhi(s.x) - b) * m0.y); }
    { float a = bflo(h.y), b = bfhi(h.y); o.y = pk_bf16(a + (bflo(s.y) - a) * m0.z, b + (bfhi(s.y) - b) * m0.w); }
    { float a = bflo(h.z), b = bfhi(h.z); o.z = pk_bf16(a + (bflo(s.z) - a) * m1.x, b + (bfhi(s.z) - b) * m1.y); }
    { float a = bflo(h.w), b = bfhi(h.w); o.w = pk_bf16(a + (bflo(s.w) - a) * m1.z, b + (bfhi(s.w) - b) * m1.w); }
    return o;
  }
};

template <class AL, class EP>
__device__ __forceinline__ void gemm_tile(const AL& al, const bf16_t* __restrict__ Bt, int K, int tm, int tn, const EP& ep, char* smem) {
  const int tid = threadIdx.x, lane = tid & 63, wid = tid >> 6, wm = wid >> 1, wn = wid & 1;
  const int fr = lane & 15, fq = lane >> 4;
  char* sA = smem; char* sB = smem + 32768;
  f32x4 acc[4][4];
#pragma unroll
  for (int a = 0; a < 4; ++a)
#pragma unroll
    for (int b = 0; b < 4; ++b) acc[a][b] = (f32x4){0.f, 0.f, 0.f, 0.f};
  uint4 pa[4], pb[4];
  const int nk = K >> 6;
  const int cr0 = tid >> 3, cc = tid & 7;
  const int soff = cr0 * 128 + ((cc ^ ((cr0 >> 1) & 7)) << 4);
  const bf16_t* bp = Bt + (size_t)(tn * 128 + cr0) * K + cc * 8;
#define GLOAD(kt) do { _Pragma("unroll") for (int i = 0; i < 4; ++i) { pa[i] = al(tm * 128 + cr0 + 32 * i, (kt) * 64 + cc * 8); pb[i] = *(const uint4*)(bp + (size_t)(32 * i) * K + (kt) * 64); } } while (0)
#define SSTORE(buf) do { _Pragma("unroll") for (int i = 0; i < 4; ++i) { *(uint4*)(sA + (buf) * 16384 + soff + i * 4096) = pa[i]; *(uint4*)(sB + (buf) * 16384 + soff + i * 4096) = pb[i]; } } while (0)
  GLOAD(0); SSTORE(0); __syncthreads();
  for (int kt = 0; kt < nk; ++kt) {
    const int buf = kt & 1;
    if (kt + 1 < nk) GLOAD(kt + 1);
#pragma unroll
    for (int kk = 0; kk < 2; ++kk) {
      bf16x8 af[4], bfr[4];
#pragma unroll
      for (int mi = 0; mi < 4; ++mi) { const int r = wm * 64 + mi * 16 + fr, c = kk * 4 + fq; af[mi] = *(const bf16x8*)(sA + buf * 16384 + r * 128 + ((c ^ ((r >> 1) & 7)) << 4)); }
#pragma unroll
      for (int ni = 0; ni < 4; ++ni) { const int r = wn * 64 + ni * 16 + fr, c = kk * 4 + fq; bfr[ni] = *(const bf16x8*)(sB + buf * 16384 + r * 128 + ((c ^ ((r >> 1) & 7)) << 4)); }
#pragma unroll
      for (int mi = 0; mi < 4; ++mi)
#pragma unroll
        for (int ni = 0; ni < 4; ++ni) acc[mi][ni] = __builtin_amdgcn_mfma_f32_16x16x32_bf16(bfr[ni], af[mi], acc[mi][ni], 0, 0, 0);
    }
    if (kt + 1 < nk) SSTORE(buf ^ 1);
    __syncthreads();
  }
#undef GLOAD
#undef SSTORE
  ep(acc, tm * 128 + wm * 64, tn * 128 + wn * 64, lane);
}

#define LAS3 __attribute__((address_space(3)))
template <int OFF>
__device__ __forceinline__ bf16x8 lds_rd128(unsigned addr) { bf16x8 v; asm volatile("ds_read_b128 %0, %1 offset:%2" : "=v"(v) : "v"(addr), "n"(OFF) : "memory"); return v; }
template <class EP>
__device__ __forceinline__ void gemm_tile_glds(const bf16_t* __restrict__ A, int lda, const bf16_t* __restrict__ Bt, int K, int tm, int tn, const EP& ep, char* smem) {
  const int tid = threadIdx.x, lane = tid & 63, wid = __builtin_amdgcn_readfirstlane(tid >> 6), wm = wid >> 1, wn = wid & 1;
  const int fr = lane & 15, fq = lane >> 4;
  f32x4 acc[4][4];
#pragma unroll
  for (int a = 0; a < 4; ++a)
#pragma unroll
    for (int b = 0; b < 4; ++b) acc[a][b] = (f32x4){0.f, 0.f, 0.f, 0.f};
  const int nk = K >> 6;
  const int lr = lane >> 3, c0 = (lane & 7) ^ (lr >> 1);
  const bf16_t* pa = A + (size_t)(tm * 128 + wid * 32 + lr) * lda;
  const bf16_t* pb = Bt + (size_t)(tn * 128 + wid * 32 + lr) * K;
  const unsigned lbase = (unsigned)(uintptr_t)(LAS3 char*)smem;
  const unsigned fsw = (unsigned)((fq ^ ((fr >> 1) & 7)) << 4);
  const unsigned aA0 = lbase + (unsigned)((wm * 64 + fr) * 128) + fsw, aA1 = lbase + (unsigned)((wm * 64 + fr) * 128) + (fsw ^ 64u);
  const unsigned aB0 = lbase + 32768u + (unsigned)((wn * 64 + fr) * 128) + fsw, aB1 = lbase + 32768u + (unsigned)((wn * 64 + fr) * 128) + (fsw ^ 64u);
#define GLDS(kt, buf) do { _Pragma("unroll") for (int i = 0; i < 4; ++i) { const int cc_ = (c0 ^ ((i & 1) << 2)) * 8 + (kt) * 64; \
    __builtin_amdgcn_global_load_lds((const unsigned*)(pa + (size_t)(i * 8) * lda + cc_), (LAS3 unsigned*)(smem + (buf) * 16384 + (wid * 4 + i) * 1024), 16, 0, 0); \
    __builtin_amdgcn_global_load_lds((const unsigned*)(pb + (size_t)(i * 8) * K + cc_), (LAS3 unsigned*)(smem + 32768 + (buf) * 16384 + (wid * 4 + i) * 1024), 16, 0, 0); } } while (0)
  GLDS(0, 0);
  asm volatile("s_waitcnt vmcnt(0)" ::: "memory");
  __builtin_amdgcn_s_barrier();
  for (int kt = 0; kt < nk; ++kt) {
    const int buf = kt & 1;
    if (kt + 1 < nk) GLDS(kt + 1, buf ^ 1);
    const unsigned bo = (unsigned)buf * 16384u;
    bf16x8 a0[4], b0[4], a1[4], b1[4];
    a0[0] = lds_rd128<0>(aA0 + bo); a0[1] = lds_rd128<2048>(aA0 + bo); a0[2] = lds_rd128<4096>(aA0 + bo); a0[3] = lds_rd128<6144>(aA0 + bo);
    b0[0] = lds_rd128<0>(aB0 + bo); b0[1] = lds_rd128<2048>(aB0 + bo); b0[2] = lds_rd128<4096>(aB0 + bo); b0[3] = lds_rd128<6144>(aB0 + bo);
    a1[0] = lds_rd128<0>(aA1 + bo); a1[1] = lds_rd128<2048>(aA1 + bo); a1[2] = lds_rd128<4096>(aA1 + bo); a1[3] = lds_rd128<6144>(aA1 + bo);
    b1[0] = lds_rd128<0>(aB1 + bo); b1[1] = lds_rd128<2048>(aB1 + bo); b1[2] = lds_rd128<4096>(aB1 + bo); b1[3] = lds_rd128<6144>(aB1 + bo);
    __builtin_amdgcn_sched_barrier(0);
    asm volatile("s_waitcnt lgkmcnt(8)" : "+v"(a0[0]), "+v"(a0[1]), "+v"(a0[2]), "+v"(a0[3]), "+v"(b0[0]), "+v"(b0[1]), "+v"(b0[2]), "+v"(b0[3]) :: "memory");
#pragma unroll
    for (int mi = 0; mi < 4; ++mi)
#pragma unroll
      for (int ni = 0; ni < 4; ++ni) acc[mi][ni] = __builtin_amdgcn_mfma_f32_16x16x32_bf16(b0[ni], a0[mi], acc[mi][ni], 0, 0, 0);
    __builtin_amdgcn_sched_barrier(0);
    asm volatile("s_waitcnt lgkmcnt(0)" : "+v"(a1[0]), "+v"(a1[1]), "+v"(a1[2]), "+v"(a1[3]), "+v"(b1[0]), "+v"(b1[1]), "+v"(b1[2]), "+v"(b1[3]) :: "memory");
#pragma unroll
    for (int mi = 0; mi < 4; ++mi)
#pragma unroll
      for (int ni = 0; ni < 4; ++ni) acc[mi][ni] = __builtin_amdgcn_mfma_f32_16x16x32_bf16(b1[ni], a1[mi], acc[mi][ni], 0, 0, 0);
    __builtin_amdgcn_sched_barrier(0);
    asm volatile("s_waitcnt vmcnt(0)" ::: "memory");
    __builtin_amdgcn_s_barrier();
    __builtin_amdgcn_sched_barrier(0);
  }
#undef GLDS
  ep(acc, tm * 128 + wm * 64, tn * 128 + wn * 64, lane);
}

struct EpiWin {
  const Params* pp;
  __device__ __forceinline__ void operator()(f32x4 (&acc)[4][4], int row0, int col0, int lane) const {
    const Params& p = *pp;
    const int fr = lane & 15, fq = lane >> 4;
    const bool sample = row0 >= NP;
    if (col0 < 640) {
      const bool isq = col0 < 512;
      const float* nw = isq ? p.q_norm : p.k_norm;
      float nwv[4][4];
#pragma unroll
      for (int ni = 0; ni < 4; ++ni)
#pragma unroll
        for (int j = 0; j < 4; ++j) nwv[ni][j] = nw[ni * 16 + fq * 4 + j];
#pragma unroll
      for (int mi = 0; mi < 4; ++mi) {
        const int row = row0 + mi * 16 + fr;
        float ss = 0.f;
#pragma unroll
        for (int ni = 0; ni < 4; ++ni)
#pragma unroll
          for (int j = 0; j < 4; ++j) ss += acc[mi][ni][j] * acc[mi][ni][j];
        ss += __shfl_xor(ss, 16); ss += __shfl_xor(ss, 32);
        const float rn = rsqrtf(ss * (1.f / 64.f) + 1e-6f);
        float y[4][4];
#pragma unroll
        for (int ni = 0; ni < 4; ++ni)
#pragma unroll
          for (int j = 0; j < 4; ++j) y[ni][j] = acc[mi][ni][j] * rn * nwv[ni][j];
        if (!sample && !isq) {
          const int kvh = (col0 - 512) >> 6;
#pragma unroll
          for (int ni = 0; ni < 4; ++ni) *(f32x4*)(p.out_k + (size_t)row * 128 + kvh * 64 + ni * 16 + fq * 4) = (f32x4){y[ni][0], y[ni][1], y[ni][2], y[ni][3]};
        }
        if (sample) {
          const int tl = (row - NP) & 1023;
          const float rp = (float)(tl >> 6), cp = (float)(tl & 63);
#pragma unroll
          for (int ni = 0; ni < 4; ++ni)
#pragma unroll
            for (int jp = 0; jp < 2; ++jp) {
              const int i = (ni * 16 + fq * 4 + jp * 2) >> 1;
              const float pos = i < 16 ? rp : cp;
              const float inv = exp2f(-(float)(i & 15) * 0.83048202372184058696f);
              const float ang = pos * inv;
              const float s = __sinf(ang), c = __cosf(ang);
              const float x0 = y[ni][2 * jp], x1 = y[ni][2 * jp + 1];
              y[ni][2 * jp] = x0 * c - x1 * s; y[ni][2 * jp + 1] = x0 * s + x1 * c;
            }
        }
        if (isq) {
          const float qs = 0.125f * 1.44269504088896f;
#pragma unroll
          for (int ni = 0; ni < 4; ++ni)
            *(uint2*)(p.Qbuf + (size_t)row * 512 + col0 + ni * 16 + fq * 4) = make_uint2(pk_bf16(y[ni][0] * qs, y[ni][1] * qs), pk_bf16(y[ni][2] * qs, y[ni][3] * qs));
        } else {
          const int kvh = (col0 - 512) >> 6;
          bf16_t* kd;
          if (!sample) kd = p.Kp + ((size_t)((row >> 8) * 2 + kvh) * 256 + (row & 255)) * 64;
          else kd = p.Ks + ((size_t)(((row - NP) >> 10) * 2 + kvh) * 1280 + ((row - NP) & 1023)) * 64;
#pragma unroll
          for (int ni = 0; ni < 4; ++ni)
            *(uint2*)(kd + ni * 16 + fq * 4) = make_uint2(pk_bf16(y[ni][0], y[ni][1]), pk_bf16(y[ni][2], y[ni][3]));
        }
      }
    } else if (col0 < 768) {
      const int kvh = (col0 - 640) >> 6;
#pragma unroll
      for (int mi = 0; mi < 4; ++mi) {
        const int row = row0 + mi * 16 + fr;
#pragma unroll
        for (int ni = 0; ni < 4; ++ni) {
          const int d0 = ni * 16 + fq * 4;
          if (!sample) {
            *(f32x4*)(p.out_v + (size_t)row * 128 + kvh * 64 + d0) = acc[mi][ni];
            bf16_t* vd = p.Vtp + ((size_t)((row >> 8) * 2 + kvh) * 64 + d0) * 256 + (row & 255);
#pragma unroll
            for (int j = 0; j < 4; ++j) vd[j * 256] = f2bf(acc[mi][ni][j]);
          } else {
            bf16_t* vd = p.Vts + ((size_t)(((row - NP) >> 10) * 2 + kvh) * 64 + d0) * 1280 + ((row - NP) & 1023);
#pragma unroll
            for (int j = 0; j < 4; ++j) vd[j * 1280] = f2bf(acc[mi][ni][j]);
          }
        }
      }
    } else {
      const int c0 = col0 - 768, seg = c0 >> 9;
      float oml[4][4];
      if (seg == 1 || seg == 2) {
#pragma unroll
        for (int ni = 0; ni < 4; ++ni)
#pragma unroll
          for (int j = 0; j < 4; ++j) { const int c = (c0 & 511) + ni * 16 + fq * 4 + j; oml[ni][j] = 1.f / (1.f + __expf(p.hgrn_lb[c] - p.hgrn_lb[512 + c])); }
      }
#pragma unroll
      for (int mi = 0; mi < 4; ++mi) {
        const int row = row0 + mi * 16 + fr;
#pragma unroll
        for (int ni = 0; ni < 4; ++ni) {
          float o[4];
#pragma unroll
          for (int j = 0; j < 4; ++j) {
            const float v = acc[mi][ni][j];
            if (seg == 0 || seg == 4) o[j] = siluf_(v);
            else if (seg == 3) o[j] = v;
            else o[j] = oml[ni][j] * sigmoidf_(-v);
          }
          *(uint2*)(p.HG + (size_t)row * 2560 + c0 + ni * 16 + fq * 4) = make_uint2(pk_bf16(o[0], o[1]), pk_bf16(o[2], o[3]));
        }
      }
    }
  }
};

struct EpiResid {
  const Params* pp; int layer, gidx; bool from_input; bool dry = false;
  __device__ __forceinline__ void operator()(f32x4 (&acc)[4][4], int row0, int col0, int lane) const {
    const Params& p = *pp;
    if (dry && p.njobs >= 0) return;
    const int fr = lane & 15, fq = lane >> 4;
    const float* gt = p.MOD + (size_t)(layer * 9 + mod_index(row0)) * 6144 + gidx * 1024;
#pragma unroll
    for (int mi = 0; mi < 4; ++mi) {
      const int row = row0 + mi * 16 + fr;
      const float* base = from_input ? (row < NP ? p.x_prompt + (size_t)row * 1024 : p.x_sample + (size_t)(row - NP) * 1024) : p.X + (size_t)row * 1024;
#pragma unroll
      for (int ni = 0; ni < 4; ++ni) {
        const int col = col0 + ni * 16 + fq * 4;
        const f32x4 b = *(const f32x4*)(base + col), g = *(const f32x4*)(gt + col);
        *(f32x4*)(p.X + (size_t)row * 1024 + col) = b + g * acc[mi][ni];
      }
    }
  }
};

template <int ACT>
struct EpiAct {
  bf16_t* O; int ldo; const float* bias;
  __device__ __forceinline__ void operator()(f32x4 (&acc)[4][4], int row0, int col0, int lane) const {
    const int fr = lane & 15, fq = lane >> 4;
#pragma unroll
    for (int ni = 0; ni < 4; ++ni) {
      const int col = col0 + ni * 16 + fq * 4;
      f32x4 bv = (f32x4){0.f, 0.f, 0.f, 0.f};
      if (ACT >= 4) bv = *(const f32x4*)(bias + col);
#pragma unroll
      for (int mi = 0; mi < 4; ++mi) {
        const int row = row0 + mi * 16 + fr;
        float o[4];
#pragma unroll
        for (int j = 0; j < 4; ++j) {
          const float v = acc[mi][ni][j] + bv[j];
          if (ACT == 0) o[j] = v;
          else if (ACT == 1) { const float r = fmaxf(v, 0.f); o[j] = r * r; }
          else if (ACT == 2) o[j] = 1.f - 2.f / (1.f + __expf(2.f * v));
          else if (ACT == 3 || ACT == 5) o[j] = sigmoidf_(v);
          else o[j] = 0.60653065971263342f * sigmoidf_(v);
        }
        *(uint2*)(O + (size_t)row * ldo + col) = make_uint2(pk_bf16(o[0], o[1]), pk_bf16(o[2], o[3]));
      }
    }
  }
};

struct EpiRwkvOut {
  const Params* pp;
  __device__ __forceinline__ void operator()(f32x4 (&acc)[4][4], int row0, int col0, int lane) const {
    const Params& p = *pp;
    const int fr = lane & 15, fq = lane >> 4, h = col0 >> 6;
#pragma unroll
    for (int mi = 0; mi < 4; ++mi) {
      const int row = row0 + mi * 16 + fr;
      float y[4][4]; float s = 0.f;
#pragma unroll
      for (int ni = 0; ni < 4; ++ni) {
        const size_t idx = (size_t)row * 1024 + col0 + ni * 16 + fq * 4;
        const uint2 a = *(const uint2*)(p.E0 + idx), b = *(const uint2*)(p.E1 + idx);
        y[ni][0] = bflo(a.x) + bflo(b.x); y[ni][1] = bfhi(a.x) + bfhi(b.x); y[ni][2] = bflo(a.y) + bflo(b.y); y[ni][3] = bfhi(a.y) + bfhi(b.y);
        s += (y[ni][0] + y[ni][1]) + (y[ni][2] + y[ni][3]);
      }
      s += __shfl_xor(s, 16); s += __shfl_xor(s, 32);
      const float mu = s * (1.f / 64.f);
      float q = 0.f;
#pragma unroll
      for (int ni = 0; ni < 4; ++ni)
#pragma unroll
        for (int j = 0; j < 4; ++j) { const float d = y[ni][j] - mu; q += d * d; }
      q += __shfl_xor(q, 16); q += __shfl_xor(q, 32);
      const float rs = rsqrtf(q * (1.f / 64.f) + 64e-5f);
      const float bs = p.BS[(size_t)row * 16 + h] + p.BS[(size_t)NTOK * 16 + (size_t)row * 16 + h];
#pragma unroll
      for (int ni = 0; ni < 4; ++ni) {
        const int col = col0 + ni * 16 + fq * 4;
        const size_t idx = (size_t)row * 1024 + col;
        const uint2 vv = *(const uint2*)(p.Vx + idx);
        const f32x4 lw = *(const f32x4*)(p.ln_w + col), lb = *(const f32x4*)(p.ln_b + col);
        const float v0 = bflo(vv.x), v1 = bfhi(vv.x), v2 = bflo(vv.y), v3 = bfhi(vv.y);
        const float o0 = ((y[ni][0] - mu) * rs * lw[0] + lb[0] + bs * v0) * acc[mi][ni][0];
        const float o1 = ((y[ni][1] - mu) * rs * lw[1] + lb[1] + bs * v1) * acc[mi][ni][1];
        const float o2 = ((y[ni][2] - mu) * rs * lw[2] + lb[2] + bs * v2) * acc[mi][ni][2];
        const float o3 = ((y[ni][3] - mu) * rs * lw[3] + lb[3] + bs * v3) * acc[mi][ni][3];
        *(uint2*)(p.ZO + idx) = make_uint2(pk_bf16(o0, o1), pk_bf16(o2, o3));
      }
    }
  }
};

template <class EP>
__device__ __forceinline__ void gemm_phase(const ALoadPlain& al, const bf16_t* Bt, int K, int ntn, const EP& ep, char* smem) {
  const int nunits = (NTOK / 128) * ntn;
  for (int u = blockIdx.x; u < nunits; u += gridDim.x) gemm_tile_glds(al.A, al.lda, Bt, K, u / ntn, u % ntn, ep, smem);
}

__device__ __forceinline__ void attn_item(const Params& p, int grp, int b, int h, int qb, char* smem) {
  const int tid = threadIdx.x, lane = tid & 63, wid = tid >> 6, qi = lane & 31, g = lane >> 5;
  const int Tk = grp ? 1280 : 256, kvh = h >> 2;
  const int rowbase = grp ? NP + b * 1024 + qb * 128 : b * 256 + qb * 128;
  const bf16_t* Kg = grp ? p.Ks + (size_t)(b * 2 + kvh) * 1280 * 64 : p.Kp + (size_t)(b * 2 + kvh) * 256 * 64;
  const bf16_t* Vg = grp ? p.Vts + (size_t)(b * 2 + kvh) * 64 * 1280 : p.Vtp + (size_t)(b * 2 + kvh) * 64 * 256;
  const int qrow = rowbase + wid * 32 + qi;
  bf16x8 Qf[4];
#pragma unroll
  for (int s = 0; s < 4; ++s) Qf[s] = *(const bf16x8*)(p.Qbuf + (size_t)qrow * 512 + h * 64 + s * 16 + g * 8);
  f32x16 O[2];
#pragma unroll
  for (int i = 0; i < 16; ++i) { O[0][i] = 0.f; O[1][i] = 0.f; }
  float m_run = -1e30f, l_run = 0.f;
  char* sK = smem; char* sV = smem + 16384;
  const int r0 = tid >> 3, c = tid & 7;
  uint4 pk[2], pv[2];
  const int ntile = Tk >> 6;
#define ALOAD(kt) do { _Pragma("unroll") for (int i = 0; i < 2; ++i) { const int r = r0 + 32 * i; pk[i] = *(const uint4*)(Kg + (size_t)((kt) * 64 + r) * 64 + c * 8); pv[i] = *(const uint4*)(Vg + (size_t)r * Tk + (kt) * 64 + c * 8); } } while (0)
#define ASTORE(buf) do { _Pragma("unroll") for (int i = 0; i < 2; ++i) { const int r = r0 + 32 * i; \
      *(uint4*)(sK + (buf) * 8192 + r * 128 + ((c ^ ((r >> 1) & 7)) << 4)) = pk[i]; \
      const int f = (r >> 1) & 15; \
      *(uint2*)(sV + (buf) * 8192 + r * 128 + (((2 * c) ^ f) << 3)) = make_uint2(pv[i].x, pv[i].y); \
      *(uint2*)(sV + (buf) * 8192 + r * 128 + (((2 * c + 1) ^ f) << 3)) = make_uint2(pv[i].z, pv[i].w); } } while (0)
  ALOAD(0); ASTORE(0); __syncthreads();
  for (int kt = 0; kt < ntile; ++kt) {
    const int buf = kt & 1;
    if (kt + 1 < ntile) ALOAD(kt + 1);
    f32x16 S[2];
#pragma unroll
    for (int t2 = 0; t2 < 2; ++t2) {
#pragma unroll
      for (int i = 0; i < 16; ++i) S[t2][i] = 0.f;
#pragma unroll
      for (int s = 0; s < 4; ++s) {
        const int r = t2 * 32 + qi, cc = 2 * s + g;
        const bf16x8 Kf = *(const bf16x8*)(sK + buf * 8192 + r * 128 + ((cc ^ ((r >> 1) & 7)) << 4));
        S[t2] = __builtin_amdgcn_mfma_f32_32x32x16_bf16(Kf, Qf[s], S[t2], 0, 0, 0);
      }
    }
    float mx = S[0][0];
#pragma unroll
    for (int i = 0; i < 16; ++i) { mx = fmaxf(mx, S[0][i]); mx = fmaxf(mx, S[1][i]); }
    mx = fmaxf(mx, __shfl_xor(mx, 32));
    const float m_new = fmaxf(m_run, mx);
    const float alpha = exp2f(m_run - m_new);
    float ls = 0.f;
#pragma unroll
    for (int i = 0; i < 16; ++i) { S[0][i] = exp2f(S[0][i] - m_new); S[1][i] = exp2f(S[1][i] - m_new); ls += S[0][i] + S[1][i]; }
    l_run = l_run * alpha + ls; m_run = m_new;
#pragma unroll
    for (int i = 0; i < 16; ++i) { O[0][i] *= alpha; O[1][i] *= alpha; }
#pragma unroll
    for (int t2 = 0; t2 < 2; ++t2)
#pragma unroll
      for (int sp = 0; sp < 2; ++sp) {
        union { bf16x8 v; unsigned u[4]; } Pf;
#pragma unroll
        for (int e = 0; e < 4; ++e) Pf.u[e] = pk_bf16(S[t2][8 * sp + 2 * e], S[t2][8 * sp + 2 * e + 1]);
#pragma unroll
        for (int ds = 0; ds < 2; ++ds) {
          const int d = ds * 32 + qi, f = (d >> 1) & 15, u1 = 8 * t2 + 4 * sp + g;
          union { bf16x8 v; uint2 u[2]; } Vf;
          Vf.u[0] = *(const uint2*)(sV + buf * 8192 + d * 128 + ((u1 ^ f) << 3));
          Vf.u[1] = *(const uint2*)(sV + buf * 8192 + d * 128 + (((u1 + 2) ^ f) << 3));
          O[ds] = __builtin_amdgcn_mfma_f32_32x32x16_bf16(Vf.v, Pf.v, O[ds], 0, 0, 0);
        }
      }
    if (kt + 1 < ntile) ASTORE(buf ^ 1);
    __syncthreads();
  }
#undef ALOAD
#undef ASTORE
  const float l = l_run + __shfl_xor(l_run, 32);
  const float inv = 1.f / l;
#pragma unroll
  for (int ds = 0; ds < 2; ++ds)
#pragma unroll
    for (int bq = 0; bq < 4; ++bq) {
      const int d0 = ds * 32 + 8 * bq + 4 * g;
      *(uint2*)(p.AO + (size_t)qrow * 1024 + h * 64 + d0) =
          make_uint2(pk_bf16(O[ds][4 * bq] * inv, O[ds][4 * bq + 1] * inv), pk_bf16(O[ds][4 * bq + 2] * inv, O[ds][4 * bq + 3] * inv));
    }
}

__device__ __forceinline__ void hgrn_item(const Params& p, int grp, int b, int h, int dir, int half, char* smem) {
  const int tid = threadIdx.x, v = half * 32 + (tid >> 3), ks = tid & 7;
  const int T = grp ? 1024 : 256, rowbase = grp ? NP + b * 1024 : b * 256;
  f32x2 S2[4];
  if (grp) {
    const float* s0 = (dir ? p.hg_b0 : p.hg_f0) + (size_t)(b * 8 + h) * 4096;
#pragma unroll
    for (int i = 0; i < 4; ++i) S2[i] = (f32x2){s0[(ks * 8 + 2 * i) * 64 + v], s0[(ks * 8 + 2 * i + 1) * 64 + v]};
  } else {
#pragma unroll
    for (int i = 0; i < 4; ++i) S2[i] = (f32x2){0.f, 0.f};
  }
  float* obuf = (float*)(smem + 32768);
  const int lt = tid >> 4, lc = (tid & 15) * 4;
  const int kfseg = dir ? 1024 : 512;
  uint2 rq, rk, rv, rq2, rk2, rv2;
  const int nch = T >> 4;
#define HLOADX(cix, q_, k_, v_) do { const int ts = (cix) * 16 + lt; const int tok = dir ? T - 1 - ts : ts; const bf16_t* src = p.HG + (size_t)(rowbase + tok) * 2560 + h * 64 + lc; \
    q_ = *(const uint2*)(src); k_ = *(const uint2*)(src + kfseg); v_ = *(const uint2*)(src + 1536); } while (0)
#define HSTORE(buf) do { float* B = (float*)(smem + (buf) * 16384) + lt * 64 + lc; \
    const float k0 = bflo(rk.x), k1 = bfhi(rk.x), k2 = bflo(rk.y), k3 = bfhi(rk.y); \
    *(float4*)(B) = make_float4(1.f - k0, 1.f - k1, 1.f - k2, 1.f - k3); *(float4*)(B + 1024) = make_float4(k0, k1, k2, k3); \
    *(float4*)(B + 2048) = make_float4(bflo(rq.x), bfhi(rq.x), bflo(rq.y), bfhi(rq.y)); *(float4*)(B + 3072) = make_float4(bflo(rv.x), bfhi(rv.x), bflo(rv.y), bfhi(rv.y)); } while (0)
  HLOADX(0, rq, rk, rv); HSTORE(0);
  HLOADX(1, rq, rk, rv);
  __syncthreads();
  float* OD = dir ? p.OB : p.OF;
  for (int cix = 0; cix < nch; ++cix) {
    const int buf = cix & 1;
    if (cix + 2 < nch) HLOADX(cix + 2, rq2, rk2, rv2);
    const float* B = (const float*)(smem + buf * 16384);
    float* ob = obuf + buf * 512;
    float4 cf[2], ck[2], cq[2]; float cv;
#define HSTEP_LOAD(t_, f_, k_, q_, v_) do { const float* Bt = B + (t_) * 64 + ks * 8; \
      f_[0] = *(const float4*)(Bt); f_[1] = *(const float4*)(Bt + 4); k_[0] = *(const float4*)(Bt + 1024); k_[1] = *(const float4*)(Bt + 1028); \
      q_[0] = *(const float4*)(Bt + 2048); q_[1] = *(const float4*)(Bt + 2052); v_ = B[3072 + (t_) * 64 + v]; } while (0)
    HSTEP_LOAD(0, cf, ck, cq, cv);
#pragma unroll 1
    for (int g = 0; g < 4; ++g) {
      float op[4];
#pragma unroll
      for (int tt = 0; tt < 4; ++tt) {
        const int t = g * 4 + tt;
        float4 nf[2], nk[2], nq[2]; float nv;
        { const int tn_ = (t + 1) & 15; HSTEP_LOAD(tn_, nf, nk, nq, nv); }
        const f32x2 vvv = (f32x2){cv, cv};
        f32x2 o0, o1;
        S2[0] = S2[0] * (f32x2){cf[0].x, cf[0].y} + vvv * (f32x2){ck[0].x, ck[0].y};
        S2[1] = S2[1] * (f32x2){cf[0].z, cf[0].w} + vvv * (f32x2){ck[0].z, ck[0].w};
        S2[2] = S2[2] * (f32x2){cf[1].x, cf[1].y} + vvv * (f32x2){ck[1].x, ck[1].y};
        S2[3] = S2[3] * (f32x2){cf[1].z, cf[1].w} + vvv * (f32x2){ck[1].z, ck[1].w};
        o0 = S2[0] * (f32x2){cq[0].x, cq[0].y}; o1 = S2[1] * (f32x2){cq[0].z, cq[0].w};
        o0 = S2[2] * (f32x2){cq[1].x, cq[1].y} + o0; o1 = S2[3] * (f32x2){cq[1].z, cq[1].w} + o1;
        const f32x2 os = o0 + o1;
        op[tt] = os.x + os.y;
        cf[0] = nf[0]; cf[1] = nf[1]; ck[0] = nk[0]; ck[1] = nk[1]; cq[0] = nq[0]; cq[1] = nq[1]; cv = nv;
      }
#pragma unroll
      for (int tt = 0; tt < 4; ++tt) { const float o = oct_sum(op[tt]); if (ks == 0) ob[(g * 4 + tt) * 32 + (tid >> 3)] = o; }
    }
#undef HSTEP_LOAD
    if (cix + 1 < nch) HSTORE(buf ^ 1);
    rq = rq2; rk = rk2; rv = rv2;
    __syncthreads();
    if (tid < 128) {
      const int ft = tid >> 3, fc = (tid & 7) * 4;
      const int ts = cix * 16 + ft; const int tok = dir ? T - 1 - ts : ts;
      *(float4*)(OD + (size_t)(rowbase + tok) * 512 + h * 64 + half * 32 + fc) = *(const float4*)(ob + ft * 32 + fc);
    }
  }
#undef HLOADX
#undef HSTORE
  if (!grp) {
    float* so = (dir ? p.out_hb : p.out_hf) + (size_t)(b * 8 + h) * 4096;
#pragma unroll
    for (int i = 0; i < 4; ++i) { so[(ks * 8 + 2 * i) * 64 + v] = S2[i].x; so[(ks * 8 + 2 * i + 1) * 64 + v] = S2[i].y; }
  }
}

__device__ __forceinline__ void mix0_phase(const Params& p, char* smem) {
  __shared__ int q_item;
  for (;;) {
    if (threadIdx.x == 0) q_item = (int)atomicAdd(&p.bar[0], 1u);
    __syncthreads();
    const int it = q_item;
    __syncthreads();
    if (it >= 1536) break;
    if (it < 768) {
      const int grp = it < 256 ? 1 : 0, a = grp ? it : it - 256;
      hgrn_item(p, grp, a >> 5, (a >> 2) & 7, (a >> 1) & 1, a & 1, smem);
    } else {
      const int grp = it < 1280 ? 1 : 0, a = grp ? it - 768 : it - 1280;
      const int b = grp ? a >> 6 : a >> 4, h = grp ? (a >> 3) & 7 : (a >> 1) & 7, qb = grp ? a & 7 : a & 1;
      attn_item(p, grp, b, h, qb, smem);
    }
    __syncthreads();
  }
}

__device__ __forceinline__ void hgrn_combine_phase(const Params& p) {
  const int gid = blockIdx.x * NT + threadIdx.x, l16 = gid & 15;
  const int ngroups = NTOK * 8;
  for (int grp = gid >> 4; grp < ngroups; grp += (gridDim.x * NT) >> 4) {
    const int row = grp >> 3, h = grp & 7;
    const size_t o = (size_t)row * 512 + h * 64 + l16 * 4;
    const float4 a = *(const float4*)(p.OF + o), b = *(const float4*)(p.OB + o);
    const float y0 = a.x + b.x, y1 = a.y + b.y, y2 = a.z + b.z, y3 = a.w + b.w;
    float ss = y0 * y0 + y1 * y1 + y2 * y2 + y3 * y3;
    ss += __shfl_xor(ss, 1); ss += __shfl_xor(ss, 2); ss += __shfl_xor(ss, 4); ss += __shfl_xor(ss, 8);
    const float rn = rsqrtf(ss * (1.f / 64.f) + 1e-6f);
    const float4 gn = *(const float4*)(p.g_norm + l16 * 4);
    const uint2 gt = *(const uint2*)(p.HG + (size_t)row * 2560 + 2048 + h * 64 + l16 * 4);
    *(uint2*)(p.AO + (size_t)row * 1024 + 512 + h * 64 + l16 * 4) =
        make_uint2(pk_bf16(y0 * rn * gn.x * bflo(gt.x), y1 * rn * gn.y * bfhi(gt.x)), pk_bf16(y2 * rn * gn.z * bflo(gt.y), y3 * rn * gn.w * bfhi(gt.y)));
  }
}

__device__ __forceinline__ void rwkv_item(const Params& p, int grp, int b, int h, int dir, char* smem, bool dry = false) {
  const bool wr = !(dry && p.njobs >= 0);
  const int tid = threadIdx.x, lane = tid & 63, wid = tid >> 6, v = tid >> 2, ks = tid & 3;
  const int T = grp ? 1024 : 256, rowbase = grp ? NP + b * 1024 : b * 256;
  const int vp = tid >> 3, k8 = tid & 7;
  f32x2 Sa[4], Sb[4];
  if (grp) {
    const float* s0 = (dir ? p.rw_b0 : p.rw_f0) + ((size_t)(b * 16 + h) * 64 + vp) * 64 + k8 * 8;
#pragma unroll
    for (int q = 0; q < 2; ++q) {
      const float4 t = *(const float4*)(s0 + q * 4), u = *(const float4*)(s0 + 2048 + q * 4);
      Sa[2 * q] = (f32x2){t.x, t.y}; Sa[2 * q + 1] = (f32x2){t.z, t.w}; Sb[2 * q] = (f32x2){u.x, u.y}; Sb[2 * q + 1] = (f32x2){u.z, u.w};
    }
  } else {
#pragma unroll
    for (int i = 0; i < 4; ++i) { Sa[i] = (f32x2){0.f, 0.f}; Sb[i] = (f32x2){0.f, 0.f}; }
  }
  const bf16_t* E = dir ? p.E1 : p.E0; const bf16_t* A = dir ? p.A1 : p.A0; bf16_t* Y = dir ? p.E1 : p.E0;
  const int lt = tid >> 4, lc = (tid & 15) * 4;
  const float4 kkc = *(const float4*)(p.k_k + h * 64 + lc), kac = *(const float4*)(p.k_a + h * 64 + lc), rkc = *(const float4*)(p.r_k + h * 64 + lc);
  float* BSd = p.BS + (size_t)dir * NTOK * 16;
  float* ybuf = (float*)(smem + 49152);
  uint2 gr, gk, gv, ge, ga;
  const int nch = T >> 4;
#define RLOAD(cix) do { const int ts = (cix) * 16 + lt; const int tok = dir ? T - 1 - ts : ts; const size_t idx = (size_t)(rowbase + tok) * 1024 + h * 64 + lc; \
    gr = *(const uint2*)(p.R + idx); gk = *(const uint2*)(p.Kx + idx); gv = *(const uint2*)(p.Vx + idx); ge = *(const uint2*)(E + idx); ga = *(const uint2*)(A + idx); } while (0)
#define RSTORE(cix, buf) do { const int ts = (cix) * 16 + lt; const int tok = dir ? T - 1 - ts : ts; \
    const float r_[4] = {bflo(gr.x), bfhi(gr.x), bflo(gr.y), bfhi(gr.y)}, k_[4] = {bflo(gk.x), bfhi(gk.x), bflo(gk.y), bfhi(gk.y)}; \
    const float e_[4] = {bflo(ge.x), bfhi(ge.x), bflo(ge.y), bfhi(ge.y)}, a_[4] = {bflo(ga.x), bfhi(ga.x), bflo(ga.y), bfhi(ga.y)}; \
    const float kc_[4] = {kkc.x, kkc.y, kkc.z, kkc.w}, ac_[4] = {kac.x, kac.y, kac.z, kac.w}, rc_[4] = {rkc.x, rkc.y, rkc.z, rkc.w}; \
    float kx[4], kd[4], ssq = 0.f, bsum = 0.f; \
    _Pragma("unroll") for (int j = 0; j < 4; ++j) { kx[j] = k_[j] * kc_[j]; ssq += kx[j] * kx[j]; kd[j] = k_[j] * (1.f + (a_[j] - 1.f) * ac_[j]); bsum += r_[j] * kd[j] * rc_[j]; } \
    ssq = hex_sum(ssq); bsum = hex_sum(bsum); const float rn = rsqrtf(fmaxf(ssq, 1e-24f)); \
    float* B = (float*)(smem + (buf) * 24576) + lt * 64 + lc; \
    *(float4*)(B) = make_float4(__expf(-e_[0]), __expf(-e_[1]), __expf(-e_[2]), __expf(-e_[3])); \
    *(float4*)(B + 1024) = make_float4(kx[0] * rn, kx[1] * rn, kx[2] * rn, kx[3] * rn); \
    *(float4*)(B + 2048) = make_float4(kx[0] * rn * a_[0], kx[1] * rn * a_[1], kx[2] * rn * a_[2], kx[3] * rn * a_[3]); \
    *(float4*)(B + 3072) = make_float4(kd[0], kd[1], kd[2], kd[3]); \
    *(float4*)(B + 4096) = make_float4(r_[0], r_[1], r_[2], r_[3]); \
    *(float4*)(B + 5120) = make_float4(bflo(gv.x), bfhi(gv.x), bflo(gv.y), bfhi(gv.y)); \
    if ((tid & 15) == 0 && wr) BSd[(size_t)(rowbase + tok) * 16 + h] = bsum; } while (0)
  RLOAD(0); RSTORE(0, 0); __syncthreads();
  for (int cix = 0; cix < nch; ++cix) {
    const int buf = cix & 1;
    if (cix + 1 < nch) RLOAD(cix + 1);
    const float* B = (const float*)(smem + buf * 24576);
    float* yb = ybuf + buf * 1024;
    float4 cw[2], ck[2], ca[2], cd[2], cr[2]; float cva, cvb;
#define RSTEP_LOAD(t_, w_, k_, a_, d_, r_, va_, vb_) do { const float* Bt = B + (t_) * 64 + k8 * 8; \
      w_[0] = *(const float4*)(Bt); w_[1] = *(const float4*)(Bt + 4); k_[0] = *(const float4*)(Bt + 1024); k_[1] = *(const float4*)(Bt + 1028); \
      a_[0] = *(const float4*)(Bt + 2048); a_[1] = *(const float4*)(Bt + 2052); d_[0] = *(const float4*)(Bt + 3072); d_[1] = *(const float4*)(Bt + 3076); \
      r_[0] = *(const float4*)(Bt + 4096); r_[1] = *(const float4*)(Bt + 4100); va_ = B[5120 + (t_) * 64 + vp]; vb_ = B[5120 + (t_) * 64 + vp + 32]; } while (0)
    RSTEP_LOAD(0, cw, ck, ca, cd, cr, cva, cvb);
#pragma unroll
    for (int t = 0; t < 16; ++t) {
      float4 nw[2], nk[2], na[2], nd[2], nr[2]; float nva = 0.f, nvb = 0.f;
      if (t + 1 < 16) RSTEP_LOAD(t + 1, nw, nk, na, nd, nr, nva, nvb);
      f32x2 w2[4], kk2[4];
#pragma unroll
      for (int q = 0; q < 2; ++q) {
        w2[2 * q] = (f32x2){cw[q].x, cw[q].y}; w2[2 * q + 1] = (f32x2){cw[q].z, cw[q].w};
        kk2[2 * q] = (f32x2){ck[q].x, ck[q].y}; kk2[2 * q + 1] = (f32x2){ck[q].z, ck[q].w};
      }
      const f32x2 sa_a = (Sa[0] * kk2[0] + Sa[1] * kk2[1]) + (Sa[2] * kk2[2] + Sa[3] * kk2[3]);
      const f32x2 sa_b = (Sb[0] * kk2[0] + Sb[1] * kk2[1]) + (Sb[2] * kk2[2] + Sb[3] * kk2[3]);
      const float saa = -oct_sum(sa_a.x + sa_a.y), sab = -oct_sum(sa_b.x + sa_b.y);
      const f32x2 saav = (f32x2){saa, saa}, sabv = (f32x2){sab, sab}, vav = (f32x2){cva, cva}, vbv = (f32x2){cvb, cvb};
      f32x2 ya = (f32x2){0.f, 0.f}, yb2 = (f32x2){0.f, 0.f};
#pragma unroll
      for (int q = 0; q < 2; ++q) {
        const f32x2 ka0 = (f32x2){ca[q].x, ca[q].y}, ka1 = (f32x2){ca[q].z, ca[q].w}, kd0 = (f32x2){cd[q].x, cd[q].y}, kd1 = (f32x2){cd[q].z, cd[q].w};
        const f32x2 r0 = (f32x2){cr[q].x, cr[q].y}, r1 = (f32x2){cr[q].z, cr[q].w};
        Sa[2 * q] = Sa[2 * q] * w2[2 * q] + (vav * kd0 + saav * ka0); Sa[2 * q + 1] = Sa[2 * q + 1] * w2[2 * q + 1] + (vav * kd1 + saav * ka1);
        Sb[2 * q] = Sb[2 * q] * w2[2 * q] + (vbv * kd0 + sabv * ka0); Sb[2 * q + 1] = Sb[2 * q + 1] * w2[2 * q + 1] + (vbv * kd1 + sabv * ka1);
        ya = Sa[2 * q] * r0 + ya; ya = Sa[2 * q + 1] * r1 + ya;
        yb2 = Sb[2 * q] * r0 + yb2; yb2 = Sb[2 * q + 1] * r1 + yb2;
      }
      const float y_a = oct_sum(ya.x + ya.y), y_b = oct_sum(yb2.x + yb2.y);
      if (k8 == 0) { yb[t * 64 + vp] = y_a; yb[t * 64 + vp + 32] = y_b; }
      if (t + 1 < 16) {
#pragma unroll
        for (int q = 0; q < 2; ++q) { cw[q] = nw[q]; ck[q] = nk[q]; ca[q] = na[q]; cd[q] = nd[q]; cr[q] = nr[q]; }
        cva = nva; cvb = nvb;
      }
    }
#undef RSTEP_LOAD
    if (cix + 1 < nch) RSTORE(cix + 1, buf ^ 1);
    __syncthreads();
    {
      const int ts = cix * 16 + lt; const int tok = dir ? T - 1 - ts : ts;
      const float4 yy = *(const float4*)(yb + lt * 64 + lc);
      if (wr) *(uint2*)(Y + (size_t)(rowbase + tok) * 1024 + h * 64 + lc) = make_uint2(pk_bf16(yy.x, yy.y), pk_bf16(yy.z, yy.w));
    }
  }
#undef RLOAD
#undef RSTORE
  if (!grp && wr) {
    float* so = (dir ? p.out_rb : p.out_rf) + ((size_t)(b * 16 + h) * 64 + vp) * 64 + k8 * 8;
#pragma unroll
    for (int q = 0; q < 2; ++q) {
      *(float4*)(so + q * 4) = make_float4(Sa[2 * q].x, Sa[2 * q].y, Sa[2 * q + 1].x, Sa[2 * q + 1].y);
      *(float4*)(so + 2048 + q * 4) = make_float4(Sb[2 * q].x, Sb[2 * q].y, Sb[2 * q + 1].x, Sb[2 * q + 1].y);
    }
  }
}

__device__ __forceinline__ void rwkv_scan_phase(const Params& p, char* smem, bool dry = false) {
  const int G = gridDim.x;
  if (G >= 512) {
    if (blockIdx.x < 256) { const int a = blockIdx.x; rwkv_item(p, 1, a >> 5, (a >> 1) & 15, a & 1, smem, dry); }
    else for (int a = blockIdx.x - 256; a < 512; a += G - 256) { rwkv_item(p, 0, a >> 5, (a >> 1) & 15, a & 1, smem, dry); __syncthreads(); }
  } else {
    for (int it = blockIdx.x; it < 768; it += G) {
      const int grp = it < 256 ? 1 : 0, a = grp ? it : it - 256;
      rwkv_item(p, grp, a >> 5, (a >> 1) & 15, a & 1, smem, dry);
      __syncthreads();
    }
  }
}

__device__ __forceinline__ void blend_phase(const Params& p) {
  const int gid = blockIdx.x * NT + threadIdx.x, nth = gridDim.x * NT;
  for (int i = gid; i < NTOK * 128; i += nth) {
    const int row = i >> 7, k = (i & 127) * 8;
    ALoadShift a0{p.H, p.mix + 0 * 1024}, a2{p.H, p.mix + 2 * 1024}, a3{p.H, p.mix + 3 * 1024};
    const size_t o = (size_t)row * 1024 + k;
    *(uint4*)(p.E0 + o) = a0(row, k); *(uint4*)(p.E1 + o) = a2(row, k); *(uint4*)(p.A1 + o) = a3(row, k);
  }
}

__device__ __forceinline__ void rwkv_proj_phase(const Params& p, char* smem) {
  const int nunits = 96 * 27;
  for (int u = blockIdx.x; u < nunits; u += gridDim.x) {
    const int tm = u < 288 ? u / 3 : (u - 288) / 24, s = u < 288 ? 24 + u % 3 : (u - 288) % 24;
    if (s < 8) { EpiAct<0> ep{p.R, 1024, nullptr}; gemm_tile_glds(p.E0, 1024, p.wr_t, 1024, tm, s, ep, smem); }
    else if (s < 16) { EpiAct<0> ep{p.Kx, 1024, nullptr}; gemm_tile_glds(p.E1, 1024, p.wk_t, 1024, tm, s - 8, ep, smem); }
    else if (s < 24) { EpiAct<0> ep{p.Vx, 1024, nullptr}; gemm_tile_glds(p.A1, 1024, p.wv_t, 1024, tm, s - 16, ep, smem); }
    else if (s == 24) { ALoadShift al{p.H, p.mix + 1 * 1024}; EpiAct<2> ep{p.LW, 128, nullptr}; gemm_tile(al, p.w1cat_t, 1024, tm, 0, ep, smem); }
    else if (s == 25) { ALoadShift al{p.H, p.mix + 4 * 1024}; EpiAct<0> ep{p.LA, 128, nullptr}; gemm_tile(al, p.a1cat_t, 1024, tm, 0, ep, smem); }
    else { ALoadShift al{p.H, p.mix + 5 * 1024}; EpiAct<3> ep{p.LG, 128, nullptr}; gemm_tile(al, p.g1_t, 1024, tm, 0, ep, smem); }
  }
}
__device__ __forceinline__ void rwkv_lora2_phase(const Params& p, char* smem) {
  const int nunits = 96 * 32;
  for (int u = blockIdx.x; u < nunits; u += gridDim.x) {
    const int tm = u >> 5, s = u & 31, which = s >> 3, tn = s & 7;
    const int d = which & 1;
    if (which < 2) { ALoadPlain al{p.LW + d * 64, 128}; EpiAct<4> ep{d ? p.E1 : p.E0, 1024, p.w0 + d * 1024}; gemm_tile_glds(al.A, al.lda, p.w2_t + (size_t)d * 65536, 64, tm, tn, ep, smem); }
    else { ALoadPlain al{p.LA + d * 64, 128}; EpiAct<5> ep{d ? p.A1 : p.A0, 1024, p.a0 + d * 1024}; gemm_tile_glds(al.A, al.lda, p.a2_t + (size_t)d * 65536, 64, tm, tn, ep, smem); }
  }
}


#define XB_TMO      128
#define XB_XCNT(j)  (256  + 64 * (j))
#define XB_XSUB(j)  (1280 + 64 * (j))
#define XB_XGEN(j)  (2304 + 64 * (j))
#define XB_TOP      3328
#define XB_TOPGEN   3392
#define XCD_BAR_WORDS 3456
#define XB_SPIN_CAP (1u << 22)
#define LAS __attribute__((address_space(3)))
__device__ __forceinline__ unsigned xb_ld(unsigned* p)              { return __hip_atomic_load(p, __ATOMIC_RELAXED, __HIP_MEMORY_SCOPE_AGENT); }
__device__ __forceinline__ unsigned xb_add(unsigned* p, unsigned v) { return __hip_atomic_fetch_add(p, v, __ATOMIC_RELAXED, __HIP_MEMORY_SCOPE_AGENT); }
__device__ __forceinline__ unsigned xb_xcc_id() { return (unsigned)__builtin_amdgcn_s_getreg((3 << 11) | 20) & 0xFu; }
#define XB_SPIN(cond, bar) do { unsigned _sp = 0; while (cond) { __builtin_amdgcn_s_sleep(1); \
    if ((++_sp & 255u) == 0u) { if (xb_ld(&(bar)[XB_TMO])) break; if (_sp > XB_SPIN_CAP) { atomicAdd(&(bar)[XB_TMO], 1u); break; } } } } while (0)
struct XcdBarrier { unsigned* bar; unsigned x; volatile LAS unsigned* st; };
__device__ __forceinline__ XcdBarrier xcd_barrier_post(unsigned* bar, volatile LAS unsigned* st) {
    XcdBarrier b; b.bar = bar; b.x = xb_xcc_id(); b.st = st;
    if (threadIdx.x == 0) (void)xb_add(&bar[XB_XCNT(b.x)], 1u);
    return b;
}
__device__ __forceinline__ void xcd_barrier_complete(unsigned* bar, unsigned x, unsigned& nloc, unsigned& nx) {
    const unsigned G = gridDim.x * gridDim.y * gridDim.z;
    unsigned sum, cnt, mine, sp = 0u;
    for (;;) {
        sum = 0u; cnt = 0u; mine = 0u;
#pragma unroll
        for (unsigned j = 0; j < 16; ++j) { const unsigned c = xb_ld(&bar[XB_XCNT(j)]); sum += c; cnt += (c > 0u) ? 1u : 0u; mine = (j == x) ? c : mine; }
        if (sum == G) break;
        __builtin_amdgcn_s_sleep(1);
        if ((++sp & 255u) == 0u) { if (xb_ld(&bar[XB_TMO])) break; if (sp > XB_SPIN_CAP) { atomicAdd(&bar[XB_TMO], 1u); break; } }
    }
    nloc = mine > 0u ? mine : 1u; nx = cnt > 0u ? cnt : 1u;
}
__device__ __forceinline__ void xcd_barrier(const XcdBarrier& b) {
    asm volatile("s_waitcnt vmcnt(0)" ::: "memory");
    __syncthreads();
    if (threadIdx.x == 0) {
        unsigned* bar = b.bar;
        __builtin_amdgcn_s_waitcnt(0);
        unsigned nloc = b.st[0], nx = b.st[1];
        if (nloc == 0u) { xcd_barrier_complete(bar, b.x, nloc, nx); b.st[0] = nloc; b.st[1] = nx; }
        const unsigned old = xb_add(&bar[XB_XSUB(b.x)], 1u);
        const unsigned gen = old / nloc;
        if (old + 1u == (gen + 1u) * nloc) {
            __builtin_amdgcn_fence(__ATOMIC_RELEASE, "agent");
            asm volatile("s_waitcnt vmcnt(0)" ::: "memory");
            const unsigned og = xb_add(&bar[XB_TOP], 1u);
            const unsigned tg = og / nx;
            if (og + 1u == (tg + 1u) * nx) xb_add(&bar[XB_TOPGEN], 1u);
            else XB_SPIN(xb_ld(&bar[XB_TOPGEN]) == tg, bar);
            __builtin_amdgcn_fence(__ATOMIC_ACQUIRE, "agent");
            xb_add(&bar[XB_XGEN(b.x)], 1u);
            asm volatile("s_waitcnt vmcnt(0)" ::: "memory");
        } else {
            XB_SPIN(xb_ld(&bar[XB_XGEN(b.x)]) == gen, bar);
            __builtin_amdgcn_fence(__ATOMIC_ACQUIRE, "agent");
            asm volatile("s_waitcnt vmcnt(0)" ::: "memory");
        }
    }
    __syncthreads();
}

__device__ __forceinline__ void run_phase(const Params& p, int ph, char* smem, bool dry = false) {
  switch (ph) {
    case 0: if (ONLY_PHASE < 0 || ONLY_PHASE == 0) phase0(p, smem); break;
    case 1: if (ONLY_PHASE < 0 || ONLY_PHASE == 1) prenorm_phase(p, 0, 0, true); break;
    case 2: if (ONLY_PHASE < 0 || ONLY_PHASE == 2) { ALoadPlain al{p.H, 1024}; EpiWin ep{&p}; gemm_phase(al, p.w_in_t, 1024, 26, ep, smem); } break;
    case 3: if (ONLY_PHASE < 0 || ONLY_PHASE == 3) mix0_phase(p, smem); break;
    case 4: if (ONLY_PHASE < 0 || ONLY_PHASE == 4) hgrn_combine_phase(p); break;
    case 5: if (ONLY_PHASE < 0 || ONLY_PHASE == 5) { ALoadPlain al{p.AO, 1024}; EpiResid ep{&p, 0, 2, true}; gemm_phase(al, p.w_out_t, 1024, 8, ep, smem); } break;
    case 6: if (ONLY_PHASE < 0 || ONLY_PHASE == 6) prenorm_phase(p, 0, 1, false); break;
    case 7: if (ONLY_PHASE < 0 || ONLY_PHASE == 7) { ALoadPlain al{p.H, 1024}; EpiAct<1> ep{p.U, 4096, nullptr}; gemm_phase(al, p.mlp1_t, 1024, 32, ep, smem); } break;
    case 8: if (ONLY_PHASE < 0 || ONLY_PHASE == 8) { ALoadPlain al{p.U, 4096}; EpiResid ep{&p, 0, 5, false, dry}; gemm_phase(al, p.mlp2_t, 4096, 8, ep, smem); } break;
    case 9: if (ONLY_PHASE < 0 || ONLY_PHASE == 9) prenorm_phase(p, 1, 0, false); break;
    case 10: if (ONLY_PHASE < 0 || ONLY_PHASE == 10) rwkv_proj_phase(p, smem); break;
    case 11: if (ONLY_PHASE < 0 || ONLY_PHASE == 11) rwkv_lora2_phase(p, smem); break;
    case 12: if (ONLY_PHASE < 0 || ONLY_PHASE == 12) rwkv_scan_phase(p, smem, dry); break;
    case 13: if (ONLY_PHASE < 0 || ONLY_PHASE == 13) { ALoadPlain al{p.LG, 128}; EpiRwkvOut ep{&p}; gemm_phase(al, p.g2_t, 128, 8, ep, smem); } break;
    case 14: if (ONLY_PHASE < 0 || ONLY_PHASE == 14) { ALoadPlain al{p.ZO, 1024}; EpiResid ep{&p, 1, 2, false, dry}; gemm_phase(al, p.wo_t, 1024, 8, ep, smem); } break;
    case 15: if (ONLY_PHASE < 0 || ONLY_PHASE == 15) prenorm_phase(p, 1, 1, false); break;
    case 16: if (ONLY_PHASE < 0 || ONLY_PHASE == 16) { ALoadPlain al{p.H, 1024}; EpiAct<1> ep{p.U, 4096, nullptr}; gemm_phase(al, p.mlp1_t + (size_t)4096 * 1024, 1024, 32, ep, smem); } break;
    case 17: if (ONLY_PHASE < 0 || ONLY_PHASE == 17) { ALoadPlain al{p.U, 4096}; EpiResid ep{&p, 1, 5, false, dry}; gemm_phase(al, p.mlp2_t + (size_t)4096 * 1024, 4096, 8, ep, smem); } break;
    case 18: blend_phase(p); break;
    default: break;
  }
}

__global__ void __launch_bounds__(NT, 2) fwd_kernel(const Params p_unused, int ph_lo, int ph_hi) {
  const Params& p = *(const Params*)__builtin_amdgcn_kernarg_segment_ptr();
  __shared__ __attribute__((aligned(16))) char smem[65536];
  __shared__ uint4 xb_words;
  if (threadIdx.x == 0) xb_words = make_uint4(0u, 0u, 0u, 0u);
  __syncthreads();
  XcdBarrier xb = xcd_barrier_post(p.bar, (volatile LAS unsigned*)&xb_words);
  if (ph_hi < 0) cg::this_grid().sync();
#ifndef PROBE_MASK
#define PROBE_MASK 0
#endif
#ifndef PROBE_DRY
#define PROBE_DRY 0
#endif
#define PHASE(n, sync_) { if ((PROBE_MASK >> n) & 1) { run_phase(p, n, smem); xcd_barrier(xb); } if ((PROBE_DRY >> n) & 1) { run_phase(p, n, smem, true); xcd_barrier(xb); } run_phase(p, n, smem); if (sync_) xcd_barrier(xb); }
  PHASE(0, 1) PHASE(1, 1) PHASE(2, 1) PHASE(3, 1) PHASE(4, 1) PHASE(5, 1) PHASE(6, 1) PHASE(7, 1) PHASE(8, 1) PHASE(9, 1) PHASE(18, 1)
  PHASE(10, 1) PHASE(11, 1) PHASE(12, 1) PHASE(13, 1) PHASE(14, 1) PHASE(15, 1) PHASE(16, 1) PHASE(17, 0)
#undef PHASE
}

extern "C" void kernel_launch(void* const* d_in, const int* in_sizes, int n_in, void* d_out, int out_size, void* d_ws, size_t ws_size, hipStream_t stream) {
  Params p; memset(&p, 0, sizeof(p));
  auto F = [&](int i) { return (const float*)d_in[i]; };
  p.x_prompt = F(0); p.x_sample = F(1); p.cache_k = F(2); p.cache_v = F(3); p.hg_f0 = F(4); p.hg_b0 = F(5); p.rw_f0 = F(6); p.rw_b0 = F(7);
  p.c = F(8); p.c_ctx = F(9); p.ada_w = F(10); p.ada_b = F(11); p.norm1_w = F(12); p.norm2_w = F(13);
  p.q_norm = F(16); p.k_norm = F(17); p.hgrn_lb = F(18); p.g_norm = F(19); p.mix = F(20);
  p.w0 = F(25); p.a0 = F(28); p.k_k = F(33); p.k_a = F(34); p.r_k = F(35); p.ln_w = F(36); p.ln_b = F(37);
  float* out = (float*)d_out;
  p.X = out; p.out_k = out + 12582912; p.out_v = out + 13107200; p.out_hf = out + 13631488; p.out_hb = out + 14155776;
  p.out_rf = out + 14680064; p.out_rb = out + 15728640;
  char* ws = (char*)d_ws; size_t off = 16384;
  p.bar = (unsigned*)ws;
  auto alloc = [&](size_t bytes) { char* r = ws + off; off += (bytes + 255) & ~(size_t)255; return r; };
  const size_t M1 = (size_t)1024 * 1024;
  p.w_in_t = (bf16_t*)alloc((size_t)3328 * 1024 * 2); p.w_out_t = (bf16_t*)alloc(M1 * 2);
  p.wr_t = (bf16_t*)alloc(M1 * 2); p.wk_t = (bf16_t*)alloc(M1 * 2); p.wv_t = (bf16_t*)alloc(M1 * 2); p.wo_t = (bf16_t*)alloc(M1 * 2);
  p.w1cat_t = (bf16_t*)alloc(128 * 1024 * 2); p.a1cat_t = (bf16_t*)alloc(128 * 1024 * 2); p.g1_t = (bf16_t*)alloc(128 * 1024 * 2);
  p.w2_t = (bf16_t*)alloc(2 * 1024 * 64 * 2); p.a2_t = (bf16_t*)alloc(2 * 1024 * 64 * 2); p.g2_t = (bf16_t*)alloc(1024 * 128 * 2);
  p.mlp1_t = (bf16_t*)alloc(2 * 4 * M1 * 2); p.mlp2_t = (bf16_t*)alloc(2 * 4 * M1 * 2);
  p.MOD = (float*)alloc((size_t)2 * 9 * 6144 * 4);
  const size_t TOKD = (size_t)NTOK * 1024;
  p.H = (bf16_t*)alloc(TOKD * 2);
  const size_t regL = off;
  p.Qbuf = (bf16_t*)alloc((size_t)NTOK * 512 * 2);
  p.Kp = (bf16_t*)alloc((size_t)32 * 256 * 64 * 2); p.Ks = (bf16_t*)alloc((size_t)16 * 1280 * 64 * 2);
  p.Vtp = (bf16_t*)alloc((size_t)32 * 64 * 256 * 2); p.Vts = (bf16_t*)alloc((size_t)16 * 64 * 1280 * 2);
  p.HG = (bf16_t*)alloc((size_t)NTOK * 2560 * 2);
  p.OF = (float*)alloc((size_t)NTOK * 512 * 4); p.OB = (float*)alloc((size_t)NTOK * 512 * 4);
  p.AO = (bf16_t*)alloc(TOKD * 2);
  size_t end0 = off;
  off = regL; p.U = (bf16_t*)alloc((size_t)NTOK * 4096 * 2);
  size_t endU = off;
  off = regL;
  p.R = (bf16_t*)alloc(TOKD * 2); p.Kx = (bf16_t*)alloc(TOKD * 2); p.Vx = (bf16_t*)alloc(TOKD * 2);
  p.LW = (bf16_t*)alloc((size_t)NTOK * 128 * 2); p.LA = (bf16_t*)alloc((size_t)NTOK * 128 * 2); p.LG = (bf16_t*)alloc((size_t)NTOK * 128 * 2);
  p.E0 = (bf16_t*)alloc(TOKD * 2); p.E1 = (bf16_t*)alloc(TOKD * 2); p.A1 = (bf16_t*)alloc(TOKD * 2);
  p.BS = (float*)alloc((size_t)2 * NTOK * 16 * 4);
  p.A0 = p.H; p.ZO = p.R;
  size_t end1 = off;
  size_t need = end0 > end1 ? end0 : end1; if (endU > need) need = endU;
  if (need > ws_size) fprintf(stderr, "workspace too small: need %zu have %zu\n", need, ws_size);
  int nj = 0, tiles = 0;
  auto job = [&](const float* src, bf16_t* dst, int K, int N) { p.jobs[nj].src = src; p.jobs[nj].dst = dst; p.jobs[nj].K = K; p.jobs[nj].N = N; p.jobs[nj].tile0 = tiles; p.jobs[nj].pad = 0; tiles += (K / 64) * (N / 64); ++nj; };
  job(F(38), p.mlp1_t, 1024, 4096); job(F(38) + 4 * M1, p.mlp1_t + 4 * M1, 1024, 4096);
  job(F(39), p.mlp2_t, 4096, 1024); job(F(39) + 4 * M1, p.mlp2_t + 4 * M1, 4096, 1024);
  job(F(14), p.w_in_t, 1024, 3328); job(F(15), p.w_out_t, 1024, 1024);
  job(F(21), p.wr_t, 1024, 1024); job(F(22), p.wk_t, 1024, 1024); job(F(23), p.wv_t, 1024, 1024); job(F(24), p.wo_t, 1024, 1024);
  job(F(26), p.w1cat_t, 1024, 64); job(F(26) + 65536, p.w1cat_t + 65536, 1024, 64);
  job(F(29), p.a1cat_t, 1024, 64); job(F(29) + 65536, p.a1cat_t + 65536, 1024, 64);
  job(F(31), p.g1_t, 1024, 128);
  job(F(27), p.w2_t, 64, 1024); job(F(27) + 65536, p.w2_t + 65536, 64, 1024);
  job(F(30), p.a2_t, 64, 1024); job(F(30) + 65536, p.a2_t + 65536, 64, 1024);
  job(F(32), p.g2_t, 128, 1024);
  p.njobs = nj; p.ntiles = tiles;

  static int grid_blocks = 0;
  if (!grid_blocks) {
    int dev = 0, cus = 0, per_cu = 0;
    hipGetDevice(&dev);
    hipDeviceGetAttribute(&cus, hipDeviceAttributeMultiprocessorCount, dev);
    hipOccupancyMaxActiveBlocksPerMultiprocessor(&per_cu, fwd_kernel, NT, 0);
    if (per_cu > 2) per_cu = 2;
    if (per_cu < 1) per_cu = 1;
    grid_blocks = cus * per_cu;
  }
  hipMemsetAsync(d_ws, 0, 16384, stream);
#if ONE_LAUNCH
  int lo = 0, hi = NPHASES;
  void* args[] = {(void*)&p, (void*)&lo, (void*)&hi};
  hipError_t e = hipLaunchCooperativeKernel((void*)fwd_kernel, dim3(grid_blocks), dim3(NT), args, 0, stream);
  if (e != hipSuccess) fprintf(stderr, "cooperative launch failed: %s (grid %d)\n", hipGetErrorString(e), grid_blocks);
#else
  for (int ph = 0; ph < NPHASES; ++ph) hipLaunchKernelGGL(fwd_kernel, dim3(grid_blocks), dim3(NT), 0, stream, p, ph, ph + 1);
#endif
}
```

```cpp
#include <hip/hip_runtime.h>
#include <hip/hip_cooperative_groups.h>
#include <stdint.h>
#include <string.h>
#include <stdio.h>
namespace cg = cooperative_groups;

#ifndef ONE_LAUNCH
#define ONE_LAUNCH 1
#endif

typedef unsigned short bf16_t;
typedef short bf16x8 __attribute__((ext_vector_type(8)));
typedef float f32x4 __attribute__((ext_vector_type(4)));
typedef float f32x16 __attribute__((ext_vector_type(16)));
typedef float f32x2 __attribute__((ext_vector_type(2)));

#define NT 256
#define NTOK 12288
#define NP 4096
#define NPHASES 18
#ifndef ONLY_PHASE
#define ONLY_PHASE -1
#endif

struct TJob { const float* src; bf16_t* dst; int K, N, tile0, pad; };

struct Params {
  const float *x_prompt, *x_sample, *cache_k, *cache_v, *hg_f0, *hg_b0, *rw_f0, *rw_b0, *c, *c_ctx;
  const float *ada_w, *ada_b, *norm1_w, *norm2_w, *q_norm, *k_norm, *hgrn_lb, *g_norm;
  const float *mix, *w0, *a0, *k_k, *k_a, *r_k, *ln_w, *ln_b;
  float *X, *out_k, *out_v, *out_hf, *out_hb, *out_rf, *out_rb;
  bf16_t *w_in_t, *w_out_t, *wr_t, *wk_t, *wv_t, *wo_t, *w1cat_t, *a1cat_t, *g1_t, *w2_t, *a2_t, *g2_t, *mlp1_t, *mlp2_t;
  float* MOD;
  bf16_t* H;
  bf16_t *Qbuf, *Kp, *Ks, *Vtp, *Vts, *HG, *AO, *U;
  float *OF, *OB;
  bf16_t *R, *Kx, *Vx, *LW, *LA, *LG, *E0, *E1, *A0, *A1, *ZO;
  float* BS;
  unsigned* bar;
  TJob jobs[20];
  int njobs, ntiles;
};

__device__ __forceinline__ unsigned pk_bf16(float lo, float hi) { unsigned r; asm("v_cvt_pk_bf16_f32 %0, %1, %2" : "=v"(r) : "v"(lo), "v"(hi)); return r; }
__device__ __forceinline__ bf16_t f2bf(float v) { return (bf16_t)(pk_bf16(v, 0.f) & 0xffffu); }
__device__ __forceinline__ float bf2f(bf16_t v) { return __uint_as_float(((unsigned)v) << 16); }
__device__ __forceinline__ float bflo(unsigned u) { return __uint_as_float(u << 16); }
__device__ __forceinline__ float bfhi(unsigned u) { return __uint_as_float(u & 0xffff0000u); }
__device__ __forceinline__ float sigmoidf_(float x) { return 1.f / (1.f + __expf(-x)); }
__device__ __forceinline__ float siluf_(float x) { return x / (1.f + __expf(-x)); }
__device__ __forceinline__ float wave_sum(float v) {
#pragma unroll
  for (int o = 32; o >= 1; o >>= 1) v += __shfl_xor(v, o);
  return v;
}
__device__ __forceinline__ float quad_sum(float v) {
  v += __int_as_float(__builtin_amdgcn_update_dpp(0, __float_as_int(v), 0xB1, 0xF, 0xF, true));
  v += __int_as_float(__builtin_amdgcn_update_dpp(0, __float_as_int(v), 0x4E, 0xF, 0xF, true));
  return v;
}
__device__ __forceinline__ float oct_sum(float v) {
  v += __int_as_float(__builtin_amdgcn_update_dpp(0, __float_as_int(v), 0xB1, 0xF, 0xF, true));
  v += __int_as_float(__builtin_amdgcn_update_dpp(0, __float_as_int(v), 0x4E, 0xF, 0xF, true));
  v += __int_as_float(__builtin_amdgcn_update_dpp(0, __float_as_int(v), 0x141, 0xF, 0xF, true));
  return v;
}
__device__ __forceinline__ float hex_sum(float v) {
  v = oct_sum(v);
  v += __int_as_float(__builtin_amdgcn_update_dpp(0, __float_as_int(v), 0x140, 0xF, 0xF, true));
  return v;
}
__device__ __forceinline__ int mod_index(int row) { return row < NP ? 0 : 1 + ((row - NP) >> 10); }

__device__ __forceinline__ void ada_item(const Params& p, int it, char* smem) {
  const int tid = threadIdx.x;
  float* sil = (float*)smem;
  for (int i = tid; i < 9 * 1024; i += NT) {
    int n = i >> 10, k = i & 1023;
    float cv = n == 0 ? p.c_ctx[k] : p.c[(n - 1) * 1024 + k];
    sil[i] = siluf_(cv);
  }
  __syncthreads();
  const int gcol = it * 64, l = gcol / 6144, j = gcol % 6144;
  const int c4 = tid & 15, ks = tid >> 4;
  const float* wp = p.ada_w + (size_t)l * 1024 * 6144 + (size_t)(ks * 64) * 6144 + j + c4 * 4;
  float acc[9][4];
#pragma unroll
  for (int n = 0; n < 9; ++n) { acc[n][0] = 0.f; acc[n][1] = 0.f; acc[n][2] = 0.f; acc[n][3] = 0.f; }
#pragma unroll 4
  for (int k = 0; k < 64; ++k) {
    const float4 w = *(const float4*)(wp + (size_t)k * 6144);
#pragma unroll
    for (int n = 0; n < 9; ++n) {
      const float s = sil[n * 1024 + ks * 64 + k];
      acc[n][0] += s * w.x; acc[n][1] += s * w.y; acc[n][2] += s * w.z; acc[n][3] += s * w.w;
    }
  }
  __syncthreads();
  float* red = (float*)smem;
#pragma unroll
  for (int n = 0; n < 9; ++n)
#pragma unroll
    for (int q = 0; q < 4; ++q) red[(ks * 9 + n) * 64 + c4 * 4 + q] = acc[n][q];
  __syncthreads();
  for (int o = tid; o < 576; o += NT) {
    const int n = o >> 6, cc = o & 63;
    float s = 0.f;
#pragma unroll
    for (int k2 = 0; k2 < 16; ++k2) s += red[(k2 * 9 + n) * 64 + cc];
    s += p.ada_b[l * 6144 + j + cc];
    p.MOD[(size_t)(l * 9 + n) * 6144 + j + cc] = s;
  }
}

__device__ __forceinline__ void transpose_item(const Params& p, int tix, char* smem) {
  const int tid = threadIdx.x;
  int j = 0;
  while (j + 1 < p.njobs && tix >= p.jobs[j + 1].tile0) ++j;
  const float* src = p.jobs[j].src; bf16_t* dst = p.jobs[j].dst;
  const int K = p.jobs[j].K, N = p.jobs[j].N, lt = tix - p.jobs[j].tile0;
  const int ntn = N >> 6, tk = lt / ntn, tn = lt % ntn;
  float* tile = (float*)smem;
#pragma unroll
  for (int i = 0; i < 4; ++i) {
    const int r = (tid >> 4) + 16 * i, c4 = tid & 15;
    const float4 v = *(const float4*)(src + (size_t)(tk * 64 + r) * N + tn * 64 + c4 * 4);
    float* t = tile + r * 65 + c4 * 4;
    t[0] = v.x; t[1] = v.y; t[2] = v.z; t[3] = v.w;
  }
  __syncthreads();
  const int n = tid >> 2, kc = (tid & 3) * 16;
  unsigned w[8];
#pragma unroll
  for (int i = 0; i < 8; ++i) w[i] = pk_bf16(tile[(kc + 2 * i) * 65 + n], tile[(kc + 2 * i + 1) * 65 + n]);
  uint4* d = (uint4*)(dst + (size_t)(tn * 64 + n) * K + tk * 64 + kc);
  d[0] = make_uint4(w[0], w[1], w[2], w[3]);
  d[1] = make_uint4(w[4], w[5], w[6], w[7]);
}

__device__ __forceinline__ void cache_item(const Params& p, int ci) {
  const int tid = threadIdx.x;
  const int base = (ci & 31) * 8192;
  for (int e = tid; e < 8192; e += NT) {
    const int idx = base + e;
    const int d = idx & 63, kvh = (idx >> 6) & 1, pp = (idx >> 7) & 255, b = idx >> 15;
    if (ci < 32) p.Ks[((size_t)(b * 2 + kvh) * 1280 + 1024 + pp) * 64 + d] = f2bf(p.cache_k[idx]);
    else p.Vts[((size_t)(b * 2 + kvh) * 64 + d) * 1280 + 1024 + pp] = f2bf(p.cache_v[idx]);
  }
}

__device__ __forceinline__ void phase0(const Params& p, char* smem) {
  const int n_ada = 192, n_tr = p.ntiles, n_cc = 64;
  const int total = n_ada + n_tr + n_cc;
  for (int it = blockIdx.x; it < total; it += gridDim.x) {
    if (it < n_ada) ada_item(p, it, smem);
    else if (it < n_ada + n_tr) transpose_item(p, it - n_ada, smem);
    else cache_item(p, it - n_ada - n_tr);
    __syncthreads();
  }
}

__device__ __forceinline__ void prenorm_phase(const Params& p, int layer, int which, bool from_input) {
  const int wave = threadIdx.x >> 6, lane = threadIdx.x & 63;
  const float* nw = (which ? p.norm2_w : p.norm1_w) + layer * 1024;
  for (int row = blockIdx.x * 4 + wave; row < NTOK; row += gridDim.x * 4) {
    const float* xr = from_input ? (row < NP ? p.x_prompt + (size_t)row * 1024 : p.x_sample + (size_t)(row - NP) * 1024)
                                 : p.X + (size_t)row * 1024;
    float4 v[4]; float ss = 0.f;
#pragma unroll
    for (int i = 0; i < 4; ++i) { v[i] = *(const float4*)(xr + i * 256 + lane * 4); ss += v[i].x * v[i].x + v[i].y * v[i].y + v[i].z * v[i].z + v[i].w * v[i].w; }
    ss = wave_sum(ss);
    const float rstd = rsqrtf(ss * (1.f / 1024.f) + 1e-6f);
    const float* md = p.MOD + (size_t)(layer * 9 + mod_index(row)) * 6144;
    const float* sh = md + (which ? 3 : 0) * 1024; const float* sc = md + (which ? 4 : 1) * 1024;
#pragma unroll
    for (int i = 0; i < 4; ++i) {
      const int c = i * 256 + lane * 4;
      const float4 w4 = *(const float4*)(nw + c), s4 = *(const float4*)(sh + c), c4 = *(const float4*)(sc + c);
      const float h0 = v[i].x * rstd * w4.x * (1.f + c4.x) + s4.x, h1 = v[i].y * rstd * w4.y * (1.f + c4.y) + s4.y;
      const float h2 = v[i].z * rstd * w4.z * (1.f + c4.z) + s4.z, h3 = v[i].w * rstd * w4.w * (1.f + c4.w) + s4.w;
      *(uint2*)(p.H + (size_t)row * 1024 + c) = make_uint2(pk_bf16(h0, h1), pk_bf16(h2, h3));
    }
  }
}

struct ALoadPlain {
  const bf16_t* A; int lda;
  __device__ __forceinline__ uint4 operator()(int row, int k) const { return *(const uint4*)(A + (size_t)row * lda + k); }
};
struct ALoadShift {
  const bf16_t* H; const float* mix;
  __device__ __forceinline__ uint4 operator()(int row, int k) const {
    const uint4 h = *(const uint4*)(H + (size_t)row * 1024 + k);
    int tl, T;
    if (row < NP) { tl = row & 255; T = 256; } else { tl = (row - NP) & 1023; T = 1024; }
    uint4 s = make_uint4(0, 0, 0, 0);
    if (k < 512) { if (tl > 0) s = *(const uint4*)(H + (size_t)(row - 1) * 1024 + k); }
    else { if (tl < T - 1) s = *(const uint4*)(H + (size_t)(row + 1) * 1024 + k); }
    const float4 m0 = *(const float4*)(mix + k), m1 = *(const float4*)(mix + k + 4);
    uint4 o;
    { float a = bflo(h.x), b = bfhi(h.x); o.x = pk_bf16(a + (bflo(s.x) - a) * m0.x, b + (bfhi(s.x) - b) * m0.y); }
    { float a = bflo(h.y), b = bfhi(h.y); o.y = pk_bf16(a + (bflo(s.y) - a) * m0.z, b + (bfhi(s.y) - b) * m0.w); }
    { float a = bflo(h.z), b = bfhi(h.z); o.z = pk_bf16(a + (bflo(s.z) - a) * m1.x, b + (bfhi(s.z) - b) * m1.y); }
    { float a = bflo(h.w), b = bfhi(h.w); o.w = pk_bf16(a + (bflo(s.w) - a) * m1.z, b + (bfhi(s.w) - b) * m1.w); }
    return o;
  }
};

template <class AL, class EP>
__device__ __forceinline__ void gemm_tile(const AL& al, const bf16_t* __restrict__ Bt, int K, int tm, int tn, const EP& ep, char* smem) {
  const int tid = threadIdx.x, lane = tid & 63, wid = tid >> 6, wm = wid >> 1, wn = wid & 1;
  const int fr = lane & 15, fq = lane >> 4;
  char* sA = smem; char* sB = smem + 32768;
  f32x4 acc[4][4];
#pragma unroll
  for (int a = 0; a < 4; ++a)
#pragma unroll
    for (int b = 0; b < 4; ++b) acc[a][b] = (f32x4){0.f, 0.f, 0.f, 0.f};
  uint4 pa[4], pb[4];
  const int nk = K >> 6;
  const int cr0 = tid >> 3, cc = tid & 7;
  const int soff = cr0 * 128 + ((cc ^ ((cr0 >> 1) & 7)) << 4);
  const bf16_t* bp = Bt + (size_t)(tn * 128 + cr0) * K + cc * 8;
#define GLOAD(kt) do { _Pragma("unroll") for (int i = 0; i < 4; ++i) { pa[i] = al(tm * 128 + cr0 + 32 * i, (kt) * 64 + cc * 8); pb[i] = *(const uint4*)(bp + (size_t)(32 * i) * K + (kt) * 64); } } while (0)
#define SSTORE(buf) do { _Pragma("unroll") for (int i = 0; i < 4; ++i) { *(uint4*)(sA + (buf) * 16384 + soff + i * 4096) = pa[i]; *(uint4*)(sB + (buf) * 16384 + soff + i * 4096) = pb[i]; } } while (0)
  GLOAD(0); SSTORE(0); __syncthreads();
  for (int kt = 0; kt < nk; ++kt) {
    const int buf = kt & 1;
    if (kt + 1 < nk) GLOAD(kt + 1);
#pragma unroll
    for (int kk = 0; kk < 2; ++kk) {
      bf16x8 af[4], bfr[4];
#pragma unroll
      for (int mi = 0; mi < 4; ++mi) { const int r = wm * 64 + mi * 16 + fr, c = kk * 4 + fq; af[mi] = *(const bf16x8*)(sA + buf * 16384 + r * 128 + ((c ^ ((r >> 1) & 7)) << 4)); }
#pragma unroll
      for (int ni = 0; ni < 4; ++ni) { const int r = wn * 64 + ni * 16 + fr, c = kk * 4 + fq; bfr[ni] = *(const bf16x8*)(sB + buf * 16384 + r * 128 + ((c ^ ((r >> 1) & 7)) << 4)); }
#pragma unroll
      for (int mi = 0; mi < 4; ++mi)
#pragma unroll
        for (int ni = 0; ni < 4; ++ni) acc[mi][ni] = __builtin_amdgcn_mfma_f32_16x16x32_bf16(bfr[ni], af[mi], acc[mi][ni], 0, 0, 0);
    }
    if (kt + 1 < nk) SSTORE(buf ^ 1);
    __syncthreads();
  }
#undef GLOAD
#undef SSTORE
  ep(acc, tm * 128 + wm * 64, tn * 128 + wn * 64, lane);
}

#define LAS3 __attribute__((address_space(3)))
template <int OFF>
__device__ __forceinline__ bf16x8 lds_rd128(unsigned addr) { bf16x8 v; asm volatile("ds_read_b128 %0, %1 offset:%2" : "=v"(v) : "v"(addr), "n"(OFF) : "memory"); return v; }
template <class EP>
__device__ __forceinline__ void gemm_tile_glds(const bf16_t* __restrict__ A, int lda, const bf16_t* __restrict__ Bt, int K, int tm, int tn, const EP& ep, char* smem) {
  const int tid = threadIdx.x, lane = tid & 63, wid = __builtin_amdgcn_readfirstlane(tid >> 6), wm = wid >> 1, wn = wid & 1;
  const int fr = lane & 15, fq = lane >> 4;
  f32x4 acc[4][4];
#pragma unroll
  for (int a = 0; a < 4; ++a)
#pragma unroll
    for (int b = 0; b < 4; ++b) acc[a][b] = (f32x4){0.f, 0.f, 0.f, 0.f};
  const int nk = K >> 6;
  const int lr = lane >> 3, c0 = (lane & 7) ^ (lr >> 1);
  const bf16_t* pa = A + (size_t)(tm * 128 + wid * 32 + lr) * lda;
  const bf16_t* pb = Bt + (size_t)(tn * 128 + wid * 32 + lr) * K;
  const unsigned lbase = (unsigned)(uintptr_t)(LAS3 char*)smem;
  const unsigned fsw = (unsigned)((fq ^ ((fr >> 1) & 7)) << 4);
  const unsigned aA0 = lbase + (unsigned)((wm * 64 + fr) * 128) + fsw, aA1 = lbase + (unsigned)((wm * 64 + fr) * 128) + (fsw ^ 64u);
  const unsigned aB0 = lbase + 32768u + (unsigned)((wn * 64 + fr) * 128) + fsw, aB1 = lbase + 32768u + (unsigned)((wn * 64 + fr) * 128) + (fsw ^ 64u);
#define GLDS(kt, buf) do { _Pragma("unroll") for (int i = 0; i < 4; ++i) { const int cc_ = (c0 ^ ((i & 1) << 2)) * 8 + (kt) * 64; \
    __builtin_amdgcn_global_load_lds((const unsigned*)(pa + (size_t)(i * 8) * lda + cc_), (LAS3 unsigned*)(smem + (buf) * 16384 + (wid * 4 + i) * 1024), 16, 0, 0); \
    __builtin_amdgcn_global_load_lds((const unsigned*)(pb + (size_t)(i * 8) * K + cc_), (LAS3 unsigned*)(smem + 32768 + (buf) * 16384 + (wid * 4 + i) * 1024), 16, 0, 0); } } while (0)
  GLDS(0, 0);
  asm volatile("s_waitcnt vmcnt(0)" ::: "memory");
  __builtin_amdgcn_s_barrier();
  for (int kt = 0; kt < nk; ++kt) {
    const int buf = kt & 1;
    if (kt + 1 < nk) GLDS(kt + 1, buf ^ 1);
    const unsigned bo = (unsigned)buf * 16384u;
    bf16x8 a0[4], b0[4], a1[4], b1[4];
    a0[0] = lds_rd128<0>(aA0 + bo); a0[1] = lds_rd128<2048>(aA0 + bo); a0[2] = lds_rd128<4096>(aA0 + bo); a0[3] = lds_rd128<6144>(aA0 + bo);
    b0[0] = lds_rd128<0>(aB0 + bo); b0[1] = lds_rd128<2048>(aB0 + bo); b0[2] = lds_rd128<4096>(aB0 + bo); b0[3] = lds_rd128<6144>(aB0 + bo);
    a1[0] = lds_rd128<0>(aA1 + bo); a1[1] = lds_rd128<2048>(aA1 + bo); a1[2] = lds_rd128<4096>(aA1 + bo); a1[3] = lds_rd128<6144>(aA1 + bo);
    b1[0] = lds_rd128<0>(aB1 + bo); b1[1] = lds_rd128<2048>(aB1 + bo); b1[2] = lds_rd128<4096>(aB1 + bo); b1[3] = lds_rd128<6144>(aB1 + bo);
    __builtin_amdgcn_sched_barrier(0);
    asm volatile("s_waitcnt lgkmcnt(8)" : "+v"(a0[0]), "+v"(a0[1]), "+v"(a0[2]), "+v"(a0[3]), "+v"(b0[0]), "+v"(b0[1]), "+v"(b0[2]), "+v"(b0[3]) :: "memory");
    __builtin_amdgcn_s_setprio(1);
#pragma unroll
    for (int mi = 0; mi < 4; ++mi)
#pragma unroll
      for (int ni = 0; ni < 4; ++ni) acc[mi][ni] = __builtin_amdgcn_mfma_f32_16x16x32_bf16(b0[ni], a0[mi], acc[mi][ni], 0, 0, 0);
    __builtin_amdgcn_sched_barrier(0);
    asm volatile("s_waitcnt lgkmcnt(0)" : "+v"(a1[0]), "+v"(a1[1]), "+v"(a1[2]), "+v"(a1[3]), "+v"(b1[0]), "+v"(b1[1]), "+v"(b1[2]), "+v"(b1[3]) :: "memory");
#pragma unroll
    for (int mi = 0; mi < 4; ++mi)
#pragma unroll
      for (int ni = 0; ni < 4; ++ni) acc[mi][ni] = __builtin_amdgcn_mfma_f32_16x16x32_bf16(b1[ni], a1[mi], acc[mi][ni], 0, 0, 0);
    __builtin_amdgcn_s_setprio(0);
    __builtin_amdgcn_sched_barrier(0);
    asm volatile("s_waitcnt vmcnt(0)" ::: "memory");
    __builtin_amdgcn_s_barrier();
    __builtin_amdgcn_sched_barrier(0);
  }
#undef GLDS
  ep(acc, tm * 128 + wm * 64, tn * 128 + wn * 64, lane);
}

struct EpiWin {
  const Params* pp;
  __device__ __forceinline__ void operator()(f32x4 (&acc)[4][4], int row0, int col0, int lane) const {
    const Params& p = *pp;
    const int fr = lane & 15, fq = lane >> 4;
    const bool sample = row0 >= NP;
    if (col0 < 640) {
      const bool isq = col0 < 512;
      const float* nw = isq ? p.q_norm : p.k_norm;
      float nwv[4][4];
#pragma unroll
      for (int ni = 0; ni < 4; ++ni)
#pragma unroll
        for (int j = 0; j < 4; ++j) nwv[ni][j] = nw[ni * 16 + fq * 4 + j];
#pragma unroll
      for (int mi = 0; mi < 4; ++mi) {
        const int row = row0 + mi * 16 + fr;
        float ss = 0.f;
#pragma unroll
        for (int ni = 0; ni < 4; ++ni)
#pragma unroll
          for (int j = 0; j < 4; ++j) ss += acc[mi][ni][j] * acc[mi][ni][j];
        ss += __shfl_xor(ss, 16); ss += __shfl_xor(ss, 32);
        const float rn = rsqrtf(ss * (1.f / 64.f) + 1e-6f);
        float y[4][4];
#pragma unroll
        for (int ni = 0; ni < 4; ++ni)
#pragma unroll
          for (int j = 0; j < 4; ++j) y[ni][j] = acc[mi][ni][j] * rn * nwv[ni][j];
        if (!sample && !isq) {
          const int kvh = (col0 - 512) >> 6;
#pragma unroll
          for (int ni = 0; ni < 4; ++ni) *(f32x4*)(p.out_k + (size_t)row * 128 + kvh * 64 + ni * 16 + fq * 4) = (f32x4){y[ni][0], y[ni][1], y[ni][2], y[ni][3]};
        }
        if (sample) {
          const int tl = (row - NP) & 1023;
          const float rp = (float)(tl >> 6), cp = (float)(tl & 63);
#pragma unroll
          for (int ni = 0; ni < 4; ++ni)
#pragma unroll
            for (int jp = 0; jp < 2; ++jp) {
              const int i = (ni * 16 + fq * 4 + jp * 2) >> 1;
              const float pos = i < 16 ? rp : cp;
              const float inv = exp2f(-(float)(i & 15) * 0.83048202372184058696f);
              const float ang = pos * inv;
              const float s = __sinf(ang), c = __cosf(ang);
              const float x0 = y[ni][2 * jp], x1 = y[ni][2 * jp + 1];
              y[ni][2 * jp] = x0 * c - x1 * s; y[ni][2 * jp + 1] = x0 * s + x1 * c;
            }
        }
        if (isq) {
          const float qs = 0.125f * 1.44269504088896f;
#pragma unroll
          for (int ni = 0; ni < 4; ++ni)
            *(uint2*)(p.Qbuf + (size_t)row * 512 + col0 + ni * 16 + fq * 4) = make_uint2(pk_bf16(y[ni][0] * qs, y[ni][1] * qs), pk_bf16(y[ni][2] * qs, y[ni][3] * qs));
        } else {
          const int kvh = (col0 - 512) >> 6;
          bf16_t* kd;
          if (!sample) kd = p.Kp + ((size_t)((row >> 8) * 2 + kvh) * 256 + (row & 255)) * 64;
          else kd = p.Ks + ((size_t)(((row - NP) >> 10) * 2 + kvh) * 1280 + ((row - NP) & 1023)) * 64;
#pragma unroll
          for (int ni = 0; ni < 4; ++ni)
            *(uint2*)(kd + ni * 16 + fq * 4) = make_uint2(pk_bf16(y[ni][0], y[ni][1]), pk_bf16(y[ni][2], y[ni][3]));
        }
      }
    } else if (col0 < 768) {
      const int kvh = (col0 - 640) >> 6;
#pragma unroll
      for (int mi = 0; mi < 4; ++mi) {
        const int row = row0 + mi * 16 + fr;
#pragma unroll
        for (int ni = 0; ni < 4; ++ni) {
          const int d0 = ni * 16 + fq * 4;
          if (!sample) {
            *(f32x4*)(p.out_v + (size_t)row * 128 + kvh * 64 + d0) = acc[mi][ni];
            bf16_t* vd = p.Vtp + ((size_t)((row >> 8) * 2 + kvh) * 64 + d0) * 256 + (row & 255);
#pragma unroll
            for (int j = 0; j < 4; ++j) vd[j * 256] = f2bf(acc[mi][ni][j]);
          } else {
            bf16_t* vd = p.Vts + ((size_t)(((row - NP) >> 10) * 2 + kvh) * 64 + d0) * 1280 + ((row - NP) & 1023);
#pragma unroll
            for (int j = 0; j < 4; ++j) vd[j * 1280] = f2bf(acc[mi][ni][j]);
          }
        }
      }
    } else {
      const int c0 = col0 - 768, seg = c0 >> 9;
      float oml[4][4];
      if (seg == 1 || seg == 2) {
#pragma unroll
        for (int ni = 0; ni < 4; ++ni)
#pragma unroll
          for (int j = 0; j < 4; ++j) { const int c = (c0 & 511) + ni * 16 + fq * 4 + j; oml[ni][j] = 1.f / (1.f + __expf(p.hgrn_lb[c] - p.hgrn_lb[512 + c])); }
      }
#pragma unroll
      for (int mi = 0; mi < 4; ++mi) {
        const int row = row0 + mi * 16 + fr;
#pragma unroll
        for (int ni = 0; ni < 4; ++ni) {
          float o[4];
#pragma unroll
          for (int j = 0; j < 4; ++j) {
            const float v = acc[mi][ni][j];
            if (seg == 0 || seg == 4) o[j] = siluf_(v);
            else if (seg == 3) o[j] = v;
            else o[j] = oml[ni][j] * sigmoidf_(-v);
          }
          *(uint2*)(p.HG + (size_t)row * 2560 + c0 + ni * 16 + fq * 4) = make_uint2(pk_bf16(o[0], o[1]), pk_bf16(o[2], o[3]));
        }
      }
    }
  }
};

struct EpiResid {
  const Params* pp; int layer, gidx; bool from_input; bool dry = false;
  __device__ __forceinline__ void operator()(f32x4 (&acc)[4][4], int row0, int col0, int lane) const {
    const Params& p = *pp;
    if (dry && p.njobs >= 0) return;
    const int fr = lane & 15, fq = lane >> 4;
    const float* gt = p.MOD + (size_t)(layer * 9 + mod_index(row0)) * 6144 + gidx * 1024;
#pragma unroll
    for (int mi = 0; mi < 4; ++mi) {
      const int row = row0 + mi * 16 + fr;
      const float* base = from_input ? (row < NP ? p.x_prompt + (size_t)row * 1024 : p.x_sample + (size_t)(row - NP) * 1024) : p.X + (size_t)row * 1024;
#pragma unroll
      for (int ni = 0; ni < 4; ++ni) {
        const int col = col0 + ni * 16 + fq * 4;
        const f32x4 b = *(const f32x4*)(base + col), g = *(const f32x4*)(gt + col);
        *(f32x4*)(p.X + (size_t)row * 1024 + col) = b + g * acc[mi][ni];
      }
    }
  }
};

template <int ACT>
struct EpiAct {
  bf16_t* O; int ldo; const float* bias;
  __device__ __forceinline__ void operator()(f32x4 (&acc)[4][4], int row0, int col0, int lane) const {
    const int fr = lane & 15, fq = lane >> 4;
#pragma unroll
    for (int ni = 0; ni < 4; ++ni) {
      const int col = col0 + ni * 16 + fq * 4;
      f32x4 bv = (f32x4){0.f, 0.f, 0.f, 0.f};
      if (ACT >= 4) bv = *(const f32x4*)(bias + col);
#pragma unroll
      for (int mi = 0; mi < 4; ++mi) {
        const int row = row0 + mi * 16 + fr;
        float o[4];
#pragma unroll
        for (int j = 0; j < 4; ++j) {
          const float v = acc[mi][ni][j] + bv[j];
          if (ACT == 0) o[j] = v;
          else if (ACT == 1) { const float r = fmaxf(v, 0.f); o[j] = r * r; }
          else if (ACT == 2) o[j] = 1.f - 2.f / (1.f + __expf(2.f * v));
          else if (ACT == 3 || ACT == 5) o[j] = sigmoidf_(v);
          else o[j] = 0.60653065971263342f * sigmoidf_(v);
        }
        *(uint2*)(O + (size_t)row * ldo + col) = make_uint2(pk_bf16(o[0], o[1]), pk_bf16(o[2], o[3]));
      }
    }
  }
};

struct EpiRwkvOut {
  const Params* pp;
  __device__ __forceinline__ void operator()(f32x4 (&acc)[4][4], int row0, int col0, int lane) const {
    const Params& p = *pp;
    const int fr = lane & 15, fq = lane >> 4, h = col0 >> 6;
#pragma unroll
    for (int mi = 0; mi < 4; ++mi) {
      const int row = row0 + mi * 16 + fr;
      float y[4][4]; float s = 0.f;
#pragma unroll
      for (int ni = 0; ni < 4; ++ni) {
        const size_t idx = (size_t)row * 1024 + col0 + ni * 16 + fq * 4;
        const uint2 a = *(const uint2*)(p.E0 + idx), b = *(const uint2*)(p.E1 + idx);
        y[ni][0] = bflo(a.x) + bflo(b.x); y[ni][1] = bfhi(a.x) + bfhi(b.x); y[ni][2] = bflo(a.y) + bflo(b.y); y[ni][3] = bfhi(a.y) + bfhi(b.y);
        s += (y[ni][0] + y[ni][1]) + (y[ni][2] + y[ni][3]);
      }
      s += __shfl_xor(s, 16); s += __shfl_xor(s, 32);
      const float mu = s * (1.f / 64.f);
      float q = 0.f;
#pragma unroll
      for (int ni = 0; ni < 4; ++ni)
#pragma unroll
        for (int j = 0; j < 4; ++j) { const float d = y[ni][j] - mu; q += d * d; }
      q += __shfl_xor(q, 16); q += __shfl_xor(q, 32);
      const float rs = rsqrtf(q * (1.f / 64.f) + 64e-5f);
      const float bs = p.BS[(size_t)row * 16 + h] + p.BS[(size_t)NTOK * 16 + (size_t)row * 16 + h];
#pragma unroll
      for (int ni = 0; ni < 4; ++ni) {
        const int col = col0 + ni * 16 + fq * 4;
        const size_t idx = (size_t)row * 1024 + col;
        const uint2 vv = *(const uint2*)(p.Vx + idx);
        const f32x4 lw = *(const f32x4*)(p.ln_w + col), lb = *(const f32x4*)(p.ln_b + col);
        const float v0 = bflo(vv.x), v1 = bfhi(vv.x), v2 = bflo(vv.y), v3 = bfhi(vv.y);
        const float o0 = ((y[ni][0] - mu) * rs * lw[0] + lb[0] + bs * v0) * acc[mi][ni][0];
        const float o1 = ((y[ni][1] - mu) * rs * lw[1] + lb[1] + bs * v1) * acc[mi][ni][1];
        const float o2 = ((y[ni][2] - mu) * rs * lw[2] + lb[2] + bs * v2) * acc[mi][ni][2];
        const float o3 = ((y[ni][3] - mu) * rs * lw[3] + lb[3] + bs * v3) * acc[mi][ni][3];
        *(uint2*)(p.ZO + idx) = make_uint2(pk_bf16(o0, o1), pk_bf16(o2, o3));
      }
    }
  }
};

template <class EP>
__device__ __forceinline__ void gemm_phase(const ALoadPlain& al, const bf16_t* Bt, int K, int ntn, const EP& ep, char* smem) {
  const int nunits = (NTOK / 128) * ntn;
  for (int u = blockIdx.x; u < nunits; u += gridDim.x) gemm_tile_glds(al.A, al.lda, Bt, K, u / ntn, u % ntn, ep, smem);
}

__device__ __forceinline__ void attn_item(const Params& p, int grp, int b, int h, int qb, char* smem) {
  const int tid = threadIdx.x, lane = tid & 63, wid = tid >> 6, qi = lane & 31, g = lane >> 5;
  const int Tk = grp ? 1280 : 256, kvh = h >> 2;
  const int rowbase = grp ? NP + b * 1024 + qb * 128 : b * 256 + qb * 128;
  const bf16_t* Kg = grp ? p.Ks + (size_t)(b * 2 + kvh) * 1280 * 64 : p.Kp + (size_t)(b * 2 + kvh) * 256 * 64;
  const bf16_t* Vg = grp ? p.Vts + (size_t)(b * 2 + kvh) * 64 * 1280 : p.Vtp + (size_t)(b * 2 + kvh) * 64 * 256;
  const int qrow = rowbase + wid * 32 + qi;
  bf16x8 Qf[4];
#pragma unroll
  for (int s = 0; s < 4; ++s) Qf[s] = *(const bf16x8*)(p.Qbuf + (size_t)qrow * 512 + h * 64 + s * 16 + g * 8);
  f32x16 O[2];
#pragma unroll
  for (int i = 0; i < 16; ++i) { O[0][i] = 0.f; O[1][i] = 0.f; }
  float m_run = -1e30f, l_run = 0.f;
  char* sK = smem; char* sV = smem + 16384;
  const int r0 = tid >> 3, c = tid & 7;
  uint4 pk[2], pv[2];
  const int ntile = Tk >> 6;
#define ALOAD(kt) do { _Pragma("unroll") for (int i = 0; i < 2; ++i) { const int r = r0 + 32 * i; pk[i] = *(const uint4*)(Kg + (size_t)((kt) * 64 + r) * 64 + c * 8); pv[i] = *(const uint4*)(Vg + (size_t)r * Tk + (kt) * 64 + c * 8); } } while (0)
#define ASTORE(buf) do { _Pragma("unroll") for (int i = 0; i < 2; ++i) { const int r = r0 + 32 * i; \
      *(uint4*)(sK + (buf) * 8192 + r * 128 + ((c ^ ((r >> 1) & 7)) << 4)) = pk[i]; \
      const int f = (r >> 1) & 15; \
      *(uint2*)(sV + (buf) * 8192 + r * 128 + (((2 * c) ^ f) << 3)) = make_uint2(pv[i].x, pv[i].y); \
      *(uint2*)(sV + (buf) * 8192 + r * 128 + (((2 * c + 1) ^ f) << 3)) = make_uint2(pv[i].z, pv[i].w); } } while (0)
  ALOAD(0); ASTORE(0); __syncthreads();
  for (int kt = 0; kt < ntile; ++kt) {
    const int buf = kt & 1;
    if (kt + 1 < ntile) ALOAD(kt + 1);
    f32x16 S[2];
#pragma unroll
    for (int t2 = 0; t2 < 2; ++t2) {
#pragma unroll
      for (int i = 0; i < 16; ++i) S[t2][i] = 0.f;
#pragma unroll
      for (int s = 0; s < 4; ++s) {
        const int r = t2 * 32 + qi, cc = 2 * s + g;
        const bf16x8 Kf = *(const bf16x8*)(sK + buf * 8192 + r * 128 + ((cc ^ ((r >> 1) & 7)) << 4));
        S[t2] = __builtin_amdgcn_mfma_f32_32x32x16_bf16(Kf, Qf[s], S[t2], 0, 0, 0);
      }
    }
    float mx = S[0][0];
#pragma unroll
    for (int i = 0; i < 16; ++i) { mx = fmaxf(mx, S[0][i]); mx = fmaxf(mx, S[1][i]); }
    mx = fmaxf(mx, __shfl_xor(mx, 32));
    const float m_new = fmaxf(m_run, mx);
    const float alpha = exp2f(m_run - m_new);
    float ls = 0.f;
#pragma unroll
    for (int i = 0; i < 16; ++i) { S[0][i] = exp2f(S[0][i] - m_new); S[1][i] = exp2f(S[1][i] - m_new); ls += S[0][i] + S[1][i]; }
    l_run = l_run * alpha + ls; m_run = m_new;
#pragma unroll
    for (int i = 0; i < 16; ++i) { O[0][i] *= alpha; O[1][i] *= alpha; }
#pragma unroll
    for (int t2 = 0; t2 < 2; ++t2)
#pragma unroll
      for (int sp = 0; sp < 2; ++sp) {
        union { bf16x8 v; unsigned u[4]; } Pf;
#pragma unroll
        for (int e = 0; e < 4; ++e) Pf.u[e] = pk_bf16(S[t2][8 * sp + 2 * e], S[t2][8 * sp + 2 * e + 1]);
#pragma unroll
        for (int ds = 0; ds < 2; ++ds) {
          const int d = ds * 32 + qi, f = (d >> 1) & 15, u1 = 8 * t2 + 4 * sp + g;
          union { bf16x8 v; uint2 u[2]; } Vf;
          Vf.u[0] = *(const uint2*)(sV + buf * 8192 + d * 128 + ((u1 ^ f) << 3));
          Vf.u[1] = *(const uint2*)(sV + buf * 8192 + d * 128 + (((u1 + 2) ^ f) << 3));
          O[ds] = __builtin_amdgcn_mfma_f32_32x32x16_bf16(Vf.v, Pf.v, O[ds], 0, 0, 0);
        }
      }
    if (kt + 1 < ntile) ASTORE(buf ^ 1);
    __syncthreads();
  }
#undef ALOAD
#undef ASTORE
  const float l = l_run + __shfl_xor(l_run, 32);
  const float inv = 1.f / l;
#pragma unroll
  for (int ds = 0; ds < 2; ++ds)
#pragma unroll
    for (int bq = 0; bq < 4; ++bq) {
      const int d0 = ds * 32 + 8 * bq + 4 * g;
      *(uint2*)(p.AO + (size_t)qrow * 1024 + h * 64 + d0) =
          make_uint2(pk_bf16(O[ds][4 * bq] * inv, O[ds][4 * bq + 1] * inv), pk_bf16(O[ds][4 * bq + 2] * inv, O[ds][4 * bq + 3] * inv));
    }
}

__device__ __forceinline__ void hgrn_item(const Params& p, int grp, int b, int h, int dir, int half, char* smem) {
  const int tid = threadIdx.x, v = half * 32 + (tid >> 3), ks = tid & 7;
  const int T = grp ? 1024 : 256, rowbase = grp ? NP + b * 1024 : b * 256;
  if (grp) __builtin_amdgcn_s_setprio(3);
  f32x2 S2[4];
  if (grp) {
    const float* s0 = (dir ? p.hg_b0 : p.hg_f0) + (size_t)(b * 8 + h) * 4096;
#pragma unroll
    for (int i = 0; i < 4; ++i) S2[i] = (f32x2){s0[(ks * 8 + 2 * i) * 64 + v], s0[(ks * 8 + 2 * i + 1) * 64 + v]};
  } else {
#pragma unroll
    for (int i = 0; i < 4; ++i) S2[i] = (f32x2){0.f, 0.f};
  }
  float* obuf = (float*)(smem + 32768);
  const int lt = tid >> 4, lc = (tid & 15) * 4;
  const int kfseg = dir ? 1024 : 512;
  uint2 rq, rk, rv, rq2, rk2, rv2;
  const int nch = T >> 4;
#define HLOADX(cix, q_, k_, v_) do { const int ts = (cix) * 16 + lt; const int tok = dir ? T - 1 - ts : ts; const bf16_t* src = p.HG + (size_t)(rowbase + tok) * 2560 + h * 64 + lc; \
    q_ = *(const uint2*)(src); k_ = *(const uint2*)(src + kfseg); v_ = *(const uint2*)(src + 1536); } while (0)
#define HSTORE(buf) do { float* B = (float*)(smem + (buf) * 16384) + lt * 64 + lc; \
    const float k0 = bflo(rk.x), k1 = bfhi(rk.x), k2 = bflo(rk.y), k3 = bfhi(rk.y); \
    *(float4*)(B) = make_float4(1.f - k0, 1.f - k1, 1.f - k2, 1.f - k3); *(float4*)(B + 1024) = make_float4(k0, k1, k2, k3); \
    *(float4*)(B + 2048) = make_float4(bflo(rq.x), bfhi(rq.x), bflo(rq.y), bfhi(rq.y)); *(float4*)(B + 3072) = make_float4(bflo(rv.x), bfhi(rv.x), bflo(rv.y), bfhi(rv.y)); } while (0)
  HLOADX(0, rq, rk, rv); HSTORE(0);
  HLOADX(1, rq, rk, rv);
  __syncthreads();
  float* OD = dir ? p.OB : p.OF;
  for (int cix = 0; cix < nch; ++cix) {
    const int buf = cix & 1;
    if (cix + 2 < nch) HLOADX(cix + 2, rq2, rk2, rv2);
    const float* B = (const float*)(smem + buf * 16384);
    float* ob = obuf + buf * 512;
    float4 cf[2], ck[2], cq[2]; float cv;
#define HSTEP_LOAD(t_, f_, k_, q_, v_) do { const float* Bt = B + (t_) * 64 + ks * 8; \
      f_[0] = *(const float4*)(Bt); f_[1] = *(const float4*)(Bt + 4); k_[0] = *(const float4*)(Bt + 1024); k_[1] = *(const float4*)(Bt + 1028); \
      q_[0] = *(const float4*)(Bt + 2048); q_[1] = *(const float4*)(Bt + 2052); v_ = B[3072 + (t_) * 64 + v]; } while (0)
    HSTEP_LOAD(0, cf, ck, cq, cv);
#pragma unroll 1
    for (int g = 0; g < 4; ++g) {
      float op[4];
#pragma unroll
      for (int tt = 0; tt < 4; ++tt) {
        const int t = g * 4 + tt;
        float4 nf[2], nk[2], nq[2]; float nv;
        { const int tn_ = (t + 1) & 15; HSTEP_LOAD(tn_, nf, nk, nq, nv); }
        const f32x2 vvv = (f32x2){cv, cv};
        f32x2 o0, o1;
        S2[0] = S2[0] * (f32x2){cf[0].x, cf[0].y} + vvv * (f32x2){ck[0].x, ck[0].y};
        S2[1] = S2[1] * (f32x2){cf[0].z, cf[0].w} + vvv * (f32x2){ck[0].z, ck[0].w};
        S2[2] = S2[2] * (f32x2){cf[1].x, cf[1].y} + vvv * (f32x2){ck[1].x, ck[1].y};
        S2[3] = S2[3] * (f32x2){cf[1].z, cf[1].w} + vvv * (f32x2){ck[1].z, ck[1].w};
        o0 = S2[0] * (f32x2){cq[0].x, cq[0].y}; o1 = S2[1] * (f32x2){cq[0].z, cq[0].w};
        o0 = S2[2] * (f32x2){cq[1].x, cq[1].y} + o0; o1 = S2[3] * (f32x2){cq[1].z, cq[1].w} + o1;
        const f32x2 os = o0 + o1;
        op[tt] = os.x + os.y;
        cf[0] = nf[0]; cf[1] = nf[1]; ck[0] = nk[0]; ck[1] = nk[1]; cq[0] = nq[0]; cq[1] = nq[1]; cv = nv;
      }
#pragma unroll
      for (int tt = 0; tt < 4; ++tt) { const float o = oct_sum(op[tt]); if (ks == 0) ob[(g * 4 + tt) * 32 + (tid >> 3)] = o; }
    }
#undef HSTEP_LOAD
    if (cix + 1 < nch) HSTORE(buf ^ 1);
    rq = rq2; rk = rk2; rv = rv2;
    __syncthreads();
    if (tid < 128) {
      const int ft = tid >> 3, fc = (tid & 7) * 4;
      const int ts = cix * 16 + ft; const int tok = dir ? T - 1 - ts : ts;
      *(float4*)(OD + (size_t)(rowbase + tok) * 512 + h * 64 + half * 32 + fc) = *(const float4*)(ob + ft * 32 + fc);
    }
  }
#undef HLOADX
#undef HSTORE
  __builtin_amdgcn_s_setprio(0);
  if (!grp) {
    float* so = (dir ? p.out_hb : p.out_hf) + (size_t)(b * 8 + h) * 4096;
#pragma unroll
    for (int i = 0; i < 4; ++i) { so[(ks * 8 + 2 * i) * 64 + v] = S2[i].x; so[(ks * 8 + 2 * i + 1) * 64 + v] = S2[i].y; }
  }
}

__device__ __forceinline__ void mix0_phase(const Params& p, char* smem) {
  __shared__ int q_item;
  for (;;) {
    if (threadIdx.x == 0) q_item = (int)atomicAdd(&p.bar[0], 1u);
    __syncthreads();
    const int it = q_item;
    __syncthreads();
    if (it >= 1536) break;
    if (it < 768) {
      const int grp = it < 256 ? 1 : 0, a = grp ? it : it - 256;
      hgrn_item(p, grp, a >> 5, (a >> 2) & 7, (a >> 1) & 1, a & 1, smem);
    } else {
      const int grp = it < 1280 ? 1 : 0, a = grp ? it - 768 : it - 1280;
      const int b = grp ? a >> 6 : a >> 4, h = grp ? (a >> 3) & 7 : (a >> 1) & 7, qb = grp ? a & 7 : a & 1;
      attn_item(p, grp, b, h, qb, smem);
    }
    __syncthreads();
  }
}

__device__ __forceinline__ void hgrn_combine_phase(const Params& p) {
  const int gid = blockIdx.x * NT + threadIdx.x, l16 = gid & 15;
  const int ngroups = NTOK * 8;
  for (int grp = gid >> 4; grp < ngroups; grp += (gridDim.x * NT) >> 4) {
    const int row = grp >> 3, h = grp & 7;
    const size_t o = (size_t)row * 512 + h * 64 + l16 * 4;
    const float4 a = *(const float4*)(p.OF + o), b = *(const float4*)(p.OB + o);
    const float y0 = a.x + b.x, y1 = a.y + b.y, y2 = a.z + b.z, y3 = a.w + b.w;
    float ss = y0 * y0 + y1 * y1 + y2 * y2 + y3 * y3;
    ss += __shfl_xor(ss, 1); ss += __shfl_xor(ss, 2); ss += __shfl_xor(ss, 4); ss += __shfl_xor(ss, 8);
    const float rn = rsqrtf(ss * (1.f / 64.f) + 1e-6f);
    const float4 gn = *(const float4*)(p.g_norm + l16 * 4);
    const uint2 gt = *(const uint2*)(p.HG + (size_t)row * 2560 + 2048 + h * 64 + l16 * 4);
    *(uint2*)(p.AO + (size_t)row * 1024 + 512 + h * 64 + l16 * 4) =
        make_uint2(pk_bf16(y0 * rn * gn.x * bflo(gt.x), y1 * rn * gn.y * bfhi(gt.x)), pk_bf16(y2 * rn * gn.z * bflo(gt.y), y3 * rn * gn.w * bfhi(gt.y)));
  }
}

__device__ __forceinline__ void rwkv_item(const Params& p, int grp, int b, int h, int dir, char* smem, bool dry = false) {
  const bool wr = !(dry && p.njobs >= 0);
  if (grp) __builtin_amdgcn_s_setprio(3);
  const int tid = threadIdx.x, lane = tid & 63, wid = tid >> 6, v = tid >> 2, ks = tid & 3;
  const int T = grp ? 1024 : 256, rowbase = grp ? NP + b * 1024 : b * 256;
  const int vp = tid >> 3, k8 = tid & 7;
  f32x2 Sa[4], Sb[4];
  if (grp) {
    const float* s0 = (dir ? p.rw_b0 : p.rw_f0) + ((size_t)(b * 16 + h) * 64 + vp) * 64 + k8 * 8;
#pragma unroll
    for (int q = 0; q < 2; ++q) {
      const float4 t = *(const float4*)(s0 + q * 4), u = *(const float4*)(s0 + 2048 + q * 4);
      Sa[2 * q] = (f32x2){t.x, t.y}; Sa[2 * q + 1] = (f32x2){t.z, t.w}; Sb[2 * q] = (f32x2){u.x, u.y}; Sb[2 * q + 1] = (f32x2){u.z, u.w};
    }
  } else {
#pragma unroll
    for (int i = 0; i < 4; ++i) { Sa[i] = (f32x2){0.f, 0.f}; Sb[i] = (f32x2){0.f, 0.f}; }
  }
  const bf16_t* E = dir ? p.E1 : p.E0; const bf16_t* A = dir ? p.A1 : p.A0; bf16_t* Y = dir ? p.E1 : p.E0;
  const int lt = tid >> 4, lc = (tid & 15) * 4;
  const float4 kkc = *(const float4*)(p.k_k + h * 64 + lc), kac = *(const float4*)(p.k_a + h * 64 + lc), rkc = *(const float4*)(p.r_k + h * 64 + lc);
  float* BSd = p.BS + (size_t)dir * NTOK * 16;
  float* ybuf = (float*)(smem + 49152);
  uint2 gr, gk, gv, ge, ga;
  const int nch = T >> 4;
#define RLOAD(cix) do { const int ts = (cix) * 16 + lt; const int tok = dir ? T - 1 - ts : ts; const size_t idx = (size_t)(rowbase + tok) * 1024 + h * 64 + lc; \
    gr = *(const uint2*)(p.R + idx); gk = *(const uint2*)(p.Kx + idx); gv = *(const uint2*)(p.Vx + idx); ge = *(const uint2*)(E + idx); ga = *(const uint2*)(A + idx); } while (0)
#define RSTORE(cix, buf) do { const int ts = (cix) * 16 + lt; const int tok = dir ? T - 1 - ts : ts; \
    const float r_[4] = {bflo(gr.x), bfhi(gr.x), bflo(gr.y), bfhi(gr.y)}, k_[4] = {bflo(gk.x), bfhi(gk.x), bflo(gk.y), bfhi(gk.y)}; \
    const float e_[4] = {bflo(ge.x), bfhi(ge.x), bflo(ge.y), bfhi(ge.y)}, a_[4] = {bflo(ga.x), bfhi(ga.x), bflo(ga.y), bfhi(ga.y)}; \
    const float kc_[4] = {kkc.x, kkc.y, kkc.z, kkc.w}, ac_[4] = {kac.x, kac.y, kac.z, kac.w}, rc_[4] = {rkc.x, rkc.y, rkc.z, rkc.w}; \
    float kx[4], kd[4], ssq = 0.f, bsum = 0.f; \
    _Pragma("unroll") for (int j = 0; j < 4; ++j) { kx[j] = k_[j] * kc_[j]; ssq += kx[j] * kx[j]; kd[j] = k_[j] * (1.f + (a_[j] - 1.f) * ac_[j]); bsum += r_[j] * kd[j] * rc_[j]; } \
    ssq = hex_sum(ssq); bsum = hex_sum(bsum); const float rn = rsqrtf(fmaxf(ssq, 1e-24f)); \
    float* B = (float*)(smem + (buf) * 24576) + lt * 64 + lc; \
    *(float4*)(B) = make_float4(__expf(-e_[0]), __expf(-e_[1]), __expf(-e_[2]), __expf(-e_[3])); \
    *(float4*)(B + 1024) = make_float4(kx[0] * rn, kx[1] * rn, kx[2] * rn, kx[3] * rn); \
    *(float4*)(B + 2048) = make_float4(kx[0] * rn * a_[0], kx[1] * rn * a_[1], kx[2] * rn * a_[2], kx[3] * rn * a_[3]); \
    *(float4*)(B + 3072) = make_float4(kd[0], kd[1], kd[2], kd[3]); \
    *(float4*)(B + 4096) = make_float4(r_[0], r_[1], r_[2], r_[3]); \
    *(float4*)(B + 5120) = make_float4(bflo(gv.x), bfhi(gv.x), bflo(gv.y), bfhi(gv.y)); \
    if ((tid & 15) == 0 && wr) BSd[(size_t)(rowbase + tok) * 16 + h] = bsum; } while (0)
  RLOAD(0); RSTORE(0, 0); __syncthreads();
  for (int cix = 0; cix < nch; ++cix) {
    const int buf = cix & 1;
    if (cix + 1 < nch) RLOAD(cix + 1);
    const float* B = (const float*)(smem + buf * 24576);
    float* yb = ybuf + buf * 1024;
    float4 cw[2], ck[2], ca[2], cd[2], cr[2]; float cva, cvb;
#define RSTEP_LOAD(t_, w_, k_, a_, d_, r_, va_, vb_) do { const float* Bt = B + (t_) * 64 + k8 * 8; \
      w_[0] = *(const float4*)(Bt); w_[1] = *(const float4*)(Bt + 4); k_[0] = *(const float4*)(Bt + 1024); k_[1] = *(const float4*)(Bt + 1028); \
      a_[0] = *(const float4*)(Bt + 2048); a_[1] = *(const float4*)(Bt + 2052); d_[0] = *(const float4*)(Bt + 3072); d_[1] = *(const float4*)(Bt + 3076); \
      r_[0] = *(const float4*)(Bt + 4096); r_[1] = *(const float4*)(Bt + 4100); va_ = B[5120 + (t_) * 64 + vp]; vb_ = B[5120 + (t_) * 64 + vp + 32]; } while (0)
    RSTEP_LOAD(0, cw, ck, ca, cd, cr, cva, cvb);
#pragma unroll
    for (int t = 0; t < 16; ++t) {
      float4 nw[2], nk[2], na[2], nd[2], nr[2]; float nva = 0.f, nvb = 0.f;
      if (t + 1 < 16) RSTEP_LOAD(t + 1, nw, nk, na, nd, nr, nva, nvb);
      f32x2 w2[4], kk2[4];
#pragma unroll
      for (int q = 0; q < 2; ++q) {
        w2[2 * q] = (f32x2){cw[q].x, cw[q].y}; w2[2 * q + 1] = (f32x2){cw[q].z, cw[q].w};
        kk2[2 * q] = (f32x2){ck[q].x, ck[q].y}; kk2[2 * q + 1] = (f32x2){ck[q].z, ck[q].w};
      }
      const f32x2 sa_a = (Sa[0] * kk2[0] + Sa[1] * kk2[1]) + (Sa[2] * kk2[2] + Sa[3] * kk2[3]);
      const f32x2 sa_b = (Sb[0] * kk2[0] + Sb[1] * kk2[1]) + (Sb[2] * kk2[2] + Sb[3] * kk2[3]);
      const float saa = -oct_sum(sa_a.x + sa_a.y), sab = -oct_sum(sa_b.x + sa_b.y);
      const f32x2 saav = (f32x2){saa, saa}, sabv = (f32x2){sab, sab}, vav = (f32x2){cva, cva}, vbv = (f32x2){cvb, cvb};
      f32x2 ya = (f32x2){0.f, 0.f}, yb2 = (f32x2){0.f, 0.f};
#pragma unroll
      for (int q = 0; q < 2; ++q) {
        const f32x2 ka0 = (f32x2){ca[q].x, ca[q].y}, ka1 = (f32x2){ca[q].z, ca[q].w}, kd0 = (f32x2){cd[q].x, cd[q].y}, kd1 = (f32x2){cd[q].z, cd[q].w};
        const f32x2 r0 = (f32x2){cr[q].x, cr[q].y}, r1 = (f32x2){cr[q].z, cr[q].w};
        Sa[2 * q] = Sa[2 * q] * w2[2 * q] + (vav * kd0 + saav * ka0); Sa[2 * q + 1] = Sa[2 * q + 1] * w2[2 * q + 1] + (vav * kd1 + saav * ka1);
        Sb[2 * q] = Sb[2 * q] * w2[2 * q] + (vbv * kd0 + sabv * ka0); Sb[2 * q + 1] = Sb[2 * q + 1] * w2[2 * q + 1] + (vbv * kd1 + sabv * ka1);
        ya = Sa[2 * q] * r0 + ya; ya = Sa[2 * q + 1] * r1 + ya;
        yb2 = Sb[2 * q] * r0 + yb2; yb2 = Sb[2 * q + 1] * r1 + yb2;
      }
      const float y_a = oct_sum(ya.x + ya.y), y_b = oct_sum(yb2.x + yb2.y);
      if (k8 == 0) { yb[t * 64 + vp] = y_a; yb[t * 64 + vp + 32] = y_b; }
      if (t + 1 < 16) {
#pragma unroll
        for (int q = 0; q < 2; ++q) { cw[q] = nw[q]; ck[q] = nk[q]; ca[q] = na[q]; cd[q] = nd[q]; cr[q] = nr[q]; }
        cva = nva; cvb = nvb;
      }
    }
#undef RSTEP_LOAD
    if (cix + 1 < nch) RSTORE(cix + 1, buf ^ 1);
    __syncthreads();
    {
      const int ts = cix * 16 + lt; const int tok = dir ? T - 1 - ts : ts;
      const float4 yy = *(const float4*)(yb + lt * 64 + lc);
      if (wr) *(uint2*)(Y + (size_t)(rowbase + tok) * 1024 + h * 64 + lc) = make_uint2(pk_bf16(yy.x, yy.y), pk_bf16(yy.z, yy.w));
    }
  }
#undef RLOAD
#undef RSTORE
  __builtin_amdgcn_s_setprio(0);
  if (!grp && wr) {
    float* so = (dir ? p.out_rb : p.out_rf) + ((size_t)(b * 16 + h) * 64 + vp) * 64 + k8 * 8;
#pragma unroll
    for (int q = 0; q < 2; ++q) {
      *(float4*)(so + q * 4) = make_float4(Sa[2 * q].x, Sa[2 * q].y, Sa[2 * q + 1].x, Sa[2 * q + 1].y);
      *(float4*)(so + 2048 + q * 4) = make_float4(Sb[2 * q].x, Sb[2 * q].y, Sb[2 * q + 1].x, Sb[2 * q + 1].y);
    }
  }
}

__device__ __forceinline__ void rwkv_scan_phase(const Params& p, char* smem, bool dry = false) {
  const int G = gridDim.x;
  if (G >= 512) {
    if (blockIdx.x < 256) { const int a = blockIdx.x; rwkv_item(p, 1, a >> 5, (a >> 1) & 15, a & 1, smem, dry); }
    else for (int a = blockIdx.x - 256; a < 512; a += G - 256) { rwkv_item(p, 0, a >> 5, (a >> 1) & 15, a & 1, smem, dry); __syncthreads(); }
  } else {
    for (int it = blockIdx.x; it < 768; it += G) {
      const int grp = it < 256 ? 1 : 0, a = grp ? it : it - 256;
      rwkv_item(p, grp, a >> 5, (a >> 1) & 15, a & 1, smem, dry);
      __syncthreads();
    }
  }
}

__device__ __forceinline__ void blend_phase(const Params& p) {
  const int gid = blockIdx.x * NT + threadIdx.x, nth = gridDim.x * NT;
  for (int i = gid; i < NTOK * 128; i += nth) {
    const int row = i >> 7, k = (i & 127) * 8;
    ALoadShift a0{p.H, p.mix + 0 * 1024}, a2{p.H, p.mix + 2 * 1024}, a3{p.H, p.mix + 3 * 1024};
    const size_t o = (size_t)row * 1024 + k;
    *(uint4*)(p.E0 + o) = a0(row, k); *(uint4*)(p.E1 + o) = a2(row, k); *(uint4*)(p.A1 + o) = a3(row, k);
  }
}

__device__ __forceinline__ void rwkv_proj_phase(const Params& p, char* smem) {
  const int nunits = 96 * 27;
  for (int u = blockIdx.x; u < nunits; u += gridDim.x) {
    const int tm = u < 288 ? u / 3 : (u - 288) / 24, s = u < 288 ? 24 + u % 3 : (u - 288) % 24;
    if (s < 8) { EpiAct<0> ep{p.R, 1024, nullptr}; gemm_tile_glds(p.E0, 1024, p.wr_t, 1024, tm, s, ep, smem); }
    else if (s < 16) { EpiAct<0> ep{p.Kx, 1024, nullptr}; gemm_tile_glds(p.E1, 1024, p.wk_t, 1024, tm, s - 8, ep, smem); }
    else if (s < 24) { EpiAct<0> ep{p.Vx, 1024, nullptr}; gemm_tile_glds(p.A1, 1024, p.wv_t, 1024, tm, s - 16, ep, smem); }
    else if (s == 24) { ALoadShift al{p.H, p.mix + 1 * 1024}; EpiAct<2> ep{p.LW, 128, nullptr}; gemm_tile(al, p.w1cat_t, 1024, tm, 0, ep, smem); }
    else if (s == 25) { ALoadShift al{p.H, p.mix + 4 * 1024}; EpiAct<0> ep{p.LA, 128, nullptr}; gemm_tile(al, p.a1cat_t, 1024, tm, 0, ep, smem); }
    else { ALoadShift al{p.H, p.mix + 5 * 1024}; EpiAct<3> ep{p.LG, 128, nullptr}; gemm_tile(al, p.g1_t, 1024, tm, 0, ep, smem); }
  }
}
__device__ __forceinline__ void rwkv_lora2_phase(const Params& p, char* smem) {
  const int nunits = 96 * 32;
  for (int u = blockIdx.x; u < nunits; u += gridDim.x) {
    const int tm = u >> 5, s = u & 31, which = s >> 3, tn = s & 7;
    const int d = which & 1;
    if (which < 2) { ALoadPlain al{p.LW + d * 64, 128}; EpiAct<4> ep{d ? p.E1 : p.E0, 1024, p.w0 + d * 1024}; gemm_tile_glds(al.A, al.lda, p.w2_t + (size_t)d * 65536, 64, tm, tn, ep, smem); }
    else { ALoadPlain al{p.LA + d * 64, 128}; EpiAct<5> ep{d ? p.A1 : p.A0, 1024, p.a0 + d * 1024}; gemm_tile_glds(al.A, al.lda, p.a2_t + (size_t)d * 65536, 64, tm, tn, ep, smem); }
  }
}


#define XB_TMO      128
#define XB_XCNT(j)  (256  + 64 * (j))
#define XB_XSUB(j)  (1280 + 64 * (j))
#define XB_XGEN(j)  (2304 + 64 * (j))
#define XB_TOP      3328
#define XB_TOPGEN   3392
#define XCD_BAR_WORDS 3456
#define XB_SPIN_CAP (1u << 22)
#define LAS __attribute__((address_space(3)))
__device__ __forceinline__ unsigned xb_ld(unsigned* p)              { return __hip_atomic_load(p, __ATOMIC_RELAXED, __HIP_MEMORY_SCOPE_AGENT); }
__device__ __forceinline__ unsigned xb_add(unsigned* p, unsigned v) { return __hip_atomic_fetch_add(p, v, __ATOMIC_RELAXED, __HIP_MEMORY_SCOPE_AGENT); }
__device__ __forceinline__ unsigned xb_xcc_id() { return (unsigned)__builtin_amdgcn_s_getreg((3 << 11) | 20) & 0xFu; }
#define XB_SPIN(cond, bar) do { unsigned _sp = 0; while (cond) { __builtin_amdgcn_s_sleep(1); \
    if ((++_sp & 255u) == 0u) { if (xb_ld(&(bar)[XB_TMO])) break; if (_sp > XB_SPIN_CAP) { atomicAdd(&(bar)[XB_TMO], 1u); break; } } } } while (0)
struct XcdBarrier { unsigned* bar; unsigned x; volatile LAS unsigned* st; };
__device__ __forceinline__ XcdBarrier xcd_barrier_post(unsigned* bar, volatile LAS unsigned* st) {
    XcdBarrier b; b.bar = bar; b.x = xb_xcc_id(); b.st = st;
    if (threadIdx.x == 0) (void)xb_add(&bar[XB_XCNT(b.x)], 1u);
    return b;
}
__device__ __forceinline__ void xcd_barrier_complete(unsigned* bar, unsigned x, unsigned& nloc, unsigned& nx) {
    const unsigned G = gridDim.x * gridDim.y * gridDim.z;
    unsigned sum, cnt, mine, sp = 0u;
    for (;;) {
        sum = 0u; cnt = 0u; mine = 0u;
#pragma unroll
        for (unsigned j = 0; j < 16; ++j) { const unsigned c = xb_ld(&bar[XB_XCNT(j)]); sum += c; cnt += (c > 0u) ? 1u : 0u; mine = (j == x) ? c : mine; }
        if (sum == G) break;
        __builtin_amdgcn_s_sleep(1);
        if ((++sp & 255u) == 0u) { if (xb_ld(&bar[XB_TMO])) break; if (sp > XB_SPIN_CAP) { atomicAdd(&bar[XB_TMO], 1u); break; } }
    }
    nloc = mine > 0u ? mine : 1u; nx = cnt > 0u ? cnt : 1u;
}
__device__ __forceinline__ void xcd_barrier(const XcdBarrier& b) {
    asm volatile("s_waitcnt vmcnt(0)" ::: "memory");
    __syncthreads();
    if (threadIdx.x == 0) {
        unsigned* bar = b.bar;
        __builtin_amdgcn_s_waitcnt(0);
        unsigned nloc = b.st[0], nx = b.st[1];
        if (nloc == 0u) { xcd_barrier_complete(bar, b.x, nloc, nx); b.st[0] = nloc; b.st[1] = nx; }
        const unsigned old = xb_add(&bar[XB_XSUB(b.x)], 1u);
        const unsigned gen = old / nloc;
        if (old + 1u == (gen + 1u) * nloc) {
            __builtin_amdgcn_fence(__ATOMIC_RELEASE, "agent");
            asm volatile("s_waitcnt vmcnt(0)" ::: "memory");
            const unsigned og = xb_add(&bar[XB_TOP], 1u);
            const unsigned tg = og / nx;
            if (og + 1u == (tg + 1u) * nx) xb_add(&bar[XB_TOPGEN], 1u);
            else XB_SPIN(xb_ld(&bar[XB_TOPGEN]) == tg, bar);
            __builtin_amdgcn_fence(__ATOMIC_ACQUIRE, "agent");
            xb_add(&bar[XB_XGEN(b.x)], 1u);
            asm volatile("s_waitcnt vmcnt(0)" ::: "memory");
        } else {
            XB_SPIN(xb_ld(&bar[XB_XGEN(b.x)]) == gen, bar);
            __builtin_amdgcn_fence(__ATOMIC_ACQUIRE, "agent");
            asm volatile("s_waitcnt vmcnt(0)" ::: "memory");
        }
    }
    __syncthreads();
}

__device__ __forceinline__ void run_phase(const Params& p, int ph, char* smem, bool dry = false) {
  switch (ph) {
    case 0: if (ONLY_PHASE < 0 || ONLY_PHASE == 0) phase0(p, smem); break;
    case 1: if (ONLY_PHASE < 0 || ONLY_PHASE == 1) prenorm_phase(p, 0, 0, true); break;
    case 2: if (ONLY_PHASE < 0 || ONLY_PHASE == 2) { ALoadPlain al{p.H, 1024}; EpiWin ep{&p}; gemm_phase(al, p.w_in_t, 1024, 26, ep, smem); } break;
    case 3: if (ONLY_PHASE < 0 || ONLY_PHASE == 3) mix0_phase(p, smem); break;
    case 4: if (ONLY_PHASE < 0 || ONLY_PHASE == 4) hgrn_combine_phase(p); break;
    case 5: if (ONLY_PHASE < 0 || ONLY_PHASE == 5) { ALoadPlain al{p.AO, 1024}; EpiResid ep{&p, 0, 2, true}; gemm_phase(al, p.w_out_t, 1024, 8, ep, smem); } break;
    case 6: if (ONLY_PHASE < 0 || ONLY_PHASE == 6) prenorm_phase(p, 0, 1, false); break;
    case 7: if (ONLY_PHASE < 0 || ONLY_PHASE == 7) { ALoadPlain al{p.H, 1024}; EpiAct<1> ep{p.U, 4096, nullptr}; gemm_phase(al, p.mlp1_t, 1024, 32, ep, smem); } break;
    case 8: if (ONLY_PHASE < 0 || ONLY_PHASE == 8) { ALoadPlain al{p.U, 4096}; EpiResid ep{&p, 0, 5, false, dry}; gemm_phase(al, p.mlp2_t, 4096, 8, ep, smem); } break;
    case 9: if (ONLY_PHASE < 0 || ONLY_PHASE == 9) prenorm_phase(p, 1, 0, false); break;
    case 10: if (ONLY_PHASE < 0 || ONLY_PHASE == 10) rwkv_proj_phase(p, smem); break;
    case 11: if (ONLY_PHASE < 0 || ONLY_PHASE == 11) rwkv_lora2_phase(p, smem); break;
    case 12: if (ONLY_PHASE < 0 || ONLY_PHASE == 12) rwkv_scan_phase(p, smem, dry); break;
    case 13: if (ONLY_PHASE < 0 || ONLY_PHASE == 13) { ALoadPlain al{p.LG, 128}; EpiRwkvOut ep{&p}; gemm_phase(al, p.g2_t, 128, 8, ep, smem); } break;
    case 14: if (ONLY_PHASE < 0 || ONLY_PHASE == 14) { ALoadPlain al{p.ZO, 1024}; EpiResid ep{&p, 1, 2, false, dry}; gemm_phase(al, p.wo_t, 1024, 8, ep, smem); } break;
    case 15: if (ONLY_PHASE < 0 || ONLY_PHASE == 15) prenorm_phase(p, 1, 1, false); break;
    case 16: if (ONLY_PHASE < 0 || ONLY_PHASE == 16) { ALoadPlain al{p.H, 1024}; EpiAct<1> ep{p.U, 4096, nullptr}; gemm_phase(al, p.mlp1_t + (size_t)4096 * 1024, 1024, 32, ep, smem); } break;
    case 17: if (ONLY_PHASE < 0 || ONLY_PHASE == 17) { ALoadPlain al{p.U, 4096}; EpiResid ep{&p, 1, 5, false, dry}; gemm_phase(al, p.mlp2_t + (size_t)4096 * 1024, 4096, 8, ep, smem); } break;
    case 18: blend_phase(p); break;
    default: break;
  }
}

__global__ void __launch_bounds__(NT, 2) fwd_kernel(const Params p_unused, int ph_lo, int ph_hi) {
  const Params& p = *(const Params*)__builtin_amdgcn_kernarg_segment_ptr();
  __shared__ __attribute__((aligned(16))) char smem[65536];
  __shared__ uint4 xb_words;
  if (threadIdx.x == 0) xb_words = make_uint4(0u, 0u, 0u, 0u);
  __syncthreads();
  XcdBarrier xb = xcd_barrier_post(p.bar, (volatile LAS unsigned*)&xb_words);
  if (ph_hi < 0) cg::this_grid().sync();
#ifndef PROBE_MASK
#define PROBE_MASK 0
#endif
#ifndef PROBE_DRY
#define PROBE_DRY 0
#endif
#define PHASE(n, sync_) { if ((PROBE_MASK >> n) & 1) { run_phase(p, n, smem); xcd_barrier(xb); } if ((PROBE_DRY >> n) & 1) { run_phase(p, n, smem, true); xcd_barrier(xb); } run_phase(p, n, smem); if (sync_) xcd_barrier(xb); }
  PHASE(0, 1) PHASE(1, 1) PHASE(2, 1) PHASE(3, 1) PHASE(4, 1) PHASE(5, 1) PHASE(6, 1) PHASE(7, 1) PHASE(8, 1) PHASE(9, 1) PHASE(18, 1)
  PHASE(10, 1) PHASE(11, 1) PHASE(12, 1) PHASE(13, 1) PHASE(14, 1) PHASE(15, 1) PHASE(16, 1) PHASE(17, 0)
#undef PHASE
}

extern "C" void kernel_launch(void* const* d_in, const int* in_sizes, int n_in, void* d_out, int out_size, void* d_ws, size_t ws_size, hipStream_t stream) {
  Params p; memset(&p, 0, sizeof(p));
  auto F = [&](int i) { return (const float*)d_in[i]; };
  p.x_prompt = F(0); p.x_sample = F(1); p.cache_k = F(2); p.cache_v = F(3); p.hg_f0 = F(4); p.hg_b0 = F(5); p.rw_f0 = F(6); p.rw_b0 = F(7);
  p.c = F(8); p.c_ctx = F(9); p.ada_w = F(10); p.ada_b = F(11); p.norm1_w = F(12); p.norm2_w = F(13);
  p.q_norm = F(16); p.k_norm = F(17); p.hgrn_lb = F(18); p.g_norm = F(19); p.mix = F(20);
  p.w0 = F(25); p.a0 = F(28); p.k_k = F(33); p.k_a = F(34); p.r_k = F(35); p.ln_w = F(36); p.ln_b = F(37);
  float* out = (float*)d_out;
  p.X = out; p.out_k = out + 12582912; p.out_v = out + 13107200; p.out_hf = out + 13631488; p.out_hb = out + 14155776;
  p.out_rf = out + 14680064; p.out_rb = out + 15728640;
  char* ws = (char*)d_ws; size_t off = 16384;
  p.bar = (unsigned*)ws;
  auto alloc = [&](size_t bytes) { char* r = ws + off; off += (bytes + 255) & ~(size_t)255; return r; };
  const size_t M1 = (size_t)1024 * 1024;
  p.w_in_t = (bf16_t*)alloc((size_t)3328 * 1024 * 2); p.w_out_t = (bf16_t*)alloc(M1 * 2);
  p.wr_t = (bf16_t*)alloc(M1 * 2); p.wk_t = (bf16_t*)alloc(M1 * 2); p.wv_t = (bf16_t*)alloc(M1 * 2); p.wo_t = (bf16_t*)alloc(M1 * 2);
  p.w1cat_t = (bf16_t*)alloc(128 * 1024 * 2); p.a1cat_t = (bf16_t*)alloc(128 * 1024 * 2); p.g1_t = (bf16_t*)alloc(128 * 1024 * 2);
  p.w2_t = (bf16_t*)alloc(2 * 1024 * 64 * 2); p.a2_t = (bf16_t*)alloc(2 * 1024 * 64 * 2); p.g2_t = (bf16_t*)alloc(1024 * 128 * 2);
  p.mlp1_t = (bf16_t*)alloc(2 * 4 * M1 * 2); p.mlp2_t = (bf16_t*)alloc(2 * 4 * M1 * 2);
  p.MOD = (float*)alloc((size_t)2 * 9 * 6144 * 4);
  const size_t TOKD = (size_t)NTOK * 1024;
  p.H = (bf16_t*)alloc(TOKD * 2);
  const size_t regL = off;
  p.Qbuf = (bf16_t*)alloc((size_t)NTOK * 512 * 2);
  p.Kp = (bf16_t*)alloc((size_t)32 * 256 * 64 * 2); p.Ks = (bf16_t*)alloc((size_t)16 * 1280 * 64 * 2);
  p.Vtp = (bf16_t*)alloc((size_t)32 * 64 * 256 * 2); p.Vts = (bf16_t*)alloc((size_t)16 * 64 * 1280 * 2);
  p.HG = (bf16_t*)alloc((size_t)NTOK * 2560 * 2);
  p.OF = (float*)alloc((size_t)NTOK * 512 * 4); p.OB = (float*)alloc((size_t)NTOK * 512 * 4);
  p.AO = (bf16_t*)alloc(TOKD * 2);
  size_t end0 = off;
  off = regL; p.U = (bf16_t*)alloc((size_t)NTOK * 4096 * 2);
  size_t endU = off;
  off = regL;
  p.R = (bf16_t*)alloc(TOKD * 2); p.Kx = (bf16_t*)alloc(TOKD * 2); p.Vx = (bf16_t*)alloc(TOKD * 2);
  p.LW = (bf16_t*)alloc((size_t)NTOK * 128 * 2); p.LA = (bf16_t*)alloc((size_t)NTOK * 128 * 2); p.LG = (bf16_t*)alloc((size_t)NTOK * 128 * 2);
  p.E0 = (bf16_t*)alloc(TOKD * 2); p.E1 = (bf16_t*)alloc(TOKD * 2); p.A1 = (bf16_t*)alloc(TOKD * 2);
  p.BS = (float*)alloc((size_t)2 * NTOK * 16 * 4);
  p.A0 = p.H; p.ZO = p.R;
  size_t end1 = off;
  size_t need = end0 > end1 ? end0 : end1; if (endU > need) need = endU;
  if (need > ws_size) fprintf(stderr, "workspace too small: need %zu have %zu\n", need, ws_size);
  int nj = 0, tiles = 0;
  auto job = [&](const float* src, bf16_t* dst, int K, int N) { p.jobs[nj].src = src; p.jobs[nj].dst = dst; p.jobs[nj].K = K; p.jobs[nj].N = N; p.jobs[nj].tile0 = tiles; p.jobs[nj].pad = 0; tiles += (K / 64) * (N / 64); ++nj; };
  job(F(38), p.mlp1_t, 1024, 4096); job(F(38) + 4 * M1, p.mlp1_t + 4 * M1, 1024, 4096);
  job(F(39), p.mlp2_t, 4096, 1024); job(F(39) + 4 * M1, p.mlp2_t + 4 * M1, 4096, 1024);
  job(F(14), p.w_in_t, 1024, 3328); job(F(15), p.w_out_t, 1024, 1024);
  job(F(21), p.wr_t, 1024, 1024); job(F(22), p.wk_t, 1024, 1024); job(F(23), p.wv_t, 1024, 1024); job(F(24), p.wo_t, 1024, 1024);
  job(F(26), p.w1cat_t, 1024, 64); job(F(26) + 65536, p.w1cat_t + 65536, 1024, 64);
  job(F(29), p.a1cat_t, 1024, 64); job(F(29) + 65536, p.a1cat_t + 65536, 1024, 64);
  job(F(31), p.g1_t, 1024, 128);
  job(F(27), p.w2_t, 64, 1024); job(F(27) + 65536, p.w2_t + 65536, 64, 1024);
  job(F(30), p.a2_t, 64, 1024); job(F(30) + 65536, p.a2_t + 65536, 64, 1024);
  job(F(32), p.g2_t, 128, 1024);
  p.njobs = nj; p.ntiles = tiles;

  static int grid_blocks = 0;
  if (!grid_blocks) {
    int dev = 0, cus = 0, per_cu = 0;
    hipGetDevice(&dev);
    hipDeviceGetAttribute(&cus, hipDeviceAttributeMultiprocessorCount, dev);
    hipOccupancyMaxActiveBlocksPerMultiprocessor(&per_cu, fwd_kernel, NT, 0);
    if (per_cu > 2) per_cu = 2;
    if (per_cu < 1) per_cu = 1;
    grid_blocks = cus * per_cu;
  }
  hipMemsetAsync(d_ws, 0, 16384, stream);
#if ONE_LAUNCH
  int lo = 0, hi = NPHASES;
  void* args[] = {(void*)&p, (void*)&lo, (void*)&hi};
  hipError_t e = hipLaunchCooperativeKernel((void*)fwd_kernel, dim3(grid_blocks), dim3(NT), args, 0, stream);
  if (e != hipSuccess) fprintf(stderr, "cooperative launch failed: %s (grid %d)\n", hipGetErrorString(e), grid_blocks);
#else
  for (int ph = 0; ph < NPHASES; ++ph) hipLaunchKernelGGL(fwd_kernel, dim3(grid_blocks), dim3(NT), 0, stream, p, ph, ph + 1);
#endif
}
```

```cpp
#include <hip/hip_runtime.h>
#include <hip/hip_cooperative_groups.h>
#include <stdint.h>
#include <string.h>
#include <stdio.h>
namespace cg = cooperative_groups;

#ifndef ONE_LAUNCH
#define ONE_LAUNCH 1
#endif

typedef unsigned short bf16_t;
typedef short bf16x8 __attribute__((ext_vector_type(8)));
typedef float f32x4 __attribute__((ext_vector_type(4)));
typedef float f32x16 __attribute__((ext_vector_type(16)));
typedef float f32x2 __attribute__((ext_vector_type(2)));

#define NT 256
#define NTOK 12288
#define NP 4096
#define NPHASES 18
#ifndef ONLY_PHASE
#define ONLY_PHASE -1
#endif

struct TJob { const float* src; bf16_t* dst; int K, N, tile0, pad; };

struct Params {
  const float *x_prompt, *x_sample, *cache_k, *cache_v, *hg_f0, *hg_b0, *rw_f0, *rw_b0, *c, *c_ctx;
  const float *ada_w, *ada_b, *norm1_w, *norm2_w, *q_norm, *k_norm, *hgrn_lb, *g_norm;
  const float *mix, *w0, *a0, *k_k, *k_a, *r_k, *ln_w, *ln_b;
  float *X, *out_k, *out_v, *out_hf, *out_hb, *out_rf, *out_rb;
  bf16_t *w_in_t, *w_out_t, *wr_t, *wk_t, *wv_t, *wo_t, *w1cat_t, *a1cat_t, *g1_t, *w2_t, *a2_t, *g2_t, *mlp1_t, *mlp2_t;
  float* MOD;
  bf16_t* H;
  bf16_t *Qbuf, *Kp, *Ks, *Vtp, *Vts, *HG, *AO, *U;
  float *OF, *OB;
  bf16_t *R, *Kx, *Vx, *LW, *LA, *LG, *E0, *E1, *A0, *A1, *ZO;
  float* BS;
  unsigned* bar;
  TJob jobs[20];
  int njobs, ntiles;
};

typedef float f32x2c __attribute__((ext_vector_type(2)));
typedef __bf16 bf16v2 __attribute__((ext_vector_type(2)));
__device__ __forceinline__ unsigned pk_bf16(float lo, float hi) { f32x2c v = {lo, hi}; bf16v2 b = __builtin_convertvector(v, bf16v2); return __builtin_bit_cast(unsigned, b); }
__device__ __forceinline__ bf16_t f2bf(float v) { return (bf16_t)(pk_bf16(v, 0.f) & 0xffffu); }
__device__ __forceinline__ float bf2f(bf16_t v) { return __uint_as_float(((unsigned)v) << 16); }
__device__ __forceinline__ float bflo(unsigned u) { return __uint_as_float(u << 16); }
__device__ __forceinline__ float bfhi(unsigned u) { return __uint_as_float(u & 0xffff0000u); }
__device__ __forceinline__ float sigmoidf_(float x) { return __builtin_amdgcn_rcpf(1.f + __expf(-x)); }
__device__ __forceinline__ float siluf_(float x) { return x * __builtin_amdgcn_rcpf(1.f + __expf(-x)); }
__device__ __forceinline__ float wave_sum(float v) {
#pragma unroll
  for (int o = 32; o >= 1; o >>= 1) v += __shfl_xor(v, o);
  return v;
}
__device__ __forceinline__ float quad_sum(float v) {
  v += __int_as_float(__builtin_amdgcn_update_dpp(0, __float_as_int(v), 0xB1, 0xF, 0xF, true));
  v += __int_as_float(__builtin_amdgcn_update_dpp(0, __float_as_int(v), 0x4E, 0xF, 0xF, true));
  return v;
}
__device__ __forceinline__ float oct_sum(float v) {
  v += __int_as_float(__builtin_amdgcn_update_dpp(0, __float_as_int(v), 0xB1, 0xF, 0xF, true));
  v += __int_as_float(__builtin_amdgcn_update_dpp(0, __float_as_int(v), 0x4E, 0xF, 0xF, true));
  v += __int_as_float(__builtin_amdgcn_update_dpp(0, __float_as_int(v), 0x141, 0xF, 0xF, true));
  return v;
}
__device__ __forceinline__ float hex_sum(float v) {
  v = oct_sum(v);
  v += __int_as_float(__builtin_amdgcn_update_dpp(0, __float_as_int(v), 0x140, 0xF, 0xF, true));
  return v;
}
__device__ __forceinline__ int mod_index(int row) { return row < NP ? 0 : 1 + ((row - NP) >> 10); }

__device__ __forceinline__ void ada_item(const Params& p, int it, char* smem) {
  const int tid = threadIdx.x;
  float* sil = (float*)smem;
  for (int i = tid; i < 9 * 1024; i += NT) {
    int n = i >> 10, k = i & 1023;
    float cv = n == 0 ? p.c_ctx[k] : p.c[(n - 1) * 1024 + k];
    sil[i] = siluf_(cv);
  }
  __syncthreads();
  const int gcol = it * 64, l = gcol / 6144, j = gcol % 6144;
  const int c4 = tid & 15, ks = tid >> 4;
  const float* wp = p.ada_w + (size_t)l * 1024 * 6144 + (size_t)(ks * 64) * 6144 + j + c4 * 4;
  float acc[9][4];
#pragma unroll
  for (int n = 0; n < 9; ++n) { acc[n][0] = 0.f; acc[n][1] = 0.f; acc[n][2] = 0.f; acc[n][3] = 0.f; }
#pragma unroll 4
  for (int k = 0; k < 64; ++k) {
    const float4 w = *(const float4*)(wp + (size_t)k * 6144);
#pragma unroll
    for (int n = 0; n < 9; ++n) {
      const float s = sil[n * 1024 + ks * 64 + k];
      acc[n][0] += s * w.x; acc[n][1] += s * w.y; acc[n][2] += s * w.z; acc[n][3] += s * w.w;
    }
  }
  __syncthreads();
  float* red = (float*)smem;
#pragma unroll
  for (int n = 0; n < 9; ++n)
#pragma unroll
    for (int q = 0; q < 4; ++q) red[(ks * 9 + n) * 64 + c4 * 4 + q] = acc[n][q];
  __syncthreads();
  for (int o = tid; o < 576; o += NT) {
    const int n = o >> 6, cc = o & 63;
    float s = 0.f;
#pragma unroll
    for (int k2 = 0; k2 < 16; ++k2) s += red[(k2 * 9 + n) * 64 + cc];
    s += p.ada_b[l * 6144 + j + cc];
    p.MOD[(size_t)(l * 9 + n) * 6144 + j + cc] = s;
  }
}

__device__ __forceinline__ void transpose_item(const Params& p, int tix, char* smem) {
  const int tid = threadIdx.x;
  int j = 0;
  while (j + 1 < p.njobs && tix >= p.jobs[j + 1].tile0) ++j;
  const float* src = p.jobs[j].src; bf16_t* dst = p.jobs[j].dst;
  const int K = p.jobs[j].K, N = p.jobs[j].N, lt = tix - p.jobs[j].tile0;
  const int ntn = N >> 6, tk = lt / ntn, tn = lt % ntn;
  float* tile = (float*)smem;
#pragma unroll
  for (int i = 0; i < 4; ++i) {
    const int r = (tid >> 4) + 16 * i, c4 = tid & 15;
    const float4 v = *(const float4*)(src + (size_t)(tk * 64 + r) * N + tn * 64 + c4 * 4);
    float* t = tile + r * 65 + c4 * 4;
    t[0] = v.x; t[1] = v.y; t[2] = v.z; t[3] = v.w;
  }
  __syncthreads();
  const int n = tid >> 2, kc = (tid & 3) * 16;
  unsigned w[8];
#pragma unroll
  for (int i = 0; i < 8; ++i) w[i] = pk_bf16(tile[(kc + 2 * i) * 65 + n], tile[(kc + 2 * i + 1) * 65 + n]);
  uint4* d = (uint4*)(dst + (size_t)(tn * 64 + n) * K + tk * 64 + kc);
  d[0] = make_uint4(w[0], w[1], w[2], w[3]);
  d[1] = make_uint4(w[4], w[5], w[6], w[7]);
}

__device__ __forceinline__ void cache_item(const Params& p, int ci) {
  const int tid = threadIdx.x;
  const int base = (ci & 31) * 8192;
  for (int e = tid; e < 8192; e += NT) {
    const int idx = base + e;
    const int d = idx & 63, kvh = (idx >> 6) & 1, pp = (idx >> 7) & 255, b = idx >> 15;
    if (ci < 32) p.Ks[((size_t)(b * 2 + kvh) * 1280 + 1024 + pp) * 64 + d] = f2bf(p.cache_k[idx]);
    else p.Vts[((size_t)(b * 2 + kvh) * 64 + d) * 1280 + 1024 + pp] = f2bf(p.cache_v[idx]);
  }
}

__device__ __forceinline__ void phase0(const Params& p, char* smem) {
  const int n_ada = 192, n_tr = p.ntiles, n_cc = 64;
  const int total = n_ada + n_tr + n_cc;
  for (int it = blockIdx.x; it < total; it += gridDim.x) {
    if (it < n_ada) ada_item(p, it, smem);
    else if (it < n_ada + n_tr) transpose_item(p, it - n_ada, smem);
    else cache_item(p, it - n_ada - n_tr);
    __syncthreads();
  }
}

__device__ __forceinline__ void prenorm_phase(const Params& p, int layer, int which, bool from_input) {
  const int wave = threadIdx.x >> 6, lane = threadIdx.x & 63;
  const float* nw = (which ? p.norm2_w : p.norm1_w) + layer * 1024;
  for (int row = blockIdx.x * 4 + wave; row < NTOK; row += gridDim.x * 4) {
    const float* xr = from_input ? (row < NP ? p.x_prompt + (size_t)row * 1024 : p.x_sample + (size_t)(row - NP) * 1024)
                                 : p.X + (size_t)row * 1024;
    float4 v[4]; float ss = 0.f;
#pragma unroll
    for (int i = 0; i < 4; ++i) { v[i] = *(const float4*)(xr + i * 256 + lane * 4); ss += v[i].x * v[i].x + v[i].y * v[i].y + v[i].z * v[i].z + v[i].w * v[i].w; }
    ss = wave_sum(ss);
    const float rstd = rsqrtf(ss * (1.f / 1024.f) + 1e-6f);
    const float* md = p.MOD + (size_t)(layer * 9 + mod_index(row)) * 6144;
    const float* sh = md + (which ? 3 : 0) * 1024; const float* sc = md + (which ? 4 : 1) * 1024;
#pragma unroll
    for (int i = 0; i < 4; ++i) {
      const int c = i * 256 + lane * 4;
      const float4 w4 = *(const float4*)(nw + c), s4 = *(const float4*)(sh + c), c4 = *(const float4*)(sc + c);
      const float h0 = v[i].x * rstd * w4.x * (1.f + c4.x) + s4.x, h1 = v[i].y * rstd * w4.y * (1.f + c4.y) + s4.y;
      const float h2 = v[i].z * rstd * w4.z * (1.f + c4.z) + s4.z, h3 = v[i].w * rstd * w4.w * (1.f + c4.w) + s4.w;
      *(uint2*)(p.H + (size_t)row * 1024 + c) = make_uint2(pk_bf16(h0, h1), pk_bf16(h2, h3));
    }
  }
}

struct ALoadPlain {
  const bf16_t* A; int lda;
  __device__ __forceinline__ uint4 operator()(int row, int k) const { return *(const uint4*)(A + (size_t)row * lda + k); }
};
struct ALoadShift {
  const bf16_t* H; const float* mix;
  __device__ __forceinline__ uint4 operator()(int row, int k) const {
    const uint4 h = *(const uint4*)(H + (size_t)row * 1024 + k);
    int tl, T;
    if (row < NP) { tl = row & 255; T = 256; } else { tl = (row - NP) & 1023; T = 1024; }
    uint4 s = make_uint4(0, 0, 0, 0);
    if (k < 512) { if (tl > 0) s = *(const uint4*)(H + (size_t)(row - 1) * 1024 + k); }
    else { if (tl < T - 1) s = *(const uint4*)(H + (size_t)(row + 1) * 1024 + k); }
    const float4 m0 = *(const float4*)(mix + k), m1 = *(const float4*)(mix + k + 4);
    uint4 o;
    { float a = bflo(h.x), b = bfhi(h.x); o.x = pk_bf16(a + (bflo(s.x) - a) * m0.x, b + (bfhi(s.x) - b) * m0.y); }
    { float a = bflo(h.y), b = bfhi(h.y); o.y = pk_bf16(a + (bflo(s.y) - a) * m0.z, b + (bfhi(s.y) - b) * m0.w); }
    { float a = bflo(h.z), b = bfhi(h.z); o.z = pk_bf16(a + (bflo(s.z) - a) * m1.x, b + (bfhi(s.z) - b) * m1.y); }
    { float a = bflo(h.w), b = bfhi(h.w); o.w = pk_bf16(a + (bflo(s.w) - a) * m1.z, b + (bfhi(s.w) - b) * m1.w); }
    return o;
  }
};

template <class AL, class EP>
__device__ __forceinline__ void gemm_tile(const AL& al, const bf16_t* __restrict__ Bt, int K, int tm, int tn, const EP& ep, char* smem) {
  const int tid = threadIdx.x, lane = tid & 63, wid = tid >> 6, wm = wid >> 1, wn = wid & 1;
  const int fr = lane & 15, fq = lane >> 4;
  char* sA = smem; char* sB = smem + 32768;
  f32x4 acc[4][4];
#pragma unroll
  for (int a = 0; a < 4; ++a)
#pragma unroll
    for (int b = 0; b < 4; ++b) acc[a][b] = (f32x4){0.f, 0.f, 0.f, 0.f};
  uint4 pa[4], pb[4];
  const int nk = K >> 6;
  const int cr0 = tid >> 3, cc = tid & 7;
  const int soff = cr0 * 128 + ((cc ^ ((cr0 >> 1) & 7)) << 4);
  const bf16_t* bp = Bt + (size_t)(tn * 128 + cr0) * K + cc * 8;
#define GLOAD(kt) do { _Pragma("unroll") for (int i = 0; i < 4; ++i) { pa[i] = al(tm * 128 + cr0 + 32 * i, (kt) * 64 + cc * 8); pb[i] = *(const uint4*)(bp + (size_t)(32 * i) * K + (kt) * 64); } } while (0)
#define SSTORE(buf) do { _Pragma("unroll") for (int i = 0; i < 4; ++i) { *(uint4*)(sA + (buf) * 16384 + soff + i * 4096) = pa[i]; *(uint4*)(sB + (buf) * 16384 + soff + i * 4096) = pb[i]; } } while (0)
  GLOAD(0); SSTORE(0); __syncthreads();
  for (int kt = 0; kt < nk; ++kt) {
    const int buf = kt & 1;
    if (kt + 1 < nk) GLOAD(kt + 1);
#pragma unroll
    for (int kk = 0; kk < 2; ++kk) {
      bf16x8 af[4], bfr[4];
#pragma unroll
      for (int mi = 0; mi < 4; ++mi) { const int r = wm * 64 + mi * 16 + fr, c = kk * 4 + fq; af[mi] = *(const bf16x8*)(sA + buf * 16384 + r * 128 + ((c ^ ((r >> 1) & 7)) << 4)); }
#pragma unroll
      for (int ni = 0; ni < 4; ++ni) { const int r = wn * 64 + ni * 16 + fr, c = kk * 4 + fq; bfr[ni] = *(const bf16x8*)(sB + buf * 16384 + r * 128 + ((c ^ ((r >> 1) & 7)) << 4)); }
#pragma unroll
      for (int mi = 0; mi < 4; ++mi)
#pragma unroll
        for (int ni = 0; ni < 4; ++ni) acc[mi][ni] = __builtin_amdgcn_mfma_f32_16x16x32_bf16(bfr[ni], af[mi], acc[mi][ni], 0, 0, 0);
    }
    if (kt + 1 < nk) SSTORE(buf ^ 1);
    __syncthreads();
  }
#undef GLOAD
#undef SSTORE
  ep(acc, tm * 128 + wm * 64, tn * 128 + wn * 64, lane);
}

#define LAS3 __attribute__((address_space(3)))
template <int OFF>
__device__ __forceinline__ bf16x8 lds_rd128(unsigned addr) { bf16x8 v; asm volatile("ds_read_b128 %0, %1 offset:%2" : "=v"(v) : "v"(addr), "n"(OFF) : "memory"); return v; }
template <class EP>
__device__ __forceinline__ void gemm_tile_glds(const bf16_t* __restrict__ A, int lda, const bf16_t* __restrict__ Bt, int K, int tm, int tn, const EP& ep, char* smem) {
  const int tid = threadIdx.x, lane = tid & 63, wid = __builtin_amdgcn_readfirstlane(tid >> 6), wm = wid >> 1, wn = wid & 1;
  const int fr = lane & 15, fq = lane >> 4;
  f32x4 acc[4][4];
#pragma unroll
  for (int a = 0; a < 4; ++a)
#pragma unroll
    for (int b = 0; b < 4; ++b) acc[a][b] = (f32x4){0.f, 0.f, 0.f, 0.f};
  const int nk = K >> 6;
  const int lr = lane >> 3, c0 = (lane & 7) ^ (lr >> 1);
  const bf16_t* pa = A + (size_t)(tm * 128 + wid * 32 + lr) * lda;
  const bf16_t* pb = Bt + (size_t)(tn * 128 + wid * 32 + lr) * K;
  const unsigned lbase = (unsigned)(uintptr_t)(LAS3 char*)smem;
  const unsigned fsw = (unsigned)((fq ^ ((fr >> 1) & 7)) << 4);
  const unsigned aA0 = lbase + (unsigned)((wm * 64 + fr) * 128) + fsw, aA1 = lbase + (unsigned)((wm * 64 + fr) * 128) + (fsw ^ 64u);
  const unsigned aB0 = lbase + 32768u + (unsigned)((wn * 64 + fr) * 128) + fsw, aB1 = lbase + 32768u + (unsigned)((wn * 64 + fr) * 128) + (fsw ^ 64u);
#define GLDS(kt, buf) do { _Pragma("unroll") for (int i = 0; i < 4; ++i) { const int cc_ = (c0 ^ ((i & 1) << 2)) * 8 + (kt) * 64; \
    __builtin_amdgcn_global_load_lds((const unsigned*)(pa + (size_t)(i * 8) * lda + cc_), (LAS3 unsigned*)(smem + (buf) * 16384 + (wid * 4 + i) * 1024), 16, 0, 0); \
    __builtin_amdgcn_global_load_lds((const unsigned*)(pb + (size_t)(i * 8) * K + cc_), (LAS3 unsigned*)(smem + 32768 + (buf) * 16384 + (wid * 4 + i) * 1024), 16, 0, 0); } } while (0)
  GLDS(0, 0);
  asm volatile("s_waitcnt vmcnt(0)" ::: "memory");
  __builtin_amdgcn_s_barrier();
  for (int kt = 0; kt < nk; ++kt) {
    const int buf = kt & 1;
    if (kt + 1 < nk) GLDS(kt + 1, buf ^ 1);
    const unsigned bo = (unsigned)buf * 16384u;
    bf16x8 a0[4], b0[4], a1[4], b1[4];
    a0[0] = lds_rd128<0>(aA0 + bo); a0[1] = lds_rd128<2048>(aA0 + bo); a0[2] = lds_rd128<4096>(aA0 + bo); a0[3] = lds_rd128<6144>(aA0 + bo);
    b0[0] = lds_rd128<0>(aB0 + bo); b0[1] = lds_rd128<2048>(aB0 + bo); b0[2] = lds_rd128<4096>(aB0 + bo); b0[3] = lds_rd128<6144>(aB0 + bo);
    a1[0] = lds_rd128<0>(aA1 + bo); a1[1] = lds_rd128<2048>(aA1 + bo); a1[2] = lds_rd128<4096>(aA1 + bo); a1[3] = lds_rd128<6144>(aA1 + bo);
    b1[0] = lds_rd128<0>(aB1 + bo); b1[1] = lds_rd128<2048>(aB1 + bo); b1[2] = lds_rd128<4096>(aB1 + bo); b1[3] = lds_rd128<6144>(aB1 + bo);
    __builtin_amdgcn_sched_barrier(0);
    asm volatile("s_waitcnt lgkmcnt(8)" : "+v"(a0[0]), "+v"(a0[1]), "+v"(a0[2]), "+v"(a0[3]), "+v"(b0[0]), "+v"(b0[1]), "+v"(b0[2]), "+v"(b0[3]) :: "memory");
    __builtin_amdgcn_s_setprio(1);
#pragma unroll
    for (int mi = 0; mi < 4; ++mi)
#pragma unroll
      for (int ni = 0; ni < 4; ++ni) acc[mi][ni] = __builtin_amdgcn_mfma_f32_16x16x32_bf16(b0[ni], a0[mi], acc[mi][ni], 0, 0, 0);
    __builtin_amdgcn_sched_barrier(0);
    asm volatile("s_waitcnt lgkmcnt(0)" : "+v"(a1[0]), "+v"(a1[1]), "+v"(a1[2]), "+v"(a1[3]), "+v"(b1[0]), "+v"(b1[1]), "+v"(b1[2]), "+v"(b1[3]) :: "memory");
#pragma unroll
    for (int mi = 0; mi < 4; ++mi)
#pragma unroll
      for (int ni = 0; ni < 4; ++ni) acc[mi][ni] = __builtin_amdgcn_mfma_f32_16x16x32_bf16(b1[ni], a1[mi], acc[mi][ni], 0, 0, 0);
    __builtin_amdgcn_s_setprio(0);
    __builtin_amdgcn_sched_barrier(0);
    asm volatile("s_waitcnt vmcnt(0)" ::: "memory");
    __builtin_amdgcn_s_barrier();
    __builtin_amdgcn_sched_barrier(0);
  }
#undef GLDS
  ep(acc, tm * 128 + wm * 64, tn * 128 + wn * 64, lane);
}

struct EpiWin {
  const Params* pp;
  __device__ __forceinline__ void operator()(f32x4 (&acc)[4][4], int row0, int col0, int lane) const {
    const Params& p = *pp;
    const int fr = lane & 15, fq = lane >> 4;
    const bool sample = row0 >= NP;
    if (col0 < 640) {
      const bool isq = col0 < 512;
      const float* nw = isq ? p.q_norm : p.k_norm;
      float nwv[4][4];
#pragma unroll
      for (int ni = 0; ni < 4; ++ni)
#pragma unroll
        for (int j = 0; j < 4; ++j) nwv[ni][j] = nw[ni * 16 + fq * 4 + j];
#pragma unroll
      for (int mi = 0; mi < 4; ++mi) {
        const int row = row0 + mi * 16 + fr;
        float ss = 0.f;
#pragma unroll
        for (int ni = 0; ni < 4; ++ni)
#pragma unroll
          for (int j = 0; j < 4; ++j) ss += acc[mi][ni][j] * acc[mi][ni][j];
        ss += __shfl_xor(ss, 16); ss += __shfl_xor(ss, 32);
        const float rn = rsqrtf(ss * (1.f / 64.f) + 1e-6f);
        float y[4][4];
#pragma unroll
        for (int ni = 0; ni < 4; ++ni)
#pragma unroll
          for (int j = 0; j < 4; ++j) y[ni][j] = acc[mi][ni][j] * rn * nwv[ni][j];
        if (!sample && !isq) {
          const int kvh = (col0 - 512) >> 6;
#pragma unroll
          for (int ni = 0; ni < 4; ++ni) *(f32x4*)(p.out_k + (size_t)row * 128 + kvh * 64 + ni * 16 + fq * 4) = (f32x4){y[ni][0], y[ni][1], y[ni][2], y[ni][3]};
        }
        if (sample) {
          const int tl = (row - NP) & 1023;
          const float rp = (float)(tl >> 6), cp = (float)(tl & 63);
#pragma unroll
          for (int ni = 0; ni < 4; ++ni)
#pragma unroll
            for (int jp = 0; jp < 2; ++jp) {
              const int i = (ni * 16 + fq * 4 + jp * 2) >> 1;
              const float pos = i < 16 ? rp : cp;
              const float inv = exp2f(-(float)(i & 15) * 0.83048202372184058696f);
              const float ang = pos * inv;
              const float s = __sinf(ang), c = __cosf(ang);
              const float x0 = y[ni][2 * jp], x1 = y[ni][2 * jp + 1];
              y[ni][2 * jp] = x0 * c - x1 * s; y[ni][2 * jp + 1] = x0 * s + x1 * c;
            }
        }
        if (isq) {
          const float qs = 0.125f * 1.44269504088896f;
#pragma unroll
          for (int ni = 0; ni < 4; ++ni)
            *(uint2*)(p.Qbuf + (size_t)row * 512 + col0 + ni * 16 + fq * 4) = make_uint2(pk_bf16(y[ni][0] * qs, y[ni][1] * qs), pk_bf16(y[ni][2] * qs, y[ni][3] * qs));
        } else {
          const int kvh = (col0 - 512) >> 6;
          bf16_t* kd;
          if (!sample) kd = p.Kp + ((size_t)((row >> 8) * 2 + kvh) * 256 + (row & 255)) * 64;
          else kd = p.Ks + ((size_t)(((row - NP) >> 10) * 2 + kvh) * 1280 + ((row - NP) & 1023)) * 64;
#pragma unroll
          for (int ni = 0; ni < 4; ++ni)
            *(uint2*)(kd + ni * 16 + fq * 4) = make_uint2(pk_bf16(y[ni][0], y[ni][1]), pk_bf16(y[ni][2], y[ni][3]));
        }
      }
    } else if (col0 < 768) {
      const int kvh = (col0 - 640) >> 6;
#pragma unroll
      for (int mi = 0; mi < 4; ++mi) {
        const int row = row0 + mi * 16 + fr;
#pragma unroll
        for (int ni = 0; ni < 4; ++ni) {
          const int d0 = ni * 16 + fq * 4;
          if (!sample) {
            *(f32x4*)(p.out_v + (size_t)row * 128 + kvh * 64 + d0) = acc[mi][ni];
            bf16_t* vd = p.Vtp + ((size_t)((row >> 8) * 2 + kvh) * 64 + d0) * 256 + (row & 255);
#pragma unroll
            for (int j = 0; j < 4; ++j) vd[j * 256] = f2bf(acc[mi][ni][j]);
          } else {
            bf16_t* vd = p.Vts + ((size_t)(((row - NP) >> 10) * 2 + kvh) * 64 + d0) * 1280 + ((row - NP) & 1023);
#pragma unroll
            for (int j = 0; j < 4; ++j) vd[j * 1280] = f2bf(acc[mi][ni][j]);
          }
        }
      }
    } else {
      const int c0 = col0 - 768, seg = c0 >> 9;
      float oml[4][4];
      if (seg == 1 || seg == 2) {
#pragma unroll
        for (int ni = 0; ni < 4; ++ni)
#pragma unroll
          for (int j = 0; j < 4; ++j) { const int c = (c0 & 511) + ni * 16 + fq * 4 + j; oml[ni][j] = __builtin_amdgcn_rcpf(1.f + __expf(p.hgrn_lb[c] - p.hgrn_lb[512 + c])); }
      }
#pragma unroll
      for (int mi = 0; mi < 4; ++mi) {
        const int row = row0 + mi * 16 + fr;
#pragma unroll
        for (int ni = 0; ni < 4; ++ni) {
          float o[4];
#pragma unroll
          for (int j = 0; j < 4; ++j) {
            const float v = acc[mi][ni][j];
            if (seg == 0 || seg == 4) o[j] = siluf_(v);
            else if (seg == 3) o[j] = v;
            else o[j] = oml[ni][j] * sigmoidf_(-v);
          }
          *(uint2*)(p.HG + (size_t)row * 2560 + c0 + ni * 16 + fq * 4) = make_uint2(pk_bf16(o[0], o[1]), pk_bf16(o[2], o[3]));
        }
      }
    }
  }
};

struct EpiResid {
  const Params* pp; int layer, gidx; bool from_input; bool dry = false;
  __device__ __forceinline__ void operator()(f32x4 (&acc)[4][4], int row0, int col0, int lane) const {
    const Params& p = *pp;
    if (dry && p.njobs >= 0) return;
    const int fr = lane & 15, fq = lane >> 4;
    const float* gt = p.MOD + (size_t)(layer * 9 + mod_index(row0)) * 6144 + gidx * 1024;
#pragma unroll
    for (int mi = 0; mi < 4; ++mi) {
      const int row = row0 + mi * 16 + fr;
      const float* base = from_input ? (row < NP ? p.x_prompt + (size_t)row * 1024 : p.x_sample + (size_t)(row - NP) * 1024) : p.X + (size_t)row * 1024;
#pragma unroll
      for (int ni = 0; ni < 4; ++ni) {
        const int col = col0 + ni * 16 + fq * 4;
        const f32x4 b = *(const f32x4*)(base + col), g = *(const f32x4*)(gt + col);
        *(f32x4*)(p.X + (size_t)row * 1024 + col) = b + g * acc[mi][ni];
      }
    }
  }
};

template <int ACT>
struct EpiAct {
  bf16_t* O; int ldo; const float* bias;
  __device__ __forceinline__ void operator()(f32x4 (&acc)[4][4], int row0, int col0, int lane) const {
    const int fr = lane & 15, fq = lane >> 4;
#pragma unroll
    for (int ni = 0; ni < 4; ++ni) {
      const int col = col0 + ni * 16 + fq * 4;
      f32x4 bv = (f32x4){0.f, 0.f, 0.f, 0.f};
      if (ACT >= 4) bv = *(const f32x4*)(bias + col);
#pragma unroll
      for (int mi = 0; mi < 4; ++mi) {
        const int row = row0 + mi * 16 + fr;
        float o[4];
#pragma unroll
        for (int j = 0; j < 4; ++j) {
          const float v = acc[mi][ni][j] + bv[j];
          if (ACT == 0) o[j] = v;
          else if (ACT == 1) { const float r = fmaxf(v, 0.f); o[j] = r * r; }
          else if (ACT == 2) o[j] = 1.f - 2.f * __builtin_amdgcn_rcpf(1.f + __expf(2.f * v));
          else if (ACT == 3 || ACT == 5) o[j] = sigmoidf_(v);
          else o[j] = 0.60653065971263342f * sigmoidf_(v);
        }
        *(uint2*)(O + (size_t)row * ldo + col) = make_uint2(pk_bf16(o[0], o[1]), pk_bf16(o[2], o[3]));
      }
    }
  }
};

struct EpiRwkvOut {
  const Params* pp;
  __device__ __forceinline__ void operator()(f32x4 (&acc)[4][4], int row0, int col0, int lane) const {
    const Params& p = *pp;
    const int fr = lane & 15, fq = lane >> 4, h = col0 >> 6;
#pragma unroll
    for (int mi = 0; mi < 4; ++mi) {
      const int row = row0 + mi * 16 + fr;
      float y[4][4]; float s = 0.f;
#pragma unroll
      for (int ni = 0; ni < 4; ++ni) {
        const size_t idx = (size_t)row * 1024 + col0 + ni * 16 + fq * 4;
        const uint2 a = *(const uint2*)(p.E0 + idx), b = *(const uint2*)(p.E1 + idx);
        y[ni][0] = bflo(a.x) + bflo(b.x); y[ni][1] = bfhi(a.x) + bfhi(b.x); y[ni][2] = bflo(a.y) + bflo(b.y); y[ni][3] = bfhi(a.y) + bfhi(b.y);
        s += (y[ni][0] + y[ni][1]) + (y[ni][2] + y[ni][3]);
      }
      s += __shfl_xor(s, 16); s += __shfl_xor(s, 32);
      const float mu = s * (1.f / 64.f);
      float q = 0.f;
#pragma unroll
      for (int ni = 0; ni < 4; ++ni)
#pragma unroll
        for (int j = 0; j < 4; ++j) { const float d = y[ni][j] - mu; q += d * d; }
      q += __shfl_xor(q, 16); q += __shfl_xor(q, 32);
      const float rs = rsqrtf(q * (1.f / 64.f) + 64e-5f);
      const float bs = p.BS[(size_t)row * 16 + h] + p.BS[(size_t)NTOK * 16 + (size_t)row * 16 + h];
#pragma unroll
      for (int ni = 0; ni < 4; ++ni) {
        const int col = col0 + ni * 16 + fq * 4;
        const size_t idx = (size_t)row * 1024 + col;
        const uint2 vv = *(const uint2*)(p.Vx + idx);
        const f32x4 lw = *(const f32x4*)(p.ln_w + col), lb = *(const f32x4*)(p.ln_b + col);
        const float v0 = bflo(vv.x), v1 = bfhi(vv.x), v2 = bflo(vv.y), v3 = bfhi(vv.y);
        const float o0 = ((y[ni][0] - mu) * rs * lw[0] + lb[0] + bs * v0) * acc[mi][ni][0];
        const float o1 = ((y[ni][1] - mu) * rs * lw[1] + lb[1] + bs * v1) * acc[mi][ni][1];
        const float o2 = ((y[ni][2] - mu) * rs * lw[2] + lb[2] + bs * v2) * acc[mi][ni][2];
        const float o3 = ((y[ni][3] - mu) * rs * lw[3] + lb[3] + bs * v3) * acc[mi][ni][3];
        *(uint2*)(p.ZO + idx) = make_uint2(pk_bf16(o0, o1), pk_bf16(o2, o3));
      }
    }
  }
};

template <class EP>
__device__ __forceinline__ void gemm_phase(const ALoadPlain& al, const bf16_t* Bt, int K, int ntn, const EP& ep, char* smem) {
  const int nunits = (NTOK / 128) * ntn;
  for (int u = blockIdx.x; u < nunits; u += gridDim.x) gemm_tile_glds(al.A, al.lda, Bt, K, u / ntn, u % ntn, ep, smem);
}

__device__ __forceinline__ void attn_item(const Params& p, int grp, int b, int h, int qb, char* smem) {
  const int tid = threadIdx.x, lane = tid & 63, wid = tid >> 6, qi = lane & 31, g = lane >> 5;
  const int Tk = grp ? 1280 : 256, kvh = h >> 2;
  const int rowbase = grp ? NP + b * 1024 + qb * 128 : b * 256 + qb * 128;
  const bf16_t* Kg = grp ? p.Ks + (size_t)(b * 2 + kvh) * 1280 * 64 : p.Kp + (size_t)(b * 2 + kvh) * 256 * 64;
  const bf16_t* Vg = grp ? p.Vts + (size_t)(b * 2 + kvh) * 64 * 1280 : p.Vtp + (size_t)(b * 2 + kvh) * 64 * 256;
  const int qrow = rowbase + wid * 32 + qi;
  bf16x8 Qf[4];
#pragma unroll
  for (int s = 0; s < 4; ++s) Qf[s] = *(const bf16x8*)(p.Qbuf + (size_t)qrow * 512 + h * 64 + s * 16 + g * 8);
  f32x16 O[2];
#pragma unroll
  for (int i = 0; i < 16; ++i) { O[0][i] = 0.f; O[1][i] = 0.f; }
  float m_run = -1e30f, l_run = 0.f;
  char* sK = smem; char* sV = smem + 16384;
  const int r0 = tid >> 3, c = tid & 7;
  uint4 pk[2], pv[2];
  const int ntile = Tk >> 6;
#define ALOAD(kt) do { _Pragma("unroll") for (int i = 0; i < 2; ++i) { const int r = r0 + 32 * i; pk[i] = *(const uint4*)(Kg + (size_t)((kt) * 64 + r) * 64 + c * 8); pv[i] = *(const uint4*)(Vg + (size_t)r * Tk + (kt) * 64 + c * 8); } } while (0)
#define ASTORE(buf) do { _Pragma("unroll") for (int i = 0; i < 2; ++i) { const int r = r0 + 32 * i; \
      *(uint4*)(sK + (buf) * 8192 + r * 128 + ((c ^ ((r >> 1) & 7)) << 4)) = pk[i]; \
      const int f = (r >> 1) & 15; \
      *(uint2*)(sV + (buf) * 8192 + r * 128 + (((2 * c) ^ f) << 3)) = make_uint2(pv[i].x, pv[i].y); \
      *(uint2*)(sV + (buf) * 8192 + r * 128 + (((2 * c + 1) ^ f) << 3)) = make_uint2(pv[i].z, pv[i].w); } } while (0)
  ALOAD(0); ASTORE(0); __syncthreads();
  for (int kt = 0; kt < ntile; ++kt) {
    const int buf = kt & 1;
    if (kt + 1 < ntile) ALOAD(kt + 1);
    f32x16 S[2];
#pragma unroll
    for (int t2 = 0; t2 < 2; ++t2) {
#pragma unroll
      for (int i = 0; i < 16; ++i) S[t2][i] = 0.f;
#pragma unroll
      for (int s = 0; s < 4; ++s) {
        const int r = t2 * 32 + qi, cc = 2 * s + g;
        const bf16x8 Kf = *(const bf16x8*)(sK + buf * 8192 + r * 128 + ((cc ^ ((r >> 1) & 7)) << 4));
        S[t2] = __builtin_amdgcn_mfma_f32_32x32x16_bf16(Kf, Qf[s], S[t2], 0, 0, 0);
      }
    }
    float mx = S[0][0];
#pragma unroll
    for (int i = 0; i < 16; ++i) { mx = fmaxf(mx, S[0][i]); mx = fmaxf(mx, S[1][i]); }
    mx = fmaxf(mx, __shfl_xor(mx, 32));
    const float m_new = fmaxf(m_run, mx);
    const float alpha = __builtin_amdgcn_exp2f(m_run - m_new);
    float ls = 0.f;
#pragma unroll
    for (int i = 0; i < 16; ++i) { S[0][i] = __builtin_amdgcn_exp2f(S[0][i] - m_new); S[1][i] = __builtin_amdgcn_exp2f(S[1][i] - m_new); ls += S[0][i] + S[1][i]; }
    l_run = l_run * alpha + ls; m_run = m_new;
#pragma unroll
    for (int i = 0; i < 16; ++i) { O[0][i] *= alpha; O[1][i] *= alpha; }
#pragma unroll
    for (int t2 = 0; t2 < 2; ++t2)
#pragma unroll
      for (int sp = 0; sp < 2; ++sp) {
        union { bf16x8 v; unsigned u[4]; } Pf;
#pragma unroll
        for (int e = 0; e < 4; ++e) Pf.u[e] = pk_bf16(S[t2][8 * sp + 2 * e], S[t2][8 * sp + 2 * e + 1]);
#pragma unroll
        for (int ds = 0; ds < 2; ++ds) {
          const int d = ds * 32 + qi, f = (d >> 1) & 15, u1 = 8 * t2 + 4 * sp + g;
          union { bf16x8 v; uint2 u[2]; } Vf;
          Vf.u[0] = *(const uint2*)(sV + buf * 8192 + d * 128 + ((u1 ^ f) << 3));
          Vf.u[1] = *(const uint2*)(sV + buf * 8192 + d * 128 + (((u1 + 2) ^ f) << 3));
          O[ds] = __builtin_amdgcn_mfma_f32_32x32x16_bf16(Vf.v, Pf.v, O[ds], 0, 0, 0);
        }
      }
    if (kt + 1 < ntile) ASTORE(buf ^ 1);
    __syncthreads();
  }
#undef ALOAD
#undef ASTORE
  const float l = l_run + __shfl_xor(l_run, 32);
  const float inv = 1.f / l;
#pragma unroll
  for (int ds = 0; ds < 2; ++ds)
#pragma unroll
    for (int bq = 0; bq < 4; ++bq) {
      const int d0 = ds * 32 + 8 * bq + 4 * g;
      *(uint2*)(p.AO + (size_t)qrow * 1024 + h * 64 + d0) =
          make_uint2(pk_bf16(O[ds][4 * bq] * inv, O[ds][4 * bq + 1] * inv), pk_bf16(O[ds][4 * bq + 2] * inv, O[ds][4 * bq + 3] * inv));
    }
}

__device__ __forceinline__ void hgrn_item(const Params& p, int grp, int b, int h, int dir, int half, char* smem) {
  const int tid = threadIdx.x, v = half * 32 + (tid >> 3), ks = tid & 7;
  const int T = grp ? 1024 : 256, rowbase = grp ? NP + b * 1024 : b * 256;
  if (grp) __builtin_amdgcn_s_setprio(3);
  f32x2 S2[4];
  if (grp) {
    const float* s0 = (dir ? p.hg_b0 : p.hg_f0) + (size_t)(b * 8 + h) * 4096;
#pragma unroll
    for (int i = 0; i < 4; ++i) S2[i] = (f32x2){s0[(ks * 8 + 2 * i) * 64 + v], s0[(ks * 8 + 2 * i + 1) * 64 + v]};
  } else {
#pragma unroll
    for (int i = 0; i < 4; ++i) S2[i] = (f32x2){0.f, 0.f};
  }
  float* obuf = (float*)(smem + 32768);
  const int lt = tid >> 4, lc = (tid & 15) * 4;
  const int kfseg = dir ? 1024 : 512;
  uint2 rq, rk, rv, rq2, rk2, rv2;
  const int nch = T >> 4;
#define HLOADX(cix, q_, k_, v_) do { const int ts = (cix) * 16 + lt; const int tok = dir ? T - 1 - ts : ts; const bf16_t* src = p.HG + (size_t)(rowbase + tok) * 2560 + h * 64 + lc; \
    q_ = *(const uint2*)(src); k_ = *(const uint2*)(src + kfseg); v_ = *(const uint2*)(src + 1536); } while (0)
#define HSTORE(buf) do { float* B = (float*)(smem + (buf) * 16384) + lt * 64 + lc; \
    const float k0 = bflo(rk.x), k1 = bfhi(rk.x), k2 = bflo(rk.y), k3 = bfhi(rk.y); \
    *(float4*)(B) = make_float4(1.f - k0, 1.f - k1, 1.f - k2, 1.f - k3); *(float4*)(B + 1024) = make_float4(k0, k1, k2, k3); \
    *(float4*)(B + 2048) = make_float4(bflo(rq.x), bfhi(rq.x), bflo(rq.y), bfhi(rq.y)); *(float4*)(B + 3072) = make_float4(bflo(rv.x), bfhi(rv.x), bflo(rv.y), bfhi(rv.y)); } while (0)
  HLOADX(0, rq, rk, rv); HSTORE(0);
  HLOADX(1, rq, rk, rv);
  __syncthreads();
  float* OD = dir ? p.OB : p.OF;
  for (int cix = 0; cix < nch; ++cix) {
    const int buf = cix & 1;
    if (cix + 2 < nch) HLOADX(cix + 2, rq2, rk2, rv2);
    const float* B = (const float*)(smem + buf * 16384);
    float* ob = obuf + buf * 512;
    float4 cf[2], ck[2], cq[2]; float cv;
#define HSTEP_LOAD(t_, f_, k_, q_, v_) do { const float* Bt = B + (t_) * 64 + ks * 8; \
      f_[0] = *(const float4*)(Bt); f_[1] = *(const float4*)(Bt + 4); k_[0] = *(const float4*)(Bt + 1024); k_[1] = *(const float4*)(Bt + 1028); \
      q_[0] = *(const float4*)(Bt + 2048); q_[1] = *(const float4*)(Bt + 2052); v_ = B[3072 + (t_) * 64 + v]; } while (0)
    HSTEP_LOAD(0, cf, ck, cq, cv);
#pragma unroll 1
    for (int g = 0; g < 4; ++g) {
      float op[4];
#pragma unroll
      for (int tt = 0; tt < 4; ++tt) {
        const int t = g * 4 + tt;
        float4 nf[2], nk[2], nq[2]; float nv;
        { const int tn_ = (t + 1) & 15; HSTEP_LOAD(tn_, nf, nk, nq, nv); }
        const f32x2 vvv = (f32x2){cv, cv};
        f32x2 o0, o1;
        S2[0] = S2[0] * (f32x2){cf[0].x, cf[0].y} + vvv * (f32x2){ck[0].x, ck[0].y};
        S2[1] = S2[1] * (f32x2){cf[0].z, cf[0].w} + vvv * (f32x2){ck[0].z, ck[0].w};
        S2[2] = S2[2] * (f32x2){cf[1].x, cf[1].y} + vvv * (f32x2){ck[1].x, ck[1].y};
        S2[3] = S2[3] * (f32x2){cf[1].z, cf[1].w} + vvv * (f32x2){ck[1].z, ck[1].w};
        o0 = S2[0] * (f32x2){cq[0].x, cq[0].y}; o1 = S2[1] * (f32x2){cq[0].z, cq[0].w};
        o0 = S2[2] * (f32x2){cq[1].x, cq[1].y} + o0; o1 = S2[3] * (f32x2){cq[1].z, cq[1].w} + o1;
        const f32x2 os = o0 + o1;
        op[tt] = os.x + os.y;
        cf[0] = nf[0]; cf[1] = nf[1]; ck[0] = nk[0]; ck[1] = nk[1]; cq[0] = nq[0]; cq[1] = nq[1]; cv = nv;
      }
#pragma unroll
      for (int tt = 0; tt < 4; ++tt) { const float o = oct_sum(op[tt]); if (ks == 0) ob[(g * 4 + tt) * 32 + (tid >> 3)] = o; }
    }
#undef HSTEP_LOAD
    if (cix + 1 < nch) HSTORE(buf ^ 1);
    rq = rq2; rk = rk2; rv = rv2;
    __syncthreads();
    if (tid < 128) {
      const int ft = tid >> 3, fc = (tid & 7) * 4;
      const int ts = cix * 16 + ft; const int tok = dir ? T - 1 - ts : ts;
      *(float4*)(OD + (size_t)(rowbase + tok) * 512 + h * 64 + half * 32 + fc) = *(const float4*)(ob + ft * 32 + fc);
    }
  }
#undef HLOADX
#undef HSTORE
  __builtin_amdgcn_s_setprio(0);
  if (!grp) {
    float* so = (dir ? p.out_hb : p.out_hf) + (size_t)(b * 8 + h) * 4096;
#pragma unroll
    for (int i = 0; i < 4; ++i) { so[(ks * 8 + 2 * i) * 64 + v] = S2[i].x; so[(ks * 8 + 2 * i + 1) * 64 + v] = S2[i].y; }
  }
}

__device__ __forceinline__ void mix0_phase(const Params& p, char* smem) {
  __shared__ int q_item;
  for (;;) {
    if (threadIdx.x == 0) q_item = (int)atomicAdd(&p.bar[0], 1u);
    __syncthreads();
    const int it = q_item;
    __syncthreads();
    if (it >= 1536) break;
    if (it < 768) {
      const int grp = it < 256 ? 1 : 0, a = grp ? it : it - 256;
      hgrn_item(p, grp, a >> 5, (a >> 2) & 7, (a >> 1) & 1, a & 1, smem);
    } else {
      const int grp = it < 1280 ? 1 : 0, a = grp ? it - 768 : it - 1280;
      const int b = grp ? a >> 6 : a >> 4, h = grp ? (a >> 3) & 7 : (a >> 1) & 7, qb = grp ? a & 7 : a & 1;
      attn_item(p, grp, b, h, qb, smem);
    }
    __syncthreads();
  }
}

__device__ __forceinline__ void hgrn_combine_phase(const Params& p) {
  const int gid = blockIdx.x * NT + threadIdx.x, l16 = gid & 15;
  const int ngroups = NTOK * 8;
  for (int grp = gid >> 4; grp < ngroups; grp += (gridDim.x * NT) >> 4) {
    const int row = grp >> 3, h = grp & 7;
    const size_t o = (size_t)row * 512 + h * 64 + l16 * 4;
    const float4 a = *(const float4*)(p.OF + o), b = *(const float4*)(p.OB + o);
    const float y0 = a.x + b.x, y1 = a.y + b.y, y2 = a.z + b.z, y3 = a.w + b.w;
    float ss = y0 * y0 + y1 * y1 + y2 * y2 + y3 * y3;
    ss += __shfl_xor(ss, 1); ss += __shfl_xor(ss, 2); ss += __shfl_xor(ss, 4); ss += __shfl_xor(ss, 8);
    const float rn = rsqrtf(ss * (1.f / 64.f) + 1e-6f);
    const float4 gn = *(const float4*)(p.g_norm + l16 * 4);
    const uint2 gt = *(const uint2*)(p.HG + (size_t)row * 2560 + 2048 + h * 64 + l16 * 4);
    *(uint2*)(p.AO + (size_t)row * 1024 + 512 + h * 64 + l16 * 4) =
        make_uint2(pk_bf16(y0 * rn * gn.x * bflo(gt.x), y1 * rn * gn.y * bfhi(gt.x)), pk_bf16(y2 * rn * gn.z * bflo(gt.y), y3 * rn * gn.w * bfhi(gt.y)));
  }
}

__device__ __forceinline__ void rwkv_item(const Params& p, int grp, int b, int h, int dir, char* smem, bool dry = false) {
  const bool wr = !(dry && p.njobs >= 0);
  if (grp) __builtin_amdgcn_s_setprio(3);
  const int tid = threadIdx.x, lane = tid & 63, wid = tid >> 6, v = tid >> 2, ks = tid & 3;
  const int T = grp ? 1024 : 256, rowbase = grp ? NP + b * 1024 : b * 256;
  const int vp = tid >> 3, k8 = tid & 7;
  f32x2 Sa[4], Sb[4];
  if (grp) {
    const float* s0 = (dir ? p.rw_b0 : p.rw_f0) + ((size_t)(b * 16 + h) * 64 + vp) * 64 + k8 * 8;
#pragma unroll
    for (int q = 0; q < 2; ++q) {
      const float4 t = *(const float4*)(s0 + q * 4), u = *(const float4*)(s0 + 2048 + q * 4);
      Sa[2 * q] = (f32x2){t.x, t.y}; Sa[2 * q + 1] = (f32x2){t.z, t.w}; Sb[2 * q] = (f32x2){u.x, u.y}; Sb[2 * q + 1] = (f32x2){u.z, u.w};
    }
  } else {
#pragma unroll
    for (int i = 0; i < 4; ++i) { Sa[i] = (f32x2){0.f, 0.f}; Sb[i] = (f32x2){0.f, 0.f}; }
  }
  const bf16_t* E = dir ? p.E1 : p.E0; const bf16_t* A = dir ? p.A1 : p.A0; bf16_t* Y = dir ? p.E1 : p.E0;
  const int lt = tid >> 4, lc = (tid & 15) * 4;
  const float4 kkc = *(const float4*)(p.k_k + h * 64 + lc), kac = *(const float4*)(p.k_a + h * 64 + lc), rkc = *(const float4*)(p.r_k + h * 64 + lc);
  float* BSd = p.BS + (size_t)dir * NTOK * 16;
  float* ybuf = (float*)(smem + 49152);
  uint2 gr, gk, gv, ge, ga;
  const int nch = T >> 4;
#define RLOAD(cix) do { const int ts = (cix) * 16 + lt; const int tok = dir ? T - 1 - ts : ts; const size_t idx = (size_t)(rowbase + tok) * 1024 + h * 64 + lc; \
    gr = *(const uint2*)(p.R + idx); gk = *(const uint2*)(p.Kx + idx); gv = *(const uint2*)(p.Vx + idx); ge = *(const uint2*)(E + idx); ga = *(const uint2*)(A + idx); } while (0)
#define RSTORE(cix, buf) do { const int ts = (cix) * 16 + lt; const int tok = dir ? T - 1 - ts : ts; \
    const float r_[4] = {bflo(gr.x), bfhi(gr.x), bflo(gr.y), bfhi(gr.y)}, k_[4] = {bflo(gk.x), bfhi(gk.x), bflo(gk.y), bfhi(gk.y)}; \
    const float e_[4] = {bflo(ge.x), bfhi(ge.x), bflo(ge.y), bfhi(ge.y)}, a_[4] = {bflo(ga.x), bfhi(ga.x), bflo(ga.y), bfhi(ga.y)}; \
    const float kc_[4] = {kkc.x, kkc.y, kkc.z, kkc.w}, ac_[4] = {kac.x, kac.y, kac.z, kac.w}, rc_[4] = {rkc.x, rkc.y, rkc.z, rkc.w}; \
    float kx[4], kd[4], ssq = 0.f, bsum = 0.f; \
    _Pragma("unroll") for (int j = 0; j < 4; ++j) { kx[j] = k_[j] * kc_[j]; ssq += kx[j] * kx[j]; kd[j] = k_[j] * (1.f + (a_[j] - 1.f) * ac_[j]); bsum += r_[j] * kd[j] * rc_[j]; } \
    ssq = hex_sum(ssq); bsum = hex_sum(bsum); const float rn = rsqrtf(fmaxf(ssq, 1e-24f)); \
    float* B = (float*)(smem + (buf) * 24576) + lt * 64 + lc; \
    *(float4*)(B) = make_float4(__expf(-e_[0]), __expf(-e_[1]), __expf(-e_[2]), __expf(-e_[3])); \
    *(float4*)(B + 1024) = make_float4(kx[0] * rn, kx[1] * rn, kx[2] * rn, kx[3] * rn); \
    *(float4*)(B + 2048) = make_float4(kx[0] * rn * a_[0], kx[1] * rn * a_[1], kx[2] * rn * a_[2], kx[3] * rn * a_[3]); \
    *(float4*)(B + 3072) = make_float4(kd[0], kd[1], kd[2], kd[3]); \
    *(float4*)(B + 4096) = make_float4(r_[0], r_[1], r_[2], r_[3]); \
    *(float4*)(B + 5120) = make_float4(bflo(gv.x), bfhi(gv.x), bflo(gv.y), bfhi(gv.y)); \
    if ((tid & 15) == 0 && wr) BSd[(size_t)(rowbase + tok) * 16 + h] = bsum; } while (0)
  RLOAD(0); RSTORE(0, 0); __syncthreads();
  for (int cix = 0; cix < nch; ++cix) {
    const int buf = cix & 1;
    if (cix + 1 < nch) RLOAD(cix + 1);
    const float* B = (const float*)(smem + buf * 24576);
    float* yb = ybuf + buf * 1024;
    float4 cw[2], ck[2], ca[2], cd[2], cr[2]; float cva, cvb;
#define RSTEP_LOAD(t_, w_, k_, a_, d_, r_, va_, vb_) do { const float* Bt = B + (t_) * 64 + k8 * 8; \
      w_[0] = *(const float4*)(Bt); w_[1] = *(const float4*)(Bt + 4); k_[0] = *(const float4*)(Bt + 1024); k_[1] = *(const float4*)(Bt + 1028); \
      a_[0] = *(const float4*)(Bt + 2048); a_[1] = *(const float4*)(Bt + 2052); d_[0] = *(const float4*)(Bt + 3072); d_[1] = *(const float4*)(Bt + 3076); \
      r_[0] = *(const float4*)(Bt + 4096); r_[1] = *(const float4*)(Bt + 4100); va_ = B[5120 + (t_) * 64 + vp]; vb_ = B[5120 + (t_) * 64 + vp + 32]; } while (0)
    RSTEP_LOAD(0, cw, ck, ca, cd, cr, cva, cvb);
#pragma unroll
    for (int t = 0; t < 16; ++t) {
      float4 nw[2], nk[2], na[2], nd[2], nr[2]; float nva = 0.f, nvb = 0.f;
      if (t + 1 < 16) RSTEP_LOAD(t + 1, nw, nk, na, nd, nr, nva, nvb);
      f32x2 w2[4], kk2[4];
#pragma unroll
      for (int q = 0; q < 2; ++q) {
        w2[2 * q] = (f32x2){cw[q].x, cw[q].y}; w2[2 * q + 1] = (f32x2){cw[q].z, cw[q].w};
        kk2[2 * q] = (f32x2){ck[q].x, ck[q].y}; kk2[2 * q + 1] = (f32x2){ck[q].z, ck[q].w};
      }
      const f32x2 sa_a = (Sa[0] * kk2[0] + Sa[1] * kk2[1]) + (Sa[2] * kk2[2] + Sa[3] * kk2[3]);
      const f32x2 sa_b = (Sb[0] * kk2[0] + Sb[1] * kk2[1]) + (Sb[2] * kk2[2] + Sb[3] * kk2[3]);
      const float saa = -oct_sum(sa_a.x + sa_a.y), sab = -oct_sum(sa_b.x + sa_b.y);
      const f32x2 saav = (f32x2){saa, saa}, sabv = (f32x2){sab, sab}, vav = (f32x2){cva, cva}, vbv = (f32x2){cvb, cvb};
      f32x2 ya = (f32x2){0.f, 0.f}, yb2 = (f32x2){0.f, 0.f};
#pragma unroll
      for (int q = 0; q < 2; ++q) {
        const f32x2 ka0 = (f32x2){ca[q].x, ca[q].y}, ka1 = (f32x2){ca[q].z, ca[q].w}, kd0 = (f32x2){cd[q].x, cd[q].y}, kd1 = (f32x2){cd[q].z, cd[q].w};
        const f32x2 r0 = (f32x2){cr[q].x, cr[q].y}, r1 = (f32x2){cr[q].z, cr[q].w};
        Sa[2 * q] = Sa[2 * q] * w2[2 * q] + (vav * kd0 + saav * ka0); Sa[2 * q + 1] = Sa[2 * q + 1] * w2[2 * q + 1] + (vav * kd1 + saav * ka1);
        Sb[2 * q] = Sb[2 * q] * w2[2 * q] + (vbv * kd0 + sabv * ka0); Sb[2 * q + 1] = Sb[2 * q + 1] * w2[2 * q + 1] + (vbv * kd1 + sabv * ka1);
        ya = Sa[2 * q] * r0 + ya; ya = Sa[2 * q + 1] * r1 + ya;
        yb2 = Sb[2 * q] * r0 + yb2; yb2 = Sb[2 * q + 1] * r1 + yb2;
      }
      const float y_a = oct_sum(ya.x + ya.y), y_b = oct_sum(yb2.x + yb2.y);
      if (k8 == 0) { yb[t * 64 + vp] = y_a; yb[t * 64 + vp + 32] = y_b; }
      if (t + 1 < 16) {
#pragma unroll
        for (int q = 0; q < 2; ++q) { cw[q] = nw[q]; ck[q] = nk[q]; ca[q] = na[q]; cd[q] = nd[q]; cr[q] = nr[q]; }
        cva = nva; cvb = nvb;
      }
    }
#undef RSTEP_LOAD
    if (cix + 1 < nch) RSTORE(cix + 1, buf ^ 1);
    __syncthreads();
    {
      const int ts = cix * 16 + lt; const int tok = dir ? T - 1 - ts : ts;
      const float4 yy = *(const float4*)(yb + lt * 64 + lc);
      if (wr) *(uint2*)(Y + (size_t)(rowbase + tok) * 1024 + h * 64 + lc) = make_uint2(pk_bf16(yy.x, yy.y), pk_bf16(yy.z, yy.w));
    }
  }
#undef RLOAD
#undef RSTORE
  __builtin_amdgcn_s_setprio(0);
  if (!grp && wr) {
    float* so = (dir ? p.out_rb : p.out_rf) + ((size_t)(b * 16 + h) * 64 + vp) * 64 + k8 * 8;
#pragma unroll
    for (int q = 0; q < 2; ++q) {
      *(float4*)(so + q * 4) = make_float4(Sa[2 * q].x, Sa[2 * q].y, Sa[2 * q + 1].x, Sa[2 * q + 1].y);
      *(float4*)(so + 2048 + q * 4) = make_float4(Sb[2 * q].x, Sb[2 * q].y, Sb[2 * q + 1].x, Sb[2 * q + 1].y);
    }
  }
}

__device__ __forceinline__ void rwkv_scan_phase(const Params& p, char* smem, bool dry = false) {
  const int G = gridDim.x;
  if (G >= 512) {
    if (blockIdx.x < 256) { const int a = blockIdx.x; rwkv_item(p, 1, a >> 5, (a >> 1) & 15, a & 1, smem, dry); }
    else for (int a = blockIdx.x - 256; a < 512; a += G - 256) { rwkv_item(p, 0, a >> 5, (a >> 1) & 15, a & 1, smem, dry); __syncthreads(); }
  } else {
    for (int it = blockIdx.x; it < 768; it += G) {
      const int grp = it < 256 ? 1 : 0, a = grp ? it : it - 256;
      rwkv_item(p, grp, a >> 5, (a >> 1) & 15, a & 1, smem, dry);
      __syncthreads();
    }
  }
}

__device__ __forceinline__ void blend_phase(const Params& p) {
  const int gid = blockIdx.x * NT + threadIdx.x, nth = gridDim.x * NT;
  for (int i = gid; i < NTOK * 128; i += nth) {
    const int row = i >> 7, k = (i & 127) * 8;
    ALoadShift a0{p.H, p.mix + 0 * 1024}, a2{p.H, p.mix + 2 * 1024}, a3{p.H, p.mix + 3 * 1024};
    const size_t o = (size_t)row * 1024 + k;
    *(uint4*)(p.E0 + o) = a0(row, k); *(uint4*)(p.E1 + o) = a2(row, k); *(uint4*)(p.A1 + o) = a3(row, k);
  }
}

__device__ __forceinline__ void rwkv_proj_phase(const Params& p, char* smem) {
  const int nunits = 96 * 27;
  for (int u = blockIdx.x; u < nunits; u += gridDim.x) {
    const int tm = u < 288 ? u / 3 : (u - 288) / 24, s = u < 288 ? 24 + u % 3 : (u - 288) % 24;
    if (s < 8) { EpiAct<0> ep{p.R, 1024, nullptr}; gemm_tile_glds(p.E0, 1024, p.wr_t, 1024, tm, s, ep, smem); }
    else if (s < 16) { EpiAct<0> ep{p.Kx, 1024, nullptr}; gemm_tile_glds(p.E1, 1024, p.wk_t, 1024, tm, s - 8, ep, smem); }
    else if (s < 24) { EpiAct<0> ep{p.Vx, 1024, nullptr}; gemm_tile_glds(p.A1, 1024, p.wv_t, 1024, tm, s - 16, ep, smem); }
    else if (s == 24) { ALoadShift al{p.H, p.mix + 1 * 1024}; EpiAct<2> ep{p.LW, 128, nullptr}; gemm_tile(al, p.w1cat_t, 1024, tm, 0, ep, smem); }
    else if (s == 25) { ALoadShift al{p.H, p.mix + 4 * 1024}; EpiAct<0> ep{p.LA, 128, nullptr}; gemm_tile(al, p.a1cat_t, 1024, tm, 0, ep, smem); }
    else { ALoadShift al{p.H, p.mix + 5 * 1024}; EpiAct<3> ep{p.LG, 128, nullptr}; gemm_tile(al, p.g1_t, 1024, tm, 0, ep, smem); }
  }
}
__device__ __forceinline__ void rwkv_lora2_phase(const Params& p, char* smem) {
  const int nunits = 96 * 32;
  for (int u = blockIdx.x; u < nunits; u += gridDim.x) {
    const int tm = u >> 5, s = u & 31, which = s >> 3, tn = s & 7;
    const int d = which & 1;
    if (which < 2) { ALoadPlain al{p.LW + d * 64, 128}; EpiAct<4> ep{d ? p.E1 : p.E0, 1024, p.w0 + d * 1024}; gemm_tile_glds(al.A, al.lda, p.w2_t + (size_t)d * 65536, 64, tm, tn, ep, smem); }
    else { ALoadPlain al{p.LA + d * 64, 128}; EpiAct<5> ep{d ? p.A1 : p.A0, 1024, p.a0 + d * 1024}; gemm_tile_glds(al.A, al.lda, p.a2_t + (size_t)d * 65536, 64, tm, tn, ep, smem); }
  }
}


#define XB_TMO      128
#define XB_XCNT(j)  (256  + 64 * (j))
#define XB_XSUB(j)  (1280 + 64 * (j))
#define XB_XGEN(j)  (2304 + 64 * (j))
#define XB_TOP      3328
#define XB_TOPGEN   3392
#define XCD_BAR_WORDS 3456
#define XB_SPIN_CAP (1u << 22)
#define LAS __attribute__((address_space(3)))
__device__ __forceinline__ unsigned xb_ld(unsigned* p)              { return __hip_atomic_load(p, __ATOMIC_RELAXED, __HIP_MEMORY_SCOPE_AGENT); }
__device__ __forceinline__ unsigned xb_add(unsigned* p, unsigned v) { return __hip_atomic_fetch_add(p, v, __ATOMIC_RELAXED, __HIP_MEMORY_SCOPE_AGENT); }
__device__ __forceinline__ unsigned xb_xcc_id() { return (unsigned)__builtin_amdgcn_s_getreg((3 << 11) | 20) & 0xFu; }
#define XB_SPIN(cond, bar) do { unsigned _sp = 0; while (cond) { __builtin_amdgcn_s_sleep(1); \
    if ((++_sp & 255u) == 0u) { if (xb_ld(&(bar)[XB_TMO])) break; if (_sp > XB_SPIN_CAP) { atomicAdd(&(bar)[XB_TMO], 1u); break; } } } } while (0)
struct XcdBarrier { unsigned* bar; unsigned x; volatile LAS unsigned* st; };
__device__ __forceinline__ XcdBarrier xcd_barrier_post(unsigned* bar, volatile LAS unsigned* st) {
    XcdBarrier b; b.bar = bar; b.x = xb_xcc_id(); b.st = st;
    if (threadIdx.x == 0) (void)xb_add(&bar[XB_XCNT(b.x)], 1u);
    return b;
}
__device__ __forceinline__ void xcd_barrier_complete(unsigned* bar, unsigned x, unsigned& nloc, unsigned& nx) {
    const unsigned G = gridDim.x * gridDim.y * gridDim.z;
    unsigned sum, cnt, mine, sp = 0u;
    for (;;) {
        sum = 0u; cnt = 0u; mine = 0u;
#pragma unroll
        for (unsigned j = 0; j < 16; ++j) { const unsigned c = xb_ld(&bar[XB_XCNT(j)]); sum += c; cnt += (c > 0u) ? 1u : 0u; mine = (j == x) ? c : mine; }
        if (sum == G) break;
        __builtin_amdgcn_s_sleep(1);
        if ((++sp & 255u) == 0u) { if (xb_ld(&bar[XB_TMO])) break; if (sp > XB_SPIN_CAP) { atomicAdd(&bar[XB_TMO], 1u); break; } }
    }
    nloc = mine > 0u ? mine : 1u; nx = cnt > 0u ? cnt : 1u;
}
__device__ __forceinline__ void xcd_barrier(const XcdBarrier& b) {
    asm volatile("s_waitcnt vmcnt(0)" ::: "memory");
    __syncthreads();
    if (threadIdx.x == 0) {
        unsigned* bar = b.bar;
        __builtin_amdgcn_s_waitcnt(0);
        unsigned nloc = b.st[0], nx = b.st[1];
        if (nloc == 0u) { xcd_barrier_complete(bar, b.x, nloc, nx); b.st[0] = nloc; b.st[1] = nx; }
        const unsigned old = xb_add(&bar[XB_XSUB(b.x)], 1u);
        const unsigned gen = old / nloc;
        if (old + 1u == (gen + 1u) * nloc) {
            __builtin_amdgcn_fence(__ATOMIC_RELEASE, "agent");
            asm volatile("s_waitcnt vmcnt(0)" ::: "memory");
            const unsigned og = xb_add(&bar[XB_TOP], 1u);
            const unsigned tg = og / nx;
            if (og + 1u == (tg + 1u) * nx) xb_add(&bar[XB_TOPGEN], 1u);
            else XB_SPIN(xb_ld(&bar[XB_TOPGEN]) == tg, bar);
            __builtin_amdgcn_fence(__ATOMIC_ACQUIRE, "agent");
            xb_add(&bar[XB_XGEN(b.x)], 1u);
            asm volatile("s_waitcnt vmcnt(0)" ::: "memory");
        } else {
            XB_SPIN(xb_ld(&bar[XB_XGEN(b.x)]) == gen, bar);
            __builtin_amdgcn_fence(__ATOMIC_ACQUIRE, "agent");
            asm volatile("s_waitcnt vmcnt(0)" ::: "memory");
        }
    }
    __syncthreads();
}

__device__ __forceinline__ void run_phase(const Params& p, int ph, char* smem, bool dry = false) {
  switch (ph) {
    case 0: if (ONLY_PHASE < 0 || ONLY_PHASE == 0) phase0(p, smem); break;
    case 1: if (ONLY_PHASE < 0 || ONLY_PHASE == 1) prenorm_phase(p, 0, 0, true); break;
    case 2: if (ONLY_PHASE < 0 || ONLY_PHASE == 2) { ALoadPlain al{p.H, 1024}; EpiWin ep{&p}; gemm_phase(al, p.w_in_t, 1024, 26, ep, smem); } break;
    case 3: if (ONLY_PHASE < 0 || ONLY_PHASE == 3) mix0_phase(p, smem); break;
    case 4: if (ONLY_PHASE < 0 || ONLY_PHASE == 4) hgrn_combine_phase(p); break;
    case 5: if (ONLY_PHASE < 0 || ONLY_PHASE == 5) { ALoadPlain al{p.AO, 1024}; EpiResid ep{&p, 0, 2, true}; gemm_phase(al, p.w_out_t, 1024, 8, ep, smem); } break;
    case 6: if (ONLY_PHASE < 0 || ONLY_PHASE == 6) prenorm_phase(p, 0, 1, false); break;
    case 7: if (ONLY_PHASE < 0 || ONLY_PHASE == 7) { ALoadPlain al{p.H, 1024}; EpiAct<1> ep{p.U, 4096, nullptr}; gemm_phase(al, p.mlp1_t, 1024, 32, ep, smem); } break;
    case 8: if (ONLY_PHASE < 0 || ONLY_PHASE == 8) { ALoadPlain al{p.U, 4096}; EpiResid ep{&p, 0, 5, false, dry}; gemm_phase(al, p.mlp2_t, 4096, 8, ep, smem); } break;
    case 9: if (ONLY_PHASE < 0 || ONLY_PHASE == 9) prenorm_phase(p, 1, 0, false); break;
    case 10: if (ONLY_PHASE < 0 || ONLY_PHASE == 10) rwkv_proj_phase(p, smem); break;
    case 11: if (ONLY_PHASE < 0 || ONLY_PHASE == 11) rwkv_lora2_phase(p, smem); break;
    case 12: if (ONLY_PHASE < 0 || ONLY_PHASE == 12) rwkv_scan_phase(p, smem, dry); break;
    case 13: if (ONLY_PHASE < 0 || ONLY_PHASE == 13) { ALoadPlain al{p.LG, 128}; EpiRwkvOut ep{&p}; gemm_phase(al, p.g2_t, 128, 8, ep, smem); } break;
    case 14: if (ONLY_PHASE < 0 || ONLY_PHASE == 14) { ALoadPlain al{p.ZO, 1024}; EpiResid ep{&p, 1, 2, false, dry}; gemm_phase(al, p.wo_t, 1024, 8, ep, smem); } break;
    case 15: if (ONLY_PHASE < 0 || ONLY_PHASE == 15) prenorm_phase(p, 1, 1, false); break;
    case 16: if (ONLY_PHASE < 0 || ONLY_PHASE == 16) { ALoadPlain al{p.H, 1024}; EpiAct<1> ep{p.U, 4096, nullptr}; gemm_phase(al, p.mlp1_t + (size_t)4096 * 1024, 1024, 32, ep, smem); } break;
    case 17: if (ONLY_PHASE < 0 || ONLY_PHASE == 17) { ALoadPlain al{p.U, 4096}; EpiResid ep{&p, 1, 5, false, dry}; gemm_phase(al, p.mlp2_t + (size_t)4096 * 1024, 4096, 8, ep, smem); } break;
    case 18: blend_phase(p); break;
    default: break;
  }
}

__global__ void __launch_bounds__(NT, 2) fwd_kernel(const Params p_unused, int ph_lo, int ph_hi) {
  const Params& p = *(const Params*)__builtin_amdgcn_kernarg_segment_ptr();
  __shared__ __attribute__((aligned(16))) char smem[65536];
  __shared__ uint4 xb_words;
  if (threadIdx.x == 0) xb_words = make_uint4(0u, 0u, 0u, 0u);
  __syncthreads();
  XcdBarrier xb = xcd_barrier_post(p.bar, (volatile LAS unsigned*)&xb_words);
  if (ph_hi < 0) cg::this_grid().sync();
#ifndef PROBE_MASK
#define PROBE_MASK 0
#endif
#ifndef PROBE_DRY
#define PROBE_DRY 0
#endif
#define PHASE(n, sync_) { if ((PROBE_MASK >> n) & 1) { run_phase(p, n, smem); xcd_barrier(xb); } if ((PROBE_DRY >> n) & 1) { run_phase(p, n, smem, true); xcd_barrier(xb); } run_phase(p, n, smem); if (sync_) xcd_barrier(xb); }
  PHASE(0, 1) PHASE(1, 1) PHASE(2, 1) PHASE(3, 1) PHASE(4, 1) PHASE(5, 1) PHASE(6, 1) PHASE(7, 1) PHASE(8, 1) PHASE(9, 1) PHASE(18, 1)
  PHASE(10, 1) PHASE(11, 1) PHASE(12, 1) PHASE(13, 1) PHASE(14, 1) PHASE(15, 1) PHASE(16, 1) PHASE(17, 0)
#undef PHASE
}

extern "C" void kernel_launch(void* const* d_in, const int* in_sizes, int n_in, void* d_out, int out_size, void* d_ws, size_t ws_size, hipStream_t stream) {
  Params p; memset(&p, 0, sizeof(p));
  auto F = [&](int i) { return (const float*)d_in[i]; };
  p.x_prompt = F(0); p.x_sample = F(1); p.cache_k = F(2); p.cache_v = F(3); p.hg_f0 = F(4); p.hg_b0 = F(5); p.rw_f0 = F(6); p.rw_b0 = F(7);
  p.c = F(8); p.c_ctx = F(9); p.ada_w = F(10); p.ada_b = F(11); p.norm1_w = F(12); p.norm2_w = F(13);
  p.q_norm = F(16); p.k_norm = F(17); p.hgrn_lb = F(18); p.g_norm = F(19); p.mix = F(20);
  p.w0 = F(25); p.a0 = F(28); p.k_k = F(33); p.k_a = F(34); p.r_k = F(35); p.ln_w = F(36); p.ln_b = F(37);
  float* out = (float*)d_out;
  p.X = out; p.out_k = out + 12582912; p.out_v = out + 13107200; p.out_hf = out + 13631488; p.out_hb = out + 14155776;
  p.out_rf = out + 14680064; p.out_rb = out + 15728640;
  char* ws = (char*)d_ws; size_t off = 16384;
  p.bar = (unsigned*)ws;
  auto alloc = [&](size_t bytes) { char* r = ws + off; off += (bytes + 255) & ~(size_t)255; return r; };
  const size_t M1 = (size_t)1024 * 1024;
  p.w_in_t = (bf16_t*)alloc((size_t)3328 * 1024 * 2); p.w_out_t = (bf16_t*)alloc(M1 * 2);
  p.wr_t = (bf16_t*)alloc(M1 * 2); p.wk_t = (bf16_t*)alloc(M1 * 2); p.wv_t = (bf16_t*)alloc(M1 * 2); p.wo_t = (bf16_t*)alloc(M1 * 2);
  p.w1cat_t = (bf16_t*)alloc(128 * 1024 * 2); p.a1cat_t = (bf16_t*)alloc(128 * 1024 * 2); p.g1_t = (bf16_t*)alloc(128 * 1024 * 2);
  p.w2_t = (bf16_t*)alloc(2 * 1024 * 64 * 2); p.a2_t = (bf16_t*)alloc(2 * 1024 * 64 * 2); p.g2_t = (bf16_t*)alloc(1024 * 128 * 2);
  p.mlp1_t = (bf16_t*)alloc(2 * 4 * M1 * 2); p.mlp2_t = (bf16_t*)alloc(2 * 4 * M1 * 2);
  p.MOD = (float*)alloc((size_t)2 * 9 * 6144 * 4);
  const size_t TOKD = (size_t)NTOK * 1024;
  p.H = (bf16_t*)alloc(TOKD * 2);
  const size_t regL = off;
  p.Qbuf = (bf16_t*)alloc((size_t)NTOK * 512 * 2);
  p.Kp = (bf16_t*)alloc((size_t)32 * 256 * 64 * 2); p.Ks = (bf16_t*)alloc((size_t)16 * 1280 * 64 * 2);
  p.Vtp = (bf16_t*)alloc((size_t)32 * 64 * 256 * 2); p.Vts = (bf16_t*)alloc((size_t)16 * 64 * 1280 * 2);
  p.HG = (bf16_t*)alloc((size_t)NTOK * 2560 * 2);
  p.OF = (float*)alloc((size_t)NTOK * 512 * 4); p.OB = (float*)alloc((size_t)NTOK * 512 * 4);
  p.AO = (bf16_t*)alloc(TOKD * 2);
  size_t end0 = off;
  off = regL; p.U = (bf16_t*)alloc((size_t)NTOK * 4096 * 2);
  size_t endU = off;
  off = regL;
  p.R = (bf16_t*)alloc(TOKD * 2); p.Kx = (bf16_t*)alloc(TOKD * 2); p.Vx = (bf16_t*)alloc(TOKD * 2);
  p.LW = (bf16_t*)alloc((size_t)NTOK * 128 * 2); p.LA = (bf16_t*)alloc((size_t)NTOK * 128 * 2); p.LG = (bf16_t*)alloc((size_t)NTOK * 128 * 2);
  p.E0 = (bf16_t*)alloc(TOKD * 2); p.E1 = (bf16_t*)alloc(TOKD * 2); p.A1 = (bf16_t*)alloc(TOKD * 2);
  p.BS = (float*)alloc((size_t)2 * NTOK * 16 * 4);
  p.A0 = p.H; p.ZO = p.R;
  size_t end1 = off;
  size_t need = end0 > end1 ? end0 : end1; if (endU > need) need = endU;
  if (need > ws_size) fprintf(stderr, "workspace too small: need %zu have %zu\n", need, ws_size);
  int nj = 0, tiles = 0;
  auto job = [&](const float* src, bf16_t* dst, int K, int N) { p.jobs[nj].src = src; p.jobs[nj].dst = dst; p.jobs[nj].K = K; p.jobs[nj].N = N; p.jobs[nj].tile0 = tiles; p.jobs[nj].pad = 0; tiles += (K / 64) * (N / 64); ++nj; };
  job(F(38), p.mlp1_t, 1024, 4096); job(F(38) + 4 * M1, p.mlp1_t + 4 * M1, 1024, 4096);
  job(F(39), p.mlp2_t, 4096, 1024); job(F(39) + 4 * M1, p.mlp2_t + 4 * M1, 4096, 1024);
  job(F(14), p.w_in_t, 1024, 3328); job(F(15), p.w_out_t, 1024, 1024);
  job(F(21), p.wr_t, 1024, 1024); job(F(22), p.wk_t, 1024, 1024); job(F(23), p.wv_t, 1024, 1024); job(F(24), p.wo_t, 1024, 1024);
  job(F(26), p.w1cat_t, 1024, 64); job(F(26) + 65536, p.w1cat_t + 65536, 1024, 64);
  job(F(29), p.a1cat_t, 1024, 64); job(F(29) + 65536, p.a1cat_t + 65536, 1024, 64);
  job(F(31), p.g1_t, 1024, 128);
  job(F(27), p.w2_t, 64, 1024); job(F(27) + 65536, p.w2_t + 65536, 64, 1024);
  job(F(30), p.a2_t, 64, 1024); job(F(30) + 65536, p.a2_t + 65536, 64, 1024);
  job(F(32), p.g2_t, 128, 1024);
  p.njobs = nj; p.ntiles = tiles;

  static int grid_blocks = 0;
  if (!grid_blocks) {
    int dev = 0, cus = 0, per_cu = 0;
    hipGetDevice(&dev);
    hipDeviceGetAttribute(&cus, hipDeviceAttributeMultiprocessorCount, dev);
    hipOccupancyMaxActiveBlocksPerMultiprocessor(&per_cu, fwd_kernel, NT, 0);
    if (per_cu > 2) per_cu = 2;
    if (per_cu < 1) per_cu = 1;
    grid_blocks = cus * per_cu;
  }
  hipMemsetAsync(d_ws, 0, 16384, stream);
#if ONE_LAUNCH
  int lo = 0, hi = NPHASES;
  void* args[] = {(void*)&p, (void*)&lo, (void*)&hi};
  hipError_t e = hipLaunchCooperativeKernel((void*)fwd_kernel, dim3(grid_blocks), dim3(NT), args, 0, stream);
  if (e != hipSuccess) fprintf(stderr, "cooperative launch failed: %s (grid %d)\n", hipGetErrorString(e), grid_blocks);
#else
  for (int ph = 0; ph < NPHASES; ++ph) hipLaunchKernelGGL(fwd_kernel, dim3(grid_blocks), dim3(NT), 0, stream, p, ph, ph + 1);
#endif
}
```

```cpp
#include <hip/hip_runtime.h>
#include <hip/hip_cooperative_groups.h>
#include <stdint.h>
#include <string.h>
#include <stdio.h>
namespace cg = cooperative_groups;

#ifndef ONE_LAUNCH
#define ONE_LAUNCH 1
#endif

typedef unsigned short bf16_t;
typedef short bf16x8 __attribute__((ext_vector_type(8)));
typedef float f32x4 __attribute__((ext_vector_type(4)));
typedef float f32x16 __attribute__((ext_vector_type(16)));
typedef float f32x2 __attribute__((ext_vector_type(2)));

#define NT 256
#define NTOK 12288
#define NP 4096
#define NPHASES 18
#ifndef ONLY_PHASE
#define ONLY_PHASE -1
#endif

struct TJob { const float* src; bf16_t* dst; int K, N, tile0, pad; };

struct Params {
  const float *x_prompt, *x_sample, *cache_k, *cache_v, *hg_f0, *hg_b0, *rw_f0, *rw_b0, *c, *c_ctx;
  const float *ada_w, *ada_b, *norm1_w, *norm2_w, *q_norm, *k_norm, *hgrn_lb, *g_norm;
  const float *mix, *w0, *a0, *k_k, *k_a, *r_k, *ln_w, *ln_b;
  float *X, *out_k, *out_v, *out_hf, *out_hb, *out_rf, *out_rb;
  bf16_t *w_in_t, *w_out_t, *wr_t, *wk_t, *wv_t, *wo_t, *w1cat_t, *a1cat_t, *g1_t, *w2_t, *a2_t, *g2_t, *mlp1_t, *mlp2_t;
  float* MOD;
  bf16_t* H;
  bf16_t *Qbuf, *Kp, *Ks, *Vtp, *Vts, *HG, *AO, *U;
  float *OF, *OB;
  bf16_t *R, *Kx, *Vx, *LW, *LA, *LG, *E0, *E1, *A0, *A1, *ZO;
  float* BS;
  unsigned* bar;
  TJob jobs[20];
  int njobs, ntiles;
};

typedef float f32x2c __attribute__((ext_vector_type(2)));
typedef __bf16 bf16v2 __attribute__((ext_vector_type(2)));
__device__ __forceinline__ unsigned pk_bf16(float lo, float hi) { f32x2c v = {lo, hi}; bf16v2 b = __builtin_convertvector(v, bf16v2); return __builtin_bit_cast(unsigned, b); }
__device__ __forceinline__ bf16_t f2bf(float v) { return (bf16_t)(pk_bf16(v, 0.f) & 0xffffu); }
__device__ __forceinline__ float bf2f(bf16_t v) { return __uint_as_float(((unsigned)v) << 16); }
__device__ __forceinline__ float bflo(unsigned u) { return __uint_as_float(u << 16); }
__device__ __forceinline__ float bfhi(unsigned u) { return __uint_as_float(u & 0xffff0000u); }
__device__ __forceinline__ float sigmoidf_(float x) { return __builtin_amdgcn_rcpf(1.f + __expf(-x)); }
__device__ __forceinline__ float siluf_(float x) { return x * __builtin_amdgcn_rcpf(1.f + __expf(-x)); }
__device__ __forceinline__ float wave_sum(float v) {
#pragma unroll
  for (int o = 32; o >= 1; o >>= 1) v += __shfl_xor(v, o);
  return v;
}
__device__ __forceinline__ float quad_sum(float v) {
  v += __int_as_float(__builtin_amdgcn_update_dpp(0, __float_as_int(v), 0xB1, 0xF, 0xF, true));
  v += __int_as_float(__builtin_amdgcn_update_dpp(0, __float_as_int(v), 0x4E, 0xF, 0xF, true));
  return v;
}
__device__ __forceinline__ float oct_sum(float v) {
  v += __int_as_float(__builtin_amdgcn_update_dpp(0, __float_as_int(v), 0xB1, 0xF, 0xF, true));
  v += __int_as_float(__builtin_amdgcn_update_dpp(0, __float_as_int(v), 0x4E, 0xF, 0xF, true));
  v += __int_as_float(__builtin_amdgcn_update_dpp(0, __float_as_int(v), 0x141, 0xF, 0xF, true));
  return v;
}
__device__ __forceinline__ float hex_sum(float v) {
  v = oct_sum(v);
  v += __int_as_float(__builtin_amdgcn_update_dpp(0, __float_as_int(v), 0x140, 0xF, 0xF, true));
  return v;
}
__device__ __forceinline__ int mod_index(int row) { return row < NP ? 0 : 1 + ((row - NP) >> 10); }

__device__ __forceinline__ void ada_item(const Params& p, int it, char* smem) {
  const int tid = threadIdx.x;
  float* sil = (float*)smem;
  for (int i = tid; i < 9 * 1024; i += NT) {
    int n = i >> 10, k = i & 1023;
    float cv = n == 0 ? p.c_ctx[k] : p.c[(n - 1) * 1024 + k];
    sil[i] = siluf_(cv);
  }
  __syncthreads();
  const int gcol = it * 64, l = gcol / 6144, j = gcol % 6144;
  const int c4 = tid & 15, ks = tid >> 4;
  const float* wp = p.ada_w + (size_t)l * 1024 * 6144 + (size_t)(ks * 64) * 6144 + j + c4 * 4;
  float acc[9][4];
#pragma unroll
  for (int n = 0; n < 9; ++n) { acc[n][0] = 0.f; acc[n][1] = 0.f; acc[n][2] = 0.f; acc[n][3] = 0.f; }
#pragma unroll 4
  for (int k = 0; k < 64; ++k) {
    const float4 w = *(const float4*)(wp + (size_t)k * 6144);
#pragma unroll
    for (int n = 0; n < 9; ++n) {
      const float s = sil[n * 1024 + ks * 64 + k];
      acc[n][0] += s * w.x; acc[n][1] += s * w.y; acc[n][2] += s * w.z; acc[n][3] += s * w.w;
    }
  }
  __syncthreads();
  float* red = (float*)smem;
#pragma unroll
  for (int n = 0; n < 9; ++n)
#pragma unroll
    for (int q = 0; q < 4; ++q) red[(ks * 9 + n) * 64 + c4 * 4 + q] = acc[n][q];
  __syncthreads();
  for (int o = tid; o < 576; o += NT) {
    const int n = o >> 6, cc = o & 63;
    float s = 0.f;
#pragma unroll
    for (int k2 = 0; k2 < 16; ++k2) s += red[(k2 * 9 + n) * 64 + cc];
    s += p.ada_b[l * 6144 + j + cc];
    p.MOD[(size_t)(l * 9 + n) * 6144 + j + cc] = s;
  }
}

__device__ __forceinline__ void transpose_item(const Params& p, int tix, char* smem) {
  const int tid = threadIdx.x;
  int j = 0;
  while (j + 1 < p.njobs && tix >= p.jobs[j + 1].tile0) ++j;
  const float* src = p.jobs[j].src; bf16_t* dst = p.jobs[j].dst;
  const int K = p.jobs[j].K, N = p.jobs[j].N, lt = tix - p.jobs[j].tile0;
  const int ntn = N >> 6, tk = lt / ntn, tn = lt % ntn;
  float* tile = (float*)smem;
#pragma unroll
  for (int i = 0; i < 4; ++i) {
    const int r = (tid >> 4) + 16 * i, c4 = tid & 15;
    const float4 v = *(const float4*)(src + (size_t)(tk * 64 + r) * N + tn * 64 + c4 * 4);
    float* t = tile + r * 65 + c4 * 4;
    t[0] = v.x; t[1] = v.y; t[2] = v.z; t[3] = v.w;
  }
  __syncthreads();
  const int n = tid >> 2, kc = (tid & 3) * 16;
  unsigned w[8];
#pragma unroll
  for (int i = 0; i < 8; ++i) w[i] = pk_bf16(tile[(kc + 2 * i) * 65 + n], tile[(kc + 2 * i + 1) * 65 + n]);
  uint4* d = (uint4*)(dst + (size_t)(tn * 64 + n) * K + tk * 64 + kc);
  d[0] = make_uint4(w[0], w[1], w[2], w[3]);
  d[1] = make_uint4(w[4], w[5], w[6], w[7]);
}

__device__ __forceinline__ void cache_item(const Params& p, int ci) {
  const int tid = threadIdx.x;
  const int base = (ci & 31) * 8192;
  for (int e = tid; e < 8192; e += NT) {
    const int idx = base + e;
    const int d = idx & 63, kvh = (idx >> 6) & 1, pp = (idx >> 7) & 255, b = idx >> 15;
    if (ci < 32) p.Ks[((size_t)(b * 2 + kvh) * 1280 + 1024 + pp) * 64 + d] = f2bf(p.cache_k[idx]);
    else p.Vts[((size_t)(b * 2 + kvh) * 64 + d) * 1280 + 1024 + pp] = f2bf(p.cache_v[idx]);
  }
}

__device__ __forceinline__ void phase0(const Params& p, char* smem) {
  const int n_ada = 192, n_tr = p.ntiles, n_cc = 64;
  const int total = n_ada + n_tr + n_cc;
  for (int it = blockIdx.x; it < total; it += gridDim.x) {
    if (it < n_ada) ada_item(p, it, smem);
    else if (it < n_ada + n_tr) transpose_item(p, it - n_ada, smem);
    else cache_item(p, it - n_ada - n_tr);
    __syncthreads();
  }
}

__device__ __forceinline__ void prenorm_phase(const Params& p, int layer, int which, bool from_input) {
  const int wave = threadIdx.x >> 6, lane = threadIdx.x & 63;
  const float* nw = (which ? p.norm2_w : p.norm1_w) + layer * 1024;
  for (int row = blockIdx.x * 4 + wave; row < NTOK; row += gridDim.x * 4) {
    const float* xr = from_input ? (row < NP ? p.x_prompt + (size_t)row * 1024 : p.x_sample + (size_t)(row - NP) * 1024)
                                 : p.X + (size_t)row * 1024;
    float4 v[4]; float ss = 0.f;
#pragma unroll
    for (int i = 0; i < 4; ++i) { v[i] = *(const float4*)(xr + i * 256 + lane * 4); ss += v[i].x * v[i].x + v[i].y * v[i].y + v[i].z * v[i].z + v[i].w * v[i].w; }
    ss = wave_sum(ss);
    const float rstd = rsqrtf(ss * (1.f / 1024.f) + 1e-6f);
    const float* md = p.MOD + (size_t)(layer * 9 + mod_index(row)) * 6144;
    const float* sh = md + (which ? 3 : 0) * 1024; const float* sc = md + (which ? 4 : 1) * 1024;
#pragma unroll
    for (int i = 0; i < 4; ++i) {
      const int c = i * 256 + lane * 4;
      const float4 w4 = *(const float4*)(nw + c), s4 = *(const float4*)(sh + c), c4 = *(const float4*)(sc + c);
      const float h0 = v[i].x * rstd * w4.x * (1.f + c4.x) + s4.x, h1 = v[i].y * rstd * w4.y * (1.f + c4.y) + s4.y;
      const float h2 = v[i].z * rstd * w4.z * (1.f + c4.z) + s4.z, h3 = v[i].w * rstd * w4.w * (1.f + c4.w) + s4.w;
      *(uint2*)(p.H + (size_t)row * 1024 + c) = make_uint2(pk_bf16(h0, h1), pk_bf16(h2, h3));
    }
  }
}

struct ALoadPlain {
  const bf16_t* A; int lda;
  __device__ __forceinline__ uint4 operator()(int row, int k) const { return *(const uint4*)(A + (size_t)row * lda + k); }
};
struct ALoadShift {
  const bf16_t* H; const float* mix;
  __device__ __forceinline__ uint4 operator()(int row, int k) const {
    const uint4 h = *(const uint4*)(H + (size_t)row * 1024 + k);
    int tl, T;
    if (row < NP) { tl = row & 255; T = 256; } else { tl = (row - NP) & 1023; T = 1024; }
    uint4 s = make_uint4(0, 0, 0, 0);
    if (k < 512) { if (tl > 0) s = *(const uint4*)(H + (size_t)(row - 1) * 1024 + k); }
    else { if (tl < T - 1) s = *(const uint4*)(H + (size_t)(row + 1) * 1024 + k); }
    const float4 m0 = *(const float4*)(mix + k), m1 = *(const float4*)(mix + k + 4);
    uint4 o;
    { float a = bflo(h.x), b = bfhi(h.x); o.x = pk_bf16(a + (bflo(s.x) - a) * m0.x, b + (bfhi(s.x) - b) * m0.y); }
    { float a = bflo(h.y), b = bfhi(h.y); o.y = pk_bf16(a + (bflo(s.y) - a) * m0.z, b + (bfhi(s.y) - b) * m0.w); }
    { float a = bflo(h.z), b = bfhi(h.z); o.z = pk_bf16(a + (bflo(s.z) - a) * m1.x, b + (bfhi(s.z) - b) * m1.y); }
    { float a = bflo(h.w), b = bfhi(h.w); o.w = pk_bf16(a + (bflo(s.w) - a) * m1.z, b + (bfhi(s.w) - b) * m1.w); }
    return o;
  }
};

template <class AL, class EP>
__device__ __forceinline__ void gemm_tile(const AL& al, const bf16_t* __restrict__ Bt, int K, int tm, int tn, const EP& ep, char* smem) {
  const int tid = threadIdx.x, lane = tid & 63, wid = tid >> 6, wm = wid >> 1, wn = wid & 1;
  const int fr = lane & 15, fq = lane >> 4;
  char* sA = smem; char* sB = smem + 32768;
  f32x4 acc[4][4];
#pragma unroll
  for (int a = 0; a < 4; ++a)
#pragma unroll
    for (int b = 0; b < 4; ++b) acc[a][b] = (f32x4){0.f, 0.f, 0.f, 0.f};
  uint4 pa[4], pb[4];
  const int nk = K >> 6;
  const int cr0 = tid >> 3, cc = tid & 7;
  const int soff = cr0 * 128 + ((cc ^ ((cr0 >> 1) & 7)) << 4);
  const bf16_t* bp = Bt + (size_t)(tn * 128 + cr0) * K + cc * 8;
#define GLOAD(kt) do { _Pragma("unroll") for (int i = 0; i < 4; ++i) { pa[i] = al(tm * 128 + cr0 + 32 * i, (kt) * 64 + cc * 8); pb[i] = *(const uint4*)(bp + (size_t)(32 * i) * K + (kt) * 64); } } while (0)
#define SSTORE(buf) do { _Pragma("unroll") for (int i = 0; i < 4; ++i) { *(uint4*)(sA + (buf) * 16384 + soff + i * 4096) = pa[i]; *(uint4*)(sB + (buf) * 16384 + soff + i * 4096) = pb[i]; } } while (0)
  GLOAD(0); SSTORE(0); __syncthreads();
  for (int kt = 0; kt < nk; ++kt) {
    const int buf = kt & 1;
    if (kt + 1 < nk) GLOAD(kt + 1);
#pragma unroll
    for (int kk = 0; kk < 2; ++kk) {
      bf16x8 af[4], bfr[4];
#pragma unroll
      for (int mi = 0; mi < 4; ++mi) { const int r = wm * 64 + mi * 16 + fr, c = kk * 4 + fq; af[mi] = *(const bf16x8*)(sA + buf * 16384 + r * 128 + ((c ^ ((r >> 1) & 7)) << 4)); }
#pragma unroll
      for (int ni = 0; ni < 4; ++ni) { const int r = wn * 64 + ni * 16 + fr, c = kk * 4 + fq; bfr[ni] = *(const bf16x8*)(sB + buf * 16384 + r * 128 + ((c ^ ((r >> 1) & 7)) << 4)); }
#pragma unroll
      for (int mi = 0; mi < 4; ++mi)
#pragma unroll
        for (int ni = 0; ni < 4; ++ni) acc[mi][ni] = __builtin_amdgcn_mfma_f32_16x16x32_bf16(bfr[ni], af[mi], acc[mi][ni], 0, 0, 0);
    }
    if (kt + 1 < nk) SSTORE(buf ^ 1);
    __syncthreads();
  }
#undef GLOAD
#undef SSTORE
  ep(acc, tm * 128 + wm * 64, tn * 128 + wn * 64, lane);
}

#define LAS3 __attribute__((address_space(3)))
template <int OFF>
__device__ __forceinline__ bf16x8 lds_rd128(unsigned addr) { bf16x8 v; asm volatile("ds_read_b128 %0, %1 offset:%2" : "=v"(v) : "v"(addr), "n"(OFF) : "memory"); return v; }
template <class EP>
__device__ __forceinline__ void gemm_tile_glds(const bf16_t* __restrict__ A, int lda, const bf16_t* __restrict__ Bt, int K, int tm, int tn, const EP& ep, char* smem) {
  const int tid = threadIdx.x, lane = tid & 63, wid = __builtin_amdgcn_readfirstlane(tid >> 6), wm = wid >> 1, wn = wid & 1;
  const int fr = lane & 15, fq = lane >> 4;
  f32x4 acc[4][4];
#pragma unroll
  for (int a = 0; a < 4; ++a)
#pragma unroll
    for (int b = 0; b < 4; ++b) acc[a][b] = (f32x4){0.f, 0.f, 0.f, 0.f};
  const int nk = K >> 6;
  const int lr = lane >> 3, c0 = (lane & 7) ^ (lr >> 1);
  const bf16_t* pa = A + (size_t)(tm * 128 + wid * 32 + lr) * lda;
  const bf16_t* pb = Bt + (size_t)(tn * 128 + wid * 32 + lr) * K;
  const unsigned lbase = (unsigned)(uintptr_t)(LAS3 char*)smem;
  const unsigned fsw = (unsigned)((fq ^ ((fr >> 1) & 7)) << 4);
  const unsigned aA0 = lbase + (unsigned)((wm * 64 + fr) * 128) + fsw, aA1 = lbase + (unsigned)((wm * 64 + fr) * 128) + (fsw ^ 64u);
  const unsigned aB0 = lbase + 32768u + (unsigned)((wn * 64 + fr) * 128) + fsw, aB1 = lbase + 32768u + (unsigned)((wn * 64 + fr) * 128) + (fsw ^ 64u);
#define GLDS(kt, buf) do { _Pragma("unroll") for (int i = 0; i < 4; ++i) { const int cc_ = (c0 ^ ((i & 1) << 2)) * 8 + (kt) * 64; \
    __builtin_amdgcn_global_load_lds((const unsigned*)(pa + (size_t)(i * 8) * lda + cc_), (LAS3 unsigned*)(smem + (buf) * 16384 + (wid * 4 + i) * 1024), 16, 0, 0); \
    __builtin_amdgcn_global_load_lds((const unsigned*)(pb + (size_t)(i * 8) * K + cc_), (LAS3 unsigned*)(smem + 32768 + (buf) * 16384 + (wid * 4 + i) * 1024), 16, 0, 0); } } while (0)
  GLDS(0, 0);
  asm volatile("s_waitcnt vmcnt(0)" ::: "memory");
  __builtin_amdgcn_s_barrier();
  for (int kt = 0; kt < nk; ++kt) {
    const int buf = kt & 1;
    if (kt + 1 < nk) GLDS(kt + 1, buf ^ 1);
    const unsigned bo = (unsigned)buf * 16384u;
    bf16x8 a0[4], b0[4], a1[4], b1[4];
    a0[0] = lds_rd128<0>(aA0 + bo); a0[1] = lds_rd128<2048>(aA0 + bo); a0[2] = lds_rd128<4096>(aA0 + bo); a0[3] = lds_rd128<6144>(aA0 + bo);
    b0[0] = lds_rd128<0>(aB0 + bo); b0[1] = lds_rd128<2048>(aB0 + bo); b0[2] = lds_rd128<4096>(aB0 + bo); b0[3] = lds_rd128<6144>(aB0 + bo);
    a1[0] = lds_rd128<0>(aA1 + bo); a1[1] = lds_rd128<2048>(aA1 + bo); a1[2] = lds_rd128<4096>(aA1 + bo); a1[3] = lds_rd128<6144>(aA1 + bo);
    b1[0] = lds_rd128<0>(aB1 + bo); b1[1] = lds_rd128<2048>(aB1 + bo); b1[2] = lds_rd128<4096>(aB1 + bo); b1[3] = lds_rd128<6144>(aB1 + bo);
    __builtin_amdgcn_sched_barrier(0);
    asm volatile("s_waitcnt lgkmcnt(8)" : "+v"(a0[0]), "+v"(a0[1]), "+v"(a0[2]), "+v"(a0[3]), "+v"(b0[0]), "+v"(b0[1]), "+v"(b0[2]), "+v"(b0[3]) :: "memory");
    __builtin_amdgcn_s_setprio(1);
#pragma unroll
    for (int mi = 0; mi < 4; ++mi)
#pragma unroll
      for (int ni = 0; ni < 4; ++ni) acc[mi][ni] = __builtin_amdgcn_mfma_f32_16x16x32_bf16(b0[ni], a0[mi], acc[mi][ni], 0, 0, 0);
    __builtin_amdgcn_sched_barrier(0);
    asm volatile("s_waitcnt lgkmcnt(0)" : "+v"(a1[0]), "+v"(a1[1]), "+v"(a1[2]), "+v"(a1[3]), "+v"(b1[0]), "+v"(b1[1]), "+v"(b1[2]), "+v"(b1[3]) :: "memory");
#pragma unroll
    for (int mi = 0; mi < 4; ++mi)
#pragma unroll
      for (int ni = 0; ni < 4; ++ni) acc[mi][ni] = __builtin_amdgcn_mfma_f32_16x16x32_bf16(b1[ni], a1[mi], acc[mi][ni], 0, 0, 0);
    __builtin_amdgcn_s_setprio(0);
    __builtin_amdgcn_sched_barrier(0);
    asm volatile("s_waitcnt vmcnt(0)" ::: "memory");
    __builtin_amdgcn_s_barrier();
    __builtin_amdgcn_sched_barrier(0);
  }
#undef GLDS
  ep(acc, tm * 128 + wm * 64, tn * 128 + wn * 64, lane);
}

struct EpiWin {
  const Params* pp;
  __device__ __forceinline__ void operator()(f32x4 (&acc)[4][4], int row0, int col0, int lane) const {
    const Params& p = *pp;
    const int fr = lane & 15, fq = lane >> 4;
    const bool sample = row0 >= NP;
    if (col0 < 640) {
      const bool isq = col0 < 512;
      const float* nw = isq ? p.q_norm : p.k_norm;
      float nwv[4][4];
#pragma unroll
      for (int ni = 0; ni < 4; ++ni)
#pragma unroll
        for (int j = 0; j < 4; ++j) nwv[ni][j] = nw[ni * 16 + fq * 4 + j];
#pragma unroll
      for (int mi = 0; mi < 4; ++mi) {
        const int row = row0 + mi * 16 + fr;
        float ss = 0.f;
#pragma unroll
        for (int ni = 0; ni < 4; ++ni)
#pragma unroll
          for (int j = 0; j < 4; ++j) ss += acc[mi][ni][j] * acc[mi][ni][j];
        ss += __shfl_xor(ss, 16); ss += __shfl_xor(ss, 32);
        const float rn = rsqrtf(ss * (1.f / 64.f) + 1e-6f);
        float y[4][4];
#pragma unroll
        for (int ni = 0; ni < 4; ++ni)
#pragma unroll
          for (int j = 0; j < 4; ++j) y[ni][j] = acc[mi][ni][j] * rn * nwv[ni][j];
        if (!sample && !isq) {
          const int kvh = (col0 - 512) >> 6;
#pragma unroll
          for (int ni = 0; ni < 4; ++ni) *(f32x4*)(p.out_k + (size_t)row * 128 + kvh * 64 + ni * 16 + fq * 4) = (f32x4){y[ni][0], y[ni][1], y[ni][2], y[ni][3]};
        }
        if (sample) {
          const int tl = (row - NP) & 1023;
          const float rp = (float)(tl >> 6), cp = (float)(tl & 63);
#pragma unroll
          for (int ni = 0; ni < 4; ++ni)
#pragma unroll
            for (int jp = 0; jp < 2; ++jp) {
              const int i = (ni * 16 + fq * 4 + jp * 2) >> 1;
              const float pos = i < 16 ? rp : cp;
              const float inv = exp2f(-(float)(i & 15) * 0.83048202372184058696f);
              const float ang = pos * inv;
              const float s = __sinf(ang), c = __cosf(ang);
              const float x0 = y[ni][2 * jp], x1 = y[ni][2 * jp + 1];
              y[ni][2 * jp] = x0 * c - x1 * s; y[ni][2 * jp + 1] = x0 * s + x1 * c;
            }
        }
        if (isq) {
          const float qs = 0.125f * 1.44269504088896f;
#pragma unroll
          for (int ni = 0; ni < 4; ++ni)
            *(uint2*)(p.Qbuf + (size_t)row * 512 + col0 + ni * 16 + fq * 4) = make_uint2(pk_bf16(y[ni][0] * qs, y[ni][1] * qs), pk_bf16(y[ni][2] * qs, y[ni][3] * qs));
        } else {
          const int kvh = (col0 - 512) >> 6;
          bf16_t* kd;
          if (!sample) kd = p.Kp + ((size_t)((row >> 8) * 2 + kvh) * 256 + (row & 255)) * 64;
          else kd = p.Ks + ((size_t)(((row - NP) >> 10) * 2 + kvh) * 1280 + ((row - NP) & 1023)) * 64;
#pragma unroll
          for (int ni = 0; ni < 4; ++ni)
            *(uint2*)(kd + ni * 16 + fq * 4) = make_uint2(pk_bf16(y[ni][0], y[ni][1]), pk_bf16(y[ni][2], y[ni][3]));
        }
      }
    } else if (col0 < 768) {
      const int kvh = (col0 - 640) >> 6;
#pragma unroll
      for (int mi = 0; mi < 4; ++mi) {
        const int row = row0 + mi * 16 + fr;
#pragma unroll
        for (int ni = 0; ni < 4; ++ni) {
          const int d0 = ni * 16 + fq * 4;
          if (!sample) {
            *(f32x4*)(p.out_v + (size_t)row * 128 + kvh * 64 + d0) = acc[mi][ni];
            bf16_t* vd = p.Vtp + ((size_t)((row >> 8) * 2 + kvh) * 64 + d0) * 256 + (row & 255);
#pragma unroll
            for (int j = 0; j < 4; ++j) vd[j * 256] = f2bf(acc[mi][ni][j]);
          } else {
            bf16_t* vd = p.Vts + ((size_t)(((row - NP) >> 10) * 2 + kvh) * 64 + d0) * 1280 + ((row - NP) & 1023);
#pragma unroll
            for (int j = 0; j < 4; ++j) vd[j * 1280] = f2bf(acc[mi][ni][j]);
          }
        }
      }
    } else {
      const int c0 = col0 - 768, seg = c0 >> 9;
      float oml[4][4];
      if (seg == 1 || seg == 2) {
#pragma unroll
        for (int ni = 0; ni < 4; ++ni)
#pragma unroll
          for (int j = 0; j < 4; ++j) { const int c = (c0 & 511) + ni * 16 + fq * 4 + j; oml[ni][j] = __builtin_amdgcn_rcpf(1.f + __expf(p.hgrn_lb[c] - p.hgrn_lb[512 + c])); }
      }
#pragma unroll
      for (int mi = 0; mi < 4; ++mi) {
        const int row = row0 + mi * 16 + fr;
#pragma unroll
        for (int ni = 0; ni < 4; ++ni) {
          float o[4];
#pragma unroll
          for (int j = 0; j < 4; ++j) {
            const float v = acc[mi][ni][j];
            if (seg == 0 || seg == 4) o[j] = siluf_(v);
            else if (seg == 3) o[j] = v;
            else o[j] = oml[ni][j] * sigmoidf_(-v);
          }
          *(uint2*)(p.HG + (size_t)row * 2560 + c0 + ni * 16 + fq * 4) = make_uint2(pk_bf16(o[0], o[1]), pk_bf16(o[2], o[3]));
        }
      }
    }
  }
};

struct EpiResid {
  const Params* pp; int layer, gidx; bool from_input; bool dry = false;
  __device__ __forceinline__ void operator()(f32x4 (&acc)[4][4], int row0, int col0, int lane) const {
    const Params& p = *pp;
    if (dry && p.njobs >= 0) return;
    const int fr = lane & 15, fq = lane >> 4;
    const float* gt = p.MOD + (size_t)(layer * 9 + mod_index(row0)) * 6144 + gidx * 1024;
#pragma unroll
    for (int mi = 0; mi < 4; ++mi) {
      const int row = row0 + mi * 16 + fr;
      const float* base = from_input ? (row < NP ? p.x_prompt + (size_t)row * 1024 : p.x_sample + (size_t)(row - NP) * 1024) : p.X + (size_t)row * 1024;
#pragma unroll
      for (int ni = 0; ni < 4; ++ni) {
        const int col = col0 + ni * 16 + fq * 4;
        const f32x4 b = *(const f32x4*)(base + col), g = *(const f32x4*)(gt + col);
        *(f32x4*)(p.X + (size_t)row * 1024 + col) = b + g * acc[mi][ni];
      }
    }
  }
};

template <int ACT>
struct EpiAct {
  bf16_t* O; int ldo; const float* bias;
  __device__ __forceinline__ void operator()(f32x4 (&acc)[4][4], int row0, int col0, int lane) const {
    const int fr = lane & 15, fq = lane >> 4;
#pragma unroll
    for (int ni = 0; ni < 4; ++ni) {
      const int col = col0 + ni * 16 + fq * 4;
      f32x4 bv = (f32x4){0.f, 0.f, 0.f, 0.f};
      if (ACT >= 4) bv = *(const f32x4*)(bias + col);
#pragma unroll
      for (int mi = 0; mi < 4; ++mi) {
        const int row = row0 + mi * 16 + fr;
        float o[4];
#pragma unroll
        for (int j = 0; j < 4; ++j) {
          const float v = acc[mi][ni][j] + bv[j];
          if (ACT == 0) o[j] = v;
          else if (ACT == 1) { const float r = fmaxf(v, 0.f); o[j] = r * r; }
          else if (ACT == 2) o[j] = 1.f - 2.f * __builtin_amdgcn_rcpf(1.f + __expf(2.f * v));
          else if (ACT == 3 || ACT == 5) o[j] = sigmoidf_(v);
          else o[j] = 0.60653065971263342f * sigmoidf_(v);
        }
        *(uint2*)(O + (size_t)row * ldo + col) = make_uint2(pk_bf16(o[0], o[1]), pk_bf16(o[2], o[3]));
      }
    }
  }
};

struct EpiRwkvOut {
  const Params* pp;
  __device__ __forceinline__ void operator()(f32x4 (&acc)[4][4], int row0, int col0, int lane) const {
    const Params& p = *pp;
    const int fr = lane & 15, fq = lane >> 4, h = col0 >> 6;
#pragma unroll
    for (int mi = 0; mi < 4; ++mi) {
      const int row = row0 + mi * 16 + fr;
      float y[4][4]; float s = 0.f;
#pragma unroll
      for (int ni = 0; ni < 4; ++ni) {
        const size_t idx = (size_t)row * 1024 + col0 + ni * 16 + fq * 4;
        const uint2 a = *(const uint2*)(p.E0 + idx), b = *(const uint2*)(p.E1 + idx);
        y[ni][0] = bflo(a.x) + bflo(b.x); y[ni][1] = bfhi(a.x) + bfhi(b.x); y[ni][2] = bflo(a.y) + bflo(b.y); y[ni][3] = bfhi(a.y) + bfhi(b.y);
        s += (y[ni][0] + y[ni][1]) + (y[ni][2] + y[ni][3]);
      }
      s += __shfl_xor(s, 16); s += __shfl_xor(s, 32);
      const float mu = s * (1.f / 64.f);
      float q = 0.f;
#pragma unroll
      for (int ni = 0; ni < 4; ++ni)
#pragma unroll
        for (int j = 0; j < 4; ++j) { const float d = y[ni][j] - mu; q += d * d; }
      q += __shfl_xor(q, 16); q += __shfl_xor(q, 32);
      const float rs = rsqrtf(q * (1.f / 64.f) + 64e-5f);
      const float bs = p.BS[(size_t)row * 16 + h] + p.BS[(size_t)NTOK * 16 + (size_t)row * 16 + h];
#pragma unroll
      for (int ni = 0; ni < 4; ++ni) {
        const int col = col0 + ni * 16 + fq * 4;
        const size_t idx = (size_t)row * 1024 + col;
        const uint2 vv = *(const uint2*)(p.Vx + idx);
        const f32x4 lw = *(const f32x4*)(p.ln_w + col), lb = *(const f32x4*)(p.ln_b + col);
        const float v0 = bflo(vv.x), v1 = bfhi(vv.x), v2 = bflo(vv.y), v3 = bfhi(vv.y);
        const float o0 = ((y[ni][0] - mu) * rs * lw[0] + lb[0] + bs * v0) * acc[mi][ni][0];
        const float o1 = ((y[ni][1] - mu) * rs * lw[1] + lb[1] + bs * v1) * acc[mi][ni][1];
        const float o2 = ((y[ni][2] - mu) * rs * lw[2] + lb[2] + bs * v2) * acc[mi][ni][2];
        const float o3 = ((y[ni][3] - mu) * rs * lw[3] + lb[3] + bs * v3) * acc[mi][ni][3];
        *(uint2*)(p.ZO + idx) = make_uint2(pk_bf16(o0, o1), pk_bf16(o2, o3));
      }
    }
  }
};

template <class EP>
__device__ __forceinline__ void gemm_phase(const ALoadPlain& al, const bf16_t* Bt, int K, int ntn, const EP& ep, char* smem) {
  const int nunits = (NTOK / 128) * ntn;
  for (int u = blockIdx.x; u < nunits; u += gridDim.x) gemm_tile_glds(al.A, al.lda, Bt, K, u / ntn, u % ntn, ep, smem);
}

__device__ __forceinline__ void attn_item(const Params& p, int grp, int b, int h, int qb, char* smem) {
  const int tid = threadIdx.x, lane = tid & 63, wid = tid >> 6, qi = lane & 31, g = lane >> 5;
  const int Tk = grp ? 1280 : 256, kvh = h >> 2;
  const int rowbase = grp ? NP + b * 1024 + qb * 128 : b * 256 + qb * 128;
  const bf16_t* Kg = grp ? p.Ks + (size_t)(b * 2 + kvh) * 1280 * 64 : p.Kp + (size_t)(b * 2 + kvh) * 256 * 64;
  const bf16_t* Vg = grp ? p.Vts + (size_t)(b * 2 + kvh) * 64 * 1280 : p.Vtp + (size_t)(b * 2 + kvh) * 64 * 256;
  const int qrow = rowbase + wid * 32 + qi;
  bf16x8 Qf[4];
#pragma unroll
  for (int s = 0; s < 4; ++s) Qf[s] = *(const bf16x8*)(p.Qbuf + (size_t)qrow * 512 + h * 64 + s * 16 + g * 8);
  f32x16 O[2];
#pragma unroll
  for (int i = 0; i < 16; ++i) { O[0][i] = 0.f; O[1][i] = 0.f; }
  float m_run = -1e30f, l_run = 0.f;
  char* sK = smem; char* sV = smem + 16384;
  const int r0 = tid >> 3, c = tid & 7;
  uint4 pk[2], pv[2];
  const int ntile = Tk >> 6;
#define ALOAD(kt) do { _Pragma("unroll") for (int i = 0; i < 2; ++i) { const int r = r0 + 32 * i; pk[i] = *(const uint4*)(Kg + (size_t)((kt) * 64 + r) * 64 + c * 8); pv[i] = *(const uint4*)(Vg + (size_t)r * Tk + (kt) * 64 + c * 8); } } while (0)
#define ASTORE(buf) do { _Pragma("unroll") for (int i = 0; i < 2; ++i) { const int r = r0 + 32 * i; \
      *(uint4*)(sK + (buf) * 8192 + r * 128 + ((c ^ ((r >> 1) & 7)) << 4)) = pk[i]; \
      const int f = (r >> 1) & 15; \
      *(uint2*)(sV + (buf) * 8192 + r * 128 + (((2 * c) ^ f) << 3)) = make_uint2(pv[i].x, pv[i].y); \
      *(uint2*)(sV + (buf) * 8192 + r * 128 + (((2 * c + 1) ^ f) << 3)) = make_uint2(pv[i].z, pv[i].w); } } while (0)
  ALOAD(0); ASTORE(0); __syncthreads();
  for (int kt = 0; kt < ntile; ++kt) {
    const int buf = kt & 1;
    if (kt + 1 < ntile) ALOAD(kt + 1);
    f32x16 S[2];
#pragma unroll
    for (int t2 = 0; t2 < 2; ++t2) {
#pragma unroll
      for (int i = 0; i < 16; ++i) S[t2][i] = 0.f;
#pragma unroll
      for (int s = 0; s < 4; ++s) {
        const int r = t2 * 32 + qi, cc = 2 * s + g;
        const bf16x8 Kf = *(const bf16x8*)(sK + buf * 8192 + r * 128 + ((cc ^ ((r >> 1) & 7)) << 4));
        S[t2] = __builtin_amdgcn_mfma_f32_32x32x16_bf16(Kf, Qf[s], S[t2], 0, 0, 0);
      }
    }
    float mx = S[0][0];
#pragma unroll
    for (int i = 0; i < 16; ++i) { mx = fmaxf(mx, S[0][i]); mx = fmaxf(mx, S[1][i]); }
    mx = fmaxf(mx, __shfl_xor(mx, 32));
    const float m_new = fmaxf(m_run, mx);
    const float alpha = __builtin_amdgcn_exp2f(m_run - m_new);
    float ls = 0.f;
#pragma unroll
    for (int i = 0; i < 16; ++i) { S[0][i] = __builtin_amdgcn_exp2f(S[0][i] - m_new); S[1][i] = __builtin_amdgcn_exp2f(S[1][i] - m_new); ls += S[0][i] + S[1][i]; }
    l_run = l_run * alpha + ls; m_run = m_new;
#pragma unroll
    for (int i = 0; i < 16; ++i) { O[0][i] *= alpha; O[1][i] *= alpha; }
#pragma unroll
    for (int t2 = 0; t2 < 2; ++t2)
#pragma unroll
      for (int sp = 0; sp < 2; ++sp) {
        union { bf16x8 v; unsigned u[4]; } Pf;
#pragma unroll
        for (int e = 0; e < 4; ++e) Pf.u[e] = pk_bf16(S[t2][8 * sp + 2 * e], S[t2][8 * sp + 2 * e + 1]);
#pragma unroll
        for (int ds = 0; ds < 2; ++ds) {
          const int d = ds * 32 + qi, f = (d >> 1) & 15, u1 = 8 * t2 + 4 * sp + g;
          union { bf16x8 v; uint2 u[2]; } Vf;
          Vf.u[0] = *(const uint2*)(sV + buf * 8192 + d * 128 + ((u1 ^ f) << 3));
          Vf.u[1] = *(const uint2*)(sV + buf * 8192 + d * 128 + (((u1 + 2) ^ f) << 3));
          O[ds] = __builtin_amdgcn_mfma_f32_32x32x16_bf16(Vf.v, Pf.v, O[ds], 0, 0, 0);
        }
      }
    if (kt + 1 < ntile) ASTORE(buf ^ 1);
    __syncthreads();
  }
#undef ALOAD
#undef ASTORE
  const float l = l_run + __shfl_xor(l_run, 32);
  const float inv = 1.f / l;
#pragma unroll
  for (int ds = 0; ds < 2; ++ds)
#pragma unroll
    for (int bq = 0; bq < 4; ++bq) {
      const int d0 = ds * 32 + 8 * bq + 4 * g;
      *(uint2*)(p.AO + (size_t)qrow * 1024 + h * 64 + d0) =
          make_uint2(pk_bf16(O[ds][4 * bq] * inv, O[ds][4 * bq + 1] * inv), pk_bf16(O[ds][4 * bq + 2] * inv, O[ds][4 * bq + 3] * inv));
    }
}

__device__ __forceinline__ void hgrn_item(const Params& p, int grp, int b, int h, int dir, int half, char* smem) {
  const int tid = threadIdx.x, v = half * 32 + (tid >> 3), ks = tid & 7;
  const int T = grp ? 1024 : 256, rowbase = grp ? NP + b * 1024 : b * 256;
  if (grp) __builtin_amdgcn_s_setprio(3);
  f32x2 S2[4];
  if (grp) {
    const float* s0 = (dir ? p.hg_b0 : p.hg_f0) + (size_t)(b * 8 + h) * 4096;
#pragma unroll
    for (int i = 0; i < 4; ++i) S2[i] = (f32x2){s0[(ks * 8 + 2 * i) * 64 + v], s0[(ks * 8 + 2 * i + 1) * 64 + v]};
  } else {
#pragma unroll
    for (int i = 0; i < 4; ++i) S2[i] = (f32x2){0.f, 0.f};
  }
  float* obuf = (float*)(smem + 32768);
  const int lt = tid >> 4, lc = (tid & 15) * 4;
  const int kfseg = dir ? 1024 : 512;
  uint2 rq, rk, rv, rq2, rk2, rv2;
  const int nch = T >> 4;
#define HLOADX(cix, q_, k_, v_) do { const int ts = (cix) * 16 + lt; const int tok = dir ? T - 1 - ts : ts; const bf16_t* src = p.HG + (size_t)(rowbase + tok) * 2560 + h * 64 + lc; \
    q_ = *(const uint2*)(src); k_ = *(const uint2*)(src + kfseg); v_ = *(const uint2*)(src + 1536); } while (0)
#define HSTORE(buf) do { float* B = (float*)(smem + (buf) * 16384) + lt * 64 + lc; \
    const float k0 = bflo(rk.x), k1 = bfhi(rk.x), k2 = bflo(rk.y), k3 = bfhi(rk.y); \
    *(float4*)(B) = make_float4(1.f - k0, 1.f - k1, 1.f - k2, 1.f - k3); *(float4*)(B + 1024) = make_float4(k0, k1, k2, k3); \
    *(float4*)(B + 2048) = make_float4(bflo(rq.x), bfhi(rq.x), bflo(rq.y), bfhi(rq.y)); *(float4*)(B + 3072) = make_float4(bflo(rv.x), bfhi(rv.x), bflo(rv.y), bfhi(rv.y)); } while (0)
  HLOADX(0, rq, rk, rv); HSTORE(0);
  HLOADX(1, rq, rk, rv);
  __syncthreads();
  float* OD = dir ? p.OB : p.OF;
  for (int cix = 0; cix < nch; ++cix) {
    const int buf = cix & 1;
    if (cix + 2 < nch) HLOADX(cix + 2, rq2, rk2, rv2);
    const float* B = (const float*)(smem + buf * 16384);
    float* ob = obuf + buf * 512;
    float4 cf[2], ck[2], cq[2]; float cv;
#define HSTEP_LOAD(t_, f_, k_, q_, v_) do { const float* Bt = B + (t_) * 64 + ks * 8; \
      f_[0] = *(const float4*)(Bt); f_[1] = *(const float4*)(Bt + 4); k_[0] = *(const float4*)(Bt + 1024); k_[1] = *(const float4*)(Bt + 1028); \
      q_[0] = *(const float4*)(Bt + 2048); q_[1] = *(const float4*)(Bt + 2052); v_ = B[3072 + (t_) * 64 + v]; } while (0)
    HSTEP_LOAD(0, cf, ck, cq, cv);
#pragma unroll 1
    for (int g = 0; g < 4; ++g) {
      float op[4];
#pragma unroll
      for (int tt = 0; tt < 4; ++tt) {
        const int t = g * 4 + tt;
        float4 nf[2], nk[2], nq[2]; float nv;
        { const int tn_ = (t + 1) & 15; HSTEP_LOAD(tn_, nf, nk, nq, nv); }
        const f32x2 vvv = (f32x2){cv, cv};
        f32x2 o0, o1;
        S2[0] = S2[0] * (f32x2){cf[0].x, cf[0].y} + vvv * (f32x2){ck[0].x, ck[0].y};
        S2[1] = S2[1] * (f32x2){cf[0].z, cf[0].w} + vvv * (f32x2){ck[0].z, ck[0].w};
        S2[2] = S2[2] * (f32x2){cf[1].x, cf[1].y} + vvv * (f32x2){ck[1].x, ck[1].y};
        S2[3] = S2[3] * (f32x2){cf[1].z, cf[1].w} + vvv * (f32x2){ck[1].z, ck[1].w};
        o0 = S2[0] * (f32x2){cq[0].x, cq[0].y}; o1 = S2[1] * (f32x2){cq[0].z, cq[0].w};
        o0 = S2[2] * (f32x2){cq[1].x, cq[1].y} + o0; o1 = S2[3] * (f32x2){cq[1].z, cq[1].w} + o1;
        const f32x2 os = o0 + o1;
        op[tt] = os.x + os.y;
        cf[0] = nf[0]; cf[1] = nf[1]; ck[0] = nk[0]; ck[1] = nk[1]; cq[0] = nq[0]; cq[1] = nq[1]; cv = nv;
      }
#pragma unroll
      for (int tt = 0; tt < 4; ++tt) { const float o = oct_sum(op[tt]); if (ks == 0) ob[(g * 4 + tt) * 32 + (tid >> 3)] = o; }
    }
#undef HSTEP_LOAD
    if (cix + 1 < nch) HSTORE(buf ^ 1);
    rq = rq2; rk = rk2; rv = rv2;
    __syncthreads();
    if (tid < 128) {
      const int ft = tid >> 3, fc = (tid & 7) * 4;
      const int ts = cix * 16 + ft; const int tok = dir ? T - 1 - ts : ts;
      *(float4*)(OD + (size_t)(rowbase + tok) * 512 + h * 64 + half * 32 + fc) = *(const float4*)(ob + ft * 32 + fc);
    }
  }
#undef HLOADX
#undef HSTORE
  __builtin_amdgcn_s_setprio(0);
  if (!grp) {
    float* so = (dir ? p.out_hb : p.out_hf) + (size_t)(b * 8 + h) * 4096;
#pragma unroll
    for (int i = 0; i < 4; ++i) { so[(ks * 8 + 2 * i) * 64 + v] = S2[i].x; so[(ks * 8 + 2 * i + 1) * 64 + v] = S2[i].y; }
  }
}

__device__ __forceinline__ void mix0_phase(const Params& p, char* smem) {
  __shared__ int q_item;
  for (;;) {
    if (threadIdx.x == 0) q_item = (int)atomicAdd(&p.bar[0], 1u);
    __syncthreads();
    const int it = q_item;
    __syncthreads();
    if (it >= 1536) break;
    const bool is_h = it < 256 || (it >= 768 && it < 1280);
    if (is_h) {
      const int grp = it < 256 ? 1 : 0, a = grp ? it : it - 768;
      hgrn_item(p, grp, a >> 5, (a >> 2) & 7, (a >> 1) & 1, a & 1, smem);
    } else {
      const int grp = it < 768 ? 1 : 0, a = grp ? it - 256 : it - 1280;
      const int b = grp ? a >> 6 : a >> 4, h = grp ? (a >> 3) & 7 : (a >> 1) & 7, qb = grp ? a & 7 : a & 1;
      attn_item(p, grp, b, h, qb, smem);
    }
    __syncthreads();
  }
}

__device__ __forceinline__ void hgrn_combine_phase(const Params& p) {
  const int gid = blockIdx.x * NT + threadIdx.x, l16 = gid & 15;
  const int ngroups = NTOK * 8;
  for (int grp = gid >> 4; grp < ngroups; grp += (gridDim.x * NT) >> 4) {
    const int row = grp >> 3, h = grp & 7;
    const size_t o = (size_t)row * 512 + h * 64 + l16 * 4;
    const float4 a = *(const float4*)(p.OF + o), b = *(const float4*)(p.OB + o);
    const float y0 = a.x + b.x, y1 = a.y + b.y, y2 = a.z + b.z, y3 = a.w + b.w;
    float ss = y0 * y0 + y1 * y1 + y2 * y2 + y3 * y3;
    ss += __shfl_xor(ss, 1); ss += __shfl_xor(ss, 2); ss += __shfl_xor(ss, 4); ss += __shfl_xor(ss, 8);
    const float rn = rsqrtf(ss * (1.f / 64.f) + 1e-6f);
    const float4 gn = *(const float4*)(p.g_norm + l16 * 4);
    const uint2 gt = *(const uint2*)(p.HG + (size_t)row * 2560 + 2048 + h * 64 + l16 * 4);
    *(uint2*)(p.AO + (size_t)row * 1024 + 512 + h * 64 + l16 * 4) =
        make_uint2(pk_bf16(y0 * rn * gn.x * bflo(gt.x), y1 * rn * gn.y * bfhi(gt.x)), pk_bf16(y2 * rn * gn.z * bflo(gt.y), y3 * rn * gn.w * bfhi(gt.y)));
  }
}

__device__ __forceinline__ void rwkv_item(const Params& p, int grp, int b, int h, int dir, char* smem, bool dry = false) {
  const bool wr = !(dry && p.njobs >= 0);
  if (grp) __builtin_amdgcn_s_setprio(3);
  const int tid = threadIdx.x, lane = tid & 63, wid = tid >> 6, v = tid >> 2, ks = tid & 3;
  const int T = grp ? 1024 : 256, rowbase = grp ? NP + b * 1024 : b * 256;
  const int vp = tid >> 3, k8 = tid & 7;
  f32x2 Sa[4], Sb[4];
  if (grp) {
    const float* s0 = (dir ? p.rw_b0 : p.rw_f0) + ((size_t)(b * 16 + h) * 64 + vp) * 64 + k8 * 8;
#pragma unroll
    for (int q = 0; q < 2; ++q) {
      const float4 t = *(const float4*)(s0 + q * 4), u = *(const float4*)(s0 + 2048 + q * 4);
      Sa[2 * q] = (f32x2){t.x, t.y}; Sa[2 * q + 1] = (f32x2){t.z, t.w}; Sb[2 * q] = (f32x2){u.x, u.y}; Sb[2 * q + 1] = (f32x2){u.z, u.w};
    }
  } else {
#pragma unroll
    for (int i = 0; i < 4; ++i) { Sa[i] = (f32x2){0.f, 0.f}; Sb[i] = (f32x2){0.f, 0.f}; }
  }
  const bf16_t* E = dir ? p.E1 : p.E0; const bf16_t* A = dir ? p.A1 : p.A0; bf16_t* Y = dir ? p.E1 : p.E0;
  const int lt = tid >> 4, lc = (tid & 15) * 4;
  const float4 kkc = *(const float4*)(p.k_k + h * 64 + lc), kac = *(const float4*)(p.k_a + h * 64 + lc), rkc = *(const float4*)(p.r_k + h * 64 + lc);
  float* BSd = p.BS + (size_t)dir * NTOK * 16;
  float* ybuf = (float*)(smem + 49152);
  uint2 gr, gk, gv, ge, ga;
  const int nch = T >> 4;
#define RLOAD(cix) do { const int ts = (cix) * 16 + lt; const int tok = dir ? T - 1 - ts : ts; const size_t idx = (size_t)(rowbase + tok) * 1024 + h * 64 + lc; \
    gr = *(const uint2*)(p.R + idx); gk = *(const uint2*)(p.Kx + idx); gv = *(const uint2*)(p.Vx + idx); ge = *(const uint2*)(E + idx); ga = *(const uint2*)(A + idx); } while (0)
#define RSTORE(cix, buf) do { const int ts = (cix) * 16 + lt; const int tok = dir ? T - 1 - ts : ts; \
    const float r_[4] = {bflo(gr.x), bfhi(gr.x), bflo(gr.y), bfhi(gr.y)}, k_[4] = {bflo(gk.x), bfhi(gk.x), bflo(gk.y), bfhi(gk.y)}; \
    const float e_[4] = {bflo(ge.x), bfhi(ge.x), bflo(ge.y), bfhi(ge.y)}, a_[4] = {bflo(ga.x), bfhi(ga.x), bflo(ga.y), bfhi(ga.y)}; \
    const float kc_[4] = {kkc.x, kkc.y, kkc.z, kkc.w}, ac_[4] = {kac.x, kac.y, kac.z, kac.w}, rc_[4] = {rkc.x, rkc.y, rkc.z, rkc.w}; \
    float kx[4], kd[4], ssq = 0.f, bsum = 0.f; \
    _Pragma("unroll") for (int j = 0; j < 4; ++j) { kx[j] = k_[j] * kc_[j]; ssq += kx[j] * kx[j]; kd[j] = k_[j] * (1.f + (a_[j] - 1.f) * ac_[j]); bsum += r_[j] * kd[j] * rc_[j]; } \
    ssq = hex_sum(ssq); bsum = hex_sum(bsum); const float rn = rsqrtf(fmaxf(ssq, 1e-24f)); \
    float* B = (float*)(smem + (buf) * 24576) + lt * 64 + lc; \
    *(float4*)(B) = make_float4(__expf(-e_[0]), __expf(-e_[1]), __expf(-e_[2]), __expf(-e_[3])); \
    *(float4*)(B + 1024) = make_float4(kx[0] * rn, kx[1] * rn, kx[2] * rn, kx[3] * rn); \
    *(float4*)(B + 2048) = make_float4(kx[0] * rn * a_[0], kx[1] * rn * a_[1], kx[2] * rn * a_[2], kx[3] * rn * a_[3]); \
    *(float4*)(B + 3072) = make_float4(kd[0], kd[1], kd[2], kd[3]); \
    *(float4*)(B + 4096) = make_float4(r_[0], r_[1], r_[2], r_[3]); \
    *(float4*)(B + 5120) = make_float4(bflo(gv.x), bfhi(gv.x), bflo(gv.y), bfhi(gv.y)); \
    if ((tid & 15) == 0 && wr) BSd[(size_t)(rowbase + tok) * 16 + h] = bsum; } while (0)
  RLOAD(0); RSTORE(0, 0); __syncthreads();
  for (int cix = 0; cix < nch; ++cix) {
    const int buf = cix & 1;
    if (cix + 1 < nch) RLOAD(cix + 1);
    const float* B = (const float*)(smem + buf * 24576);
    float* yb = ybuf + buf * 1024;
    float4 cw[2], ck[2], ca[2], cd[2], cr[2]; float cva, cvb;
#define RSTEP_LOAD(t_, w_, k_, a_, d_, r_, va_, vb_) do { const float* Bt = B + (t_) * 64 + k8 * 8; \
      w_[0] = *(const float4*)(Bt); w_[1] = *(const float4*)(Bt + 4); k_[0] = *(const float4*)(Bt + 1024); k_[1] = *(const float4*)(Bt + 1028); \
      a_[0] = *(const float4*)(Bt + 2048); a_[1] = *(const float4*)(Bt + 2052); d_[0] = *(const float4*)(Bt + 3072); d_[1] = *(const float4*)(Bt + 3076); \
      r_[0] = *(const float4*)(Bt + 4096); r_[1] = *(const float4*)(Bt + 4100); va_ = B[5120 + (t_) * 64 + vp]; vb_ = B[5120 + (t_) * 64 + vp + 32]; } while (0)
    RSTEP_LOAD(0, cw, ck, ca, cd, cr, cva, cvb);
#pragma unroll
    for (int t = 0; t < 16; ++t) {
      float4 nw[2], nk[2], na[2], nd[2], nr[2]; float nva = 0.f, nvb = 0.f;
      if (t + 1 < 16) RSTEP_LOAD(t + 1, nw, nk, na, nd, nr, nva, nvb);
      f32x2 w2[4], kk2[4];
#pragma unroll
      for (int q = 0; q < 2; ++q) {
        w2[2 * q] = (f32x2){cw[q].x, cw[q].y}; w2[2 * q + 1] = (f32x2){cw[q].z, cw[q].w};
        kk2[2 * q] = (f32x2){ck[q].x, ck[q].y}; kk2[2 * q + 1] = (f32x2){ck[q].z, ck[q].w};
      }
      const f32x2 sa_a = (Sa[0] * kk2[0] + Sa[1] * kk2[1]) + (Sa[2] * kk2[2] + Sa[3] * kk2[3]);
      const f32x2 sa_b = (Sb[0] * kk2[0] + Sb[1] * kk2[1]) + (Sb[2] * kk2[2] + Sb[3] * kk2[3]);
      const float saa = -oct_sum(sa_a.x + sa_a.y), sab = -oct_sum(sa_b.x + sa_b.y);
      const f32x2 saav = (f32x2){saa, saa}, sabv = (f32x2){sab, sab}, vav = (f32x2){cva, cva}, vbv = (f32x2){cvb, cvb};
      f32x2 ya = (f32x2){0.f, 0.f}, yb2 = (f32x2){0.f, 0.f};
#pragma unroll
      for (int q = 0; q < 2; ++q) {
        const f32x2 ka0 = (f32x2){ca[q].x, ca[q].y}, ka1 = (f32x2){ca[q].z, ca[q].w}, kd0 = (f32x2){cd[q].x, cd[q].y}, kd1 = (f32x2){cd[q].z, cd[q].w};
        const f32x2 r0 = (f32x2){cr[q].x, cr[q].y}, r1 = (f32x2){cr[q].z, cr[q].w};
        Sa[2 * q] = Sa[2 * q] * w2[2 * q] + (vav * kd0 + saav * ka0); Sa[2 * q + 1] = Sa[2 * q + 1] * w2[2 * q + 1] + (vav * kd1 + saav * ka1);
        Sb[2 * q] = Sb[2 * q] * w2[2 * q] + (vbv * kd0 + sabv * ka0); Sb[2 * q + 1] = Sb[2 * q + 1] * w2[2 * q + 1] + (vbv * kd1 + sabv * ka1);
        ya = Sa[2 * q] * r0 + ya; ya = Sa[2 * q + 1] * r1 + ya;
        yb2 = Sb[2 * q] * r0 + yb2; yb2 = Sb[2 * q + 1] * r1 + yb2;
      }
      const float y_a = oct_sum(ya.x + ya.y), y_b = oct_sum(yb2.x + yb2.y);
      if (k8 == 0) { yb[t * 64 + vp] = y_a; yb[t * 64 + vp + 32] = y_b; }
      if (t + 1 < 16) {
#pragma unroll
        for (int q = 0; q < 2; ++q) { cw[q] = nw[q]; ck[q] = nk[q]; ca[q] = na[q]; cd[q] = nd[q]; cr[q] = nr[q]; }
        cva = nva; cvb = nvb;
      }
    }
#undef RSTEP_LOAD
    if (cix + 1 < nch) RSTORE(cix + 1, buf ^ 1);
    __syncthreads();
    {
      const int ts = cix * 16 + lt; const int tok = dir ? T - 1 - ts : ts;
      const float4 yy = *(const float4*)(yb + lt * 64 + lc);
      if (wr) *(uint2*)(Y + (size_t)(rowbase + tok) * 1024 + h * 64 + lc) = make_uint2(pk_bf16(yy.x, yy.y), pk_bf16(yy.z, yy.w));
    }
  }
#undef RLOAD
#undef RSTORE
  __builtin_amdgcn_s_setprio(0);
  if (!grp && wr) {
    float* so = (dir ? p.out_rb : p.out_rf) + ((size_t)(b * 16 + h) * 64 + vp) * 64 + k8 * 8;
#pragma unroll
    for (int q = 0; q < 2; ++q) {
      *(float4*)(so + q * 4) = make_float4(Sa[2 * q].x, Sa[2 * q].y, Sa[2 * q + 1].x, Sa[2 * q + 1].y);
      *(float4*)(so + 2048 + q * 4) = make_float4(Sb[2 * q].x, Sb[2 * q].y, Sb[2 * q + 1].x, Sb[2 * q + 1].y);
    }
  }
}

__device__ __forceinline__ void rwkv_scan_phase(const Params& p, char* smem, bool dry = false) {
  const int G = gridDim.x;
  if (G >= 512) {
    if (blockIdx.x < 256) { const int a = blockIdx.x; rwkv_item(p, 1, a >> 5, (a >> 1) & 15, a & 1, smem, dry); }
    else for (int a = blockIdx.x - 256; a < 512; a += G - 256) { rwkv_item(p, 0, a >> 5, (a >> 1) & 15, a & 1, smem, dry); __syncthreads(); }
  } else {
    for (int it = blockIdx.x; it < 768; it += G) {
      const int grp = it < 256 ? 1 : 0, a = grp ? it : it - 256;
      rwkv_item(p, grp, a >> 5, (a >> 1) & 15, a & 1, smem, dry);
      __syncthreads();
    }
  }
}

__device__ __forceinline__ void blend_phase(const Params& p) {
  const int gid = blockIdx.x * NT + threadIdx.x, nth = gridDim.x * NT;
  for (int i = gid; i < NTOK * 128; i += nth) {
    const int row = i >> 7, k = (i & 127) * 8;
    ALoadShift a0{p.H, p.mix + 0 * 1024}, a2{p.H, p.mix + 2 * 1024}, a3{p.H, p.mix + 3 * 1024};
    const size_t o = (size_t)row * 1024 + k;
    *(uint4*)(p.E0 + o) = a0(row, k); *(uint4*)(p.E1 + o) = a2(row, k); *(uint4*)(p.A1 + o) = a3(row, k);
  }
}

__device__ __forceinline__ void rwkv_proj_phase(const Params& p, char* smem) {
  const int nunits = 96 * 27;
  for (int u = blockIdx.x; u < nunits; u += gridDim.x) {
    const int tm = u < 288 ? u / 3 : (u - 288) / 24, s = u < 288 ? 24 + u % 3 : (u - 288) % 24;
    if (s < 8) { EpiAct<0> ep{p.R, 1024, nullptr}; gemm_tile_glds(p.E0, 1024, p.wr_t, 1024, tm, s, ep, smem); }
    else if (s < 16) { EpiAct<0> ep{p.Kx, 1024, nullptr}; gemm_tile_glds(p.E1, 1024, p.wk_t, 1024, tm, s - 8, ep, smem); }
    else if (s < 24) { EpiAct<0> ep{p.Vx, 1024, nullptr}; gemm_tile_glds(p.A1, 1024, p.wv_t, 1024, tm, s - 16, ep, smem); }
    else if (s == 24) { ALoadShift al{p.H, p.mix + 1 * 1024}; EpiAct<2> ep{p.LW, 128, nullptr}; gemm_tile(al, p.w1cat_t, 1024, tm, 0, ep, smem); }
    else if (s == 25) { ALoadShift al{p.H, p.mix + 4 * 1024}; EpiAct<0> ep{p.LA, 128, nullptr}; gemm_tile(al, p.a1cat_t, 1024, tm, 0, ep, smem); }
    else { ALoadShift al{p.H, p.mix + 5 * 1024}; EpiAct<3> ep{p.LG, 128, nullptr}; gemm_tile(al, p.g1_t, 1024, tm, 0, ep, smem); }
  }
}
__device__ __forceinline__ void rwkv_lora2_phase(const Params& p, char* smem) {
  const int nunits = 96 * 32;
  for (int u = blockIdx.x; u < nunits; u += gridDim.x) {
    const int tm = u >> 5, s = u & 31, which = s >> 3, tn = s & 7;
    const int d = which & 1;
    if (which < 2) { ALoadPlain al{p.LW + d * 64, 128}; EpiAct<4> ep{d ? p.E1 : p.E0, 1024, p.w0 + d * 1024}; gemm_tile_glds(al.A, al.lda, p.w2_t + (size_t)d * 65536, 64, tm, tn, ep, smem); }
    else { ALoadPlain al{p.LA + d * 64, 128}; EpiAct<5> ep{d ? p.A1 : p.A0, 1024, p.a0 + d * 1024}; gemm_tile_glds(al.A, al.lda, p.a2_t + (size_t)d * 65536, 64, tm, tn, ep, smem); }
  }
}


#define XB_TMO      128
#define XB_XCNT(j)  (256  + 64 * (j))
#define XB_XSUB(j)  (1280 + 64 * (j))
#define XB_XGEN(j)  (2304 + 64 * (j))
#define XB_TOP      3328
#define XB_TOPGEN   3392
#define XCD_BAR_WORDS 3456
#define XB_SPIN_CAP (1u << 22)
#define LAS __attribute__((address_space(3)))
__device__ __forceinline__ unsigned xb_ld(unsigned* p)              { return __hip_atomic_load(p, __ATOMIC_RELAXED, __HIP_MEMORY_SCOPE_AGENT); }
__device__ __forceinline__ unsigned xb_add(unsigned* p, unsigned v) { return __hip_atomic_fetch_add(p, v, __ATOMIC_RELAXED, __HIP_MEMORY_SCOPE_AGENT); }
__device__ __forceinline__ unsigned xb_xcc_id() { return (unsigned)__builtin_amdgcn_s_getreg((3 << 11) | 20) & 0xFu; }
#define XB_SPIN(cond, bar) do { unsigned _sp = 0; while (cond) { __builtin_amdgcn_s_sleep(1); \
    if ((++_sp & 255u) == 0u) { if (xb_ld(&(bar)[XB_TMO])) break; if (_sp > XB_SPIN_CAP) { atomicAdd(&(bar)[XB_TMO], 1u); break; } } } } while (0)
struct XcdBarrier { unsigned* bar; unsigned x; volatile LAS unsigned* st; };
__device__ __forceinline__ XcdBarrier xcd_barrier_post(unsigned* bar, volatile LAS unsigned* st) {
    XcdBarrier b; b.bar = bar; b.x = xb_xcc_id(); b.st = st;
    if (threadIdx.x == 0) (void)xb_add(&bar[XB_XCNT(b.x)], 1u);
    return b;
}
__device__ __forceinline__ void xcd_barrier_complete(unsigned* bar, unsigned x, unsigned& nloc, unsigned& nx) {
    const unsigned G = gridDim.x * gridDim.y * gridDim.z;
    unsigned sum, cnt, mine, sp = 0u;
    for (;;) {
        sum = 0u; cnt = 0u; mine = 0u;
#pragma unroll
        for (unsigned j = 0; j < 16; ++j) { const unsigned c = xb_ld(&bar[XB_XCNT(j)]); sum += c; cnt += (c > 0u) ? 1u : 0u; mine = (j == x) ? c : mine; }
        if (sum == G) break;
        __builtin_amdgcn_s_sleep(1);
        if ((++sp & 255u) == 0u) { if (xb_ld(&bar[XB_TMO])) break; if (sp > XB_SPIN_CAP) { atomicAdd(&bar[XB_TMO], 1u); break; } }
    }
    nloc = mine > 0u ? mine : 1u; nx = cnt > 0u ? cnt : 1u;
}
__device__ __forceinline__ void xcd_barrier(const XcdBarrier& b) {
    asm volatile("s_waitcnt vmcnt(0)" ::: "memory");
    __syncthreads();
    if (threadIdx.x == 0) {
        unsigned* bar = b.bar;
        __builtin_amdgcn_s_waitcnt(0);
        unsigned nloc = b.st[0], nx = b.st[1];
        if (nloc == 0u) { xcd_barrier_complete(bar, b.x, nloc, nx); b.st[0] = nloc; b.st[1] = nx; }
        const unsigned old = xb_add(&bar[XB_XSUB(b.x)], 1u);
        const unsigned gen = old / nloc;
        if (old + 1u == (gen + 1u) * nloc) {
            __builtin_amdgcn_fence(__ATOMIC_RELEASE, "agent");
            asm volatile("s_waitcnt vmcnt(0)" ::: "memory");
            const unsigned og = xb_add(&bar[XB_TOP], 1u);
            const unsigned tg = og / nx;
            if (og + 1u == (tg + 1u) * nx) xb_add(&bar[XB_TOPGEN], 1u);
            else XB_SPIN(xb_ld(&bar[XB_TOPGEN]) == tg, bar);
            __builtin_amdgcn_fence(__ATOMIC_ACQUIRE, "agent");
            xb_add(&bar[XB_XGEN(b.x)], 1u);
            asm volatile("s_waitcnt vmcnt(0)" ::: "memory");
        } else {
            XB_SPIN(xb_ld(&bar[XB_XGEN(b.x)]) == gen, bar);
            __builtin_amdgcn_fence(__ATOMIC_ACQUIRE, "agent");
            asm volatile("s_waitcnt vmcnt(0)" ::: "memory");
        }
    }
    __syncthreads();
}

__device__ __forceinline__ void run_phase(const Params& p, int ph, char* smem, bool dry = false) {
  switch (ph) {
    case 0: if (ONLY_PHASE < 0 || ONLY_PHASE == 0) phase0(p, smem); break;
    case 1: if (ONLY_PHASE < 0 || ONLY_PHASE == 1) prenorm_phase(p, 0, 0, true); break;
    case 2: if (ONLY_PHASE < 0 || ONLY_PHASE == 2) { ALoadPlain al{p.H, 1024}; EpiWin ep{&p}; gemm_phase(al, p.w_in_t, 1024, 26, ep, smem); } break;
    case 3: if (ONLY_PHASE < 0 || ONLY_PHASE == 3) mix0_phase(p, smem); break;
    case 4: if (ONLY_PHASE < 0 || ONLY_PHASE == 4) hgrn_combine_phase(p); break;
    case 5: if (ONLY_PHASE < 0 || ONLY_PHASE == 5) { ALoadPlain al{p.AO, 1024}; EpiResid ep{&p, 0, 2, true}; gemm_phase(al, p.w_out_t, 1024, 8, ep, smem); } break;
    case 6: if (ONLY_PHASE < 0 || ONLY_PHASE == 6) prenorm_phase(p, 0, 1, false); break;
    case 7: if (ONLY_PHASE < 0 || ONLY_PHASE == 7) { ALoadPlain al{p.H, 1024}; EpiAct<1> ep{p.U, 4096, nullptr}; gemm_phase(al, p.mlp1_t, 1024, 32, ep, smem); } break;
    case 8: if (ONLY_PHASE < 0 || ONLY_PHASE == 8) { ALoadPlain al{p.U, 4096}; EpiResid ep{&p, 0, 5, false, dry}; gemm_phase(al, p.mlp2_t, 4096, 8, ep, smem); } break;
    case 9: if (ONLY_PHASE < 0 || ONLY_PHASE == 9) prenorm_phase(p, 1, 0, false); break;
    case 10: if (ONLY_PHASE < 0 || ONLY_PHASE == 10) rwkv_proj_phase(p, smem); break;
    case 11: if (ONLY_PHASE < 0 || ONLY_PHASE == 11) rwkv_lora2_phase(p, smem); break;
    case 12: if (ONLY_PHASE < 0 || ONLY_PHASE == 12) rwkv_scan_phase(p, smem, dry); break;
    case 13: if (ONLY_PHASE < 0 || ONLY_PHASE == 13) { ALoadPlain al{p.LG, 128}; EpiRwkvOut ep{&p}; gemm_phase(al, p.g2_t, 128, 8, ep, smem); } break;
    case 14: if (ONLY_PHASE < 0 || ONLY_PHASE == 14) { ALoadPlain al{p.ZO, 1024}; EpiResid ep{&p, 1, 2, false, dry}; gemm_phase(al, p.wo_t, 1024, 8, ep, smem); } break;
    case 15: if (ONLY_PHASE < 0 || ONLY_PHASE == 15) prenorm_phase(p, 1, 1, false); break;
    case 16: if (ONLY_PHASE < 0 || ONLY_PHASE == 16) { ALoadPlain al{p.H, 1024}; EpiAct<1> ep{p.U, 4096, nullptr}; gemm_phase(al, p.mlp1_t + (size_t)4096 * 1024, 1024, 32, ep, smem); } break;
    case 17: if (ONLY_PHASE < 0 || ONLY_PHASE == 17) { ALoadPlain al{p.U, 4096}; EpiResid ep{&p, 1, 5, false, dry}; gemm_phase(al, p.mlp2_t + (size_t)4096 * 1024, 4096, 8, ep, smem); } break;
    case 18: blend_phase(p); break;
    default: break;
  }
}

__global__ void __launch_bounds__(NT, 2) fwd_kernel(const Params p_unused, int ph_lo, int ph_hi) {
  const Params& p = *(const Params*)__builtin_amdgcn_kernarg_segment_ptr();
  __shared__ __attribute__((aligned(16))) char smem[65536];
  __shared__ uint4 xb_words;
  if (threadIdx.x == 0) xb_words = make_uint4(0u, 0u, 0u, 0u);
  __syncthreads();
  XcdBarrier xb = xcd_barrier_post(p.bar, (volatile LAS unsigned*)&xb_words);
  if (ph_hi < 0) cg::this_grid().sync();
#ifndef PROBE_MASK
#define PROBE_MASK 0
#endif
#ifndef PROBE_DRY
#define PROBE_DRY 0
#endif
#define PHASE(n, sync_) { if ((PROBE_MASK >> n) & 1) { run_phase(p, n, smem); xcd_barrier(xb); } if ((PROBE_DRY >> n) & 1) { run_phase(p, n, smem, true); xcd_barrier(xb); } run_phase(p, n, smem); if (sync_) xcd_barrier(xb); }
  PHASE(0, 1) PHASE(1, 1) PHASE(2, 1) PHASE(3, 1) PHASE(4, 1) PHASE(5, 1) PHASE(6, 1) PHASE(7, 1) PHASE(8, 1) PHASE(9, 1) PHASE(18, 1)
  PHASE(10, 1) PHASE(11, 1) PHASE(12, 1) PHASE(13, 1) PHASE(14, 1) PHASE(15, 1) PHASE(16, 1) PHASE(17, 0)
#undef PHASE
}

extern "C" void kernel_launch(void* const* d_in, const int* in_sizes, int n_in, void* d_out, int out_size, void* d_ws, size_t ws_size, hipStream_t stream) {
  Params p; memset(&p, 0, sizeof(p));
  auto F = [&](int i) { return (const float*)d_in[i]; };
  p.x_prompt = F(0); p.x_sample = F(1); p.cache_k = F(2); p.cache_v = F(3); p.hg_f0 = F(4); p.hg_b0 = F(5); p.rw_f0 = F(6); p.rw_b0 = F(7);
  p.c = F(8); p.c_ctx = F(9); p.ada_w = F(10); p.ada_b = F(11); p.norm1_w = F(12); p.norm2_w = F(13);
  p.q_norm = F(16); p.k_norm = F(17); p.hgrn_lb = F(18); p.g_norm = F(19); p.mix = F(20);
  p.w0 = F(25); p.a0 = F(28); p.k_k = F(33); p.k_a = F(34); p.r_k = F(35); p.ln_w = F(36); p.ln_b = F(37);
  float* out = (float*)d_out;
  p.X = out; p.out_k = out + 12582912; p.out_v = out + 13107200; p.out_hf = out + 13631488; p.out_hb = out + 14155776;
  p.out_rf = out + 14680064; p.out_rb = out + 15728640;
  char* ws = (char*)d_ws; size_t off = 16384;
  p.bar = (unsigned*)ws;
  auto alloc = [&](size_t bytes) { char* r = ws + off; off += (bytes + 255) & ~(size_t)255; return r; };
  const size_t M1 = (size_t)1024 * 1024;
  p.w_in_t = (bf16_t*)alloc((size_t)3328 * 1024 * 2); p.w_out_t = (bf16_t*)alloc(M1 * 2);
  p.wr_t = (bf16_t*)alloc(M1 * 2); p.wk_t = (bf16_t*)alloc(M1 * 2); p.wv_t = (bf16_t*)alloc(M1 * 2); p.wo_t = (bf16_t*)alloc(M1 * 2);
  p.w1cat_t = (bf16_t*)alloc(128 * 1024 * 2); p.a1cat_t = (bf16_t*)alloc(128 * 1024 * 2); p.g1_t = (bf16_t*)alloc(128 * 1024 * 2);
  p.w2_t = (bf16_t*)alloc(2 * 1024 * 64 * 2); p.a2_t = (bf16_t*)alloc(2 * 1024 * 64 * 2); p.g2_t = (bf16_t*)alloc(1024 * 128 * 2);
  p.mlp1_t = (bf16_t*)alloc(2 * 4 * M1 * 2); p.mlp2_t = (bf16_t*)alloc(2 * 4 * M1 * 2);
  p.MOD = (float*)alloc((size_t)2 * 9 * 6144 * 4);
  const size_t TOKD = (size_t)NTOK * 1024;
  p.H = (bf16_t*)alloc(TOKD * 2);
  const size_t regL = off;
  p.Qbuf = (bf16_t*)alloc((size_t)NTOK * 512 * 2);
  p.Kp = (bf16_t*)alloc((size_t)32 * 256 * 64 * 2); p.Ks = (bf16_t*)alloc((size_t)16 * 1280 * 64 * 2);
  p.Vtp = (bf16_t*)alloc((size_t)32 * 64 * 256 * 2); p.Vts = (bf16_t*)alloc((size_t)16 * 64 * 1280 * 2);
  p.HG = (bf16_t*)alloc((size_t)NTOK * 2560 * 2);
  p.OF = (float*)alloc((size_t)NTOK * 512 * 4); p.OB = (float*)alloc((size_t)NTOK * 512 * 4);
  p.AO = (bf16_t*)alloc(TOKD * 2);
  size_t end0 = off;
  off = regL; p.U = (bf16_t*)alloc((size_t)NTOK * 4096 * 2);
  size_t endU = off;
  off = regL;
  p.R = (bf16_t*)alloc(TOKD * 2); p.Kx = (bf16_t*)alloc(TOKD * 2); p.Vx = (bf16_t*)alloc(TOKD * 2);
  p.LW = (bf16_t*)alloc((size_t)NTOK * 128 * 2); p.LA = (bf16_t*)alloc((size_t)NTOK * 128 * 2); p.LG = (bf16_t*)alloc((size_t)NTOK * 128 * 2);
  p.E0 = (bf16_t*)alloc(TOKD * 2); p.E1 = (bf16_t*)alloc(TOKD * 2); p.A1 = (bf16_t*)alloc(TOKD * 2);
  p.BS = (float*)alloc((size_t)2 * NTOK * 16 * 4);
  p.A0 = p.H; p.ZO = p.R;
  size_t end1 = off;
  size_t need = end0 > end1 ? end0 : end1; if (endU > need) need = endU;
  if (need > ws_size) fprintf(stderr, "workspace too small: need %zu have %zu\n", need, ws_size);
  int nj = 0, tiles = 0;
  auto job = [&](const float* src, bf16_t* dst, int K, int N) { p.jobs[nj].src = src; p.jobs[nj].dst = dst; p.jobs[nj].K = K; p.jobs[nj].N = N; p.jobs[nj].tile0 = tiles; p.jobs[nj].pad = 0; tiles += (K / 64) * (N / 64); ++nj; };
  job(F(38), p.mlp1_t, 1024, 4096); job(F(38) + 4 * M1, p.mlp1_t + 4 * M1, 1024, 4096);
  job(F(39), p.mlp2_t, 4096, 1024); job(F(39) + 4 * M1, p.mlp2_t + 4 * M1, 4096, 1024);
  job(F(14), p.w_in_t, 1024, 3328); job(F(15), p.w_out_t, 1024, 1024);
  job(F(21), p.wr_t, 1024, 1024); job(F(22), p.wk_t, 1024, 1024); job(F(23), p.wv_t, 1024, 1024); job(F(24), p.wo_t, 1024, 1024);
  job(F(26), p.w1cat_t, 1024, 64); job(F(26) + 65536, p.w1cat_t + 65536, 1024, 64);
  job(F(29), p.a1cat_t, 1024, 64); job(F(29) + 65536, p.a1cat_t + 65536, 1024, 64);
  job(F(31), p.g1_t, 1024, 128);
  job(F(27), p.w2_t, 64, 1024); job(F(27) + 65536, p.w2_t + 65536, 64, 1024);
  job(F(30), p.a2_t, 64, 1024); job(F(30) + 65536, p.a2_t + 65536, 64, 1024);
  job(F(32), p.g2_t, 128, 1024);
  p.njobs = nj; p.ntiles = tiles;

  static int grid_blocks = 0;
  if (!grid_blocks) {
    int dev = 0, cus = 0, per_cu = 0;
    hipGetDevice(&dev);
    hipDeviceGetAttribute(&cus, hipDeviceAttributeMultiprocessorCount, dev);
    hipOccupancyMaxActiveBlocksPerMultiprocessor(&per_cu, fwd_kernel, NT, 0);
    if (per_cu > 2) per_cu = 2;
    if (per_cu < 1) per_cu = 1;
    grid_blocks = cus * per_cu;
  }
  hipMemsetAsync(d_ws, 0, 16384, stream);
#if ONE_LAUNCH
  int lo = 0, hi = NPHASES;
  void* args[] = {(void*)&p, (void*)&lo, (void*)&hi};
  hipError_t e = hipLaunchCooperativeKernel((void*)fwd_kernel, dim3(grid_blocks), dim3(NT), args, 0, stream);
  if (e != hipSuccess) fprintf(stderr, "cooperative launch failed: %s (grid %d)\n", hipGetErrorString(e), grid_blocks);
#else
  for (int ph = 0; ph < NPHASES; ++ph) hipLaunchKernelGGL(fwd_kernel, dim3(grid_blocks), dim3(NT), 0, stream, p, ph, ph + 1);
#endif
}
```

```cpp
#include <hip/hip_runtime.h>
#include <hip/hip_cooperative_groups.h>
#include <stdint.h>
#include <string.h>
#include <stdio.h>
namespace cg = cooperative_groups;

#ifndef ONE_LAUNCH
#define ONE_LAUNCH 1
#endif

typedef unsigned short bf16_t;
typedef short bf16x8 __attribute__((ext_vector_type(8)));
typedef float f32x4 __attribute__((ext_vector_type(4)));
typedef float f32x16 __attribute__((ext_vector_type(16)));
typedef float f32x2 __attribute__((ext_vector_type(2)));

#define NT 256
#define NTOK 12288
#define NP 4096
#define NPHASES 18
#ifndef ONLY_PHASE
#define ONLY_PHASE -1
#endif

struct TJob { const float* src; bf16_t* dst; int K, N, tile0, pad; };

struct Params {
  const float *x_prompt, *x_sample, *cache_k, *cache_v, *hg_f0, *hg_b0, *rw_f0, *rw_b0, *c, *c_ctx;
  const float *ada_w, *ada_b, *norm1_w, *norm2_w, *q_norm, *k_norm, *hgrn_lb, *g_norm;
  const float *mix, *w0, *a0, *k_k, *k_a, *r_k, *ln_w, *ln_b;
  float *X, *out_k, *out_v, *out_hf, *out_hb, *out_rf, *out_rb;
  bf16_t *w_in_t, *w_out_t, *wr_t, *wk_t, *wv_t, *wo_t, *w1cat_t, *a1cat_t, *g1_t, *w2_t, *a2_t, *g2_t, *mlp1_t, *mlp2_t;
  float* MOD;
  bf16_t* H;
  bf16_t *Qbuf, *Kp, *Ks, *Vtp, *Vts, *HG, *AO, *U;
  float *OF, *OB;
  bf16_t *R, *Kx, *Vx, *LW, *LA, *LG, *E0, *E1, *A0, *A1, *ZO;
  float* BS;
  unsigned* bar;
  TJob jobs[20];
  int njobs, ntiles;
};

typedef float f32x2c __attribute__((ext_vector_type(2)));
typedef __bf16 bf16v2 __attribute__((ext_vector_type(2)));
__device__ __forceinline__ unsigned pk_bf16(float lo, float hi) { f32x2c v = {lo, hi}; bf16v2 b = __builtin_convertvector(v, bf16v2); return __builtin_bit_cast(unsigned, b); }
__device__ __forceinline__ bf16_t f2bf(float v) { return (bf16_t)(pk_bf16(v, 0.f) & 0xffffu); }
__device__ __forceinline__ float bf2f(bf16_t v) { return __uint_as_float(((unsigned)v) << 16); }
__device__ __forceinline__ float bflo(unsigned u) { return __uint_as_float(u << 16); }
__device__ __forceinline__ float bfhi(unsigned u) { return __uint_as_float(u & 0xffff0000u); }
__device__ __forceinline__ float sigmoidf_(float x) { return __builtin_amdgcn_rcpf(1.f + __expf(-x)); }
__device__ __forceinline__ float siluf_(float x) { return x * __builtin_amdgcn_rcpf(1.f + __expf(-x)); }
__device__ __forceinline__ float wave_sum(float v) {
#pragma unroll
  for (int o = 32; o >= 1; o >>= 1) v += __shfl_xor(v, o);
  return v;
}
__device__ __forceinline__ float quad_sum(float v) {
  v += __int_as_float(__builtin_amdgcn_update_dpp(0, __float_as_int(v), 0xB1, 0xF, 0xF, true));
  v += __int_as_float(__builtin_amdgcn_update_dpp(0, __float_as_int(v), 0x4E, 0xF, 0xF, true));
  return v;
}
__device__ __forceinline__ float oct_sum(float v) {
  v += __int_as_float(__builtin_amdgcn_update_dpp(0, __float_as_int(v), 0xB1, 0xF, 0xF, true));
  v += __int_as_float(__builtin_amdgcn_update_dpp(0, __float_as_int(v), 0x4E, 0xF, 0xF, true));
  v += __int_as_float(__builtin_amdgcn_update_dpp(0, __float_as_int(v), 0x141, 0xF, 0xF, true));
  return v;
}
__device__ __forceinline__ float hex_sum(float v) {
  v = oct_sum(v);
  v += __int_as_float(__builtin_amdgcn_update_dpp(0, __float_as_int(v), 0x140, 0xF, 0xF, true));
  return v;
}
__device__ __forceinline__ int mod_index(int row) { return row < NP ? 0 : 1 + ((row - NP) >> 10); }

__device__ __forceinline__ void ada_item(const Params& p, int it, char* smem) {
  const int tid = threadIdx.x;
  float* sil = (float*)smem;
  for (int i = tid; i < 9 * 1024; i += NT) {
    int n = i >> 10, k = i & 1023;
    float cv = n == 0 ? p.c_ctx[k] : p.c[(n - 1) * 1024 + k];
    sil[i] = siluf_(cv);
  }
  __syncthreads();
  const int gcol = it * 64, l = gcol / 6144, j = gcol % 6144;
  const int c4 = tid & 15, ks = tid >> 4;
  const float* wp = p.ada_w + (size_t)l * 1024 * 6144 + (size_t)(ks * 64) * 6144 + j + c4 * 4;
  float acc[9][4];
#pragma unroll
  for (int n = 0; n < 9; ++n) { acc[n][0] = 0.f; acc[n][1] = 0.f; acc[n][2] = 0.f; acc[n][3] = 0.f; }
#pragma unroll 4
  for (int k = 0; k < 64; ++k) {
    const float4 w = *(const float4*)(wp + (size_t)k * 6144);
#pragma unroll
    for (int n = 0; n < 9; ++n) {
      const float s = sil[n * 1024 + ks * 64 + k];
      acc[n][0] += s * w.x; acc[n][1] += s * w.y; acc[n][2] += s * w.z; acc[n][3] += s * w.w;
    }
  }
  __syncthreads();
  float* red = (float*)smem;
#pragma unroll
  for (int n = 0; n < 9; ++n)
#pragma unroll
    for (int q = 0; q < 4; ++q) red[(ks * 9 + n) * 64 + c4 * 4 + q] = acc[n][q];
  __syncthreads();
  for (int o = tid; o < 576; o += NT) {
    const int n = o >> 6, cc = o & 63;
    float s = 0.f;
#pragma unroll
    for (int k2 = 0; k2 < 16; ++k2) s += red[(k2 * 9 + n) * 64 + cc];
    s += p.ada_b[l * 6144 + j + cc];
    p.MOD[(size_t)(l * 9 + n) * 6144 + j + cc] = s;
  }
}

__device__ __forceinline__ void transpose_item(const Params& p, int tix, char* smem) {
  const int tid = threadIdx.x;
  int j = 0;
  while (j + 1 < p.njobs && tix >= p.jobs[j + 1].tile0) ++j;
  const float* src = p.jobs[j].src; bf16_t* dst = p.jobs[j].dst;
  const int K = p.jobs[j].K, N = p.jobs[j].N, lt = tix - p.jobs[j].tile0;
  const int ntn = N >> 6, tk = lt / ntn, tn = lt % ntn;
  float* tile = (float*)smem;
#pragma unroll
  for (int i = 0; i < 4; ++i) {
    const int r = (tid >> 4) + 16 * i, c4 = tid & 15;
    const float4 v = *(const float4*)(src + (size_t)(tk * 64 + r) * N + tn * 64 + c4 * 4);
    float* t = tile + r * 65 + c4 * 4;
    t[0] = v.x; t[1] = v.y; t[2] = v.z; t[3] = v.w;
  }
  __syncthreads();
  const int n = tid >> 2, kc = (tid & 3) * 16;
  unsigned w[8];
#pragma unroll
  for (int i = 0; i < 8; ++i) w[i] = pk_bf16(tile[(kc + 2 * i) * 65 + n], tile[(kc + 2 * i + 1) * 65 + n]);
  uint4* d = (uint4*)(dst + (size_t)(tn * 64 + n) * K + tk * 64 + kc);
  d[0] = make_uint4(w[0], w[1], w[2], w[3]);
  d[1] = make_uint4(w[4], w[5], w[6], w[7]);
}

__device__ __forceinline__ void cache_item(const Params& p, int ci) {
  const int tid = threadIdx.x;
  const int base = (ci & 31) * 8192;
  for (int e = tid; e < 8192; e += NT) {
    const int idx = base + e;
    const int d = idx & 63, kvh = (idx >> 6) & 1, pp = (idx >> 7) & 255, b = idx >> 15;
    if (ci < 32) p.Ks[((size_t)(b * 2 + kvh) * 1280 + 1024 + pp) * 64 + d] = f2bf(p.cache_k[idx]);
    else p.Vts[((size_t)(b * 2 + kvh) * 64 + d) * 1280 + 1024 + pp] = f2bf(p.cache_v[idx]);
  }
}

__device__ __forceinline__ void phase0(const Params& p, char* smem) {
  const int n_ada = 192, n_tr = p.ntiles, n_cc = 64;
  const int total = n_ada + n_tr + n_cc;
  for (int it = blockIdx.x; it < total; it += gridDim.x) {
    if (it < n_ada) ada_item(p, it, smem);
    else if (it < n_ada + n_tr) transpose_item(p, it - n_ada, smem);
    else cache_item(p, it - n_ada - n_tr);
    __syncthreads();
  }
}

__device__ __forceinline__ void prenorm_phase(const Params& p, int layer, int which, bool from_input) {
  const int wave = threadIdx.x >> 6, lane = threadIdx.x & 63;
  const float* nw = (which ? p.norm2_w : p.norm1_w) + layer * 1024;
  for (int row = blockIdx.x * 4 + wave; row < NTOK; row += gridDim.x * 4) {
    const float* xr = from_input ? (row < NP ? p.x_prompt + (size_t)row * 1024 : p.x_sample + (size_t)(row - NP) * 1024)
                                 : p.X + (size_t)row * 1024;
    float4 v[4]; float ss = 0.f;
#pragma unroll
    for (int i = 0; i < 4; ++i) { v[i] = *(const float4*)(xr + i * 256 + lane * 4); ss += v[i].x * v[i].x + v[i].y * v[i].y + v[i].z * v[i].z + v[i].w * v[i].w; }
    ss = wave_sum(ss);
    const float rstd = rsqrtf(ss * (1.f / 1024.f) + 1e-6f);
    const float* md = p.MOD + (size_t)(layer * 9 + mod_index(row)) * 6144;
    const float* sh = md + (which ? 3 : 0) * 1024; const float* sc = md + (which ? 4 : 1) * 1024;
#pragma unroll
    for (int i = 0; i < 4; ++i) {
      const int c = i * 256 + lane * 4;
      const float4 w4 = *(const float4*)(nw + c), s4 = *(const float4*)(sh + c), c4 = *(const float4*)(sc + c);
      const float h0 = v[i].x * rstd * w4.x * (1.f + c4.x) + s4.x, h1 = v[i].y * rstd * w4.y * (1.f + c4.y) + s4.y;
      const float h2 = v[i].z * rstd * w4.z * (1.f + c4.z) + s4.z, h3 = v[i].w * rstd * w4.w * (1.f + c4.w) + s4.w;
      *(uint2*)(p.H + (size_t)row * 1024 + c) = make_uint2(pk_bf16(h0, h1), pk_bf16(h2, h3));
    }
  }
}

struct ALoadPlain {
  const bf16_t* A; int lda;
  __device__ __forceinline__ uint4 operator()(int row, int k) const { return *(const uint4*)(A + (size_t)row * lda + k); }
};
struct ALoadShift {
  const bf16_t* H; const float* mix;
  __device__ __forceinline__ uint4 operator()(int row, int k) const {
    const uint4 h = *(const uint4*)(H + (size_t)row * 1024 + k);
    int tl, T;
    if (row < NP) { tl = row & 255; T = 256; } else { tl = (row - NP) & 1023; T = 1024; }
    uint4 s = make_uint4(0, 0, 0, 0);
    if (k < 512) { if (tl > 0) s = *(const uint4*)(H + (size_t)(row - 1) * 1024 + k); }
    else { if (tl < T - 1) s = *(const uint4*)(H + (size_t)(row + 1) * 1024 + k); }
    const float4 m0 = *(const float4*)(mix + k), m1 = *(const float4*)(mix + k + 4);
    uint4 o;
    { float a = bflo(h.x), b = bfhi(h.x); o.x = pk_bf16(a + (bflo(s.x) - a) * m0.x, b + (bfhi(s.x) - b) * m0.y); }
    { float a = bflo(h.y), b = bfhi(h.y); o.y = pk_bf16(a + (bflo(s.y) - a) * m0.z, b + (bfhi(s.y) - b) * m0.w); }
    { float a = bflo(h.z), b = bfhi(h.z); o.z = pk_bf16(a + (bflo(s.z) - a) * m1.x, b + (bfhi(s.z) - b) * m1.y); }
    { float a = bflo(h.w), b = bfhi(h.w); o.w = pk_bf16(a + (bflo(s.w) - a) * m1.z, b + (bfhi(s.w) - b) * m1.w); }
    return o;
  }
};

template <class AL, class EP>
__device__ __forceinline__ void gemm_tile(const AL& al, const bf16_t* __restrict__ Bt, int K, int tm, int tn, const EP& ep, char* smem) {
  const int tid = threadIdx.x, lane = tid & 63, wid = tid >> 6, wm = wid >> 1, wn = wid & 1;
  const int fr = lane & 15, fq = lane >> 4;
  char* sA = smem; char* sB = smem + 32768;
  f32x4 acc[4][4];
#pragma unroll
  for (int a = 0; a < 4; ++a)
#pragma unroll
    for (int b = 0; b < 4; ++b) acc[a][b] = (f32x4){0.f, 0.f, 0.f, 0.f};
  uint4 pa[4], pb[4];
  const int nk = K >> 6;
  const int cr0 = tid >> 3, cc = tid & 7;
  const int soff = cr0 * 128 + ((cc ^ ((cr0 >> 1) & 7)) << 4);
  const bf16_t* bp = Bt + (size_t)(tn * 128 + cr0) * K + cc * 8;
#define GLOAD(kt) do { _Pragma("unroll") for (int i = 0; i < 4; ++i) { pa[i] = al(tm * 128 + cr0 + 32 * i, (kt) * 64 + cc * 8); pb[i] = *(const uint4*)(bp + (size_t)(32 * i) * K + (kt) * 64); } } while (0)
#define SSTORE(buf) do { _Pragma("unroll") for (int i = 0; i < 4; ++i) { *(uint4*)(sA + (buf) * 16384 + soff + i * 4096) = pa[i]; *(uint4*)(sB + (buf) * 16384 + soff + i * 4096) = pb[i]; } } while (0)
  GLOAD(0); SSTORE(0); __syncthreads();
  for (int kt = 0; kt < nk; ++kt) {
    const int buf = kt & 1;
    if (kt + 1 < nk) GLOAD(kt + 1);
#pragma unroll
    for (int kk = 0; kk < 2; ++kk) {
      bf16x8 af[4], bfr[4];
#pragma unroll
      for (int mi = 0; mi < 4; ++mi) { const int r = wm * 64 + mi * 16 + fr, c = kk * 4 + fq; af[mi] = *(const bf16x8*)(sA + buf * 16384 + r * 128 + ((c ^ ((r >> 1) & 7)) << 4)); }
#pragma unroll
      for (int ni = 0; ni < 4; ++ni) { const int r = wn * 64 + ni * 16 + fr, c = kk * 4 + fq; bfr[ni] = *(const bf16x8*)(sB + buf * 16384 + r * 128 + ((c ^ ((r >> 1) & 7)) << 4)); }
#pragma unroll
      for (int mi = 0; mi < 4; ++mi)
#pragma unroll
        for (int ni = 0; ni < 4; ++ni) acc[mi][ni] = __builtin_amdgcn_mfma_f32_16x16x32_bf16(bfr[ni], af[mi], acc[mi][ni], 0, 0, 0);
    }
    if (kt + 1 < nk) SSTORE(buf ^ 1);
    __syncthreads();
  }
#undef GLOAD
#undef SSTORE
  ep(acc, tm * 128 + wm * 64, tn * 128 + wn * 64, lane);
}

#define LAS3 __attribute__((address_space(3)))
template <int OFF>
__device__ __forceinline__ bf16x8 lds_rd128(unsigned addr) { bf16x8 v; asm volatile("ds_read_b128 %0, %1 offset:%2" : "=v"(v) : "v"(addr), "n"(OFF) : "memory"); return v; }
template <class EP>
__device__ __forceinline__ void gemm_tile_glds(const bf16_t* __restrict__ A, int lda, const bf16_t* __restrict__ Bt, int K, int tm, int tn, const EP& ep, char* smem) {
  const int tid = threadIdx.x, lane = tid & 63, wid = __builtin_amdgcn_readfirstlane(tid >> 6), wm = wid >> 1, wn = wid & 1;
  const int fr = lane & 15, fq = lane >> 4;
  f32x4 acc[4][4];
#pragma unroll
  for (int a = 0; a < 4; ++a)
#pragma unroll
    for (int b = 0; b < 4; ++b) acc[a][b] = (f32x4){0.f, 0.f, 0.f, 0.f};
  const int nk = K >> 6;
  const int lr = lane >> 3, c0 = (lane & 7) ^ (lr >> 1);
  const bf16_t* pa = A + (size_t)(tm * 128 + wid * 32 + lr) * lda;
  const bf16_t* pb = Bt + (size_t)(tn * 128 + wid * 32 + lr) * K;
  const unsigned lbase = (unsigned)(uintptr_t)(LAS3 char*)smem;
  const unsigned fsw = (unsigned)((fq ^ ((fr >> 1) & 7)) << 4);
  const unsigned aA0 = lbase + (unsigned)((wm * 64 + fr) * 128) + fsw, aA1 = lbase + (unsigned)((wm * 64 + fr) * 128) + (fsw ^ 64u);
  const unsigned aB0 = lbase + 32768u + (unsigned)((wn * 64 + fr) * 128) + fsw, aB1 = lbase + 32768u + (unsigned)((wn * 64 + fr) * 128) + (fsw ^ 64u);
#define GLDS(kt, buf) do { _Pragma("unroll") for (int i = 0; i < 4; ++i) { const int cc_ = (c0 ^ ((i & 1) << 2)) * 8 + (kt) * 64; \
    __builtin_amdgcn_global_load_lds((const unsigned*)(pa + (size_t)(i * 8) * lda + cc_), (LAS3 unsigned*)(smem + (buf) * 16384 + (wid * 4 + i) * 1024), 16, 0, 0); \
    __builtin_amdgcn_global_load_lds((const unsigned*)(pb + (size_t)(i * 8) * K + cc_), (LAS3 unsigned*)(smem + 32768 + (buf) * 16384 + (wid * 4 + i) * 1024), 16, 0, 0); } } while (0)
  GLDS(0, 0);
  asm volatile("s_waitcnt vmcnt(0)" ::: "memory");
  __builtin_amdgcn_s_barrier();
  for (int kt = 0; kt < nk; ++kt) {
    const int buf = kt & 1;
    if (kt + 1 < nk) GLDS(kt + 1, buf ^ 1);
    const unsigned bo = (unsigned)buf * 16384u;
    bf16x8 a0[4], b0[4], a1[4], b1[4];
    a0[0] = lds_rd128<0>(aA0 + bo); a0[1] = lds_rd128<2048>(aA0 + bo); a0[2] = lds_rd128<4096>(aA0 + bo); a0[3] = lds_rd128<6144>(aA0 + bo);
    b0[0] = lds_rd128<0>(aB0 + bo); b0[1] = lds_rd128<2048>(aB0 + bo); b0[2] = lds_rd128<4096>(aB0 + bo); b0[3] = lds_rd128<6144>(aB0 + bo);
    a1[0] = lds_rd128<0>(aA1 + bo); a1[1] = lds_rd128<2048>(aA1 + bo); a1[2] = lds_rd128<4096>(aA1 + bo); a1[3] = lds_rd128<6144>(aA1 + bo);
    b1[0] = lds_rd128<0>(aB1 + bo); b1[1] = lds_rd128<2048>(aB1 + bo); b1[2] = lds_rd128<4096>(aB1 + bo); b1[3] = lds_rd128<6144>(aB1 + bo);
    __builtin_amdgcn_sched_barrier(0);
    asm volatile("s_waitcnt lgkmcnt(8)" : "+v"(a0[0]), "+v"(a0[1]), "+v"(a0[2]), "+v"(a0[3]), "+v"(b0[0]), "+v"(b0[1]), "+v"(b0[2]), "+v"(b0[3]) :: "memory");
    __builtin_amdgcn_s_setprio(1);
#pragma unroll
    for (int mi = 0; mi < 4; ++mi)
#pragma unroll
      for (int ni = 0; ni < 4; ++ni) acc[mi][ni] = __builtin_amdgcn_mfma_f32_16x16x32_bf16(b0[ni], a0[mi], acc[mi][ni], 0, 0, 0);
    __builtin_amdgcn_sched_barrier(0);
    asm volatile("s_waitcnt lgkmcnt(0)" : "+v"(a1[0]), "+v"(a1[1]), "+v"(a1[2]), "+v"(a1[3]), "+v"(b1[0]), "+v"(b1[1]), "+v"(b1[2]), "+v"(b1[3]) :: "memory");
#pragma unroll
    for (int mi = 0; mi < 4; ++mi)
#pragma unroll
      for (int ni = 0; ni < 4; ++ni) acc[mi][ni] = __builtin_amdgcn_mfma_f32_16x16x32_bf16(b1[ni], a1[mi], acc[mi][ni], 0, 0, 0);
    __builtin_amdgcn_s_setprio(0);
    __builtin_amdgcn_sched_barrier(0);
    asm volatile("s_waitcnt vmcnt(0)" ::: "memory");
    __builtin_amdgcn_s_barrier();
    __builtin_amdgcn_sched_barrier(0);
  }
#undef GLDS
  ep(acc, tm * 128 + wm * 64, tn * 128 + wn * 64, lane);
}

struct EpiWin {
  const Params* pp;
  __device__ __forceinline__ void operator()(f32x4 (&acc)[4][4], int row0, int col0, int lane) const {
    const Params& p = *pp;
    const int fr = lane & 15, fq = lane >> 4;
    const bool sample = row0 >= NP;
    if (col0 < 640) {
      const bool isq = col0 < 512;
      const float* nw = isq ? p.q_norm : p.k_norm;
      float nwv[4][4];
#pragma unroll
      for (int ni = 0; ni < 4; ++ni)
#pragma unroll
        for (int j = 0; j < 4; ++j) nwv[ni][j] = nw[ni * 16 + fq * 4 + j];
#pragma unroll
      for (int mi = 0; mi < 4; ++mi) {
        const int row = row0 + mi * 16 + fr;
        float ss = 0.f;
#pragma unroll
        for (int ni = 0; ni < 4; ++ni)
#pragma unroll
          for (int j = 0; j < 4; ++j) ss += acc[mi][ni][j] * acc[mi][ni][j];
        ss += __shfl_xor(ss, 16); ss += __shfl_xor(ss, 32);
        const float rn = rsqrtf(ss * (1.f / 64.f) + 1e-6f);
        float y[4][4];
#pragma unroll
        for (int ni = 0; ni < 4; ++ni)
#pragma unroll
          for (int j = 0; j < 4; ++j) y[ni][j] = acc[mi][ni][j] * rn * nwv[ni][j];
        if (!sample && !isq) {
          const int kvh = (col0 - 512) >> 6;
#pragma unroll
          for (int ni = 0; ni < 4; ++ni) *(f32x4*)(p.out_k + (size_t)row * 128 + kvh * 64 + ni * 16 + fq * 4) = (f32x4){y[ni][0], y[ni][1], y[ni][2], y[ni][3]};
        }
        if (sample) {
          const int tl = (row - NP) & 1023;
          const float rp = (float)(tl >> 6), cp = (float)(tl & 63);
#pragma unroll
          for (int ni = 0; ni < 4; ++ni)
#pragma unroll
            for (int jp = 0; jp < 2; ++jp) {
              const int i = (ni * 16 + fq * 4 + jp * 2) >> 1;
              const float pos = i < 16 ? rp : cp;
              const float inv = exp2f(-(float)(i & 15) * 0.83048202372184058696f);
              const float ang = pos * inv;
              const float s = __sinf(ang), c = __cosf(ang);
              const float x0 = y[ni][2 * jp], x1 = y[ni][2 * jp + 1];
              y[ni][2 * jp] = x0 * c - x1 * s; y[ni][2 * jp + 1] = x0 * s + x1 * c;
            }
        }
        if (isq) {
          const float qs = 0.125f * 1.44269504088896f;
#pragma unroll
          for (int ni = 0; ni < 4; ++ni)
            *(uint2*)(p.Qbuf + (size_t)row * 512 + col0 + ni * 16 + fq * 4) = make_uint2(pk_bf16(y[ni][0] * qs, y[ni][1] * qs), pk_bf16(y[ni][2] * qs, y[ni][3] * qs));
        } else {
          const int kvh = (col0 - 512) >> 6;
          bf16_t* kd;
          if (!sample) kd = p.Kp + ((size_t)((row >> 8) * 2 + kvh) * 256 + (row & 255)) * 64;
          else kd = p.Ks + ((size_t)(((row - NP) >> 10) * 2 + kvh) * 1280 + ((row - NP) & 1023)) * 64;
#pragma unroll
          for (int ni = 0; ni < 4; ++ni)
            *(uint2*)(kd + ni * 16 + fq * 4) = make_uint2(pk_bf16(y[ni][0], y[ni][1]), pk_bf16(y[ni][2], y[ni][3]));
        }
      }
    } else if (col0 < 768) {
      const int kvh = (col0 - 640) >> 6;
#pragma unroll
      for (int mi = 0; mi < 4; ++mi) {
        const int row = row0 + mi * 16 + fr;
#pragma unroll
        for (int ni = 0; ni < 4; ++ni) {
          const int d0 = ni * 16 + fq * 4;
          if (!sample) {
            *(f32x4*)(p.out_v + (size_t)row * 128 + kvh * 64 + d0) = acc[mi][ni];
            bf16_t* vd = p.Vtp + ((size_t)((row >> 8) * 2 + kvh) * 64 + d0) * 256 + (row & 255);
#pragma unroll
            for (int j = 0; j < 4; ++j) vd[j * 256] = f2bf(acc[mi][ni][j]);
          } else {
            bf16_t* vd = p.Vts + ((size_t)(((row - NP) >> 10) * 2 + kvh) * 64 + d0) * 1280 + ((row - NP) & 1023);
#pragma unroll
            for (int j = 0; j < 4; ++j) vd[j * 1280] = f2bf(acc[mi][ni][j]);
          }
        }
      }
    } else {
      const int c0 = col0 - 768, seg = c0 >> 9;
      float oml[4][4];
      if (seg == 1 || seg == 2) {
#pragma unroll
        for (int ni = 0; ni < 4; ++ni)
#pragma unroll
          for (int j = 0; j < 4; ++j) { const int c = (c0 & 511) + ni * 16 + fq * 4 + j; oml[ni][j] = __builtin_amdgcn_rcpf(1.f + __expf(p.hgrn_lb[c] - p.hgrn_lb[512 + c])); }
      }
#pragma unroll
      for (int mi = 0; mi < 4; ++mi) {
        const int row = row0 + mi * 16 + fr;
#pragma unroll
        for (int ni = 0; ni < 4; ++ni) {
          float o[4];
#pragma unroll
          for (int j = 0; j < 4; ++j) {
            const float v = acc[mi][ni][j];
            if (seg == 0 || seg == 4) o[j] = siluf_(v);
            else if (seg == 3) o[j] = v;
            else o[j] = oml[ni][j] * sigmoidf_(-v);
          }
          *(uint2*)(p.HG + (size_t)row * 2560 + c0 + ni * 16 + fq * 4) = make_uint2(pk_bf16(o[0], o[1]), pk_bf16(o[2], o[3]));
        }
      }
    }
  }
};

struct EpiResid {
  const Params* pp; int layer, gidx; bool from_input; bool dry = false;
  __device__ __forceinline__ void operator()(f32x4 (&acc)[4][4], int row0, int col0, int lane) const {
    const Params& p = *pp;
    if (dry && p.njobs >= 0) return;
    const int fr = lane & 15, fq = lane >> 4;
    const float* gt = p.MOD + (size_t)(layer * 9 + mod_index(row0)) * 6144 + gidx * 1024;
#pragma unroll
    for (int mi = 0; mi < 4; ++mi) {
      const int row = row0 + mi * 16 + fr;
      const float* base = from_input ? (row < NP ? p.x_prompt + (size_t)row * 1024 : p.x_sample + (size_t)(row - NP) * 1024) : p.X + (size_t)row * 1024;
#pragma unroll
      for (int ni = 0; ni < 4; ++ni) {
        const int col = col0 + ni * 16 + fq * 4;
        const f32x4 b = *(const f32x4*)(base + col), g = *(const f32x4*)(gt + col);
        *(f32x4*)(p.X + (size_t)row * 1024 + col) = b + g * acc[mi][ni];
      }
    }
  }
};

template <int ACT>
struct EpiAct {
  bf16_t* O; int ldo; const float* bias;
  __device__ __forceinline__ void operator()(f32x4 (&acc)[4][4], int row0, int col0, int lane) const {
    const int fr = lane & 15, fq = lane >> 4;
#pragma unroll
    for (int ni = 0; ni < 4; ++ni) {
      const int col = col0 + ni * 16 + fq * 4;
      f32x4 bv = (f32x4){0.f, 0.f, 0.f, 0.f};
      if (ACT >= 4) bv = *(const f32x4*)(bias + col);
#pragma unroll
      for (int mi = 0; mi < 4; ++mi) {
        const int row = row0 + mi * 16 + fr;
        float o[4];
#pragma unroll
        for (int j = 0; j < 4; ++j) {
          const float v = acc[mi][ni][j] + bv[j];
          if (ACT == 0) o[j] = v;
          else if (ACT == 1) { const float r = fmaxf(v, 0.f); o[j] = r * r; }
          else if (ACT == 2) o[j] = 1.f - 2.f * __builtin_amdgcn_rcpf(1.f + __expf(2.f * v));
          else if (ACT == 3 || ACT == 5) o[j] = sigmoidf_(v);
          else o[j] = 0.60653065971263342f * sigmoidf_(v);
        }
        *(uint2*)(O + (size_t)row * ldo + col) = make_uint2(pk_bf16(o[0], o[1]), pk_bf16(o[2], o[3]));
      }
    }
  }
};

struct EpiRwkvOut {
  const Params* pp;
  __device__ __forceinline__ void operator()(f32x4 (&acc)[4][4], int row0, int col0, int lane) const {
    const Params& p = *pp;
    const int fr = lane & 15, fq = lane >> 4, h = col0 >> 6;
#pragma unroll
    for (int mi = 0; mi < 4; ++mi) {
      const int row = row0 + mi * 16 + fr;
      float y[4][4]; float s = 0.f;
#pragma unroll
      for (int ni = 0; ni < 4; ++ni) {
        const size_t idx = (size_t)row * 1024 + col0 + ni * 16 + fq * 4;
        const uint2 a = *(const uint2*)(p.E0 + idx), b = *(const uint2*)(p.E1 + idx);
        y[ni][0] = bflo(a.x) + bflo(b.x); y[ni][1] = bfhi(a.x) + bfhi(b.x); y[ni][2] = bflo(a.y) + bflo(b.y); y[ni][3] = bfhi(a.y) + bfhi(b.y);
        s += (y[ni][0] + y[ni][1]) + (y[ni][2] + y[ni][3]);
      }
      s += __shfl_xor(s, 16); s += __shfl_xor(s, 32);
      const float mu = s * (1.f / 64.f);
      float q = 0.f;
#pragma unroll
      for (int ni = 0; ni < 4; ++ni)
#pragma unroll
        for (int j = 0; j < 4; ++j) { const float d = y[ni][j] - mu; q += d * d; }
      q += __shfl_xor(q, 16); q += __shfl_xor(q, 32);
      const float rs = rsqrtf(q * (1.f / 64.f) + 64e-5f);
      const float bs = p.BS[(size_t)row * 16 + h] + p.BS[(size_t)NTOK * 16 + (size_t)row * 16 + h];
#pragma unroll
      for (int ni = 0; ni < 4; ++ni) {
        const int col = col0 + ni * 16 + fq * 4;
        const size_t idx = (size_t)row * 1024 + col;
        const uint2 vv = *(const uint2*)(p.Vx + idx);
        const f32x4 lw = *(const f32x4*)(p.ln_w + col), lb = *(const f32x4*)(p.ln_b + col);
        const float v0 = bflo(vv.x), v1 = bfhi(vv.x), v2 = bflo(vv.y), v3 = bfhi(vv.y);
        const float o0 = ((y[ni][0] - mu) * rs * lw[0] + lb[0] + bs * v0) * acc[mi][ni][0];
        const float o1 = ((y[ni][1] - mu) * rs * lw[1] + lb[1] + bs * v1) * acc[mi][ni][1];
        const float o2 = ((y[ni][2] - mu) * rs * lw[2] + lb[2] + bs * v2) * acc[mi][ni][2];
        const float o3 = ((y[ni][3] - mu) * rs * lw[3] + lb[3] + bs * v3) * acc[mi][ni][3];
        *(uint2*)(p.ZO + idx) = make_uint2(pk_bf16(o0, o1), pk_bf16(o2, o3));
      }
    }
  }
};

template <class EP>
__device__ __forceinline__ void gemm_phase(const ALoadPlain& al, const bf16_t* Bt, int K, int ntn, const EP& ep, char* smem) {
  const int nunits = (NTOK / 128) * ntn;
  for (int u = blockIdx.x; u < nunits; u += gridDim.x) gemm_tile_glds(al.A, al.lda, Bt, K, u / ntn, u % ntn, ep, smem);
}

__device__ __forceinline__ void attn_item(const Params& p, int grp, int b, int h, int qb, char* smem) {
  const int tid = threadIdx.x, lane = tid & 63, wid = tid >> 6, qi = lane & 31, g = lane >> 5;
  const int Tk = grp ? 1280 : 256, kvh = h >> 2;
  const int rowbase = grp ? NP + b * 1024 + qb * 128 : b * 256 + qb * 128;
  const bf16_t* Kg = grp ? p.Ks + (size_t)(b * 2 + kvh) * 1280 * 64 : p.Kp + (size_t)(b * 2 + kvh) * 256 * 64;
  const bf16_t* Vg = grp ? p.Vts + (size_t)(b * 2 + kvh) * 64 * 1280 : p.Vtp + (size_t)(b * 2 + kvh) * 64 * 256;
  const int qrow = rowbase + wid * 32 + qi;
  bf16x8 Qf[4];
#pragma unroll
  for (int s = 0; s < 4; ++s) Qf[s] = *(const bf16x8*)(p.Qbuf + (size_t)qrow * 512 + h * 64 + s * 16 + g * 8);
  f32x16 O[2];
#pragma unroll
  for (int i = 0; i < 16; ++i) { O[0][i] = 0.f; O[1][i] = 0.f; }
  float m_run = -1e30f, l_run = 0.f;
  char* sK = smem; char* sV = smem + 16384;
  const int r0 = tid >> 3, c = tid & 7;
  uint4 pk[2], pv[2];
  const int ntile = Tk >> 6;
#define ALOAD(kt) do { _Pragma("unroll") for (int i = 0; i < 2; ++i) { const int r = r0 + 32 * i; pk[i] = *(const uint4*)(Kg + (size_t)((kt) * 64 + r) * 64 + c * 8); pv[i] = *(const uint4*)(Vg + (size_t)r * Tk + (kt) * 64 + c * 8); } } while (0)
#define ASTORE(buf) do { _Pragma("unroll") for (int i = 0; i < 2; ++i) { const int r = r0 + 32 * i; \
      *(uint4*)(sK + (buf) * 8192 + r * 128 + ((c ^ ((r >> 1) & 7)) << 4)) = pk[i]; \
      const int f = (r >> 1) & 15; \
      *(uint2*)(sV + (buf) * 8192 + r * 128 + (((2 * c) ^ f) << 3)) = make_uint2(pv[i].x, pv[i].y); \
      *(uint2*)(sV + (buf) * 8192 + r * 128 + (((2 * c + 1) ^ f) << 3)) = make_uint2(pv[i].z, pv[i].w); } } while (0)
  ALOAD(0); ASTORE(0); __syncthreads();
  for (int kt = 0; kt < ntile; ++kt) {
    const int buf = kt & 1;
    if (kt + 1 < ntile) ALOAD(kt + 1);
    f32x16 S[2];
#pragma unroll
    for (int t2 = 0; t2 < 2; ++t2) {
#pragma unroll
      for (int i = 0; i < 16; ++i) S[t2][i] = 0.f;
#pragma unroll
      for (int s = 0; s < 4; ++s) {
        const int r = t2 * 32 + qi, cc = 2 * s + g;
        const bf16x8 Kf = *(const bf16x8*)(sK + buf * 8192 + r * 128 + ((cc ^ ((r >> 1) & 7)) << 4));
        S[t2] = __builtin_amdgcn_mfma_f32_32x32x16_bf16(Kf, Qf[s], S[t2], 0, 0, 0);
      }
    }
    float mx = S[0][0];
#pragma unroll
    for (int i = 0; i < 16; ++i) { mx = fmaxf(mx, S[0][i]); mx = fmaxf(mx, S[1][i]); }
    mx = fmaxf(mx, __shfl_xor(mx, 32));
    const float m_new = fmaxf(m_run, mx);
    const float alpha = __builtin_amdgcn_exp2f(m_run - m_new);
    float ls = 0.f;
#pragma unroll
    for (int i = 0; i < 16; ++i) { S[0][i] = __builtin_amdgcn_exp2f(S[0][i] - m_new); S[1][i] = __builtin_amdgcn_exp2f(S[1][i] - m_new); ls += S[0][i] + S[1][i]; }
    l_run = l_run * alpha + ls; m_run = m_new;
#pragma unroll
    for (int i = 0; i < 16; ++i) { O[0][i] *= alpha; O[1][i] *= alpha; }
#pragma unroll
    for (int t2 = 0; t2 < 2; ++t2)
#pragma unroll
      for (int sp = 0; sp < 2; ++sp) {
        union { bf16x8 v; unsigned u[4]; } Pf;
#pragma unroll
        for (int e = 0; e < 4; ++e) Pf.u[e] = pk_bf16(S[t2][8 * sp + 2 * e], S[t2][8 * sp + 2 * e + 1]);
#pragma unroll
        for (int ds = 0; ds < 2; ++ds) {
          const int d = ds * 32 + qi, f = (d >> 1) & 15, u1 = 8 * t2 + 4 * sp + g;
          union { bf16x8 v; uint2 u[2]; } Vf;
          Vf.u[0] = *(const uint2*)(sV + buf * 8192 + d * 128 + ((u1 ^ f) << 3));
          Vf.u[1] = *(const uint2*)(sV + buf * 8192 + d * 128 + (((u1 + 2) ^ f) << 3));
          O[ds] = __builtin_amdgcn_mfma_f32_32x32x16_bf16(Vf.v, Pf.v, O[ds], 0, 0, 0);
        }
      }
    if (kt + 1 < ntile) ASTORE(buf ^ 1);
    __syncthreads();
  }
#undef ALOAD
#undef ASTORE
  const float l = l_run + __shfl_xor(l_run, 32);
  const float inv = 1.f / l;
#pragma unroll
  for (int ds = 0; ds < 2; ++ds)
#pragma unroll
    for (int bq = 0; bq < 4; ++bq) {
      const int d0 = ds * 32 + 8 * bq + 4 * g;
      *(uint2*)(p.AO + (size_t)qrow * 1024 + h * 64 + d0) =
          make_uint2(pk_bf16(O[ds][4 * bq] * inv, O[ds][4 * bq + 1] * inv), pk_bf16(O[ds][4 * bq + 2] * inv, O[ds][4 * bq + 3] * inv));
    }
}

__device__ __forceinline__ void hgrn_item(const Params& p, int grp, int b, int h, int dir, int half, char* smem) {
  const int tid = threadIdx.x, v = half * 32 + (tid >> 3), ks = tid & 7;
  const int T = grp ? 1024 : 256, rowbase = grp ? NP + b * 1024 : b * 256;
  if (grp) __builtin_amdgcn_s_setprio(3);
  f32x2 S2[4];
  if (grp) {
    const float* s0 = (dir ? p.hg_b0 : p.hg_f0) + (size_t)(b * 8 + h) * 4096;
#pragma unroll
    for (int i = 0; i < 4; ++i) S2[i] = (f32x2){s0[(ks * 8 + 2 * i) * 64 + v], s0[(ks * 8 + 2 * i + 1) * 64 + v]};
  } else {
#pragma unroll
    for (int i = 0; i < 4; ++i) S2[i] = (f32x2){0.f, 0.f};
  }
  float* obuf = (float*)(smem + 32768);
  const int lt = tid >> 4, lc = (tid & 15) * 4;
  const int kfseg = dir ? 1024 : 512;
  uint2 rq, rk, rv, rq2, rk2, rv2;
  const int nch = T >> 4;
#define HLOADX(cix, q_, k_, v_) do { const int ts = (cix) * 16 + lt; const int tok = dir ? T - 1 - ts : ts; const bf16_t* src = p.HG + (size_t)(rowbase + tok) * 2560 + h * 64 + lc; \
    q_ = *(const uint2*)(src); k_ = *(const uint2*)(src + kfseg); v_ = *(const uint2*)(src + 1536); } while (0)
#define HSTORE(buf) do { float* B = (float*)(smem + (buf) * 16384) + lt * 64 + lc; \
    const float k0 = bflo(rk.x), k1 = bfhi(rk.x), k2 = bflo(rk.y), k3 = bfhi(rk.y); \
    *(float4*)(B) = make_float4(1.f - k0, 1.f - k1, 1.f - k2, 1.f - k3); *(float4*)(B + 1024) = make_float4(k0, k1, k2, k3); \
    *(float4*)(B + 2048) = make_float4(bflo(rq.x), bfhi(rq.x), bflo(rq.y), bfhi(rq.y)); *(float4*)(B + 3072) = make_float4(bflo(rv.x), bfhi(rv.x), bflo(rv.y), bfhi(rv.y)); } while (0)
  HLOADX(0, rq, rk, rv); HSTORE(0);
  HLOADX(1, rq, rk, rv);
  __syncthreads();
  float* OD = dir ? p.OB : p.OF;
  for (int cix = 0; cix < nch; ++cix) {
    const int buf = cix & 1;
    if (cix + 2 < nch) HLOADX(cix + 2, rq2, rk2, rv2);
    const float* B = (const float*)(smem + buf * 16384);
    float* ob = obuf + buf * 512;
    float4 cf[2], ck[2], cq[2]; float cv;
#define HSTEP_LOAD(t_, f_, k_, q_, v_) do { const float* Bt = B + (t_) * 64 + ks * 8; \
      f_[0] = *(const float4*)(Bt); f_[1] = *(const float4*)(Bt + 4); k_[0] = *(const float4*)(Bt + 1024); k_[1] = *(const float4*)(Bt + 1028); \
      q_[0] = *(const float4*)(Bt + 2048); q_[1] = *(const float4*)(Bt + 2052); v_ = B[3072 + (t_) * 64 + v]; } while (0)
    HSTEP_LOAD(0, cf, ck, cq, cv);
#pragma unroll 1
    for (int g = 0; g < 4; ++g) {
      float op[4];
#pragma unroll
      for (int tt = 0; tt < 4; ++tt) {
        const int t = g * 4 + tt;
        float4 nf[2], nk[2], nq[2]; float nv;
        { const int tn_ = (t + 1) & 15; HSTEP_LOAD(tn_, nf, nk, nq, nv); }
        const f32x2 vvv = (f32x2){cv, cv};
        f32x2 o0, o1;
        S2[0] = S2[0] * (f32x2){cf[0].x, cf[0].y} + vvv * (f32x2){ck[0].x, ck[0].y};
        S2[1] = S2[1] * (f32x2){cf[0].z, cf[0].w} + vvv * (f32x2){ck[0].z, ck[0].w};
        S2[2] = S2[2] * (f32x2){cf[1].x, cf[1].y} + vvv * (f32x2){ck[1].x, ck[1].y};
        S2[3] = S2[3] * (f32x2){cf[1].z, cf[1].w} + vvv * (f32x2){ck[1].z, ck[1].w};
        o0 = S2[0] * (f32x2){cq[0].x, cq[0].y}; o1 = S2[1] * (f32x2){cq[0].z, cq[0].w};
        o0 = S2[2] * (f32x2){cq[1].x, cq[1].y} + o0; o1 = S2[3] * (f32x2){cq[1].z, cq[1].w} + o1;
        const f32x2 os = o0 + o1;
        op[tt] = os.x + os.y;
        cf[0] = nf[0]; cf[1] = nf[1]; ck[0] = nk[0]; ck[1] = nk[1]; cq[0] = nq[0]; cq[1] = nq[1]; cv = nv;
      }
      __builtin_amdgcn_sched_barrier(0);
#define DPPADD(x, ctrl) x += __int_as_float(__builtin_amdgcn_update_dpp(0, __float_as_int(x), ctrl, 0xF, 0xF, true))
      DPPADD(op[0], 0xB1); DPPADD(op[1], 0xB1); DPPADD(op[2], 0xB1); DPPADD(op[3], 0xB1);
      DPPADD(op[0], 0x4E); DPPADD(op[1], 0x4E); DPPADD(op[2], 0x4E); DPPADD(op[3], 0x4E);
      DPPADD(op[0], 0x141); DPPADD(op[1], 0x141); DPPADD(op[2], 0x141); DPPADD(op[3], 0x141);
#undef DPPADD
      if (ks == 0) {
#pragma unroll
        for (int tt = 0; tt < 4; ++tt) ob[(g * 4 + tt) * 32 + (tid >> 3)] = op[tt];
      }
      __builtin_amdgcn_sched_barrier(0);
    }
#undef HSTEP_LOAD
    if (cix + 1 < nch) HSTORE(buf ^ 1);
    rq = rq2; rk = rk2; rv = rv2;
    __syncthreads();
    if (tid < 128) {
      const int ft = tid >> 3, fc = (tid & 7) * 4;
      const int ts = cix * 16 + ft; const int tok = dir ? T - 1 - ts : ts;
      *(float4*)(OD + (size_t)(rowbase + tok) * 512 + h * 64 + half * 32 + fc) = *(const float4*)(ob + ft * 32 + fc);
    }
  }
#undef HLOADX
#undef HSTORE
  __builtin_amdgcn_s_setprio(0);
  if (!grp) {
    float* so = (dir ? p.out_hb : p.out_hf) + (size_t)(b * 8 + h) * 4096;
#pragma unroll
    for (int i = 0; i < 4; ++i) { so[(ks * 8 + 2 * i) * 64 + v] = S2[i].x; so[(ks * 8 + 2 * i + 1) * 64 + v] = S2[i].y; }
  }
}

__device__ __forceinline__ void mix0_phase(const Params& p, char* smem) {
  __shared__ int q_item;
  for (;;) {
    if (threadIdx.x == 0) q_item = (int)atomicAdd(&p.bar[0], 1u);
    __syncthreads();
    const int it = q_item;
    __syncthreads();
    if (it >= 1536) break;
    const bool is_h = it < 256 || (it >= 768 && it < 1280);
    if (is_h) {
      const int grp = it < 256 ? 1 : 0, a = grp ? it : it - 768;
      hgrn_item(p, grp, a >> 5, (a >> 2) & 7, (a >> 1) & 1, a & 1, smem);
    } else {
      const int grp = it < 768 ? 1 : 0, a = grp ? it - 256 : it - 1280;
      const int b = grp ? a >> 6 : a >> 4, h = grp ? (a >> 3) & 7 : (a >> 1) & 7, qb = grp ? a & 7 : a & 1;
      attn_item(p, grp, b, h, qb, smem);
    }
    __syncthreads();
  }
}

__device__ __forceinline__ void hgrn_combine_phase(const Params& p) {
  const int gid = blockIdx.x * NT + threadIdx.x, l16 = gid & 15;
  const int ngroups = NTOK * 8;
  for (int grp = gid >> 4; grp < ngroups; grp += (gridDim.x * NT) >> 4) {
    const int row = grp >> 3, h = grp & 7;
    const size_t o = (size_t)row * 512 + h * 64 + l16 * 4;
    const float4 a = *(const float4*)(p.OF + o), b = *(const float4*)(p.OB + o);
    const float y0 = a.x + b.x, y1 = a.y + b.y, y2 = a.z + b.z, y3 = a.w + b.w;
    float ss = y0 * y0 + y1 * y1 + y2 * y2 + y3 * y3;
    ss += __shfl_xor(ss, 1); ss += __shfl_xor(ss, 2); ss += __shfl_xor(ss, 4); ss += __shfl_xor(ss, 8);
    const float rn = rsqrtf(ss * (1.f / 64.f) + 1e-6f);
    const float4 gn = *(const float4*)(p.g_norm + l16 * 4);
    const uint2 gt = *(const uint2*)(p.HG + (size_t)row * 2560 + 2048 + h * 64 + l16 * 4);
    *(uint2*)(p.AO + (size_t)row * 1024 + 512 + h * 64 + l16 * 4) =
        make_uint2(pk_bf16(y0 * rn * gn.x * bflo(gt.x), y1 * rn * gn.y * bfhi(gt.x)), pk_bf16(y2 * rn * gn.z * bflo(gt.y), y3 * rn * gn.w * bfhi(gt.y)));
  }
}

__device__ __forceinline__ void rwkv_item(const Params& p, int grp, int b, int h, int dir, char* smem, bool dry = false) {
  const bool wr = !(dry && p.njobs >= 0);
  if (grp) __builtin_amdgcn_s_setprio(3);
  const int tid = threadIdx.x, lane = tid & 63, wid = tid >> 6, v = tid >> 2, ks = tid & 3;
  const int T = grp ? 1024 : 256, rowbase = grp ? NP + b * 1024 : b * 256;
  const int vp = tid >> 3, k8 = tid & 7;
  f32x2 Sa[4], Sb[4];
  if (grp) {
    const float* s0 = (dir ? p.rw_b0 : p.rw_f0) + ((size_t)(b * 16 + h) * 64 + vp) * 64 + k8 * 8;
#pragma unroll
    for (int q = 0; q < 2; ++q) {
      const float4 t = *(const float4*)(s0 + q * 4), u = *(const float4*)(s0 + 2048 + q * 4);
      Sa[2 * q] = (f32x2){t.x, t.y}; Sa[2 * q + 1] = (f32x2){t.z, t.w}; Sb[2 * q] = (f32x2){u.x, u.y}; Sb[2 * q + 1] = (f32x2){u.z, u.w};
    }
  } else {
#pragma unroll
    for (int i = 0; i < 4; ++i) { Sa[i] = (f32x2){0.f, 0.f}; Sb[i] = (f32x2){0.f, 0.f}; }
  }
  const bf16_t* E = dir ? p.E1 : p.E0; const bf16_t* A = dir ? p.A1 : p.A0; bf16_t* Y = dir ? p.E1 : p.E0;
  const int lt = tid >> 4, lc = (tid & 15) * 4;
  const float4 kkc = *(const float4*)(p.k_k + h * 64 + lc), kac = *(const float4*)(p.k_a + h * 64 + lc), rkc = *(const float4*)(p.r_k + h * 64 + lc);
  float* BSd = p.BS + (size_t)dir * NTOK * 16;
  float* ybuf = (float*)(smem + 49152);
  uint2 gr, gk, gv, ge, ga;
  const int nch = T >> 4;
#define RLOAD(cix) do { const int ts = (cix) * 16 + lt; const int tok = dir ? T - 1 - ts : ts; const size_t idx = (size_t)(rowbase + tok) * 1024 + h * 64 + lc; \
    gr = *(const uint2*)(p.R + idx); gk = *(const uint2*)(p.Kx + idx); gv = *(const uint2*)(p.Vx + idx); ge = *(const uint2*)(E + idx); ga = *(const uint2*)(A + idx); } while (0)
#define RSTORE(cix, buf) do { const int ts = (cix) * 16 + lt; const int tok = dir ? T - 1 - ts : ts; \
    const float r_[4] = {bflo(gr.x), bfhi(gr.x), bflo(gr.y), bfhi(gr.y)}, k_[4] = {bflo(gk.x), bfhi(gk.x), bflo(gk.y), bfhi(gk.y)}; \
    const float e_[4] = {bflo(ge.x), bfhi(ge.x), bflo(ge.y), bfhi(ge.y)}, a_[4] = {bflo(ga.x), bfhi(ga.x), bflo(ga.y), bfhi(ga.y)}; \
    const float kc_[4] = {kkc.x, kkc.y, kkc.z, kkc.w}, ac_[4] = {kac.x, kac.y, kac.z, kac.w}, rc_[4] = {rkc.x, rkc.y, rkc.z, rkc.w}; \
    float kx[4], kd[4], ssq = 0.f, bsum = 0.f; \
    _Pragma("unroll") for (int j = 0; j < 4; ++j) { kx[j] = k_[j] * kc_[j]; ssq += kx[j] * kx[j]; kd[j] = k_[j] * (1.f + (a_[j] - 1.f) * ac_[j]); bsum += r_[j] * kd[j] * rc_[j]; } \
    ssq = hex_sum(ssq); bsum = hex_sum(bsum); const float rn = rsqrtf(fmaxf(ssq, 1e-24f)); \
    float* B = (float*)(smem + (buf) * 24576) + lt * 64 + lc; \
    *(float4*)(B) = make_float4(__expf(-e_[0]), __expf(-e_[1]), __expf(-e_[2]), __expf(-e_[3])); \
    *(float4*)(B + 1024) = make_float4(kx[0] * rn, kx[1] * rn, kx[2] * rn, kx[3] * rn); \
    *(float4*)(B + 2048) = make_float4(kx[0] * rn * a_[0], kx[1] * rn * a_[1], kx[2] * rn * a_[2], kx[3] * rn * a_[3]); \
    *(float4*)(B + 3072) = make_float4(kd[0], kd[1], kd[2], kd[3]); \
    *(float4*)(B + 4096) = make_float4(r_[0], r_[1], r_[2], r_[3]); \
    *(float4*)(B + 5120) = make_float4(bflo(gv.x), bfhi(gv.x), bflo(gv.y), bfhi(gv.y)); \
    if ((tid & 15) == 0 && wr) BSd[(size_t)(rowbase + tok) * 16 + h] = bsum; } while (0)
  RLOAD(0); RSTORE(0, 0); __syncthreads();
  for (int cix = 0; cix < nch; ++cix) {
    const int buf = cix & 1;
    if (cix + 1 < nch) RLOAD(cix + 1);
    const float* B = (const float*)(smem + buf * 24576);
    float* yb = ybuf + buf * 1024;
    float4 cw[2], ck[2], ca[2], cd[2], cr[2]; float cva, cvb;
#define RSTEP_LOAD(t_, w_, k_, a_, d_, r_, va_, vb_) do { const float* Bt = B + (t_) * 64 + k8 * 8; \
      w_[0] = *(const float4*)(Bt); w_[1] = *(const float4*)(Bt + 4); k_[0] = *(const float4*)(Bt + 1024); k_[1] = *(const float4*)(Bt + 1028); \
      a_[0] = *(const float4*)(Bt + 2048); a_[1] = *(const float4*)(Bt + 2052); d_[0] = *(const float4*)(Bt + 3072); d_[1] = *(const float4*)(Bt + 3076); \
      r_[0] = *(const float4*)(Bt + 4096); r_[1] = *(const float4*)(Bt + 4100); va_ = B[5120 + (t_) * 64 + vp]; vb_ = B[5120 + (t_) * 64 + vp + 32]; } while (0)
    RSTEP_LOAD(0, cw, ck, ca, cd, cr, cva, cvb);
#pragma unroll
    for (int t = 0; t < 16; ++t) {
      float4 nw[2], nk[2], na[2], nd[2], nr[2]; float nva = 0.f, nvb = 0.f;
      if (t + 1 < 16) RSTEP_LOAD(t + 1, nw, nk, na, nd, nr, nva, nvb);
      f32x2 w2[4], kk2[4];
#pragma unroll
      for (int q = 0; q < 2; ++q) {
        w2[2 * q] = (f32x2){cw[q].x, cw[q].y}; w2[2 * q + 1] = (f32x2){cw[q].z, cw[q].w};
        kk2[2 * q] = (f32x2){ck[q].x, ck[q].y}; kk2[2 * q + 1] = (f32x2){ck[q].z, ck[q].w};
      }
      const f32x2 sa_a = (Sa[0] * kk2[0] + Sa[1] * kk2[1]) + (Sa[2] * kk2[2] + Sa[3] * kk2[3]);
      const f32x2 sa_b = (Sb[0] * kk2[0] + Sb[1] * kk2[1]) + (Sb[2] * kk2[2] + Sb[3] * kk2[3]);
      const float saa = -oct_sum(sa_a.x + sa_a.y), sab = -oct_sum(sa_b.x + sa_b.y);
      const f32x2 saav = (f32x2){saa, saa}, sabv = (f32x2){sab, sab}, vav = (f32x2){cva, cva}, vbv = (f32x2){cvb, cvb};
      f32x2 ya = (f32x2){0.f, 0.f}, yb2 = (f32x2){0.f, 0.f};
#pragma unroll
      for (int q = 0; q < 2; ++q) {
        const f32x2 ka0 = (f32x2){ca[q].x, ca[q].y}, ka1 = (f32x2){ca[q].z, ca[q].w}, kd0 = (f32x2){cd[q].x, cd[q].y}, kd1 = (f32x2){cd[q].z, cd[q].w};
        const f32x2 r0 = (f32x2){cr[q].x, cr[q].y}, r1 = (f32x2){cr[q].z, cr[q].w};
        Sa[2 * q] = Sa[2 * q] * w2[2 * q] + (vav * kd0 + saav * ka0); Sa[2 * q + 1] = Sa[2 * q + 1] * w2[2 * q + 1] + (vav * kd1 + saav * ka1);
        Sb[2 * q] = Sb[2 * q] * w2[2 * q] + (vbv * kd0 + sabv * ka0); Sb[2 * q + 1] = Sb[2 * q + 1] * w2[2 * q + 1] + (vbv * kd1 + sabv * ka1);
        ya = Sa[2 * q] * r0 + ya; ya = Sa[2 * q + 1] * r1 + ya;
        yb2 = Sb[2 * q] * r0 + yb2; yb2 = Sb[2 * q + 1] * r1 + yb2;
      }
      const float y_a = oct_sum(ya.x + ya.y), y_b = oct_sum(yb2.x + yb2.y);
      if (k8 == 0) { yb[t * 64 + vp] = y_a; yb[t * 64 + vp + 32] = y_b; }
      if (t + 1 < 16) {
#pragma unroll
        for (int q = 0; q < 2; ++q) { cw[q] = nw[q]; ck[q] = nk[q]; ca[q] = na[q]; cd[q] = nd[q]; cr[q] = nr[q]; }
        cva = nva; cvb = nvb;
      }
    }
#undef RSTEP_LOAD
    if (cix + 1 < nch) RSTORE(cix + 1, buf ^ 1);
    __syncthreads();
    {
      const int ts = cix * 16 + lt; const int tok = dir ? T - 1 - ts : ts;
      const float4 yy = *(const float4*)(yb + lt * 64 + lc);
      if (wr) *(uint2*)(Y + (size_t)(rowbase + tok) * 1024 + h * 64 + lc) = make_uint2(pk_bf16(yy.x, yy.y), pk_bf16(yy.z, yy.w));
    }
  }
#undef RLOAD
#undef RSTORE
  __builtin_amdgcn_s_setprio(0);
  if (!grp && wr) {
    float* so = (dir ? p.out_rb : p.out_rf) + ((size_t)(b * 16 + h) * 64 + vp) * 64 + k8 * 8;
#pragma unroll
    for (int q = 0; q < 2; ++q) {
      *(float4*)(so + q * 4) = make_float4(Sa[2 * q].x, Sa[2 * q].y, Sa[2 * q + 1].x, Sa[2 * q + 1].y);
      *(float4*)(so + 2048 + q * 4) = make_float4(Sb[2 * q].x, Sb[2 * q].y, Sb[2 * q + 1].x, Sb[2 * q + 1].y);
    }
  }
}

__device__ __forceinline__ void rwkv_scan_phase(const Params& p, char* smem, bool dry = false) {
  const int G = gridDim.x;
  if (G >= 512) {
    if (blockIdx.x < 256) { const int a = blockIdx.x; rwkv_item(p, 1, a >> 5, (a >> 1) & 15, a & 1, smem, dry); }
    else for (int a = blockIdx.x - 256; a < 512; a += G - 256) { rwkv_item(p, 0, a >> 5, (a >> 1) & 15, a & 1, smem, dry); __syncthreads(); }
  } else {
    for (int it = blockIdx.x; it < 768; it += G) {
      const int grp = it < 256 ? 1 : 0, a = grp ? it : it - 256;
      rwkv_item(p, grp, a >> 5, (a >> 1) & 15, a & 1, smem, dry);
      __syncthreads();
    }
  }
}

__device__ __forceinline__ void blend_phase(const Params& p) {
  const int gid = blockIdx.x * NT + threadIdx.x, nth = gridDim.x * NT;
  for (int i = gid; i < NTOK * 128; i += nth) {
    const int row = i >> 7, k = (i & 127) * 8;
    ALoadShift a0{p.H, p.mix + 0 * 1024}, a2{p.H, p.mix + 2 * 1024}, a3{p.H, p.mix + 3 * 1024};
    const size_t o = (size_t)row * 1024 + k;
    *(uint4*)(p.E0 + o) = a0(row, k); *(uint4*)(p.E1 + o) = a2(row, k); *(uint4*)(p.A1 + o) = a3(row, k);
  }
}

__device__ __forceinline__ void rwkv_proj_phase(const Params& p, char* smem) {
  const int nunits = 96 * 27;
  for (int u = blockIdx.x; u < nunits; u += gridDim.x) {
    const int tm = u < 288 ? u / 3 : (u - 288) / 24, s = u < 288 ? 24 + u % 3 : (u - 288) % 24;
    if (s < 8) { EpiAct<0> ep{p.R, 1024, nullptr}; gemm_tile_glds(p.E0, 1024, p.wr_t, 1024, tm, s, ep, smem); }
    else if (s < 16) { EpiAct<0> ep{p.Kx, 1024, nullptr}; gemm_tile_glds(p.E1, 1024, p.wk_t, 1024, tm, s - 8, ep, smem); }
    else if (s < 24) { EpiAct<0> ep{p.Vx, 1024, nullptr}; gemm_tile_glds(p.A1, 1024, p.wv_t, 1024, tm, s - 16, ep, smem); }
    else if (s == 24) { ALoadShift al{p.H, p.mix + 1 * 1024}; EpiAct<2> ep{p.LW, 128, nullptr}; gemm_tile(al, p.w1cat_t, 1024, tm, 0, ep, smem); }
    else if (s == 25) { ALoadShift al{p.H, p.mix + 4 * 1024}; EpiAct<0> ep{p.LA, 128, nullptr}; gemm_tile(al, p.a1cat_t, 1024, tm, 0, ep, smem); }
    else { ALoadShift al{p.H, p.mix + 5 * 1024}; EpiAct<3> ep{p.LG, 128, nullptr}; gemm_tile(al, p.g1_t, 1024, tm, 0, ep, smem); }
  }
}
__device__ __forceinline__ void rwkv_lora2_phase(const Params& p, char* smem) {
  const int nunits = 96 * 32;
  for (int u = blockIdx.x; u < nunits; u += gridDim.x) {
    const int tm = u >> 5, s = u & 31, which = s >> 3, tn = s & 7;
    const int d = which & 1;
    if (which < 2) { ALoadPlain al{p.LW + d * 64, 128}; EpiAct<4> ep{d ? p.E1 : p.E0, 1024, p.w0 + d * 1024}; gemm_tile_glds(al.A, al.lda, p.w2_t + (size_t)d * 65536, 64, tm, tn, ep, smem); }
    else { ALoadPlain al{p.LA + d * 64, 128}; EpiAct<5> ep{d ? p.A1 : p.A0, 1024, p.a0 + d * 1024}; gemm_tile_glds(al.A, al.lda, p.a2_t + (size_t)d * 65536, 64, tm, tn, ep, smem); }
  }
}


#define XB_TMO      128
#define XB_XCNT(j)  (256  + 64 * (j))
#define XB_XSUB(j)  (1280 + 64 * (j))
#define XB_XGEN(j)  (2304 + 64 * (j))
#define XB_TOP      3328
#define XB_TOPGEN   3392
#define XCD_BAR_WORDS 3456
#define XB_SPIN_CAP (1u << 22)
#define LAS __attribute__((address_space(3)))
__device__ __forceinline__ unsigned xb_ld(unsigned* p)              { return __hip_atomic_load(p, __ATOMIC_RELAXED, __HIP_MEMORY_SCOPE_AGENT); }
__device__ __forceinline__ unsigned xb_add(unsigned* p, unsigned v) { return __hip_atomic_fetch_add(p, v, __ATOMIC_RELAXED, __HIP_MEMORY_SCOPE_AGENT); }
__device__ __forceinline__ unsigned xb_xcc_id() { return (unsigned)__builtin_amdgcn_s_getreg((3 << 11) | 20) & 0xFu; }
#define XB_SPIN(cond, bar) do { unsigned _sp = 0; while (cond) { __builtin_amdgcn_s_sleep(1); \
    if ((++_sp & 255u) == 0u) { if (xb_ld(&(bar)[XB_TMO])) break; if (_sp > XB_SPIN_CAP) { atomicAdd(&(bar)[XB_TMO], 1u); break; } } } } while (0)
struct XcdBarrier { unsigned* bar; unsigned x; volatile LAS unsigned* st; };
__device__ __forceinline__ XcdBarrier xcd_barrier_post(unsigned* bar, volatile LAS unsigned* st) {
    XcdBarrier b; b.bar = bar; b.x = xb_xcc_id(); b.st = st;
    if (threadIdx.x == 0) (void)xb_add(&bar[XB_XCNT(b.x)], 1u);
    return b;
}
__device__ __forceinline__ void xcd_barrier_complete(unsigned* bar, unsigned x, unsigned& nloc, unsigned& nx) {
    const unsigned G = gridDim.x * gridDim.y * gridDim.z;
    unsigned sum, cnt, mine, sp = 0u;
    for (;;) {
        sum = 0u; cnt = 0u; mine = 0u;
#pragma unroll
        for (unsigned j = 0; j < 16; ++j) { const unsigned c = xb_ld(&bar[XB_XCNT(j)]); sum += c; cnt += (c > 0u) ? 1u : 0u; mine = (j == x) ? c : mine; }
        if (sum == G) break;
        __builtin_amdgcn_s_sleep(1);
        if ((++sp & 255u) == 0u) { if (xb_ld(&bar[XB_TMO])) break; if (sp > XB_SPIN_CAP) { atomicAdd(&bar[XB_TMO], 1u); break; } }
    }
    nloc = mine > 0u ? mine : 1u; nx = cnt > 0u ? cnt : 1u;
}
__device__ __forceinline__ void xcd_barrier(const XcdBarrier& b) {
    asm volatile("s_waitcnt vmcnt(0)" ::: "memory");
    __syncthreads();
    if (threadIdx.x == 0) {
        unsigned* bar = b.bar;
        __builtin_amdgcn_s_waitcnt(0);
        unsigned nloc = b.st[0], nx = b.st[1];
        if (nloc == 0u) { xcd_barrier_complete(bar, b.x, nloc, nx); b.st[0] = nloc; b.st[1] = nx; }
        const unsigned old = xb_add(&bar[XB_XSUB(b.x)], 1u);
        const unsigned gen = old / nloc;
        if (old + 1u == (gen + 1u) * nloc) {
            __builtin_amdgcn_fence(__ATOMIC_RELEASE, "agent");
            asm volatile("s_waitcnt vmcnt(0)" ::: "memory");
            const unsigned og = xb_add(&bar[XB_TOP], 1u);
            const unsigned tg = og / nx;
            if (og + 1u == (tg + 1u) * nx) xb_add(&bar[XB_TOPGEN], 1u);
            else XB_SPIN(xb_ld(&bar[XB_TOPGEN]) == tg, bar);
            __builtin_amdgcn_fence(__ATOMIC_ACQUIRE, "agent");
            xb_add(&bar[XB_XGEN(b.x)], 1u);
            asm volatile("s_waitcnt vmcnt(0)" ::: "memory");
        } else {
            XB_SPIN(xb_ld(&bar[XB_XGEN(b.x)]) == gen, bar);
            __builtin_amdgcn_fence(__ATOMIC_ACQUIRE, "agent");
            asm volatile("s_waitcnt vmcnt(0)" ::: "memory");
        }
    }
    __syncthreads();
}

__device__ __forceinline__ void run_phase(const Params& p, int ph, char* smem, bool dry = false) {
  switch (ph) {
    case 0: if (ONLY_PHASE < 0 || ONLY_PHASE == 0) phase0(p, smem); break;
    case 1: if (ONLY_PHASE < 0 || ONLY_PHASE == 1) prenorm_phase(p, 0, 0, true); break;
    case 2: if (ONLY_PHASE < 0 || ONLY_PHASE == 2) { ALoadPlain al{p.H, 1024}; EpiWin ep{&p}; gemm_phase(al, p.w_in_t, 1024, 26, ep, smem); } break;
    case 3: if (ONLY_PHASE < 0 || ONLY_PHASE == 3) mix0_phase(p, smem); break;
    case 4: if (ONLY_PHASE < 0 || ONLY_PHASE == 4) hgrn_combine_phase(p); break;
    case 5: if (ONLY_PHASE < 0 || ONLY_PHASE == 5) { ALoadPlain al{p.AO, 1024}; EpiResid ep{&p, 0, 2, true}; gemm_phase(al, p.w_out_t, 1024, 8, ep, smem); } break;
    case 6: if (ONLY_PHASE < 0 || ONLY_PHASE == 6) prenorm_phase(p, 0, 1, false); break;
    case 7: if (ONLY_PHASE < 0 || ONLY_PHASE == 7) { ALoadPlain al{p.H, 1024}; EpiAct<1> ep{p.U, 4096, nullptr}; gemm_phase(al, p.mlp1_t, 1024, 32, ep, smem); } break;
    case 8: if (ONLY_PHASE < 0 || ONLY_PHASE == 8) { ALoadPlain al{p.U, 4096}; EpiResid ep{&p, 0, 5, false, dry}; gemm_phase(al, p.mlp2_t, 4096, 8, ep, smem); } break;
    case 9: if (ONLY_PHASE < 0 || ONLY_PHASE == 9) prenorm_phase(p, 1, 0, false); break;
    case 10: if (ONLY_PHASE < 0 || ONLY_PHASE == 10) rwkv_proj_phase(p, smem); break;
    case 11: if (ONLY_PHASE < 0 || ONLY_PHASE == 11) rwkv_lora2_phase(p, smem); break;
    case 12: if (ONLY_PHASE < 0 || ONLY_PHASE == 12) rwkv_scan_phase(p, smem, dry); break;
    case 13: if (ONLY_PHASE < 0 || ONLY_PHASE == 13) { ALoadPlain al{p.LG, 128}; EpiRwkvOut ep{&p}; gemm_phase(al, p.g2_t, 128, 8, ep, smem); } break;
    case 14: if (ONLY_PHASE < 0 || ONLY_PHASE == 14) { ALoadPlain al{p.ZO, 1024}; EpiResid ep{&p, 1, 2, false, dry}; gemm_phase(al, p.wo_t, 1024, 8, ep, smem); } break;
    case 15: if (ONLY_PHASE < 0 || ONLY_PHASE == 15) prenorm_phase(p, 1, 1, false); break;
    case 16: if (ONLY_PHASE < 0 || ONLY_PHASE == 16) { ALoadPlain al{p.H, 1024}; EpiAct<1> ep{p.U, 4096, nullptr}; gemm_phase(al, p.mlp1_t + (size_t)4096 * 1024, 1024, 32, ep, smem); } break;
    case 17: if (ONLY_PHASE < 0 || ONLY_PHASE == 17) { ALoadPlain al{p.U, 4096}; EpiResid ep{&p, 1, 5, false, dry}; gemm_phase(al, p.mlp2_t + (size_t)4096 * 1024, 4096, 8, ep, smem); } break;
    case 18: blend_phase(p); break;
    default: break;
  }
}

__global__ void __launch_bounds__(NT, 2) fwd_kernel(const Params p_unused, int ph_lo, int ph_hi) {
  const Params& p = *(const Params*)__builtin_amdgcn_kernarg_segment_ptr();
  __shared__ __attribute__((aligned(16))) char smem[65536];
  __shared__ uint4 xb_words;
  if (threadIdx.x == 0) xb_words = make_uint4(0u, 0u, 0u, 0u);
  __syncthreads();
  XcdBarrier xb = xcd_barrier_post(p.bar, (volatile LAS unsigned*)&xb_words);
  if (ph_hi < 0) cg::this_grid().sync();
#ifndef PROBE_MASK
#define PROBE_MASK 0
#endif
#ifndef PROBE_DRY
#define PROBE_DRY 0
#endif
#define PHASE(n, sync_) { if ((PROBE_MASK >> n) & 1) { run_phase(p, n, smem); xcd_barrier(xb); } if ((PROBE_DRY >> n) & 1) { run_phase(p, n, smem, true); xcd_barrier(xb); } run_phase(p, n, smem); if (sync_) xcd_barrier(xb); }
  PHASE(0, 1) PHASE(1, 1) PHASE(2, 1) PHASE(3, 1) PHASE(4, 1) PHASE(5, 1) PHASE(6, 1) PHASE(7, 1) PHASE(8, 1) PHASE(9, 1) PHASE(18, 1)
  PHASE(10, 1) PHASE(11, 1) PHASE(12, 1) PHASE(13, 1) PHASE(14, 1) PHASE(15, 1) PHASE(16, 1) PHASE(17, 0)
#undef PHASE
}

extern "C" void kernel_launch(void* const* d_in, const int* in_sizes, int n_in, void* d_out, int out_size, void* d_ws, size_t ws_size, hipStream_t stream) {
  Params p; memset(&p, 0, sizeof(p));
  auto F = [&](int i) { return (const float*)d_in[i]; };
  p.x_prompt = F(0); p.x_sample = F(1); p.cache_k = F(2); p.cache_v = F(3); p.hg_f0 = F(4); p.hg_b0 = F(5); p.rw_f0 = F(6); p.rw_b0 = F(7);
  p.c = F(8); p.c_ctx = F(9); p.ada_w = F(10); p.ada_b = F(11); p.norm1_w = F(12); p.norm2_w = F(13);
  p.q_norm = F(16); p.k_norm = F(17); p.hgrn_lb = F(18); p.g_norm = F(19); p.mix = F(20);
  p.w0 = F(25); p.a0 = F(28); p.k_k = F(33); p.k_a = F(34); p.r_k = F(35); p.ln_w = F(36); p.ln_b = F(37);
  float* out = (float*)d_out;
  p.X = out; p.out_k = out + 12582912; p.out_v = out + 13107200; p.out_hf = out + 13631488; p.out_hb = out + 14155776;
  p.out_rf = out + 14680064; p.out_rb = out + 15728640;
  char* ws = (char*)d_ws; size_t off = 16384;
  p.bar = (unsigned*)ws;
  auto alloc = [&](size_t bytes) { char* r = ws + off; off += (bytes + 255) & ~(size_t)255; return r; };
  const size_t M1 = (size_t)1024 * 1024;
  p.w_in_t = (bf16_t*)alloc((size_t)3328 * 1024 * 2); p.w_out_t = (bf16_t*)alloc(M1 * 2);
  p.wr_t = (bf16_t*)alloc(M1 * 2); p.wk_t = (bf16_t*)alloc(M1 * 2); p.wv_t = (bf16_t*)alloc(M1 * 2); p.wo_t = (bf16_t*)alloc(M1 * 2);
  p.w1cat_t = (bf16_t*)alloc(128 * 1024 * 2); p.a1cat_t = (bf16_t*)alloc(128 * 1024 * 2); p.g1_t = (bf16_t*)alloc(128 * 1024 * 2);
  p.w2_t = (bf16_t*)alloc(2 * 1024 * 64 * 2); p.a2_t = (bf16_t*)alloc(2 * 1024 * 64 * 2); p.g2_t = (bf16_t*)alloc(1024 * 128 * 2);
  p.mlp1_t = (bf16_t*)alloc(2 * 4 * M1 * 2); p.mlp2_t = (bf16_t*)alloc(2 * 4 * M1 * 2);
  p.MOD = (float*)alloc((size_t)2 * 9 * 6144 * 4);
  const size_t TOKD = (size_t)NTOK * 1024;
  p.H = (bf16_t*)alloc(TOKD * 2);
  const size_t regL = off;
  p.Qbuf = (bf16_t*)alloc((size_t)NTOK * 512 * 2);
  p.Kp = (bf16_t*)alloc((size_t)32 * 256 * 64 * 2); p.Ks = (bf16_t*)alloc((size_t)16 * 1280 * 64 * 2);
  p.Vtp = (bf16_t*)alloc((size_t)32 * 64 * 256 * 2); p.Vts = (bf16_t*)alloc((size_t)16 * 64 * 1280 * 2);
  p.HG = (bf16_t*)alloc((size_t)NTOK * 2560 * 2);
  p.OF = (float*)alloc((size_t)NTOK * 512 * 4); p.OB = (float*)alloc((size_t)NTOK * 512 * 4);
  p.AO = (bf16_t*)alloc(TOKD * 2);
  size_t end0 = off;
  off = regL; p.U = (bf16_t*)alloc((size_t)NTOK * 4096 * 2);
  size_t endU = off;
  off = regL;
  p.R = (bf16_t*)alloc(TOKD * 2); p.Kx = (bf16_t*)alloc(TOKD * 2); p.Vx = (bf16_t*)alloc(TOKD * 2);
  p.LW = (bf16_t*)alloc((size_t)NTOK * 128 * 2); p.LA = (bf16_t*)alloc((size_t)NTOK * 128 * 2); p.LG = (bf16_t*)alloc((size_t)NTOK * 128 * 2);
  p.E0 = (bf16_t*)alloc(TOKD * 2); p.E1 = (bf16_t*)alloc(TOKD * 2); p.A1 = (bf16_t*)alloc(TOKD * 2);
  p.BS = (float*)alloc((size_t)2 * NTOK * 16 * 4);
  p.A0 = p.H; p.ZO = p.R;
  size_t end1 = off;
  size_t need = end0 > end1 ? end0 : end1; if (endU > need) need = endU;
  if (need > ws_size) fprintf(stderr, "workspace too small: need %zu have %zu\n", need, ws_size);
  int nj = 0, tiles = 0;
  auto job = [&](const float* src, bf16_t* dst, int K, int N) { p.jobs[nj].src = src; p.jobs[nj].dst = dst; p.jobs[nj].K = K; p.jobs[nj].N = N; p.jobs[nj].tile0 = tiles; p.jobs[nj].pad = 0; tiles += (K / 64) * (N / 64); ++nj; };
  job(F(38), p.mlp1_t, 1024, 4096); job(F(38) + 4 * M1, p.mlp1_t + 4 * M1, 1024, 4096);
  job(F(39), p.mlp2_t, 4096, 1024); job(F(39) + 4 * M1, p.mlp2_t + 4 * M1, 4096, 1024);
  job(F(14), p.w_in_t, 1024, 3328); job(F(15), p.w_out_t, 1024, 1024);
  job(F(21), p.wr_t, 1024, 1024); job(F(22), p.wk_t, 1024, 1024); job(F(23), p.wv_t, 1024, 1024); job(F(24), p.wo_t, 1024, 1024);
  job(F(26), p.w1cat_t, 1024, 64); job(F(26) + 65536, p.w1cat_t + 65536, 1024, 64);
  job(F(29), p.a1cat_t, 1024, 64); job(F(29) + 65536, p.a1cat_t + 65536, 1024, 64);
  job(F(31), p.g1_t, 1024, 128);
  job(F(27), p.w2_t, 64, 1024); job(F(27) + 65536, p.w2_t + 65536, 64, 1024);
  job(F(30), p.a2_t, 64, 1024); job(F(30) + 65536, p.a2_t + 65536, 64, 1024);
  job(F(32), p.g2_t, 128, 1024);
  p.njobs = nj; p.ntiles = tiles;

  static int grid_blocks = 0;
  if (!grid_blocks) {
    int dev = 0, cus = 0, per_cu = 0;
    hipGetDevice(&dev);
    hipDeviceGetAttribute(&cus, hipDeviceAttributeMultiprocessorCount, dev);
    hipOccupancyMaxActiveBlocksPerMultiprocessor(&per_cu, fwd_kernel, NT, 0);
    if (per_cu > 2) per_cu = 2;
    if (per_cu < 1) per_cu = 1;
    grid_blocks = cus * per_cu;
  }
  hipMemsetAsync(d_ws, 0, 16384, stream);
#if ONE_LAUNCH
  int lo = 0, hi = NPHASES;
  void* args[] = {(void*)&p, (void*)&lo, (void*)&hi};
  hipError_t e = hipLaunchCooperativeKernel((void*)fwd_kernel, dim3(grid_blocks), dim3(NT), args, 0, stream);
  if (e != hipSuccess) fprintf(stderr, "cooperative launch failed: %s (grid %d)\n", hipGetErrorString(e), grid_blocks);
#else
  for (int ph = 0; ph < NPHASES; ++ph) hipLaunchKernelGGL(fwd_kernel, dim3(grid_blocks), dim3(NT), 0, stream, p, ph, ph + 1);
#endif
}
```

```cpp
#include <hip/hip_runtime.h>
#include <hip/hip_cooperative_groups.h>
#include <stdint.h>
#include <string.h>
#include <stdio.h>
namespace cg = cooperative_groups;

typedef unsigned short bf16_t;
typedef short bf16x8 __attribute__((ext_vector_type(8)));
typedef float f32x4 __attribute__((ext_vector_type(4)));
typedef float f32x16 __attribute__((ext_vector_type(16)));
typedef float f32x2 __attribute__((ext_vector_type(2)));

#define NT 256
#define NTOK 12288
#define NP 4096
#define NPHASES 18
#ifndef ONLY_PHASE
#define ONLY_PHASE -1
#endif

struct TJob { const float* src; bf16_t* dst; int K, N, tile0, pad; };

struct Params {
  const float *x_prompt, *x_sample, *cache_k, *cache_v, *hg_f0, *hg_b0, *rw_f0, *rw_b0, *c, *c_ctx;
  const float *ada_w, *ada_b, *norm1_w, *norm2_w, *q_norm, *k_norm, *hgrn_lb, *g_norm;
  const float *mix, *w0, *a0, *k_k, *k_a, *r_k, *ln_w, *ln_b;
  float *X, *out_k, *out_v, *out_hf, *out_hb, *out_rf, *out_rb;
  bf16_t *w_in_t, *w_out_t, *wr_t, *wk_t, *wv_t, *wo_t, *w1cat_t, *a1cat_t, *g1_t, *w2_t, *a2_t, *g2_t, *mlp1_t, *mlp2_t;
  float* MOD;
  bf16_t* H;
  bf16_t *Qbuf, *Kp, *Ks, *Vtp, *Vts, *HG, *AO, *U;
  float *OF, *OB;
  bf16_t *R, *Kx, *Vx, *LW, *LA, *LG, *E0, *E1, *A0, *A1, *ZO;
  float* BS;
  unsigned* bar;
  TJob jobs[20];
  int njobs, ntiles;
};

typedef float f32x2c __attribute__((ext_vector_type(2)));
typedef __bf16 bf16v2 __attribute__((ext_vector_type(2)));
__device__ __forceinline__ unsigned pk_bf16(float lo, float hi) { f32x2c v = {lo, hi}; bf16v2 b = __builtin_convertvector(v, bf16v2); return __builtin_bit_cast(unsigned, b); }
__device__ __forceinline__ bf16_t f2bf(float v) { return (bf16_t)(pk_bf16(v, 0.f) & 0xffffu); }
__device__ __forceinline__ float bf2f(bf16_t v) { return __uint_as_float(((unsigned)v) << 16); }
__device__ __forceinline__ float bflo(unsigned u) { return __uint_as_float(u << 16); }
__device__ __forceinline__ float bfhi(unsigned u) { return __uint_as_float(u & 0xffff0000u); }
__device__ __forceinline__ float sigmoidf_(float x) { return __builtin_amdgcn_rcpf(1.f + __expf(-x)); }
__device__ __forceinline__ float siluf_(float x) { return x * __builtin_amdgcn_rcpf(1.f + __expf(-x)); }
__device__ __forceinline__ float wave_sum(float v) {
#pragma unroll
  for (int o = 32; o >= 1; o >>= 1) v += __shfl_xor(v, o);
  return v;
}
__device__ __forceinline__ float quad_sum(float v) {
  v += __int_as_float(__builtin_amdgcn_update_dpp(0, __float_as_int(v), 0xB1, 0xF, 0xF, true));
  v += __int_as_float(__builtin_amdgcn_update_dpp(0, __float_as_int(v), 0x4E, 0xF, 0xF, true));
  return v;
}
__device__ __forceinline__ float oct_sum(float v) {
  v += __int_as_float(__builtin_amdgcn_update_dpp(0, __float_as_int(v), 0xB1, 0xF, 0xF, true));
  v += __int_as_float(__builtin_amdgcn_update_dpp(0, __float_as_int(v), 0x4E, 0xF, 0xF, true));
  v += __int_as_float(__builtin_amdgcn_update_dpp(0, __float_as_int(v), 0x141, 0xF, 0xF, true));
  return v;
}
__device__ __forceinline__ float hex_sum(float v) {
  v = oct_sum(v);
  v += __int_as_float(__builtin_amdgcn_update_dpp(0, __float_as_int(v), 0x140, 0xF, 0xF, true));
  return v;
}
__device__ __forceinline__ int mod_index(int row) { return row < NP ? 0 : 1 + ((row - NP) >> 10); }

__device__ __forceinline__ void ada_item(const Params& p, int it, char* smem) {
  const int tid = threadIdx.x;
  float* sil = (float*)smem;
  for (int i = tid; i < 9 * 1024; i += NT) {
    int n = i >> 10, k = i & 1023;
    float cv = n == 0 ? p.c_ctx[k] : p.c[(n - 1) * 1024 + k];
    sil[i] = siluf_(cv);
  }
  __syncthreads();
  const int gcol = it * 64, l = gcol / 6144, j = gcol % 6144;
  const int c4 = tid & 15, ks = tid >> 4;
  const float* wp = p.ada_w + (size_t)l * 1024 * 6144 + (size_t)(ks * 64) * 6144 + j + c4 * 4;
  float acc[9][4];
#pragma unroll
  for (int n = 0; n < 9; ++n) { acc[n][0] = 0.f; acc[n][1] = 0.f; acc[n][2] = 0.f; acc[n][3] = 0.f; }
#pragma unroll 4
  for (int k = 0; k < 64; ++k) {
    const float4 w = *(const float4*)(wp + (size_t)k * 6144);
#pragma unroll
    for (int n = 0; n < 9; ++n) {
      const float s = sil[n * 1024 + ks * 64 + k];
      acc[n][0] += s * w.x; acc[n][1] += s * w.y; acc[n][2] += s * w.z; acc[n][3] += s * w.w;
    }
  }
  __syncthreads();
  float* red = (float*)smem;
#pragma unroll
  for (int n = 0; n < 9; ++n)
#pragma unroll
    for (int q = 0; q < 4; ++q) red[(ks * 9 + n) * 64 + c4 * 4 + q] = acc[n][q];
  __syncthreads();
  for (int o = tid; o < 576; o += NT) {
    const int n = o >> 6, cc = o & 63;
    float s = 0.f;
#pragma unroll
    for (int k2 = 0; k2 < 16; ++k2) s += red[(k2 * 9 + n) * 64 + cc];
    s += p.ada_b[l * 6144 + j + cc];
    p.MOD[(size_t)(l * 9 + n) * 6144 + j + cc] = s;
  }
}

__device__ __forceinline__ void transpose_item(const Params& p, int tix, char* smem) {
  const int tid = threadIdx.x;
  int j = 0;
  while (j + 1 < p.njobs && tix >= p.jobs[j + 1].tile0) ++j;
  const float* src = p.jobs[j].src; bf16_t* dst = p.jobs[j].dst;
  const int K = p.jobs[j].K, N = p.jobs[j].N, lt = tix - p.jobs[j].tile0;
  const int ntn = N >> 6, tk = lt / ntn, tn = lt % ntn;
  float* tile = (float*)smem;
#pragma unroll
  for (int i = 0; i < 4; ++i) {
    const int r = (tid >> 4) + 16 * i, c4 = tid & 15;
    const float4 v = *(const float4*)(src + (size_t)(tk * 64 + r) * N + tn * 64 + c4 * 4);
    float* t = tile + r * 65 + c4 * 4;
    t[0] = v.x; t[1] = v.y; t[2] = v.z; t[3] = v.w;
  }
  __syncthreads();
  const int n = tid >> 2, kc = (tid & 3) * 16;
  unsigned w[8];
#pragma unroll
  for (int i = 0; i < 8; ++i) w[i] = pk_bf16(tile[(kc + 2 * i) * 65 + n], tile[(kc + 2 * i + 1) * 65 + n]);
  uint4* d = (uint4*)(dst + (size_t)(tn * 64 + n) * K + tk * 64 + kc);
  d[0] = make_uint4(w[0], w[1], w[2], w[3]);
  d[1] = make_uint4(w[4], w[5], w[6], w[7]);
}

__device__ __forceinline__ void cache_item(const Params& p, int ci) {
  const int tid = threadIdx.x;
  const int base = (ci & 31) * 8192;
  for (int e = tid; e < 8192; e += NT) {
    const int idx = base + e;
    const int d = idx & 63, kvh = (idx >> 6) & 1, pp = (idx >> 7) & 255, b = idx >> 15;
    if (ci < 32) p.Ks[((size_t)(b * 2 + kvh) * 1280 + 1024 + pp) * 64 + d] = f2bf(p.cache_k[idx]);
    else p.Vts[((size_t)(b * 2 + kvh) * 64 + d) * 1280 + 1024 + pp] = f2bf(p.cache_v[idx]);
  }
}

__device__ __forceinline__ void phase0(const Params& p, char* smem) {
  const int n_ada = 192, n_tr = p.ntiles, n_cc = 64;
  const int total = n_ada + n_tr + n_cc;
  for (int it = blockIdx.x; it < total; it += gridDim.x) {
    if (it < n_ada) ada_item(p, it, smem);
    else if (it < n_ada + n_tr) transpose_item(p, it - n_ada, smem);
    else cache_item(p, it - n_ada - n_tr);
    __syncthreads();
  }
}

__device__ __forceinline__ void prenorm_phase(const Params& p, int layer, int which, bool from_input) {
  const int wave = threadIdx.x >> 6, lane = threadIdx.x & 63;
  const float* nw = (which ? p.norm2_w : p.norm1_w) + layer * 1024;
  for (int row = blockIdx.x * 4 + wave; row < NTOK; row += gridDim.x * 4) {
    const float* xr = from_input ? (row < NP ? p.x_prompt + (size_t)row * 1024 : p.x_sample + (size_t)(row - NP) * 1024)
                                 : p.X + (size_t)row * 1024;
    float4 v[4]; float ss = 0.f;
#pragma unroll
    for (int i = 0; i < 4; ++i) { v[i] = *(const float4*)(xr + i * 256 + lane * 4); ss += v[i].x * v[i].x + v[i].y * v[i].y + v[i].z * v[i].z + v[i].w * v[i].w; }
    ss = wave_sum(ss);
    const float rstd = rsqrtf(ss * (1.f / 1024.f) + 1e-6f);
    const float* md = p.MOD + (size_t)(layer * 9 + mod_index(row)) * 6144;
    const float* sh = md + (which ? 3 : 0) * 1024; const float* sc = md + (which ? 4 : 1) * 1024;
#pragma unroll
    for (int i = 0; i < 4; ++i) {
      const int c = i * 256 + lane * 4;
      const float4 w4 = *(const float4*)(nw + c), s4 = *(const float4*)(sh + c), c4 = *(const float4*)(sc + c);
      const float h0 = v[i].x * rstd * w4.x * (1.f + c4.x) + s4.x, h1 = v[i].y * rstd * w4.y * (1.f + c4.y) + s4.y;
      const float h2 = v[i].z * rstd * w4.z * (1.f + c4.z) + s4.z, h3 = v[i].w * rstd * w4.w * (1.f + c4.w) + s4.w;
      *(uint2*)(p.H + (size_t)row * 1024 + c) = make_uint2(pk_bf16(h0, h1), pk_bf16(h2, h3));
    }
  }
}

struct ALoadPlain {
  const bf16_t* A; int lda;
  __device__ __forceinline__ uint4 operator()(int row, int k) const { return *(const uint4*)(A + (size_t)row * lda + k); }
};
struct ALoadShift {
  const bf16_t* H; const float* mix;
  __device__ __forceinline__ uint4 operator()(int row, int k) const {
    const uint4 h = *(const uint4*)(H + (size_t)row * 1024 + k);
    int tl, T;
    if (row < NP) { tl = row & 255; T = 256; } else { tl = (row - NP) & 1023; T = 1024; }
    uint4 s = make_uint4(0, 0, 0, 0);
    if (k < 512) { if (tl > 0) s = *(const uint4*)(H + (size_t)(row - 1) * 1024 + k); }
    else { if (tl < T - 1) s = *(const uint4*)(H + (size_t)(row + 1) * 1024 + k); }
    const float4 m0 = *(const float4*)(mix + k), m1 = *(const float4*)(mix + k + 4);
    uint4 o;
    { float a = bflo(h.x), b = bfhi(h.x); o.x = pk_bf16(a + (bflo(s.x) - a) * m0.x, b + (bfhi(s.x) - b) * m0.y); }
    { float a = bflo(h.y), b = bfhi(h.y); o.y = pk_bf16(a + (bflo(s.y) - a) * m0.z, b + (bfhi(s.y) - b) * m0.w); }
    { float a = bflo(h.z), b = bfhi(h.z); o.z = pk_bf16(a + (bflo(s.z) - a) * m1.x, b + (bfhi(s.z) - b) * m1.y); }
    { float a = bflo(h.w), b = bfhi(h.w); o.w = pk_bf16(a + (bflo(s.w) - a) * m1.z, b + (bfhi(s.w) - b) * m1.w); }
    return o;
  }
};

template <class AL, class EP>
__device__ __forceinline__ void gemm_tile(const AL& al, const bf16_t* __restrict__ Bt, int K, int tm, int tn, const EP& ep, char* smem) {
  const int tid = threadIdx.x, lane = tid & 63, wid = tid >> 6, wm = wid >> 1, wn = wid & 1;
  const int fr = lane & 15, fq = lane >> 4;
  char* sA = smem; char* sB = smem + 32768;
  f32x4 acc[4][4];
#pragma unroll
  for (int a = 0; a < 4; ++a)
#pragma unroll
    for (int b = 0; b < 4; ++b) acc[a][b] = (f32x4){0.f, 0.f, 0.f, 0.f};
  uint4 pa[4], pb[4];
  const int nk = K >> 6;
  const int cr0 = tid >> 3, cc = tid & 7;
  const int soff = cr0 * 128 + ((cc ^ ((cr0 >> 1) & 7)) << 4);
  const bf16_t* bp = Bt + (size_t)(tn * 128 + cr0) * K + cc * 8;
#define GLOAD(kt) do { _Pragma("unroll") for (int i = 0; i < 4; ++i) { pa[i] = al(tm * 128 + cr0 + 32 * i, (kt) * 64 + cc * 8); pb[i] = *(const uint4*)(bp + (size_t)(32 * i) * K + (kt) * 64); } } while (0)
#define SSTORE(buf) do { _Pragma("unroll") for (int i = 0; i < 4; ++i) { *(uint4*)(sA + (buf) * 16384 + soff + i * 4096) = pa[i]; *(uint4*)(sB + (buf) * 16384 + soff + i * 4096) = pb[i]; } } while (0)
  GLOAD(0); SSTORE(0); __syncthreads();
  for (int kt = 0; kt < nk; ++kt) {
    const int buf = kt & 1;
    if (kt + 1 < nk) GLOAD(kt + 1);
#pragma unroll
    for (int kk = 0; kk < 2; ++kk) {
      bf16x8 af[4], bfr[4];
#pragma unroll
      for (int mi = 0; mi < 4; ++mi) { const int r = wm * 64 + mi * 16 + fr, c = kk * 4 + fq; af[mi] = *(const bf16x8*)(sA + buf * 16384 + r * 128 + ((c ^ ((r >> 1) & 7)) << 4)); }
#pragma unroll
      for (int ni = 0; ni < 4; ++ni) { const int r = wn * 64 + ni * 16 + fr, c = kk * 4 + fq; bfr[ni] = *(const bf16x8*)(sB + buf * 16384 + r * 128 + ((c ^ ((r >> 1) & 7)) << 4)); }
#pragma unroll
      for (int mi = 0; mi < 4; ++mi)
#pragma unroll
        for (int ni = 0; ni < 4; ++ni) acc[mi][ni] = __builtin_amdgcn_mfma_f32_16x16x32_bf16(bfr[ni], af[mi], acc[mi][ni], 0, 0, 0);
    }
    if (kt + 1 < nk) SSTORE(buf ^ 1);
    __syncthreads();
  }
#undef GLOAD
#undef SSTORE
  ep(acc, tm * 128 + wm * 64, tn * 128 + wn * 64, lane);
}

#define LAS3 __attribute__((address_space(3)))
template <int OFF>
__device__ __forceinline__ bf16x8 lds_rd128(unsigned addr) { bf16x8 v; asm volatile("ds_read_b128 %0, %1 offset:%2" : "=v"(v) : "v"(addr), "n"(OFF) : "memory"); return v; }
template <class EP>
__device__ __forceinline__ void gemm_tile_glds(const bf16_t* __restrict__ A, int lda, const bf16_t* __restrict__ Bt, int K, int tm, int tn, const EP& ep, char* smem) {
  const int tid = threadIdx.x, lane = tid & 63, wid = __builtin_amdgcn_readfirstlane(tid >> 6), wm = wid >> 1, wn = wid & 1;
  const int fr = lane & 15, fq = lane >> 4;
  f32x4 acc[4][4];
#pragma unroll
  for (int a = 0; a < 4; ++a)
#pragma unroll
    for (int b = 0; b < 4; ++b) acc[a][b] = (f32x4){0.f, 0.f, 0.f, 0.f};
  const int nk = K >> 6;
  const int lr = lane >> 3, c0 = (lane & 7) ^ (lr >> 1);
  const bf16_t* pa = A + (size_t)(tm * 128 + wid * 32 + lr) * lda;
  const bf16_t* pb = Bt + (size_t)(tn * 128 + wid * 32 + lr) * K;
  const unsigned lbase = (unsigned)(uintptr_t)(LAS3 char*)smem;
  const unsigned fsw = (unsigned)((fq ^ ((fr >> 1) & 7)) << 4);
  const unsigned aA0 = lbase + (unsigned)((wm * 64 + fr) * 128) + fsw, aA1 = lbase + (unsigned)((wm * 64 + fr) * 128) + (fsw ^ 64u);
  const unsigned aB0 = lbase + 32768u + (unsigned)((wn * 64 + fr) * 128) + fsw, aB1 = lbase + 32768u + (unsigned)((wn * 64 + fr) * 128) + (fsw ^ 64u);
#define GLDS(kt, buf) do { _Pragma("unroll") for (int i = 0; i < 4; ++i) { const int cc_ = (c0 ^ ((i & 1) << 2)) * 8 + (kt) * 64; \
    __builtin_amdgcn_global_load_lds((const unsigned*)(pa + (size_t)(i * 8) * lda + cc_), (LAS3 unsigned*)(smem + (buf) * 16384 + (wid * 4 + i) * 1024), 16, 0, 0); \
    __builtin_amdgcn_global_load_lds((const unsigned*)(pb + (size_t)(i * 8) * K + cc_), (LAS3 unsigned*)(smem + 32768 + (buf) * 16384 + (wid * 4 + i) * 1024), 16, 0, 0); } } while (0)
  GLDS(0, 0);
  asm volatile("s_waitcnt vmcnt(0)" ::: "memory");
  __builtin_amdgcn_s_barrier();
  for (int kt = 0; kt < nk; ++kt) {
    const int buf = kt & 1;
    if (kt + 1 < nk) GLDS(kt + 1, buf ^ 1);
    const unsigned bo = (unsigned)buf * 16384u;
    bf16x8 a0[4], b0[4], a1[4], b1[4];
    a0[0] = lds_rd128<0>(aA0 + bo); a0[1] = lds_rd128<2048>(aA0 + bo); a0[2] = lds_rd128<4096>(aA0 + bo); a0[3] = lds_rd128<6144>(aA0 + bo);
    b0[0] = lds_rd128<0>(aB0 + bo); b0[1] = lds_rd128<2048>(aB0 + bo); b0[2] = lds_rd128<4096>(aB0 + bo); b0[3] = lds_rd128<6144>(aB0 + bo);
    a1[0] = lds_rd128<0>(aA1 + bo); a1[1] = lds_rd128<2048>(aA1 + bo); a1[2] = lds_rd128<4096>(aA1 + bo); a1[3] = lds_rd128<6144>(aA1 + bo);
    b1[0] = lds_rd128<0>(aB1 + bo); b1[1] = lds_rd128<2048>(aB1 + bo); b1[2] = lds_rd128<4096>(aB1 + bo); b1[3] = lds_rd128<6144>(aB1 + bo);
    __builtin_amdgcn_sched_barrier(0);
    asm volatile("s_waitcnt lgkmcnt(8)" : "+v"(a0[0]), "+v"(a0[1]), "+v"(a0[2]), "+v"(a0[3]), "+v"(b0[0]), "+v"(b0[1]), "+v"(b0[2]), "+v"(b0[3]) :: "memory");
    __builtin_amdgcn_s_setprio(1);
#pragma unroll
    for (int mi = 0; mi < 4; ++mi)
#pragma unroll
      for (int ni = 0; ni < 4; ++ni) acc[mi][ni] = __builtin_amdgcn_mfma_f32_16x16x32_bf16(b0[ni], a0[mi], acc[mi][ni], 0, 0, 0);
    __builtin_amdgcn_sched_barrier(0);
    asm volatile("s_waitcnt lgkmcnt(0)" : "+v"(a1[0]), "+v"(a1[1]), "+v"(a1[2]), "+v"(a1[3]), "+v"(b1[0]), "+v"(b1[1]), "+v"(b1[2]), "+v"(b1[3]) :: "memory");
#pragma unroll
    for (int mi = 0; mi < 4; ++mi)
#pragma unroll
      for (int ni = 0; ni < 4; ++ni) acc[mi][ni] = __builtin_amdgcn_mfma_f32_16x16x32_bf16(b1[ni], a1[mi], acc[mi][ni], 0, 0, 0);
    __builtin_amdgcn_s_setprio(0);
    __builtin_amdgcn_sched_barrier(0);
    asm volatile("s_waitcnt vmcnt(0)" ::: "memory");
    __builtin_amdgcn_s_barrier();
    __builtin_amdgcn_sched_barrier(0);
  }
#undef GLDS
  ep(acc, tm * 128 + wm * 64, tn * 128 + wn * 64, lane);
}

struct EpiWin {
  const Params* pp;
  __device__ __forceinline__ void operator()(f32x4 (&acc)[4][4], int row0, int col0, int lane) const {
    const Params& p = *pp;
    const int fr = lane & 15, fq = lane >> 4;
    const bool sample = row0 >= NP;
    if (col0 < 640) {
      const bool isq = col0 < 512;
      const float* nw = isq ? p.q_norm : p.k_norm;
      float nwv[4][4];
#pragma unroll
      for (int ni = 0; ni < 4; ++ni)
#pragma unroll
        for (int j = 0; j < 4; ++j) nwv[ni][j] = nw[ni * 16 + fq * 4 + j];
#pragma unroll
      for (int mi = 0; mi < 4; ++mi) {
        const int row = row0 + mi * 16 + fr;
        float ss = 0.f;
#pragma unroll
        for (int ni = 0; ni < 4; ++ni)
#pragma unroll
          for (int j = 0; j < 4; ++j) ss += acc[mi][ni][j] * acc[mi][ni][j];
        ss += __shfl_xor(ss, 16); ss += __shfl_xor(ss, 32);
        const float rn = rsqrtf(ss * (1.f / 64.f) + 1e-6f);
        float y[4][4];
#pragma unroll
        for (int ni = 0; ni < 4; ++ni)
#pragma unroll
          for (int j = 0; j < 4; ++j) y[ni][j] = acc[mi][ni][j] * rn * nwv[ni][j];
        if (!sample && !isq) {
          const int kvh = (col0 - 512) >> 6;
#pragma unroll
          for (int ni = 0; ni < 4; ++ni) *(f32x4*)(p.out_k + (size_t)row * 128 + kvh * 64 + ni * 16 + fq * 4) = (f32x4){y[ni][0], y[ni][1], y[ni][2], y[ni][3]};
        }
        if (sample) {
          const int tl = (row - NP) & 1023;
          const float rp = (float)(tl >> 6), cp = (float)(tl & 63);
#pragma unroll
          for (int ni = 0; ni < 4; ++ni)
#pragma unroll
            for (int jp = 0; jp < 2; ++jp) {
              const int i = (ni * 16 + fq * 4 + jp * 2) >> 1;
              const float pos = i < 16 ? rp : cp;
              const float inv = exp2f(-(float)(i & 15) * 0.83048202372184058696f);
              const float ang = pos * inv;
              const float s = __sinf(ang), c = __cosf(ang);
              const float x0 = y[ni][2 * jp], x1 = y[ni][2 * jp + 1];
              y[ni][2 * jp] = x0 * c - x1 * s; y[ni][2 * jp + 1] = x0 * s + x1 * c;
            }
        }
        if (isq) {
          const float qs = 0.125f * 1.44269504088896f;
#pragma unroll
          for (int ni = 0; ni < 4; ++ni)
            *(uint2*)(p.Qbuf + (size_t)row * 512 + col0 + ni * 16 + fq * 4) = make_uint2(pk_bf16(y[ni][0] * qs, y[ni][1] * qs), pk_bf16(y[ni][2] * qs, y[ni][3] * qs));
        } else {
          const int kvh = (col0 - 512) >> 6;
          bf16_t* kd;
          if (!sample) kd = p.Kp + ((size_t)((row >> 8) * 2 + kvh) * 256 + (row & 255)) * 64;
          else kd = p.Ks + ((size_t)(((row - NP) >> 10) * 2 + kvh) * 1280 + ((row - NP) & 1023)) * 64;
#pragma unroll
          for (int ni = 0; ni < 4; ++ni)
            *(uint2*)(kd + ni * 16 + fq * 4) = make_uint2(pk_bf16(y[ni][0], y[ni][1]), pk_bf16(y[ni][2], y[ni][3]));
        }
      }
    } else if (col0 < 768) {
      const int kvh = (col0 - 640) >> 6;
#pragma unroll
      for (int mi = 0; mi < 4; ++mi) {
        const int row = row0 + mi * 16 + fr;
#pragma unroll
        for (int ni = 0; ni < 4; ++ni) {
          const int d0 = ni * 16 + fq * 4;
          if (!sample) {
            *(f32x4*)(p.out_v + (size_t)row * 128 + kvh * 64 + d0) = acc[mi][ni];
            bf16_t* vd = p.Vtp + ((size_t)((row >> 8) * 2 + kvh) * 64 + d0) * 256 + (row & 255);
#pragma unroll
            for (int j = 0; j < 4; ++j) vd[j * 256] = f2bf(acc[mi][ni][j]);
          } else {
            bf16_t* vd = p.Vts + ((size_t)(((row - NP) >> 10) * 2 + kvh) * 64 + d0) * 1280 + ((row - NP) & 1023);
#pragma unroll
            for (int j = 0; j < 4; ++j) vd[j * 1280] = f2bf(acc[mi][ni][j]);
          }
        }
      }
    } else {
      const int c0 = col0 - 768, seg = c0 >> 9;
      float oml[4][4];
      if (seg == 1 || seg == 2) {
#pragma unroll
        for (int ni = 0; ni < 4; ++ni)
#pragma unroll
          for (int j = 0; j < 4; ++j) { const int c = (c0 & 511) + ni * 16 + fq * 4 + j; oml[ni][j] = __builtin_amdgcn_rcpf(1.f + __expf(p.hgrn_lb[c] - p.hgrn_lb[512 + c])); }
      }
#pragma unroll
      for (int mi = 0; mi < 4; ++mi) {
        const int row = row0 + mi * 16 + fr;
#pragma unroll
        for (int ni = 0; ni < 4; ++ni) {
          float o[4];
#pragma unroll
          for (int j = 0; j < 4; ++j) {
            const float v = acc[mi][ni][j];
            if (seg == 0 || seg == 4) o[j] = siluf_(v);
            else if (seg == 3) o[j] = v;
            else o[j] = oml[ni][j] * sigmoidf_(-v);
          }
          *(uint2*)(p.HG + (size_t)row * 2560 + c0 + ni * 16 + fq * 4) = make_uint2(pk_bf16(o[0], o[1]), pk_bf16(o[2], o[3]));
        }
      }
    }
  }
};

struct EpiResid {
  const Params* pp; int layer, gidx; bool from_input; bool dry = false;
  __device__ __forceinline__ void operator()(f32x4 (&acc)[4][4], int row0, int col0, int lane) const {
    const Params& p = *pp;
    if (dry && p.njobs >= 0) return;
    const int fr = lane & 15, fq = lane >> 4;
    const float* gt = p.MOD + (size_t)(layer * 9 + mod_index(row0)) * 6144 + gidx * 1024;
#pragma unroll
    for (int mi = 0; mi < 4; ++mi) {
      const int row = row0 + mi * 16 + fr;
      const float* base = from_input ? (row < NP ? p.x_prompt + (size_t)row * 1024 : p.x_sample + (size_t)(row - NP) * 1024) : p.X + (size_t)row * 1024;
#pragma unroll
      for (int ni = 0; ni < 4; ++ni) {
        const int col = col0 + ni * 16 + fq * 4;
        const f32x4 b = *(const f32x4*)(base + col), g = *(const f32x4*)(gt + col);
        *(f32x4*)(p.X + (size_t)row * 1024 + col) = b + g * acc[mi][ni];
      }
    }
  }
};

template <int ACT>
struct EpiAct {
  bf16_t* O; int ldo; const float* bias;
  __device__ __forceinline__ void operator()(f32x4 (&acc)[4][4], int row0, int col0, int lane) const {
    const int fr = lane & 15, fq = lane >> 4;
#pragma unroll
    for (int ni = 0; ni < 4; ++ni) {
      const int col = col0 + ni * 16 + fq * 4;
      f32x4 bv = (f32x4){0.f, 0.f, 0.f, 0.f};
      if (ACT >= 4) bv = *(const f32x4*)(bias + col);
#pragma unroll
      for (int mi = 0; mi < 4; ++mi) {
        const int row = row0 + mi * 16 + fr;
        float o[4];
#pragma unroll
        for (int j = 0; j < 4; ++j) {
          const float v = acc[mi][ni][j] + bv[j];
          if (ACT == 0) o[j] = v;
          else if (ACT == 1) { const float r = fmaxf(v, 0.f); o[j] = r * r; }
          else if (ACT == 2) o[j] = 1.f - 2.f * __builtin_amdgcn_rcpf(1.f + __expf(2.f * v));
          else if (ACT == 3 || ACT == 5) o[j] = sigmoidf_(v);
          else o[j] = 0.60653065971263342f * sigmoidf_(v);
        }
        *(uint2*)(O + (size_t)row * ldo + col) = make_uint2(pk_bf16(o[0], o[1]), pk_bf16(o[2], o[3]));
      }
    }
  }
};

struct EpiRwkvOut {
  const Params* pp;
  __device__ __forceinline__ void operator()(f32x4 (&acc)[4][4], int row0, int col0, int lane) const {
    const Params& p = *pp;
    const int fr = lane & 15, fq = lane >> 4, h = col0 >> 6;
#pragma unroll
    for (int mi = 0; mi < 4; ++mi) {
      const int row = row0 + mi * 16 + fr;
      float y[4][4]; float s = 0.f;
#pragma unroll
      for (int ni = 0; ni < 4; ++ni) {
        const size_t idx = (size_t)row * 1024 + col0 + ni * 16 + fq * 4;
        const uint2 a = *(const uint2*)(p.E0 + idx), b = *(const uint2*)(p.E1 + idx);
        y[ni][0] = bflo(a.x) + bflo(b.x); y[ni][1] = bfhi(a.x) + bfhi(b.x); y[ni][2] = bflo(a.y) + bflo(b.y); y[ni][3] = bfhi(a.y) + bfhi(b.y);
        s += (y[ni][0] + y[ni][1]) + (y[ni][2] + y[ni][3]);
      }
      s += __shfl_xor(s, 16); s += __shfl_xor(s, 32);
      const float mu = s * (1.f / 64.f);
      float q = 0.f;
#pragma unroll
      for (int ni = 0; ni < 4; ++ni)
#pragma unroll
        for (int j = 0; j < 4; ++j) { const float d = y[ni][j] - mu; q += d * d; }
      q += __shfl_xor(q, 16); q += __shfl_xor(q, 32);
      const float rs = rsqrtf(q * (1.f / 64.f) + 64e-5f);
      const float bs = p.BS[(size_t)row * 16 + h] + p.BS[(size_t)NTOK * 16 + (size_t)row * 16 + h];
#pragma unroll
      for (int ni = 0; ni < 4; ++ni) {
        const int col = col0 + ni * 16 + fq * 4;
        const size_t idx = (size_t)row * 1024 + col;
        const uint2 vv = *(const uint2*)(p.Vx + idx);
        const f32x4 lw = *(const f32x4*)(p.ln_w + col), lb = *(const f32x4*)(p.ln_b + col);
        const float v0 = bflo(vv.x), v1 = bfhi(vv.x), v2 = bflo(vv.y), v3 = bfhi(vv.y);
        const float o0 = ((y[ni][0] - mu) * rs * lw[0] + lb[0] + bs * v0) * acc[mi][ni][0];
        const float o1 = ((y[ni][1] - mu) * rs * lw[1] + lb[1] + bs * v1) * acc[mi][ni][1];
        const float o2 = ((y[ni][2] - mu) * rs * lw[2] + lb[2] + bs * v2) * acc[mi][ni][2];
        const float o3 = ((y[ni][3] - mu) * rs * lw[3] + lb[3] + bs * v3) * acc[mi][ni][3];
        *(uint2*)(p.ZO + idx) = make_uint2(pk_bf16(o0, o1), pk_bf16(o2, o3));
      }
    }
  }
};

template <class EP>
__device__ __forceinline__ void gemm_phase(const ALoadPlain& al, const bf16_t* Bt, int K, int ntn, const EP& ep, char* smem) {
  const int nunits = (NTOK / 128) * ntn;
  for (int u = blockIdx.x; u < nunits; u += gridDim.x) gemm_tile_glds(al.A, al.lda, Bt, K, u / ntn, u % ntn, ep, smem);
}

__device__ __forceinline__ void attn_item(const Params& p, int grp, int b, int h, int qb, char* smem) {
  const int tid = threadIdx.x, lane = tid & 63, wid = tid >> 6, qi = lane & 31, g = lane >> 5;
  const int Tk = grp ? 1280 : 256, kvh = h >> 2;
  const int rowbase = grp ? NP + b * 1024 + qb * 128 : b * 256 + qb * 128;
  const bf16_t* Kg = grp ? p.Ks + (size_t)(b * 2 + kvh) * 1280 * 64 : p.Kp + (size_t)(b * 2 + kvh) * 256 * 64;
  const bf16_t* Vg = grp ? p.Vts + (size_t)(b * 2 + kvh) * 64 * 1280 : p.Vtp + (size_t)(b * 2 + kvh) * 64 * 256;
  const int qrow = rowbase + wid * 32 + qi;
  bf16x8 Qf[4];
#pragma unroll
  for (int s = 0; s < 4; ++s) Qf[s] = *(const bf16x8*)(p.Qbuf + (size_t)qrow * 512 + h * 64 + s * 16 + g * 8);
  f32x16 O[2];
#pragma unroll
  for (int i = 0; i < 16; ++i) { O[0][i] = 0.f; O[1][i] = 0.f; }
  float m_run = -1e30f, l_run = 0.f;
  char* sK = smem; char* sV = smem + 16384;
  const int r0 = tid >> 3, c = tid & 7;
  uint4 pk[2], pv[2];
  const int ntile = Tk >> 6;
#define ALOAD(kt) do { _Pragma("unroll") for (int i = 0; i < 2; ++i) { const int r = r0 + 32 * i; pk[i] = *(const uint4*)(Kg + (size_t)((kt) * 64 + r) * 64 + c * 8); pv[i] = *(const uint4*)(Vg + (size_t)r * Tk + (kt) * 64 + c * 8); } } while (0)
#define ASTORE(buf) do { _Pragma("unroll") for (int i = 0; i < 2; ++i) { const int r = r0 + 32 * i; \
      *(uint4*)(sK + (buf) * 8192 + r * 128 + ((c ^ ((r >> 1) & 7)) << 4)) = pk[i]; \
      const int f = (r >> 1) & 15; \
      *(uint2*)(sV + (buf) * 8192 + r * 128 + (((2 * c) ^ f) << 3)) = make_uint2(pv[i].x, pv[i].y); \
      *(uint2*)(sV + (buf) * 8192 + r * 128 + (((2 * c + 1) ^ f) << 3)) = make_uint2(pv[i].z, pv[i].w); } } while (0)
  ALOAD(0); ASTORE(0); __syncthreads();
  for (int kt = 0; kt < ntile; ++kt) {
    const int buf = kt & 1;
    if (kt + 1 < ntile) ALOAD(kt + 1);
    f32x16 S[2];
#pragma unroll
    for (int t2 = 0; t2 < 2; ++t2) {
#pragma unroll
      for (int i = 0; i < 16; ++i) S[t2][i] = 0.f;
#pragma unroll
      for (int s = 0; s < 4; ++s) {
        const int r = t2 * 32 + qi, cc = 2 * s + g;
        const bf16x8 Kf = *(const bf16x8*)(sK + buf * 8192 + r * 128 + ((cc ^ ((r >> 1) & 7)) << 4));
        S[t2] = __builtin_amdgcn_mfma_f32_32x32x16_bf16(Kf, Qf[s], S[t2], 0, 0, 0);
      }
    }
    float mx = S[0][0];
#pragma unroll
    for (int i = 0; i < 16; ++i) { mx = fmaxf(mx, S[0][i]); mx = fmaxf(mx, S[1][i]); }
    mx = fmaxf(mx, __shfl_xor(mx, 32));
    const float m_new = fmaxf(m_run, mx);
    const float alpha = __builtin_amdgcn_exp2f(m_run - m_new);
    float ls = 0.f;
#pragma unroll
    for (int i = 0; i < 16; ++i) { S[0][i] = __builtin_amdgcn_exp2f(S[0][i] - m_new); S[1][i] = __builtin_amdgcn_exp2f(S[1][i] - m_new); ls += S[0][i] + S[1][i]; }
    l_run = l_run * alpha + ls; m_run = m_new;
#pragma unroll
    for (int i = 0; i < 16; ++i) { O[0][i] *= alpha; O[1][i] *= alpha; }
#pragma unroll
    for (int t2 = 0; t2 < 2; ++t2)
#pragma unroll
      for (int sp = 0; sp < 2; ++sp) {
        union { bf16x8 v; unsigned u[4]; } Pf;
#pragma unroll
        for (int e = 0; e < 4; ++e) Pf.u[e] = pk_bf16(S[t2][8 * sp + 2 * e], S[t2][8 * sp + 2 * e + 1]);
#pragma unroll
        for (int ds = 0; ds < 2; ++ds) {
          const int d = ds * 32 + qi, f = (d >> 1) & 15, u1 = 8 * t2 + 4 * sp + g;
          union { bf16x8 v; uint2 u[2]; } Vf;
          Vf.u[0] = *(const uint2*)(sV + buf * 8192 + d * 128 + ((u1 ^ f) << 3));
          Vf.u[1] = *(const uint2*)(sV + buf * 8192 + d * 128 + (((u1 + 2) ^ f) << 3));
          O[ds] = __builtin_amdgcn_mfma_f32_32x32x16_bf16(Vf.v, Pf.v, O[ds], 0, 0, 0);
        }
      }
    if (kt + 1 < ntile) ASTORE(buf ^ 1);
    __syncthreads();
  }
#undef ALOAD
#undef ASTORE
  const float l = l_run + __shfl_xor(l_run, 32);
  const float inv = 1.f / l;
#pragma unroll
  for (int ds = 0; ds < 2; ++ds)
#pragma unroll
    for (int bq = 0; bq < 4; ++bq) {
      const int d0 = ds * 32 + 8 * bq + 4 * g;
      *(uint2*)(p.AO + (size_t)qrow * 1024 + h * 64 + d0) =
          make_uint2(pk_bf16(O[ds][4 * bq] * inv, O[ds][4 * bq + 1] * inv), pk_bf16(O[ds][4 * bq + 2] * inv, O[ds][4 * bq + 3] * inv));
    }
}

__device__ __forceinline__ void hgrn_item(const Params& p, int grp, int b, int h, int dir, int half, char* smem) {
  const int tid = threadIdx.x, v = half * 32 + (tid >> 3), ks = tid & 7;
  const int T = grp ? 1024 : 256, rowbase = grp ? NP + b * 1024 : b * 256;
  if (grp) __builtin_amdgcn_s_setprio(3);
  f32x2 S2[4];
  if (grp) {
    const float* s0 = (dir ? p.hg_b0 : p.hg_f0) + (size_t)(b * 8 + h) * 4096;
#pragma unroll
    for (int i = 0; i < 4; ++i) S2[i] = (f32x2){s0[(ks * 8 + 2 * i) * 64 + v], s0[(ks * 8 + 2 * i + 1) * 64 + v]};
  } else {
#pragma unroll
    for (int i = 0; i < 4; ++i) S2[i] = (f32x2){0.f, 0.f};
  }
  float* obuf = (float*)(smem + 32768);
  const int lt = tid >> 4, lc = (tid & 15) * 4;
  const int kfseg = dir ? 1024 : 512;
  uint2 rq, rk, rv, rq2, rk2, rv2;
  const int nch = T >> 4;
#define HLOADX(cix, q_, k_, v_) do { const int ts = (cix) * 16 + lt; const int tok = dir ? T - 1 - ts : ts; const bf16_t* src = p.HG + (size_t)(rowbase + tok) * 2560 + h * 64 + lc; \
    q_ = *(const uint2*)(src); k_ = *(const uint2*)(src + kfseg); v_ = *(const uint2*)(src + 1536); } while (0)
#define HSTORE(buf) do { float* B = (float*)(smem + (buf) * 16384) + lt * 64 + lc; \
    const float k0 = bflo(rk.x), k1 = bfhi(rk.x), k2 = bflo(rk.y), k3 = bfhi(rk.y); \
    *(float4*)(B) = make_float4(1.f - k0, 1.f - k1, 1.f - k2, 1.f - k3); *(float4*)(B + 1024) = make_float4(k0, k1, k2, k3); \
    *(float4*)(B + 2048) = make_float4(bflo(rq.x), bfhi(rq.x), bflo(rq.y), bfhi(rq.y)); *(float4*)(B + 3072) = make_float4(bflo(rv.x), bfhi(rv.x), bflo(rv.y), bfhi(rv.y)); } while (0)
  HLOADX(0, rq, rk, rv); HSTORE(0);
  HLOADX(1, rq, rk, rv);
  __syncthreads();
  float* OD = dir ? p.OB : p.OF;
  for (int cix = 0; cix < nch; ++cix) {
    const int buf = cix & 1;
    if (cix + 2 < nch) HLOADX(cix + 2, rq2, rk2, rv2);
    const float* B = (const float*)(smem + buf * 16384);
    float* ob = obuf + buf * 512;
    float4 cf[2], ck[2], cq[2]; float cv;
#define HSTEP_LOAD(t_, f_, k_, q_, v_) do { const float* Bt = B + (t_) * 64 + ks * 8; \
      f_[0] = *(const float4*)(Bt); f_[1] = *(const float4*)(Bt + 4); k_[0] = *(const float4*)(Bt + 1024); k_[1] = *(const float4*)(Bt + 1028); \
      q_[0] = *(const float4*)(Bt + 2048); q_[1] = *(const float4*)(Bt + 2052); v_ = B[3072 + (t_) * 64 + v]; } while (0)
    HSTEP_LOAD(0, cf, ck, cq, cv);
#pragma unroll 1
    for (int g = 0; g < 4; ++g) {
      float op[4];
#pragma unroll
      for (int tt = 0; tt < 4; ++tt) {
        const int t = g * 4 + tt;
        float4 nf[2], nk[2], nq[2]; float nv;
        { const int tn_ = (t + 1) & 15; HSTEP_LOAD(tn_, nf, nk, nq, nv); }
        const f32x2 vvv = (f32x2){cv, cv};
        f32x2 o0, o1;
        S2[0] = S2[0] * (f32x2){cf[0].x, cf[0].y} + vvv * (f32x2){ck[0].x, ck[0].y};
        S2[1] = S2[1] * (f32x2){cf[0].z, cf[0].w} + vvv * (f32x2){ck[0].z, ck[0].w};
        S2[2] = S2[2] * (f32x2){cf[1].x, cf[1].y} + vvv * (f32x2){ck[1].x, ck[1].y};
        S2[3] = S2[3] * (f32x2){cf[1].z, cf[1].w} + vvv * (f32x2){ck[1].z, ck[1].w};
        o0 = S2[0] * (f32x2){cq[0].x, cq[0].y}; o1 = S2[1] * (f32x2){cq[0].z, cq[0].w};
        o0 = S2[2] * (f32x2){cq[1].x, cq[1].y} + o0; o1 = S2[3] * (f32x2){cq[1].z, cq[1].w} + o1;
        const f32x2 os = o0 + o1;
        op[tt] = os.x + os.y;
        cf[0] = nf[0]; cf[1] = nf[1]; ck[0] = nk[0]; ck[1] = nk[1]; cq[0] = nq[0]; cq[1] = nq[1]; cv = nv;
      }
      __builtin_amdgcn_sched_barrier(0);
#define DPPADD(x, ctrl) x += __int_as_float(__builtin_amdgcn_update_dpp(0, __float_as_int(x), ctrl, 0xF, 0xF, true))
      DPPADD(op[0], 0xB1); DPPADD(op[1], 0xB1); DPPADD(op[2], 0xB1); DPPADD(op[3], 0xB1);
      DPPADD(op[0], 0x4E); DPPADD(op[1], 0x4E); DPPADD(op[2], 0x4E); DPPADD(op[3], 0x4E);
      DPPADD(op[0], 0x141); DPPADD(op[1], 0x141); DPPADD(op[2], 0x141); DPPADD(op[3], 0x141);
#undef DPPADD
      if (ks == 0) {
#pragma unroll
        for (int tt = 0; tt < 4; ++tt) ob[(g * 4 + tt) * 32 + (tid >> 3)] = op[tt];
      }
      __builtin_amdgcn_sched_barrier(0);
    }
#undef HSTEP_LOAD
    if (cix + 1 < nch) HSTORE(buf ^ 1);
    rq = rq2; rk = rk2; rv = rv2;
    __syncthreads();
    if (tid < 128) {
      const int ft = tid >> 3, fc = (tid & 7) * 4;
      const int ts = cix * 16 + ft; const int tok = dir ? T - 1 - ts : ts;
      *(float4*)(OD + (size_t)(rowbase + tok) * 512 + h * 64 + half * 32 + fc) = *(const float4*)(ob + ft * 32 + fc);
    }
  }
#undef HLOADX
#undef HSTORE
  __builtin_amdgcn_s_setprio(0);
  if (!grp) {
    float* so = (dir ? p.out_hb : p.out_hf) + (size_t)(b * 8 + h) * 4096;
#pragma unroll
    for (int i = 0; i < 4; ++i) { so[(ks * 8 + 2 * i) * 64 + v] = S2[i].x; so[(ks * 8 + 2 * i + 1) * 64 + v] = S2[i].y; }
  }
}

__device__ __forceinline__ void mix0_phase(const Params& p, char* smem) {
  __shared__ int q_item;
  for (;;) {
    if (threadIdx.x == 0) q_item = (int)atomicAdd(&p.bar[0], 1u);
    __syncthreads();
    const int it = q_item;
    __syncthreads();
    if (it >= 1536) break;
    const bool is_h = it < 256 || (it >= 768 && it < 1280);
    if (is_h) {
      const int grp = it < 256 ? 1 : 0, a = grp ? it : it - 768;
      hgrn_item(p, grp, a >> 5, (a >> 2) & 7, (a >> 1) & 1, a & 1, smem);
    } else {
      const int grp = it < 768 ? 1 : 0, a = grp ? it - 256 : it - 1280;
      const int b = grp ? a >> 6 : a >> 4, h = grp ? (a >> 3) & 7 : (a >> 1) & 7, qb = grp ? a & 7 : a & 1;
      attn_item(p, grp, b, h, qb, smem);
    }
    __syncthreads();
  }
}

__device__ __forceinline__ void hgrn_combine_phase(const Params& p) {
  const int gid = blockIdx.x * NT + threadIdx.x, l16 = gid & 15;
  const int ngroups = NTOK * 8;
  for (int grp = gid >> 4; grp < ngroups; grp += (gridDim.x * NT) >> 4) {
    const int row = grp >> 3, h = grp & 7;
    const size_t o = (size_t)row * 512 + h * 64 + l16 * 4;
    const float4 a = *(const float4*)(p.OF + o), b = *(const float4*)(p.OB + o);
    const float y0 = a.x + b.x, y1 = a.y + b.y, y2 = a.z + b.z, y3 = a.w + b.w;
    float ss = y0 * y0 + y1 * y1 + y2 * y2 + y3 * y3;
    ss += __shfl_xor(ss, 1); ss += __shfl_xor(ss, 2); ss += __shfl_xor(ss, 4); ss += __shfl_xor(ss, 8);
    const float rn = rsqrtf(ss * (1.f / 64.f) + 1e-6f);
    const float4 gn = *(const float4*)(p.g_norm + l16 * 4);
    const uint2 gt = *(const uint2*)(p.HG + (size_t)row * 2560 + 2048 + h * 64 + l16 * 4);
    *(uint2*)(p.AO + (size_t)row * 1024 + 512 + h * 64 + l16 * 4) =
        make_uint2(pk_bf16(y0 * rn * gn.x * bflo(gt.x), y1 * rn * gn.y * bfhi(gt.x)), pk_bf16(y2 * rn * gn.z * bflo(gt.y), y3 * rn * gn.w * bfhi(gt.y)));
  }
}

__device__ __forceinline__ void rwkv_item(const Params& p, int grp, int b, int h, int dir, char* smem, bool dry = false) {
  const bool wr = !(dry && p.njobs >= 0);
  if (grp) __builtin_amdgcn_s_setprio(3);
  const int tid = threadIdx.x, lane = tid & 63, wid = tid >> 6, v = tid >> 2, ks = tid & 3;
  const int T = grp ? 1024 : 256, rowbase = grp ? NP + b * 1024 : b * 256;
  const int vp = tid >> 3, k8 = tid & 7;
  f32x2 Sa[4], Sb[4];
  if (grp) {
    const float* s0 = (dir ? p.rw_b0 : p.rw_f0) + ((size_t)(b * 16 + h) * 64 + vp) * 64 + k8 * 8;
#pragma unroll
    for (int q = 0; q < 2; ++q) {
      const float4 t = *(const float4*)(s0 + q * 4), u = *(const float4*)(s0 + 2048 + q * 4);
      Sa[2 * q] = (f32x2){t.x, t.y}; Sa[2 * q + 1] = (f32x2){t.z, t.w}; Sb[2 * q] = (f32x2){u.x, u.y}; Sb[2 * q + 1] = (f32x2){u.z, u.w};
    }
  } else {
#pragma unroll
    for (int i = 0; i < 4; ++i) { Sa[i] = (f32x2){0.f, 0.f}; Sb[i] = (f32x2){0.f, 0.f}; }
  }
  const bf16_t* E = dir ? p.E1 : p.E0; const bf16_t* A = dir ? p.A1 : p.A0; bf16_t* Y = dir ? p.E1 : p.E0;
  const int lt = tid >> 4, lc = (tid & 15) * 4;
  const float4 kkc = *(const float4*)(p.k_k + h * 64 + lc), kac = *(const float4*)(p.k_a + h * 64 + lc), rkc = *(const float4*)(p.r_k + h * 64 + lc);
  float* BSd = p.BS + (size_t)dir * NTOK * 16;
  float* ybuf = (float*)(smem + 49152);
  uint2 gr, gk, gv, ge, ga;
  const int nch = T >> 4;
#define RLOAD(cix) do { const int ts = (cix) * 16 + lt; const int tok = dir ? T - 1 - ts : ts; const size_t idx = (size_t)(rowbase + tok) * 1024 + h * 64 + lc; \
    gr = *(const uint2*)(p.R + idx); gk = *(const uint2*)(p.Kx + idx); gv = *(const uint2*)(p.Vx + idx); ge = *(const uint2*)(E + idx); ga = *(const uint2*)(A + idx); } while (0)
#define RSTORE(cix, buf) do { const int ts = (cix) * 16 + lt; const int tok = dir ? T - 1 - ts : ts; \
    const float r_[4] = {bflo(gr.x), bfhi(gr.x), bflo(gr.y), bfhi(gr.y)}, k_[4] = {bflo(gk.x), bfhi(gk.x), bflo(gk.y), bfhi(gk.y)}; \
    const float e_[4] = {bflo(ge.x), bfhi(ge.x), bflo(ge.y), bfhi(ge.y)}, a_[4] = {bflo(ga.x), bfhi(ga.x), bflo(ga.y), bfhi(ga.y)}; \
    const float kc_[4] = {kkc.x, kkc.y, kkc.z, kkc.w}, ac_[4] = {kac.x, kac.y, kac.z, kac.w}, rc_[4] = {rkc.x, rkc.y, rkc.z, rkc.w}; \
    float kx[4], kd[4], ssq = 0.f, bsum = 0.f; \
    _Pragma("unroll") for (int j = 0; j < 4; ++j) { kx[j] = k_[j] * kc_[j]; ssq += kx[j] * kx[j]; kd[j] = k_[j] * (1.f + (a_[j] - 1.f) * ac_[j]); bsum += r_[j] * kd[j] * rc_[j]; } \
    ssq = hex_sum(ssq); bsum = hex_sum(bsum); const float rn = rsqrtf(fmaxf(ssq, 1e-24f)); \
    float* B = (float*)(smem + (buf) * 24576) + lt * 64 + lc; \
    *(float4*)(B) = make_float4(__expf(-e_[0]), __expf(-e_[1]), __expf(-e_[2]), __expf(-e_[3])); \
    *(float4*)(B + 1024) = make_float4(kx[0] * rn, kx[1] * rn, kx[2] * rn, kx[3] * rn); \
    *(float4*)(B + 2048) = make_float4(kx[0] * rn * a_[0], kx[1] * rn * a_[1], kx[2] * rn * a_[2], kx[3] * rn * a_[3]); \
    *(float4*)(B + 3072) = make_float4(kd[0], kd[1], kd[2], kd[3]); \
    *(float4*)(B + 4096) = make_float4(r_[0], r_[1], r_[2], r_[3]); \
    *(float4*)(B + 5120) = make_float4(bflo(gv.x), bfhi(gv.x), bflo(gv.y), bfhi(gv.y)); \
    if ((tid & 15) == 0 && wr) BSd[(size_t)(rowbase + tok) * 16 + h] = bsum; } while (0)
  RLOAD(0); RSTORE(0, 0); __syncthreads();
  for (int cix = 0; cix < nch; ++cix) {
    const int buf = cix & 1;
    if (cix + 1 < nch) RLOAD(cix + 1);
    const float* B = (const float*)(smem + buf * 24576);
    float* yb = ybuf + buf * 1024;
    float4 cw[2], ck[2], ca[2], cd[2], cr[2]; float cva, cvb;
#define RSTEP_LOAD(t_, w_, k_, a_, d_, r_, va_, vb_) do { const float* Bt = B + (t_) * 64 + k8 * 8; \
      w_[0] = *(const float4*)(Bt); w_[1] = *(const float4*)(Bt + 4); k_[0] = *(const float4*)(Bt + 1024); k_[1] = *(const float4*)(Bt + 1028); \
      a_[0] = *(const float4*)(Bt + 2048); a_[1] = *(const float4*)(Bt + 2052); d_[0] = *(const float4*)(Bt + 3072); d_[1] = *(const float4*)(Bt + 3076); \
      r_[0] = *(const float4*)(Bt + 4096); r_[1] = *(const float4*)(Bt + 4100); va_ = B[5120 + (t_) * 64 + vp]; vb_ = B[5120 + (t_) * 64 + vp + 32]; } while (0)
    RSTEP_LOAD(0, cw, ck, ca, cd, cr, cva, cvb);
#pragma unroll
    for (int t = 0; t < 16; ++t) {
      float4 nw[2], nk[2], na[2], nd[2], nr[2]; float nva = 0.f, nvb = 0.f;
      if (t + 1 < 16) RSTEP_LOAD(t + 1, nw, nk, na, nd, nr, nva, nvb);
      f32x2 w2[4], kk2[4];
#pragma unroll
      for (int q = 0; q < 2; ++q) {
        w2[2 * q] = (f32x2){cw[q].x, cw[q].y}; w2[2 * q + 1] = (f32x2){cw[q].z, cw[q].w};
        kk2[2 * q] = (f32x2){ck[q].x, ck[q].y}; kk2[2 * q + 1] = (f32x2){ck[q].z, ck[q].w};
      }
      const f32x2 sa_a = (Sa[0] * kk2[0] + Sa[1] * kk2[1]) + (Sa[2] * kk2[2] + Sa[3] * kk2[3]);
      const f32x2 sa_b = (Sb[0] * kk2[0] + Sb[1] * kk2[1]) + (Sb[2] * kk2[2] + Sb[3] * kk2[3]);
      const float saa = -oct_sum(sa_a.x + sa_a.y), sab = -oct_sum(sa_b.x + sa_b.y);
      const f32x2 saav = (f32x2){saa, saa}, sabv = (f32x2){sab, sab}, vav = (f32x2){cva, cva}, vbv = (f32x2){cvb, cvb};
      f32x2 ya = (f32x2){0.f, 0.f}, yb2 = (f32x2){0.f, 0.f};
#pragma unroll
      for (int q = 0; q < 2; ++q) {
        const f32x2 ka0 = (f32x2){ca[q].x, ca[q].y}, ka1 = (f32x2){ca[q].z, ca[q].w}, kd0 = (f32x2){cd[q].x, cd[q].y}, kd1 = (f32x2){cd[q].z, cd[q].w};
        const f32x2 r0 = (f32x2){cr[q].x, cr[q].y}, r1 = (f32x2){cr[q].z, cr[q].w};
        Sa[2 * q] = Sa[2 * q] * w2[2 * q] + (vav * kd0 + saav * ka0); Sa[2 * q + 1] = Sa[2 * q + 1] * w2[2 * q + 1] + (vav * kd1 + saav * ka1);
        Sb[2 * q] = Sb[2 * q] * w2[2 * q] + (vbv * kd0 + sabv * ka0); Sb[2 * q + 1] = Sb[2 * q + 1] * w2[2 * q + 1] + (vbv * kd1 + sabv * ka1);
        ya = Sa[2 * q] * r0 + ya; ya = Sa[2 * q + 1] * r1 + ya;
        yb2 = Sb[2 * q] * r0 + yb2; yb2 = Sb[2 * q + 1] * r1 + yb2;
      }
      const float y_a = oct_sum(ya.x + ya.y), y_b = oct_sum(yb2.x + yb2.y);
      if (k8 == 0) { yb[t * 64 + vp] = y_a; yb[t * 64 + vp + 32] = y_b; }
      if (t + 1 < 16) {
#pragma unroll
        for (int q = 0; q < 2; ++q) { cw[q] = nw[q]; ck[q] = nk[q]; ca[q] = na[q]; cd[q] = nd[q]; cr[q] = nr[q]; }
        cva = nva; cvb = nvb;
      }
    }
#undef RSTEP_LOAD
    if (cix + 1 < nch) RSTORE(cix + 1, buf ^ 1);
    __syncthreads();
    {
      const int ts = cix * 16 + lt; const int tok = dir ? T - 1 - ts : ts;
      const float4 yy = *(const float4*)(yb + lt * 64 + lc);
      if (wr) *(uint2*)(Y + (size_t)(rowbase + tok) * 1024 + h * 64 + lc) = make_uint2(pk_bf16(yy.x, yy.y), pk_bf16(yy.z, yy.w));
    }
  }
#undef RLOAD
#undef RSTORE
  __builtin_amdgcn_s_setprio(0);
  if (!grp && wr) {
    float* so = (dir ? p.out_rb : p.out_rf) + ((size_t)(b * 16 + h) * 64 + vp) * 64 + k8 * 8;
#pragma unroll
    for (int q = 0; q < 2; ++q) {
      *(float4*)(so + q * 4) = make_float4(Sa[2 * q].x, Sa[2 * q].y, Sa[2 * q + 1].x, Sa[2 * q + 1].y);
      *(float4*)(so + 2048 + q * 4) = make_float4(Sb[2 * q].x, Sb[2 * q].y, Sb[2 * q + 1].x, Sb[2 * q + 1].y);
    }
  }
}

__device__ __forceinline__ void rwkv_scan_phase(const Params& p, char* smem, bool dry = false) {
  const int G = gridDim.x;
  if (G >= 512) {
    if (blockIdx.x < 256) { const int a = blockIdx.x; rwkv_item(p, 1, a >> 5, (a >> 1) & 15, a & 1, smem, dry); }
    else for (int a = blockIdx.x - 256; a < 512; a += G - 256) { rwkv_item(p, 0, a >> 5, (a >> 1) & 15, a & 1, smem, dry); __syncthreads(); }
  } else {
    for (int it = blockIdx.x; it < 768; it += G) {
      const int grp = it < 256 ? 1 : 0, a = grp ? it : it - 256;
      rwkv_item(p, grp, a >> 5, (a >> 1) & 15, a & 1, smem, dry);
      __syncthreads();
    }
  }
}

__device__ __forceinline__ void blend_phase(const Params& p) {
  const int gid = blockIdx.x * NT + threadIdx.x, nth = gridDim.x * NT;
  for (int i = gid; i < NTOK * 128; i += nth) {
    const int row = i >> 7, k = (i & 127) * 8;
    ALoadShift a0{p.H, p.mix + 0 * 1024}, a2{p.H, p.mix + 2 * 1024}, a3{p.H, p.mix + 3 * 1024};
    const size_t o = (size_t)row * 1024 + k;
    *(uint4*)(p.E0 + o) = a0(row, k); *(uint4*)(p.E1 + o) = a2(row, k); *(uint4*)(p.A1 + o) = a3(row, k);
  }
}

__device__ __forceinline__ void rwkv_proj_phase(const Params& p, char* smem) {
  const int nunits = 96 * 27;
  for (int u = blockIdx.x; u < nunits; u += gridDim.x) {
    const int tm = u < 288 ? u / 3 : (u - 288) / 24, s = u < 288 ? 24 + u % 3 : (u - 288) % 24;
    if (s < 8) { EpiAct<0> ep{p.R, 1024, nullptr}; gemm_tile_glds(p.E0, 1024, p.wr_t, 1024, tm, s, ep, smem); }
    else if (s < 16) { EpiAct<0> ep{p.Kx, 1024, nullptr}; gemm_tile_glds(p.E1, 1024, p.wk_t, 1024, tm, s - 8, ep, smem); }
    else if (s < 24) { EpiAct<0> ep{p.Vx, 1024, nullptr}; gemm_tile_glds(p.A1, 1024, p.wv_t, 1024, tm, s - 16, ep, smem); }
    else if (s == 24) { ALoadShift al{p.H, p.mix + 1 * 1024}; EpiAct<2> ep{p.LW, 128, nullptr}; gemm_tile(al, p.w1cat_t, 1024, tm, 0, ep, smem); }
    else if (s == 25) { ALoadShift al{p.H, p.mix + 4 * 1024}; EpiAct<0> ep{p.LA, 128, nullptr}; gemm_tile(al, p.a1cat_t, 1024, tm, 0, ep, smem); }
    else { ALoadShift al{p.H, p.mix + 5 * 1024}; EpiAct<3> ep{p.LG, 128, nullptr}; gemm_tile(al, p.g1_t, 1024, tm, 0, ep, smem); }
  }
}
__device__ __forceinline__ void rwkv_lora2_phase(const Params& p, char* smem) {
  const int nunits = 96 * 32;
  for (int u = blockIdx.x; u < nunits; u += gridDim.x) {
    const int tm = u >> 5, s = u & 31, which = s >> 3, tn = s & 7;
    const int d = which & 1;
    if (which < 2) { ALoadPlain al{p.LW + d * 64, 128}; EpiAct<4> ep{d ? p.E1 : p.E0, 1024, p.w0 + d * 1024}; gemm_tile_glds(al.A, al.lda, p.w2_t + (size_t)d * 65536, 64, tm, tn, ep, smem); }
    else { ALoadPlain al{p.LA + d * 64, 128}; EpiAct<5> ep{d ? p.A1 : p.A0, 1024, p.a0 + d * 1024}; gemm_tile_glds(al.A, al.lda, p.a2_t + (size_t)d * 65536, 64, tm, tn, ep, smem); }
  }
}


#define XB_TMO      128
#define XB_XCNT(j)  (256  + 64 * (j))
#define XB_XSUB(j)  (1280 + 64 * (j))
#define XB_XGEN(j)  (2304 + 64 * (j))
#define XB_TOP      3328
#define XB_TOPGEN   3392
#define XCD_BAR_WORDS 3456
#define XB_SPIN_CAP (1u << 22)
#define LAS __attribute__((address_space(3)))
__device__ __forceinline__ unsigned xb_ld(unsigned* p)              { return __hip_atomic_load(p, __ATOMIC_RELAXED, __HIP_MEMORY_SCOPE_AGENT); }
__device__ __forceinline__ unsigned xb_add(unsigned* p, unsigned v) { return __hip_atomic_fetch_add(p, v, __ATOMIC_RELAXED, __HIP_MEMORY_SCOPE_AGENT); }
__device__ __forceinline__ unsigned xb_xcc_id() { return (unsigned)__builtin_amdgcn_s_getreg((3 << 11) | 20) & 0xFu; }
#define XB_SPIN(cond, bar) do { unsigned _sp = 0; while (cond) { __builtin_amdgcn_s_sleep(1); \
    if ((++_sp & 255u) == 0u) { if (xb_ld(&(bar)[XB_TMO])) break; if (_sp > XB_SPIN_CAP) { atomicAdd(&(bar)[XB_TMO], 1u); break; } } } } while (0)
struct XcdBarrier { unsigned* bar; unsigned x; volatile LAS unsigned* st; };
__device__ __forceinline__ XcdBarrier xcd_barrier_post(unsigned* bar, volatile LAS unsigned* st) {
    XcdBarrier b; b.bar = bar; b.x = xb_xcc_id(); b.st = st;
    if (threadIdx.x == 0) (void)xb_add(&bar[XB_XCNT(b.x)], 1u);
    return b;
}
__device__ __forceinline__ void xcd_barrier_complete(unsigned* bar, unsigned x, unsigned& nloc, unsigned& nx) {
    const unsigned G = gridDim.x * gridDim.y * gridDim.z;
    unsigned sum, cnt, mine, sp = 0u;
    for (;;) {
        sum = 0u; cnt = 0u; mine = 0u;
#pragma unroll
        for (unsigned j = 0; j < 16; ++j) { const unsigned c = xb_ld(&bar[XB_XCNT(j)]); sum += c; cnt += (c > 0u) ? 1u : 0u; mine = (j == x) ? c : mine; }
        if (sum == G) break;
        __builtin_amdgcn_s_sleep(1);
        if ((++sp & 255u) == 0u) { if (xb_ld(&bar[XB_TMO])) break; if (sp > XB_SPIN_CAP) { atomicAdd(&bar[XB_TMO], 1u); break; } }
    }
    nloc = mine > 0u ? mine : 1u; nx = cnt > 0u ? cnt : 1u;
}
__device__ __forceinline__ void xcd_barrier(const XcdBarrier& b) {
    asm volatile("s_waitcnt vmcnt(0)" ::: "memory");
    __syncthreads();
    if (threadIdx.x == 0) {
        unsigned* bar = b.bar;
        __builtin_amdgcn_s_waitcnt(0);
        unsigned nloc = b.st[0], nx = b.st[1];
        if (nloc == 0u) { xcd_barrier_complete(bar, b.x, nloc, nx); b.st[0] = nloc; b.st[1] = nx; }
        const unsigned old = xb_add(&bar[XB_XSUB(b.x)], 1u);
        const unsigned gen = old / nloc;
        if (old + 1u == (gen + 1u) * nloc) {
            __builtin_amdgcn_fence(__ATOMIC_RELEASE, "agent");
            asm volatile("s_waitcnt vmcnt(0)" ::: "memory");
            const unsigned og = xb_add(&bar[XB_TOP], 1u);
            const unsigned tg = og / nx;
            if (og + 1u == (tg + 1u) * nx) xb_add(&bar[XB_TOPGEN], 1u);
            else XB_SPIN(xb_ld(&bar[XB_TOPGEN]) == tg, bar);
            __builtin_amdgcn_fence(__ATOMIC_ACQUIRE, "agent");
            xb_add(&bar[XB_XGEN(b.x)], 1u);
            asm volatile("s_waitcnt vmcnt(0)" ::: "memory");
        } else {
            XB_SPIN(xb_ld(&bar[XB_XGEN(b.x)]) == gen, bar);
            __builtin_amdgcn_fence(__ATOMIC_ACQUIRE, "agent");
            asm volatile("s_waitcnt vmcnt(0)" ::: "memory");
        }
    }
    __syncthreads();
}

__device__ __forceinline__ void run_phase(const Params& p, int ph, char* smem, bool dry = false) {
  switch (ph) {
    case 0: if (ONLY_PHASE < 0 || ONLY_PHASE == 0) phase0(p, smem); break;
    case 1: if (ONLY_PHASE < 0 || ONLY_PHASE == 1) prenorm_phase(p, 0, 0, true); break;
    case 2: if (ONLY_PHASE < 0 || ONLY_PHASE == 2) { ALoadPlain al{p.H, 1024}; EpiWin ep{&p}; gemm_phase(al, p.w_in_t, 1024, 26, ep, smem); } break;
    case 3: if (ONLY_PHASE < 0 || ONLY_PHASE == 3) mix0_phase(p, smem); break;
    case 4: if (ONLY_PHASE < 0 || ONLY_PHASE == 4) hgrn_combine_phase(p); break;
    case 5: if (ONLY_PHASE < 0 || ONLY_PHASE == 5) { ALoadPlain al{p.AO, 1024}; EpiResid ep{&p, 0, 2, true}; gemm_phase(al, p.w_out_t, 1024, 8, ep, smem); } break;
    case 6: if (ONLY_PHASE < 0 || ONLY_PHASE == 6) prenorm_phase(p, 0, 1, false); break;
    case 7: if (ONLY_PHASE < 0 || ONLY_PHASE == 7) { ALoadPlain al{p.H, 1024}; EpiAct<1> ep{p.U, 4096, nullptr}; gemm_phase(al, p.mlp1_t, 1024, 32, ep, smem); } break;
    case 8: if (ONLY_PHASE < 0 || ONLY_PHASE == 8) { ALoadPlain al{p.U, 4096}; EpiResid ep{&p, 0, 5, false, dry}; gemm_phase(al, p.mlp2_t, 4096, 8, ep, smem); } break;
    case 9: if (ONLY_PHASE < 0 || ONLY_PHASE == 9) prenorm_phase(p, 1, 0, false); break;
    case 10: if (ONLY_PHASE < 0 || ONLY_PHASE == 10) rwkv_proj_phase(p, smem); break;
    case 11: if (ONLY_PHASE < 0 || ONLY_PHASE == 11) rwkv_lora2_phase(p, smem); break;
    case 12: if (ONLY_PHASE < 0 || ONLY_PHASE == 12) rwkv_scan_phase(p, smem, dry); break;
    case 13: if (ONLY_PHASE < 0 || ONLY_PHASE == 13) { ALoadPlain al{p.LG, 128}; EpiRwkvOut ep{&p}; gemm_phase(al, p.g2_t, 128, 8, ep, smem); } break;
    case 14: if (ONLY_PHASE < 0 || ONLY_PHASE == 14) { ALoadPlain al{p.ZO, 1024}; EpiResid ep{&p, 1, 2, false, dry}; gemm_phase(al, p.wo_t, 1024, 8, ep, smem); } break;
    case 15: if (ONLY_PHASE < 0 || ONLY_PHASE == 15) prenorm_phase(p, 1, 1, false); break;
    case 16: if (ONLY_PHASE < 0 || ONLY_PHASE == 16) { ALoadPlain al{p.H, 1024}; EpiAct<1> ep{p.U, 4096, nullptr}; gemm_phase(al, p.mlp1_t + (size_t)4096 * 1024, 1024, 32, ep, smem); } break;
    case 17: if (ONLY_PHASE < 0 || ONLY_PHASE == 17) { ALoadPlain al{p.U, 4096}; EpiResid ep{&p, 1, 5, false, dry}; gemm_phase(al, p.mlp2_t + (size_t)4096 * 1024, 4096, 8, ep, smem); } break;
    case 18: blend_phase(p); break;
    default: break;
  }
}

__global__ void __launch_bounds__(NT, 2) fwd_kernel(const Params p_unused, int ph_lo, int ph_hi) {
  const Params& p = *(const Params*)__builtin_amdgcn_kernarg_segment_ptr();
  __shared__ __attribute__((aligned(16))) char smem[65536];
  __shared__ uint4 xb_words;
  if (threadIdx.x == 0) xb_words = make_uint4(0u, 0u, 0u, 0u);
  __syncthreads();
  XcdBarrier xb = xcd_barrier_post(p.bar, (volatile LAS unsigned*)&xb_words);
  if (ph_hi < 0) cg::this_grid().sync();
#ifndef PROBE_MASK
#define PROBE_MASK 0
#endif
#ifndef PROBE_DRY
#define PROBE_DRY 0
#endif
#define PHASE(n, sync_) { if ((PROBE_MASK >> n) & 1) { run_phase(p, n, smem); xcd_barrier(xb); } if ((PROBE_DRY >> n) & 1) { run_phase(p, n, smem, true); xcd_barrier(xb); } run_phase(p, n, smem); if (sync_) xcd_barrier(xb); }
  PHASE(0, 1) PHASE(1, 1) PHASE(2, 1) PHASE(3, 1) PHASE(4, 1) PHASE(5, 1) PHASE(6, 1) PHASE(7, 1) PHASE(8, 1) PHASE(9, 1) PHASE(18, 1)
  PHASE(10, 1) PHASE(11, 1) PHASE(12, 1) PHASE(13, 1) PHASE(14, 1) PHASE(15, 1) PHASE(16, 1) PHASE(17, 0)
#undef PHASE
}

extern "C" void kernel_launch(void* const* d_in, const int* in_sizes, int n_in, void* d_out, int out_size, void* d_ws, size_t ws_size, hipStream_t stream) {
  Params p; memset(&p, 0, sizeof(p));
  auto F = [&](int i) { return (const float*)d_in[i]; };
  p.x_prompt = F(0); p.x_sample = F(1); p.cache_k = F(2); p.cache_v = F(3); p.hg_f0 = F(4); p.hg_b0 = F(5); p.rw_f0 = F(6); p.rw_b0 = F(7);
  p.c = F(8); p.c_ctx = F(9); p.ada_w = F(10); p.ada_b = F(11); p.norm1_w = F(12); p.norm2_w = F(13);
  p.q_norm = F(16); p.k_norm = F(17); p.hgrn_lb = F(18); p.g_norm = F(19); p.mix = F(20);
  p.w0 = F(25); p.a0 = F(28); p.k_k = F(33); p.k_a = F(34); p.r_k = F(35); p.ln_w = F(36); p.ln_b = F(37);
  float* out = (float*)d_out;
  p.X = out; p.out_k = out + 12582912; p.out_v = out + 13107200; p.out_hf = out + 13631488; p.out_hb = out + 14155776;
  p.out_rf = out + 14680064; p.out_rb = out + 15728640;
  char* ws = (char*)d_ws; size_t off = 16384;
  p.bar = (unsigned*)ws;
  auto alloc = [&](size_t bytes) { char* r = ws + off; off += (bytes + 255) & ~(size_t)255; return r; };
  const size_t M1 = (size_t)1024 * 1024;
  p.w_in_t = (bf16_t*)alloc((size_t)3328 * 1024 * 2); p.w_out_t = (bf16_t*)alloc(M1 * 2);
  p.wr_t = (bf16_t*)alloc(M1 * 2); p.wk_t = (bf16_t*)alloc(M1 * 2); p.wv_t = (bf16_t*)alloc(M1 * 2); p.wo_t = (bf16_t*)alloc(M1 * 2);
  p.w1cat_t = (bf16_t*)alloc(128 * 1024 * 2); p.a1cat_t = (bf16_t*)alloc(128 * 1024 * 2); p.g1_t = (bf16_t*)alloc(128 * 1024 * 2);
  p.w2_t = (bf16_t*)alloc(2 * 1024 * 64 * 2); p.a2_t = (bf16_t*)alloc(2 * 1024 * 64 * 2); p.g2_t = (bf16_t*)alloc(1024 * 128 * 2);
  p.mlp1_t = (bf16_t*)alloc(2 * 4 * M1 * 2); p.mlp2_t = (bf16_t*)alloc(2 * 4 * M1 * 2);
  p.MOD = (float*)alloc((size_t)2 * 9 * 6144 * 4);
  const size_t TOKD = (size_t)NTOK * 1024;
  p.H = (bf16_t*)alloc(TOKD * 2);
  const size_t regL = off;
  p.Qbuf = (bf16_t*)alloc((size_t)NTOK * 512 * 2);
  p.Kp = (bf16_t*)alloc((size_t)32 * 256 * 64 * 2); p.Ks = (bf16_t*)alloc((size_t)16 * 1280 * 64 * 2);
  p.Vtp = (bf16_t*)alloc((size_t)32 * 64 * 256 * 2); p.Vts = (bf16_t*)alloc((size_t)16 * 64 * 1280 * 2);
  p.HG = (bf16_t*)alloc((size_t)NTOK * 2560 * 2);
  p.OF = (float*)alloc((size_t)NTOK * 512 * 4); p.OB = (float*)alloc((size_t)NTOK * 512 * 4);
  p.AO = (bf16_t*)alloc(TOKD * 2);
  size_t end0 = off;
  off = regL; p.U = (bf16_t*)alloc((size_t)NTOK * 4096 * 2);
  size_t endU = off;
  off = regL;
  p.R = (bf16_t*)alloc(TOKD * 2); p.Kx = (bf16_t*)alloc(TOKD * 2); p.Vx = (bf16_t*)alloc(TOKD * 2);
  p.LW = (bf16_t*)alloc((size_t)NTOK * 128 * 2); p.LA = (bf16_t*)alloc((size_t)NTOK * 128 * 2); p.LG = (bf16_t*)alloc((size_t)NTOK * 128 * 2);
  p.E0 = (bf16_t*)alloc(TOKD * 2); p.E1 = (bf16_t*)alloc(TOKD * 2); p.A1 = (bf16_t*)alloc(TOKD * 2);
  p.BS = (float*)alloc((size_t)2 * NTOK * 16 * 4);
  p.A0 = p.H; p.ZO = p.R;
  size_t end1 = off;
  size_t need = end0 > end1 ? end0 : end1; if (endU > need) need = endU;
  if (need > ws_size) fprintf(stderr, "workspace too small: need %zu have %zu\n", need, ws_size);
  int nj = 0, tiles = 0;
  auto job = [&](const float* src, bf16_t* dst, int K, int N) { p.jobs[nj].src = src; p.jobs[nj].dst = dst; p.jobs[nj].K = K; p.jobs[nj].N = N; p.jobs[nj].tile0 = tiles; p.jobs[nj].pad = 0; tiles += (K / 64) * (N / 64); ++nj; };
  job(F(38), p.mlp1_t, 1024, 4096); job(F(38) + 4 * M1, p.mlp1_t + 4 * M1, 1024, 4096);
  job(F(39), p.mlp2_t, 4096, 1024); job(F(39) + 4 * M1, p.mlp2_t + 4 * M1, 4096, 1024);
  job(F(14), p.w_in_t, 1024, 3328); job(F(15), p.w_out_t, 1024, 1024);
  job(F(21), p.wr_t, 1024, 1024); job(F(22), p.wk_t, 1024, 1024); job(F(23), p.wv_t, 1024, 1024); job(F(24), p.wo_t, 1024, 1024);
  job(F(26), p.w1cat_t, 1024, 64); job(F(26) + 65536, p.w1cat_t + 65536, 1024, 64);
  job(F(29), p.a1cat_t, 1024, 64); job(F(29) + 65536, p.a1cat_t + 65536, 1024, 64);
  job(F(31), p.g1_t, 1024, 128);
  job(F(27), p.w2_t, 64, 1024); job(F(27) + 65536, p.w2_t + 65536, 64, 1024);
  job(F(30), p.a2_t, 64, 1024); job(F(30) + 65536, p.a2_t + 65536, 64, 1024);
  job(F(32), p.g2_t, 128, 1024);
  p.njobs = nj; p.ntiles = tiles;

  static int grid_blocks = 0;
  if (!grid_blocks) {
    int dev = 0, cus = 0, per_cu = 0;
    hipGetDevice(&dev);
    hipDeviceGetAttribute(&cus, hipDeviceAttributeMultiprocessorCount, dev);
    hipOccupancyMaxActiveBlocksPerMultiprocessor(&per_cu, fwd_kernel, NT, 0);
    if (per_cu > 2) per_cu = 2;
    if (per_cu < 1) per_cu = 1;
    grid_blocks = cus * per_cu;
  }
  hipMemsetAsync(d_ws, 0, 16384, stream);
  int lo = 0, hi = NPHASES;
  void* args[] = {(void*)&p, (void*)&lo, (void*)&hi};
  hipError_t e = hipLaunchCooperativeKernel((void*)fwd_kernel, dim3(grid_blocks), dim3(NT), args, 0, stream);
  if (e != hipSuccess) fprintf(stderr, "cooperative launch failed: %s (grid %d)\n", hipGetErrorString(e), grid_blocks);
}
```

```cpp
#include <hip/hip_runtime.h>
#include <hip/hip_cooperative_groups.h>
#include <stdint.h>
#include <string.h>
#include <stdio.h>
namespace cg = cooperative_groups;

typedef unsigned short bf16_t;
typedef short bf16x8 __attribute__((ext_vector_type(8)));
typedef float f32x4 __attribute__((ext_vector_type(4)));
typedef float f32x16 __attribute__((ext_vector_type(16)));
typedef float f32x2 __attribute__((ext_vector_type(2)));

#define NT 256
#define NTOK 12288
#define NP 4096
#define NPHASES 18
#ifndef ONLY_PHASE
#define ONLY_PHASE -1
#endif

struct TJob { const float* src; bf16_t* dst; int K, N, tile0, pad; };

struct Params {
  const float *x_prompt, *x_sample, *cache_k, *cache_v, *hg_f0, *hg_b0, *rw_f0, *rw_b0, *c, *c_ctx;
  const float *ada_w, *ada_b, *norm1_w, *norm2_w, *q_norm, *k_norm, *hgrn_lb, *g_norm;
  const float *mix, *w0, *a0, *k_k, *k_a, *r_k, *ln_w, *ln_b;
  float *X, *out_k, *out_v, *out_hf, *out_hb, *out_rf, *out_rb;
  bf16_t *w_in_t, *w_out_t, *wr_t, *wk_t, *wv_t, *wo_t, *w1cat_t, *a1cat_t, *g1_t, *w2_t, *a2_t, *g2_t, *mlp1_t, *mlp2_t;
  float* MOD;
  float *SSQ, *BM;
  bf16_t* H;
  bf16_t *Qbuf, *Kp, *Ks, *Vtp, *Vts, *HG, *AO, *U;
  float *OF, *OB;
  bf16_t *R, *Kx, *Vx, *LW, *LA, *LG, *E0, *E1, *A0, *A1, *ZO;
  float* BS;
  unsigned* bar;
  TJob jobs[20];
  int njobs, ntiles;
};

typedef float f32x2c __attribute__((ext_vector_type(2)));
typedef __bf16 bf16v2 __attribute__((ext_vector_type(2)));
__device__ __forceinline__ unsigned pk_bf16(float lo, float hi) { f32x2c v = {lo, hi}; bf16v2 b = __builtin_convertvector(v, bf16v2); return __builtin_bit_cast(unsigned, b); }
__device__ __forceinline__ bf16_t f2bf(float v) { return (bf16_t)(pk_bf16(v, 0.f) & 0xffffu); }
__device__ __forceinline__ float bf2f(bf16_t v) { return __uint_as_float(((unsigned)v) << 16); }
__device__ __forceinline__ float bflo(unsigned u) { return __uint_as_float(u << 16); }
__device__ __forceinline__ float bfhi(unsigned u) { return __uint_as_float(u & 0xffff0000u); }
__device__ __forceinline__ float sigmoidf_(float x) { return __builtin_amdgcn_rcpf(1.f + __expf(-x)); }
__device__ __forceinline__ float siluf_(float x) { return x * __builtin_amdgcn_rcpf(1.f + __expf(-x)); }
__device__ __forceinline__ float wave_sum(float v) {
#pragma unroll
  for (int o = 32; o >= 1; o >>= 1) v += __shfl_xor(v, o);
  return v;
}
__device__ __forceinline__ float quad_sum(float v) {
  v += __int_as_float(__builtin_amdgcn_update_dpp(0, __float_as_int(v), 0xB1, 0xF, 0xF, true));
  v += __int_as_float(__builtin_amdgcn_update_dpp(0, __float_as_int(v), 0x4E, 0xF, 0xF, true));
  return v;
}
__device__ __forceinline__ float oct_sum(float v) {
  v += __int_as_float(__builtin_amdgcn_update_dpp(0, __float_as_int(v), 0xB1, 0xF, 0xF, true));
  v += __int_as_float(__builtin_amdgcn_update_dpp(0, __float_as_int(v), 0x4E, 0xF, 0xF, true));
  v += __int_as_float(__builtin_amdgcn_update_dpp(0, __float_as_int(v), 0x141, 0xF, 0xF, true));
  return v;
}
__device__ __forceinline__ float hex_sum(float v) {
  v = oct_sum(v);
  v += __int_as_float(__builtin_amdgcn_update_dpp(0, __float_as_int(v), 0x140, 0xF, 0xF, true));
  return v;
}
__device__ __forceinline__ int mod_index(int row) { return row < NP ? 0 : 1 + ((row - NP) >> 10); }

__device__ __forceinline__ void ada_item(const Params& p, int it, char* smem) {
  const int tid = threadIdx.x;
  float* sil = (float*)smem;
  for (int i = tid; i < 9 * 1024; i += NT) {
    int n = i >> 10, k = i & 1023;
    float cv = n == 0 ? p.c_ctx[k] : p.c[(n - 1) * 1024 + k];
    sil[i] = siluf_(cv);
  }
  __syncthreads();
  const int gcol = it * 64, l = gcol / 6144, j = gcol % 6144;
  const int c4 = tid & 15, ks = tid >> 4;
  const float* wp = p.ada_w + (size_t)l * 1024 * 6144 + (size_t)(ks * 64) * 6144 + j + c4 * 4;
  float acc[9][4];
#pragma unroll
  for (int n = 0; n < 9; ++n) { acc[n][0] = 0.f; acc[n][1] = 0.f; acc[n][2] = 0.f; acc[n][3] = 0.f; }
#pragma unroll 4
  for (int k = 0; k < 64; ++k) {
    const float4 w = *(const float4*)(wp + (size_t)k * 6144);
#pragma unroll
    for (int n = 0; n < 9; ++n) {
      const float s = sil[n * 1024 + ks * 64 + k];
      acc[n][0] += s * w.x; acc[n][1] += s * w.y; acc[n][2] += s * w.z; acc[n][3] += s * w.w;
    }
  }
  __syncthreads();
  float* red = (float*)smem;
#pragma unroll
  for (int n = 0; n < 9; ++n)
#pragma unroll
    for (int q = 0; q < 4; ++q) red[(ks * 9 + n) * 64 + c4 * 4 + q] = acc[n][q];
  __syncthreads();
  for (int o = tid; o < 576; o += NT) {
    const int n = o >> 6, cc = o & 63;
    float s = 0.f;
#pragma unroll
    for (int k2 = 0; k2 < 16; ++k2) s += red[(k2 * 9 + n) * 64 + cc];
    s += p.ada_b[l * 6144 + j + cc];
    p.MOD[(size_t)(l * 9 + n) * 6144 + j + cc] = s;
  }
}

__device__ __forceinline__ void transpose_item(const Params& p, int tix, char* smem) {
  const int tid = threadIdx.x;
  int j = 0;
  while (j + 1 < p.njobs && tix >= p.jobs[j + 1].tile0) ++j;
  const float* src = p.jobs[j].src; bf16_t* dst = p.jobs[j].dst;
  const int K = p.jobs[j].K, N = p.jobs[j].N, lt = tix - p.jobs[j].tile0;
  const int ntn = N >> 6, tk = lt / ntn, tn = lt % ntn;
  float* tile = (float*)smem;
#pragma unroll
  for (int i = 0; i < 4; ++i) {
    const int r = (tid >> 4) + 16 * i, c4 = tid & 15;
    const float4 v = *(const float4*)(src + (size_t)(tk * 64 + r) * N + tn * 64 + c4 * 4);
    float* t = tile + r * 65 + c4 * 4;
    t[0] = v.x; t[1] = v.y; t[2] = v.z; t[3] = v.w;
  }
  __syncthreads();
  const int n = tid >> 2, kc = (tid & 3) * 16;
  unsigned w[8];
#pragma unroll
  for (int i = 0; i < 8; ++i) w[i] = pk_bf16(tile[(kc + 2 * i) * 65 + n], tile[(kc + 2 * i + 1) * 65 + n]);
  uint4* d = (uint4*)(dst + (size_t)(tn * 64 + n) * K + tk * 64 + kc);
  d[0] = make_uint4(w[0], w[1], w[2], w[3]);
  d[1] = make_uint4(w[4], w[5], w[6], w[7]);
}

__device__ __forceinline__ void cache_item(const Params& p, int ci) {
  const int tid = threadIdx.x;
  const int base = (ci & 31) * 8192;
  for (int e = tid; e < 8192; e += NT) {
    const int idx = base + e;
    const int d = idx & 63, kvh = (idx >> 6) & 1, pp = (idx >> 7) & 255, b = idx >> 15;
    if (ci < 32) p.Ks[((size_t)(b * 2 + kvh) * 1280 + 1024 + pp) * 64 + d] = f2bf(p.cache_k[idx]);
    else p.Vts[((size_t)(b * 2 + kvh) * 64 + d) * 1280 + 1024 + pp] = f2bf(p.cache_v[idx]);
  }
}

__device__ __forceinline__ void phase0(const Params& p, char* smem) {
  const int n_ada = 192, n_tr = p.ntiles, n_cc = 64;
  const int total = n_ada + n_tr + n_cc;
  for (int it = blockIdx.x; it < total; it += gridDim.x) {
    if (it < n_ada) ada_item(p, it, smem);
    else if (it < n_ada + n_tr) transpose_item(p, it - n_ada, smem);
    else cache_item(p, it - n_ada - n_tr);
    __syncthreads();
  }
}

__device__ __forceinline__ void prenorm_phase(const Params& p, int layer, int which, bool from_input) {
  const int wave = threadIdx.x >> 6, lane = threadIdx.x & 63;
  const float* nw = (which ? p.norm2_w : p.norm1_w) + layer * 1024;
  for (int row = blockIdx.x * 4 + wave; row < NTOK; row += gridDim.x * 4) {
    const float* xr = from_input ? (row < NP ? p.x_prompt + (size_t)row * 1024 : p.x_sample + (size_t)(row - NP) * 1024)
                                 : p.X + (size_t)row * 1024;
    float4 v[4]; float ss = 0.f;
#pragma unroll
    for (int i = 0; i < 4; ++i) { v[i] = *(const float4*)(xr + i * 256 + lane * 4); ss += v[i].x * v[i].x + v[i].y * v[i].y + v[i].z * v[i].z + v[i].w * v[i].w; }
    ss = wave_sum(ss);
    const float rstd = rsqrtf(ss * (1.f / 1024.f) + 1e-6f);
    const float* md = p.MOD + (size_t)(layer * 9 + mod_index(row)) * 6144;
    const float* sh = md + (which ? 3 : 0) * 1024; const float* sc = md + (which ? 4 : 1) * 1024;
#pragma unroll
    for (int i = 0; i < 4; ++i) {
      const int c = i * 256 + lane * 4;
      const float4 w4 = *(const float4*)(nw + c), s4 = *(const float4*)(sh + c), c4 = *(const float4*)(sc + c);
      const float h0 = v[i].x * rstd * w4.x * (1.f + c4.x) + s4.x, h1 = v[i].y * rstd * w4.y * (1.f + c4.y) + s4.y;
      const float h2 = v[i].z * rstd * w4.z * (1.f + c4.z) + s4.z, h3 = v[i].w * rstd * w4.w * (1.f + c4.w) + s4.w;
      *(uint2*)(p.H + (size_t)row * 1024 + c) = make_uint2(pk_bf16(h0, h1), pk_bf16(h2, h3));
    }
  }
}

__device__ __forceinline__ void mlp_bias_phase(const Params& p) {
  const int gid = blockIdx.x * NT + threadIdx.x, nth = gridDim.x * NT;
  for (int i = gid; i < 2 * NTOK; i += nth) p.SSQ[i] = 0.f;
  const int wave = threadIdx.x >> 6, lane = threadIdx.x & 63;
  for (int o = blockIdx.x * 4 + wave; o < 2 * 4096; o += gridDim.x * 4) {
    const int l = o >> 12, n = o & 4095;
    const bf16_t* wrow = p.mlp1_t + (size_t)l * 4096 * 1024 + (size_t)n * 1024 + lane * 16;
    const uint4 w0 = *(const uint4*)(wrow), w1 = *(const uint4*)(wrow + 8);
    const float wv[16] = {bflo(w0.x), bfhi(w0.x), bflo(w0.y), bfhi(w0.y), bflo(w0.z), bfhi(w0.z), bflo(w0.w), bfhi(w0.w),
                          bflo(w1.x), bfhi(w1.x), bflo(w1.y), bfhi(w1.y), bflo(w1.z), bfhi(w1.z), bflo(w1.w), bfhi(w1.w)};
#pragma unroll 1
    for (int m = 0; m < 9; ++m) {
      const float* sh = p.MOD + (size_t)(l * 9 + m) * 6144 + 3 * 1024 + lane * 16;
      float acc = 0.f;
#pragma unroll
      for (int q = 0; q < 4; ++q) { const float4 s4 = *(const float4*)(sh + q * 4); acc += s4.x * wv[q * 4] + s4.y * wv[q * 4 + 1] + s4.z * wv[q * 4 + 2] + s4.w * wv[q * 4 + 3]; }
      acc = wave_sum(acc);
      if (lane == 0) p.BM[(size_t)(l * 9 + m) * 4096 + n] = acc;
    }
  }
}

struct ALoadPlain {
  const bf16_t* A; int lda;
  __device__ __forceinline__ uint4 operator()(int row, int k) const { return *(const uint4*)(A + (size_t)row * lda + k); }
};
struct ALoadShift {
  const bf16_t* H; const float* mix;
  __device__ __forceinline__ uint4 operator()(int row, int k) const {
    const uint4 h = *(const uint4*)(H + (size_t)row * 1024 + k);
    int tl, T;
    if (row < NP) { tl = row & 255; T = 256; } else { tl = (row - NP) & 1023; T = 1024; }
    uint4 s = make_uint4(0, 0, 0, 0);
    if (k < 512) { if (tl > 0) s = *(const uint4*)(H + (size_t)(row - 1) * 1024 + k); }
    else { if (tl < T - 1) s = *(const uint4*)(H + (size_t)(row + 1) * 1024 + k); }
    const float4 m0 = *(const float4*)(mix + k), m1 = *(const float4*)(mix + k + 4);
    uint4 o;
    { float a = bflo(h.x), b = bfhi(h.x); o.x = pk_bf16(a + (bflo(s.x) - a) * m0.x, b + (bfhi(s.x) - b) * m0.y); }
    { float a = bflo(h.y), b = bfhi(h.y); o.y = pk_bf16(a + (bflo(s.y) - a) * m0.z, b + (bfhi(s.y) - b) * m0.w); }
    { float a = bflo(h.z), b = bfhi(h.z); o.z = pk_bf16(a + (bflo(s.z) - a) * m1.x, b + (bfhi(s.z) - b) * m1.y); }
    { float a = bflo(h.w), b = bfhi(h.w); o.w = pk_bf16(a + (bflo(s.w) - a) * m1.z, b + (bfhi(s.w) - b) * m1.w); }
    return o;
  }
};

template <class AL, class EP>
__device__ __forceinline__ void gemm_tile(const AL& al, const bf16_t* __restrict__ Bt, int K, int tm, int tn, const EP& ep, char* smem) {
  const int tid = threadIdx.x, lane = tid & 63, wid = tid >> 6, wm = wid >> 1, wn = wid & 1;
  const int fr = lane & 15, fq = lane >> 4;
  char* sA = smem; char* sB = smem + 32768;
  f32x4 acc[4][4];
#pragma unroll
  for (int a = 0; a < 4; ++a)
#pragma unroll
    for (int b = 0; b < 4; ++b) acc[a][b] = (f32x4){0.f, 0.f, 0.f, 0.f};
  uint4 pa[4], pb[4];
  const int nk = K >> 6;
  const int cr0 = tid >> 3, cc = tid & 7;
  const int soff = cr0 * 128 + ((cc ^ ((cr0 >> 1) & 7)) << 4);
  const bf16_t* bp = Bt + (size_t)(tn * 128 + cr0) * K + cc * 8;
#define GLOAD(kt) do { _Pragma("unroll") for (int i = 0; i < 4; ++i) { pa[i] = al(tm * 128 + cr0 + 32 * i, (kt) * 64 + cc * 8); pb[i] = *(const uint4*)(bp + (size_t)(32 * i) * K + (kt) * 64); } } while (0)
#define SSTORE(buf) do { _Pragma("unroll") for (int i = 0; i < 4; ++i) { *(uint4*)(sA + (buf) * 16384 + soff + i * 4096) = pa[i]; *(uint4*)(sB + (buf) * 16384 + soff + i * 4096) = pb[i]; } } while (0)
  GLOAD(0); SSTORE(0); __syncthreads();
  for (int kt = 0; kt < nk; ++kt) {
    const int buf = kt & 1;
    if (kt + 1 < nk) GLOAD(kt + 1);
#pragma unroll
    for (int kk = 0; kk < 2; ++kk) {
      bf16x8 af[4], bfr[4];
#pragma unroll
      for (int mi = 0; mi < 4; ++mi) { const int r = wm * 64 + mi * 16 + fr, c = kk * 4 + fq; af[mi] = *(const bf16x8*)(sA + buf * 16384 + r * 128 + ((c ^ ((r >> 1) & 7)) << 4)); }
#pragma unroll
      for (int ni = 0; ni < 4; ++ni) { const int r = wn * 64 + ni * 16 + fr, c = kk * 4 + fq; bfr[ni] = *(const bf16x8*)(sB + buf * 16384 + r * 128 + ((c ^ ((r >> 1) & 7)) << 4)); }
#pragma unroll
      for (int mi = 0; mi < 4; ++mi)
#pragma unroll
        for (int ni = 0; ni < 4; ++ni) acc[mi][ni] = __builtin_amdgcn_mfma_f32_16x16x32_bf16(bfr[ni], af[mi], acc[mi][ni], 0, 0, 0);
    }
    if (kt + 1 < nk) SSTORE(buf ^ 1);
    __syncthreads();
  }
#undef GLOAD
#undef SSTORE
  ep(acc, tm * 128 + wm * 64, tn * 128 + wn * 64, lane);
}

#define LAS3 __attribute__((address_space(3)))
template <int OFF>
__device__ __forceinline__ bf16x8 lds_rd128(unsigned addr) { bf16x8 v; asm volatile("ds_read_b128 %0, %1 offset:%2" : "=v"(v) : "v"(addr), "n"(OFF) : "memory"); return v; }
template <class EP>
__device__ __forceinline__ void gemm_tile_glds(const bf16_t* __restrict__ A, int lda, const bf16_t* __restrict__ Bt, int K, int tm, int tn, const EP& ep, char* smem) {
  const int tid = threadIdx.x, lane = tid & 63, wid = __builtin_amdgcn_readfirstlane(tid >> 6), wm = wid >> 1, wn = wid & 1;
  const int fr = lane & 15, fq = lane >> 4;
  f32x4 acc[4][4];
#pragma unroll
  for (int a = 0; a < 4; ++a)
#pragma unroll
    for (int b = 0; b < 4; ++b) acc[a][b] = (f32x4){0.f, 0.f, 0.f, 0.f};
  const int nk = K >> 6;
  const int lr = lane >> 3, c0 = (lane & 7) ^ (lr >> 1);
  const bf16_t* pa = A + (size_t)(tm * 128 + wid * 32 + lr) * lda;
  const bf16_t* pb = Bt + (size_t)(tn * 128 + wid * 32 + lr) * K;
  const unsigned lbase = (unsigned)(uintptr_t)(LAS3 char*)smem;
  const unsigned fsw = (unsigned)((fq ^ ((fr >> 1) & 7)) << 4);
  const unsigned aA0 = lbase + (unsigned)((wm * 64 + fr) * 128) + fsw, aA1 = lbase + (unsigned)((wm * 64 + fr) * 128) + (fsw ^ 64u);
  const unsigned aB0 = lbase + 32768u + (unsigned)((wn * 64 + fr) * 128) + fsw, aB1 = lbase + 32768u + (unsigned)((wn * 64 + fr) * 128) + (fsw ^ 64u);
#define GLDS(kt, buf) do { _Pragma("unroll") for (int i = 0; i < 4; ++i) { const int cc_ = (c0 ^ ((i & 1) << 2)) * 8 + (kt) * 64; \
    __builtin_amdgcn_global_load_lds((const unsigned*)(pa + (size_t)(i * 8) * lda + cc_), (LAS3 unsigned*)(smem + (buf) * 16384 + (wid * 4 + i) * 1024), 16, 0, 0); \
    __builtin_amdgcn_global_load_lds((const unsigned*)(pb + (size_t)(i * 8) * K + cc_), (LAS3 unsigned*)(smem + 32768 + (buf) * 16384 + (wid * 4 + i) * 1024), 16, 0, 0); } } while (0)
  GLDS(0, 0);
  asm volatile("s_waitcnt vmcnt(0)" ::: "memory");
  __builtin_amdgcn_s_barrier();
  for (int kt = 0; kt < nk; ++kt) {
    const int buf = kt & 1;
    if (kt + 1 < nk) GLDS(kt + 1, buf ^ 1);
    const unsigned bo = (unsigned)buf * 16384u;
    bf16x8 a0[4], b0[4], a1[4], b1[4];
    a0[0] = lds_rd128<0>(aA0 + bo); a0[1] = lds_rd128<2048>(aA0 + bo); a0[2] = lds_rd128<4096>(aA0 + bo); a0[3] = lds_rd128<6144>(aA0 + bo);
    b0[0] = lds_rd128<0>(aB0 + bo); b0[1] = lds_rd128<2048>(aB0 + bo); b0[2] = lds_rd128<4096>(aB0 + bo); b0[3] = lds_rd128<6144>(aB0 + bo);
    a1[0] = lds_rd128<0>(aA1 + bo); a1[1] = lds_rd128<2048>(aA1 + bo); a1[2] = lds_rd128<4096>(aA1 + bo); a1[3] = lds_rd128<6144>(aA1 + bo);
    b1[0] = lds_rd128<0>(aB1 + bo); b1[1] = lds_rd128<2048>(aB1 + bo); b1[2] = lds_rd128<4096>(aB1 + bo); b1[3] = lds_rd128<6144>(aB1 + bo);
    __builtin_amdgcn_sched_barrier(0);
    asm volatile("s_waitcnt lgkmcnt(8)" : "+v"(a0[0]), "+v"(a0[1]), "+v"(a0[2]), "+v"(a0[3]), "+v"(b0[0]), "+v"(b0[1]), "+v"(b0[2]), "+v"(b0[3]) :: "memory");
    __builtin_amdgcn_s_setprio(1);
#pragma unroll
    for (int mi = 0; mi < 4; ++mi)
#pragma unroll
      for (int ni = 0; ni < 4; ++ni) acc[mi][ni] = __builtin_amdgcn_mfma_f32_16x16x32_bf16(b0[ni], a0[mi], acc[mi][ni], 0, 0, 0);
    __builtin_amdgcn_sched_barrier(0);
    asm volatile("s_waitcnt lgkmcnt(0)" : "+v"(a1[0]), "+v"(a1[1]), "+v"(a1[2]), "+v"(a1[3]), "+v"(b1[0]), "+v"(b1[1]), "+v"(b1[2]), "+v"(b1[3]) :: "memory");
#pragma unroll
    for (int mi = 0; mi < 4; ++mi)
#pragma unroll
      for (int ni = 0; ni < 4; ++ni) acc[mi][ni] = __builtin_amdgcn_mfma_f32_16x16x32_bf16(b1[ni], a1[mi], acc[mi][ni], 0, 0, 0);
    __builtin_amdgcn_s_setprio(0);
    __builtin_amdgcn_sched_barrier(0);
    asm volatile("s_waitcnt vmcnt(0)" ::: "memory");
    __builtin_amdgcn_s_barrier();
    __builtin_amdgcn_sched_barrier(0);
  }
#undef GLDS
  ep(acc, tm * 128 + wm * 64, tn * 128 + wn * 64, lane);
}

struct EpiWin {
  const Params* pp;
  __device__ __forceinline__ void operator()(f32x4 (&acc)[4][4], int row0, int col0, int lane) const {
    const Params& p = *pp;
    const int fr = lane & 15, fq = lane >> 4;
    const bool sample = row0 >= NP;
    if (col0 < 640) {
      const bool isq = col0 < 512;
      const float* nw = isq ? p.q_norm : p.k_norm;
      float nwv[4][4];
#pragma unroll
      for (int ni = 0; ni < 4; ++ni)
#pragma unroll
        for (int j = 0; j < 4; ++j) nwv[ni][j] = nw[ni * 16 + fq * 4 + j];
#pragma unroll
      for (int mi = 0; mi < 4; ++mi) {
        const int row = row0 + mi * 16 + fr;
        float ss = 0.f;
#pragma unroll
        for (int ni = 0; ni < 4; ++ni)
#pragma unroll
          for (int j = 0; j < 4; ++j) ss += acc[mi][ni][j] * acc[mi][ni][j];
        ss += __shfl_xor(ss, 16); ss += __shfl_xor(ss, 32);
        const float rn = rsqrtf(ss * (1.f / 64.f) + 1e-6f);
        float y[4][4];
#pragma unroll
        for (int ni = 0; ni < 4; ++ni)
#pragma unroll
          for (int j = 0; j < 4; ++j) y[ni][j] = acc[mi][ni][j] * rn * nwv[ni][j];
        if (!sample && !isq) {
          const int kvh = (col0 - 512) >> 6;
#pragma unroll
          for (int ni = 0; ni < 4; ++ni) *(f32x4*)(p.out_k + (size_t)row * 128 + kvh * 64 + ni * 16 + fq * 4) = (f32x4){y[ni][0], y[ni][1], y[ni][2], y[ni][3]};
        }
        if (sample) {
          const int tl = (row - NP) & 1023;
          const float rp = (float)(tl >> 6), cp = (float)(tl & 63);
#pragma unroll
          for (int ni = 0; ni < 4; ++ni)
#pragma unroll
            for (int jp = 0; jp < 2; ++jp) {
              const int i = (ni * 16 + fq * 4 + jp * 2) >> 1;
              const float pos = i < 16 ? rp : cp;
              const float inv = exp2f(-(float)(i & 15) * 0.83048202372184058696f);
              const float ang = pos * inv;
              const float s = __sinf(ang), c = __cosf(ang);
              const float x0 = y[ni][2 * jp], x1 = y[ni][2 * jp + 1];
              y[ni][2 * jp] = x0 * c - x1 * s; y[ni][2 * jp + 1] = x0 * s + x1 * c;
            }
        }
        if (isq) {
          const float qs = 0.125f * 1.44269504088896f;
#pragma unroll
          for (int ni = 0; ni < 4; ++ni)
            *(uint2*)(p.Qbuf + (size_t)row * 512 + col0 + ni * 16 + fq * 4) = make_uint2(pk_bf16(y[ni][0] * qs, y[ni][1] * qs), pk_bf16(y[ni][2] * qs, y[ni][3] * qs));
        } else {
          const int kvh = (col0 - 512) >> 6;
          bf16_t* kd;
          if (!sample) kd = p.Kp + ((size_t)((row >> 8) * 2 + kvh) * 256 + (row & 255)) * 64;
          else kd = p.Ks + ((size_t)(((row - NP) >> 10) * 2 + kvh) * 1280 + ((row - NP) & 1023)) * 64;
#pragma unroll
          for (int ni = 0; ni < 4; ++ni)
            *(uint2*)(kd + ni * 16 + fq * 4) = make_uint2(pk_bf16(y[ni][0], y[ni][1]), pk_bf16(y[ni][2], y[ni][3]));
        }
      }
    } else if (col0 < 768) {
      const int kvh = (col0 - 640) >> 6;
#pragma unroll
      for (int mi = 0; mi < 4; ++mi) {
        const int row = row0 + mi * 16 + fr;
#pragma unroll
        for (int ni = 0; ni < 4; ++ni) {
          const int d0 = ni * 16 + fq * 4;
          if (!sample) {
            *(f32x4*)(p.out_v + (size_t)row * 128 + kvh * 64 + d0) = acc[mi][ni];
            bf16_t* vd = p.Vtp + ((size_t)((row >> 8) * 2 + kvh) * 64 + d0) * 256 + (row & 255);
#pragma unroll
            for (int j = 0; j < 4; ++j) vd[j * 256] = f2bf(acc[mi][ni][j]);
          } else {
            bf16_t* vd = p.Vts + ((size_t)(((row - NP) >> 10) * 2 + kvh) * 64 + d0) * 1280 + ((row - NP) & 1023);
#pragma unroll
            for (int j = 0; j < 4; ++j) vd[j * 1280] = f2bf(acc[mi][ni][j]);
          }
        }
      }
    } else {
      const int c0 = col0 - 768, seg = c0 >> 9;
      float oml[4][4];
      if (seg == 1 || seg == 2) {
#pragma unroll
        for (int ni = 0; ni < 4; ++ni)
#pragma unroll
          for (int j = 0; j < 4; ++j) { const int c = (c0 & 511) + ni * 16 + fq * 4 + j; oml[ni][j] = __builtin_amdgcn_rcpf(1.f + __expf(p.hgrn_lb[c] - p.hgrn_lb[512 + c])); }
      }
#pragma unroll
      for (int mi = 0; mi < 4; ++mi) {
        const int row = row0 + mi * 16 + fr;
#pragma unroll
        for (int ni = 0; ni < 4; ++ni) {
          float o[4];
#pragma unroll
          for (int j = 0; j < 4; ++j) {
            const float v = acc[mi][ni][j];
            if (seg == 0 || seg == 4) o[j] = siluf_(v);
            else if (seg == 3) o[j] = v;
            else o[j] = oml[ni][j] * sigmoidf_(-v);
          }
          *(uint2*)(p.HG + (size_t)row * 2560 + c0 + ni * 16 + fq * 4) = make_uint2(pk_bf16(o[0], o[1]), pk_bf16(o[2], o[3]));
        }
      }
    }
  }
};

struct EpiResid {
  const Params* pp; int layer, gidx; bool from_input; bool dry = false; bool fuse_norm2 = false;
  __device__ __forceinline__ void operator()(f32x4 (&acc)[4][4], int row0, int col0, int lane) const {
    const Params& p = *pp;
    if (dry && p.njobs >= 0) return;
    const int fr = lane & 15, fq = lane >> 4;
    const float* md = p.MOD + (size_t)(layer * 9 + mod_index(row0)) * 6144;
    const float* gt = md + gidx * 1024;
#pragma unroll
    for (int mi = 0; mi < 4; ++mi) {
      const int row = row0 + mi * 16 + fr;
      const float* base = from_input ? (row < NP ? p.x_prompt + (size_t)row * 1024 : p.x_sample + (size_t)(row - NP) * 1024) : p.X + (size_t)row * 1024;
      float ss = 0.f;
#pragma unroll
      for (int ni = 0; ni < 4; ++ni) {
        const int col = col0 + ni * 16 + fq * 4;
        const f32x4 b = *(const f32x4*)(base + col), g = *(const f32x4*)(gt + col);
        const f32x4 xn = b + g * acc[mi][ni];
        *(f32x4*)(p.X + (size_t)row * 1024 + col) = xn;
        if (fuse_norm2) {
          const f32x4 w2 = *(const f32x4*)(p.norm2_w + layer * 1024 + col), sc = *(const f32x4*)(md + 4 * 1024 + col);
          const f32x4 hv = xn * (w2 * (sc + 1.f));
          *(uint2*)(p.H + (size_t)row * 1024 + col) = make_uint2(pk_bf16(hv[0], hv[1]), pk_bf16(hv[2], hv[3]));
          ss += xn[0] * xn[0] + xn[1] * xn[1] + xn[2] * xn[2] + xn[3] * xn[3];
        }
      }
      if (fuse_norm2) {
        ss += __shfl_xor(ss, 16); ss += __shfl_xor(ss, 32);
        if (fq == 0) atomicAdd(p.SSQ + layer * NTOK + row, ss);
      }
    }
  }
};

struct EpiMlpUp {
  const Params* pp; int layer;
  __device__ __forceinline__ void operator()(f32x4 (&acc)[4][4], int row0, int col0, int lane) const {
    const Params& p = *pp;
    const int fr = lane & 15, fq = lane >> 4;
    const float* bm = p.BM + (size_t)(layer * 9 + mod_index(row0)) * 4096;
    float rs[4];
#pragma unroll
    for (int mi = 0; mi < 4; ++mi) rs[mi] = rsqrtf(p.SSQ[layer * NTOK + row0 + mi * 16 + fr] * (1.f / 1024.f) + 1e-6f);
#pragma unroll
    for (int ni = 0; ni < 4; ++ni) {
      const int col = col0 + ni * 16 + fq * 4;
      const f32x4 bv = *(const f32x4*)(bm + col);
#pragma unroll
      for (int mi = 0; mi < 4; ++mi) {
        const int row = row0 + mi * 16 + fr;
        float o[4];
#pragma unroll
        for (int j = 0; j < 4; ++j) { const float r = fmaxf(acc[mi][ni][j] * rs[mi] + bv[j], 0.f); o[j] = r * r; }
        *(uint2*)(p.U + (size_t)row * 4096 + col) = make_uint2(pk_bf16(o[0], o[1]), pk_bf16(o[2], o[3]));
      }
    }
  }
};

template <int ACT>
struct EpiAct {
  bf16_t* O; int ldo; const float* bias;
  __device__ __forceinline__ void operator()(f32x4 (&acc)[4][4], int row0, int col0, int lane) const {
    const int fr = lane & 15, fq = lane >> 4;
#pragma unroll
    for (int ni = 0; ni < 4; ++ni) {
      const int col = col0 + ni * 16 + fq * 4;
      f32x4 bv = (f32x4){0.f, 0.f, 0.f, 0.f};
      if (ACT >= 4) bv = *(const f32x4*)(bias + col);
#pragma unroll
      for (int mi = 0; mi < 4; ++mi) {
        const int row = row0 + mi * 16 + fr;
        float o[4];
#pragma unroll
        for (int j = 0; j < 4; ++j) {
          const float v = acc[mi][ni][j] + bv[j];
          if (ACT == 0) o[j] = v;
          else if (ACT == 1) { const float r = fmaxf(v, 0.f); o[j] = r * r; }
          else if (ACT == 2) o[j] = 1.f - 2.f * __builtin_amdgcn_rcpf(1.f + __expf(2.f * v));
          else if (ACT == 3 || ACT == 5) o[j] = sigmoidf_(v);
          else o[j] = 0.60653065971263342f * sigmoidf_(v);
        }
        *(uint2*)(O + (size_t)row * ldo + col) = make_uint2(pk_bf16(o[0], o[1]), pk_bf16(o[2], o[3]));
      }
    }
  }
};

struct EpiRwkvOut {
  const Params* pp;
  __device__ __forceinline__ void operator()(f32x4 (&acc)[4][4], int row0, int col0, int lane) const {
    const Params& p = *pp;
    const int fr = lane & 15, fq = lane >> 4, h = col0 >> 6;
#pragma unroll
    for (int mi = 0; mi < 4; ++mi) {
      const int row = row0 + mi * 16 + fr;
      float y[4][4]; float s = 0.f;
#pragma unroll
      for (int ni = 0; ni < 4; ++ni) {
        const size_t idx = (size_t)row * 1024 + col0 + ni * 16 + fq * 4;
        const uint2 a = *(const uint2*)(p.E0 + idx), b = *(const uint2*)(p.E1 + idx);
        y[ni][0] = bflo(a.x) + bflo(b.x); y[ni][1] = bfhi(a.x) + bfhi(b.x); y[ni][2] = bflo(a.y) + bflo(b.y); y[ni][3] = bfhi(a.y) + bfhi(b.y);
        s += (y[ni][0] + y[ni][1]) + (y[ni][2] + y[ni][3]);
      }
      s += __shfl_xor(s, 16); s += __shfl_xor(s, 32);
      const float mu = s * (1.f / 64.f);
      float q = 0.f;
#pragma unroll
      for (int ni = 0; ni < 4; ++ni)
#pragma unroll
        for (int j = 0; j < 4; ++j) { const float d = y[ni][j] - mu; q += d * d; }
      q += __shfl_xor(q, 16); q += __shfl_xor(q, 32);
      const float rs = rsqrtf(q * (1.f / 64.f) + 64e-5f);
      const float bs = p.BS[(size_t)row * 16 + h] + p.BS[(size_t)NTOK * 16 + (size_t)row * 16 + h];
#pragma unroll
      for (int ni = 0; ni < 4; ++ni) {
        const int col = col0 + ni * 16 + fq * 4;
        const size_t idx = (size_t)row * 1024 + col;
        const uint2 vv = *(const uint2*)(p.Vx + idx);
        const f32x4 lw = *(const f32x4*)(p.ln_w + col), lb = *(const f32x4*)(p.ln_b + col);
        const float v0 = bflo(vv.x), v1 = bfhi(vv.x), v2 = bflo(vv.y), v3 = bfhi(vv.y);
        const float o0 = ((y[ni][0] - mu) * rs * lw[0] + lb[0] + bs * v0) * acc[mi][ni][0];
        const float o1 = ((y[ni][1] - mu) * rs * lw[1] + lb[1] + bs * v1) * acc[mi][ni][1];
        const float o2 = ((y[ni][2] - mu) * rs * lw[2] + lb[2] + bs * v2) * acc[mi][ni][2];
        const float o3 = ((y[ni][3] - mu) * rs * lw[3] + lb[3] + bs * v3) * acc[mi][ni][3];
        *(uint2*)(p.ZO + idx) = make_uint2(pk_bf16(o0, o1), pk_bf16(o2, o3));
      }
    }
  }
};

template <class EP>
__device__ __forceinline__ void gemm_phase(const ALoadPlain& al, const bf16_t* Bt, int K, int ntn, const EP& ep, char* smem) {
  const int nunits = (NTOK / 128) * ntn;
  for (int u = blockIdx.x; u < nunits; u += gridDim.x) gemm_tile_glds(al.A, al.lda, Bt, K, u / ntn, u % ntn, ep, smem);
}

__device__ __forceinline__ void attn_item(const Params& p, int grp, int b, int h, int qb, char* smem) {
  const int tid = threadIdx.x, lane = tid & 63, wid = tid >> 6, qi = lane & 31, g = lane >> 5;
  const int Tk = grp ? 1280 : 256, kvh = h >> 2;
  const int rowbase = grp ? NP + b * 1024 + qb * 128 : b * 256 + qb * 128;
  const bf16_t* Kg = grp ? p.Ks + (size_t)(b * 2 + kvh) * 1280 * 64 : p.Kp + (size_t)(b * 2 + kvh) * 256 * 64;
  const bf16_t* Vg = grp ? p.Vts + (size_t)(b * 2 + kvh) * 64 * 1280 : p.Vtp + (size_t)(b * 2 + kvh) * 64 * 256;
  const int qrow = rowbase + wid * 32 + qi;
  bf16x8 Qf[4];
#pragma unroll
  for (int s = 0; s < 4; ++s) Qf[s] = *(const bf16x8*)(p.Qbuf + (size_t)qrow * 512 + h * 64 + s * 16 + g * 8);
  f32x16 O[2];
#pragma unroll
  for (int i = 0; i < 16; ++i) { O[0][i] = 0.f; O[1][i] = 0.f; }
  float m_run = -1e30f, l_run = 0.f;
  char* sK = smem; char* sV = smem + 16384;
  const int r0 = tid >> 3, c = tid & 7;
  uint4 pk[2], pv[2];
  const int ntile = Tk >> 6;
#define ALOAD(kt) do { _Pragma("unroll") for (int i = 0; i < 2; ++i) { const int r = r0 + 32 * i; pk[i] = *(const uint4*)(Kg + (size_t)((kt) * 64 + r) * 64 + c * 8); pv[i] = *(const uint4*)(Vg + (size_t)r * Tk + (kt) * 64 + c * 8); } } while (0)
#define ASTORE(buf) do { _Pragma("unroll") for (int i = 0; i < 2; ++i) { const int r = r0 + 32 * i; \
      *(uint4*)(sK + (buf) * 8192 + r * 128 + ((c ^ ((r >> 1) & 7)) << 4)) = pk[i]; \
      const int f = (r >> 1) & 15; \
      *(uint2*)(sV + (buf) * 8192 + r * 128 + (((2 * c) ^ f) << 3)) = make_uint2(pv[i].x, pv[i].y); \
      *(uint2*)(sV + (buf) * 8192 + r * 128 + (((2 * c + 1) ^ f) << 3)) = make_uint2(pv[i].z, pv[i].w); } } while (0)
  ALOAD(0); ASTORE(0); __syncthreads();
  for (int kt = 0; kt < ntile; ++kt) {
    const int buf = kt & 1;
    if (kt + 1 < ntile) ALOAD(kt + 1);
    f32x16 S[2];
#pragma unroll
    for (int t2 = 0; t2 < 2; ++t2) {
#pragma unroll
      for (int i = 0; i < 16; ++i) S[t2][i] = 0.f;
#pragma unroll
      for (int s = 0; s < 4; ++s) {
        const int r = t2 * 32 + qi, cc = 2 * s + g;
        const bf16x8 Kf = *(const bf16x8*)(sK + buf * 8192 + r * 128 + ((cc ^ ((r >> 1) & 7)) << 4));
        S[t2] = __builtin_amdgcn_mfma_f32_32x32x16_bf16(Kf, Qf[s], S[t2], 0, 0, 0);
      }
    }
    float mx = S[0][0];
#pragma unroll
    for (int i = 0; i < 16; ++i) { mx = fmaxf(mx, S[0][i]); mx = fmaxf(mx, S[1][i]); }
    mx = fmaxf(mx, __shfl_xor(mx, 32));
    const float m_new = fmaxf(m_run, mx);
    const float alpha = __builtin_amdgcn_exp2f(m_run - m_new);
    float ls = 0.f;
#pragma unroll
    for (int i = 0; i < 16; ++i) { S[0][i] = __builtin_amdgcn_exp2f(S[0][i] - m_new); S[1][i] = __builtin_amdgcn_exp2f(S[1][i] - m_new); ls += S[0][i] + S[1][i]; }
    l_run = l_run * alpha + ls; m_run = m_new;
#pragma unroll
    for (int i = 0; i < 16; ++i) { O[0][i] *= alpha; O[1][i] *= alpha; }
#pragma unroll
    for (int t2 = 0; t2 < 2; ++t2)
#pragma unroll
      for (int sp = 0; sp < 2; ++sp) {
        union { bf16x8 v; unsigned u[4]; } Pf;
#pragma unroll
        for (int e = 0; e < 4; ++e) Pf.u[e] = pk_bf16(S[t2][8 * sp + 2 * e], S[t2][8 * sp + 2 * e + 1]);
#pragma unroll
        for (int ds = 0; ds < 2; ++ds) {
          const int d = ds * 32 + qi, f = (d >> 1) & 15, u1 = 8 * t2 + 4 * sp + g;
          union { bf16x8 v; uint2 u[2]; } Vf;
          Vf.u[0] = *(const uint2*)(sV + buf * 8192 + d * 128 + ((u1 ^ f) << 3));
          Vf.u[1] = *(const uint2*)(sV + buf * 8192 + d * 128 + (((u1 + 2) ^ f) << 3));
          O[ds] = __builtin_amdgcn_mfma_f32_32x32x16_bf16(Vf.v, Pf.v, O[ds], 0, 0, 0);
        }
      }
    if (kt + 1 < ntile) ASTORE(buf ^ 1);
    __syncthreads();
  }
#undef ALOAD
#undef ASTORE
  const float l = l_run + __shfl_xor(l_run, 32);
  const float inv = 1.f / l;
#pragma unroll
  for (int ds = 0; ds < 2; ++ds)
#pragma unroll
    for (int bq = 0; bq < 4; ++bq) {
      const int d0 = ds * 32 + 8 * bq + 4 * g;
      *(uint2*)(p.AO + (size_t)qrow * 1024 + h * 64 + d0) =
          make_uint2(pk_bf16(O[ds][4 * bq] * inv, O[ds][4 * bq + 1] * inv), pk_bf16(O[ds][4 * bq + 2] * inv, O[ds][4 * bq + 3] * inv));
    }
}

__device__ __forceinline__ void hgrn_item(const Params& p, int grp, int b, int h, int dir, int half, char* smem) {
  const int tid = threadIdx.x, v = half * 32 + (tid >> 3), ks = tid & 7;
  const int T = grp ? 1024 : 256, rowbase = grp ? NP + b * 1024 : b * 256;
  if (grp) __builtin_amdgcn_s_setprio(3);
  f32x2 S2[4];
  if (grp) {
    const float* s0 = (dir ? p.hg_b0 : p.hg_f0) + (size_t)(b * 8 + h) * 4096;
#pragma unroll
    for (int i = 0; i < 4; ++i) S2[i] = (f32x2){s0[(ks * 8 + 2 * i) * 64 + v], s0[(ks * 8 + 2 * i + 1) * 64 + v]};
  } else {
#pragma unroll
    for (int i = 0; i < 4; ++i) S2[i] = (f32x2){0.f, 0.f};
  }
  float* obuf = (float*)(smem + 32768);
  const int lt = tid >> 4, lc = (tid & 15) * 4;
  const int kfseg = dir ? 1024 : 512;
  uint2 rq, rk, rv, rq2, rk2, rv2;
  const int nch = T >> 4;
#define HLOADX(cix, q_, k_, v_) do { const int ts = (cix) * 16 + lt; const int tok = dir ? T - 1 - ts : ts; const bf16_t* src = p.HG + (size_t)(rowbase + tok) * 2560 + h * 64 + lc; \
    q_ = *(const uint2*)(src); k_ = *(const uint2*)(src + kfseg); v_ = *(const uint2*)(src + 1536); } while (0)
#define HSTORE(buf) do { float* B = (float*)(smem + (buf) * 16384) + lt * 64 + lc; \
    const float k0 = bflo(rk.x), k1 = bfhi(rk.x), k2 = bflo(rk.y), k3 = bfhi(rk.y); \
    *(float4*)(B) = make_float4(1.f - k0, 1.f - k1, 1.f - k2, 1.f - k3); *(float4*)(B + 1024) = make_float4(k0, k1, k2, k3); \
    *(float4*)(B + 2048) = make_float4(bflo(rq.x), bfhi(rq.x), bflo(rq.y), bfhi(rq.y)); *(float4*)(B + 3072) = make_float4(bflo(rv.x), bfhi(rv.x), bflo(rv.y), bfhi(rv.y)); } while (0)
  HLOADX(0, rq, rk, rv); HSTORE(0);
  HLOADX(1, rq, rk, rv);
  __syncthreads();
  float* OD = dir ? p.OB : p.OF;
  for (int cix = 0; cix < nch; ++cix) {
    const int buf = cix & 1;
    if (cix + 2 < nch) HLOADX(cix + 2, rq2, rk2, rv2);
    const float* B = (const float*)(smem + buf * 16384);
    float* ob = obuf + buf * 512;
    float4 cf[2], ck[2], cq[2]; float cv;
#define HSTEP_LOAD(t_, f_, k_, q_, v_) do { const float* Bt = B + (t_) * 64 + ks * 8; \
      f_[0] = *(const float4*)(Bt); f_[1] = *(const float4*)(Bt + 4); k_[0] = *(const float4*)(Bt + 1024); k_[1] = *(const float4*)(Bt + 1028); \
      q_[0] = *(const float4*)(Bt + 2048); q_[1] = *(const float4*)(Bt + 2052); v_ = B[3072 + (t_) * 64 + v]; } while (0)
    HSTEP_LOAD(0, cf, ck, cq, cv);
#pragma unroll 1
    for (int g = 0; g < 4; ++g) {
      float op[4];
#pragma unroll
      for (int tt = 0; tt < 4; ++tt) {
        const int t = g * 4 + tt;
        float4 nf[2], nk[2], nq[2]; float nv;
        { const int tn_ = (t + 1) & 15; HSTEP_LOAD(tn_, nf, nk, nq, nv); }
        const f32x2 vvv = (f32x2){cv, cv};
        f32x2 o0, o1;
        S2[0] = S2[0] * (f32x2){cf[0].x, cf[0].y} + vvv * (f32x2){ck[0].x, ck[0].y};
        S2[1] = S2[1] * (f32x2){cf[0].z, cf[0].w} + vvv * (f32x2){ck[0].z, ck[0].w};
        S2[2] = S2[2] * (f32x2){cf[1].x, cf[1].y} + vvv * (f32x2){ck[1].x, ck[1].y};
        S2[3] = S2[3] * (f32x2){cf[1].z, cf[1].w} + vvv * (f32x2){ck[1].z, ck[1].w};
        o0 = S2[0] * (f32x2){cq[0].x, cq[0].y}; o1 = S2[1] * (f32x2){cq[0].z, cq[0].w};
        o0 = S2[2] * (f32x2){cq[1].x, cq[1].y} + o0; o1 = S2[3] * (f32x2){cq[1].z, cq[1].w} + o1;
        const f32x2 os = o0 + o1;
        op[tt] = os.x + os.y;
        cf[0] = nf[0]; cf[1] = nf[1]; ck[0] = nk[0]; ck[1] = nk[1]; cq[0] = nq[0]; cq[1] = nq[1]; cv = nv;
      }
      __builtin_amdgcn_sched_barrier(0);
#define DPPADD(x, ctrl) x += __int_as_float(__builtin_amdgcn_update_dpp(0, __float_as_int(x), ctrl, 0xF, 0xF, true))
      DPPADD(op[0], 0xB1); DPPADD(op[1], 0xB1); DPPADD(op[2], 0xB1); DPPADD(op[3], 0xB1);
      DPPADD(op[0], 0x4E); DPPADD(op[1], 0x4E); DPPADD(op[2], 0x4E); DPPADD(op[3], 0x4E);
      DPPADD(op[0], 0x141); DPPADD(op[1], 0x141); DPPADD(op[2], 0x141); DPPADD(op[3], 0x141);
#undef DPPADD
      if (ks == 0) {
#pragma unroll
        for (int tt = 0; tt < 4; ++tt) ob[(g * 4 + tt) * 32 + (tid >> 3)] = op[tt];
      }
      __builtin_amdgcn_sched_barrier(0);
    }
#undef HSTEP_LOAD
    if (cix + 1 < nch) HSTORE(buf ^ 1);
    rq = rq2; rk = rk2; rv = rv2;
    __syncthreads();
    if (tid < 128) {
      const int ft = tid >> 3, fc = (tid & 7) * 4;
      const int ts = cix * 16 + ft; const int tok = dir ? T - 1 - ts : ts;
      *(float4*)(OD + (size_t)(rowbase + tok) * 512 + h * 64 + half * 32 + fc) = *(const float4*)(ob + ft * 32 + fc);
    }
  }
#undef HLOADX
#undef HSTORE
  __builtin_amdgcn_s_setprio(0);
  if (!grp) {
    float* so = (dir ? p.out_hb : p.out_hf) + (size_t)(b * 8 + h) * 4096;
#pragma unroll
    for (int i = 0; i < 4; ++i) { so[(ks * 8 + 2 * i) * 64 + v] = S2[i].x; so[(ks * 8 + 2 * i + 1) * 64 + v] = S2[i].y; }
  }
}

__device__ __forceinline__ void mix0_phase(const Params& p, char* smem) {
  __shared__ int q_item;
  for (;;) {
    if (threadIdx.x == 0) q_item = (int)atomicAdd(&p.bar[0], 1u);
    __syncthreads();
    const int it = q_item;
    __syncthreads();
    if (it >= 1536) break;
    const bool is_h = it < 256 || (it >= 768 && it < 1280);
    if (is_h) {
      const int grp = it < 256 ? 1 : 0, a = grp ? it : it - 768;
      hgrn_item(p, grp, a >> 5, (a >> 2) & 7, (a >> 1) & 1, a & 1, smem);
    } else {
      const int grp = it < 768 ? 1 : 0, a = grp ? it - 256 : it - 1280;
      const int b = grp ? a >> 6 : a >> 4, h = grp ? (a >> 3) & 7 : (a >> 1) & 7, qb = grp ? a & 7 : a & 1;
      attn_item(p, grp, b, h, qb, smem);
    }
    __syncthreads();
  }
}

__device__ __forceinline__ void hgrn_combine_phase(const Params& p) {
  const int gid = blockIdx.x * NT + threadIdx.x, l16 = gid & 15;
  const int ngroups = NTOK * 8;
  for (int grp = gid >> 4; grp < ngroups; grp += (gridDim.x * NT) >> 4) {
    const int row = grp >> 3, h = grp & 7;
    const size_t o = (size_t)row * 512 + h * 64 + l16 * 4;
    const float4 a = *(const float4*)(p.OF + o), b = *(const float4*)(p.OB + o);
    const float y0 = a.x + b.x, y1 = a.y + b.y, y2 = a.z + b.z, y3 = a.w + b.w;
    float ss = y0 * y0 + y1 * y1 + y2 * y2 + y3 * y3;
    ss += __shfl_xor(ss, 1); ss += __shfl_xor(ss, 2); ss += __shfl_xor(ss, 4); ss += __shfl_xor(ss, 8);
    const float rn = rsqrtf(ss * (1.f / 64.f) + 1e-6f);
    const float4 gn = *(const float4*)(p.g_norm + l16 * 4);
    const uint2 gt = *(const uint2*)(p.HG + (size_t)row * 2560 + 2048 + h * 64 + l16 * 4);
    *(uint2*)(p.AO + (size_t)row * 1024 + 512 + h * 64 + l16 * 4) =
        make_uint2(pk_bf16(y0 * rn * gn.x * bflo(gt.x), y1 * rn * gn.y * bfhi(gt.x)), pk_bf16(y2 * rn * gn.z * bflo(gt.y), y3 * rn * gn.w * bfhi(gt.y)));
  }
}

__device__ __forceinline__ void rwkv_item(const Params& p, int grp, int b, int h, int dir, char* smem, bool dry = false) {
  const bool wr = !(dry && p.njobs >= 0);
  if (grp) __builtin_amdgcn_s_setprio(3);
  const int tid = threadIdx.x, lane = tid & 63, wid = tid >> 6, v = tid >> 2, ks = tid & 3;
  const int T = grp ? 1024 : 256, rowbase = grp ? NP + b * 1024 : b * 256;
  const int vp = tid >> 3, k8 = tid & 7;
  f32x2 Sa[4], Sb[4];
  if (grp) {
    const float* s0 = (dir ? p.rw_b0 : p.rw_f0) + ((size_t)(b * 16 + h) * 64 + vp) * 64 + k8 * 8;
#pragma unroll
    for (int q = 0; q < 2; ++q) {
      const float4 t = *(const float4*)(s0 + q * 4), u = *(const float4*)(s0 + 2048 + q * 4);
      Sa[2 * q] = (f32x2){t.x, t.y}; Sa[2 * q + 1] = (f32x2){t.z, t.w}; Sb[2 * q] = (f32x2){u.x, u.y}; Sb[2 * q + 1] = (f32x2){u.z, u.w};
    }
  } else {
#pragma unroll
    for (int i = 0; i < 4; ++i) { Sa[i] = (f32x2){0.f, 0.f}; Sb[i] = (f32x2){0.f, 0.f}; }
  }
  const bf16_t* E = dir ? p.E1 : p.E0; const bf16_t* A = dir ? p.A1 : p.A0; bf16_t* Y = dir ? p.E1 : p.E0;
  const int lt = tid >> 4, lc = (tid & 15) * 4;
  const float4 kkc = *(const float4*)(p.k_k + h * 64 + lc), kac = *(const float4*)(p.k_a + h * 64 + lc), rkc = *(const float4*)(p.r_k + h * 64 + lc);
  float* BSd = p.BS + (size_t)dir * NTOK * 16;
  float* ybuf = (float*)(smem + 49152);
  uint2 gr, gk, gv, ge, ga;
  const int nch = T >> 4;
#define RLOAD(cix) do { const int ts = (cix) * 16 + lt; const int tok = dir ? T - 1 - ts : ts; const size_t idx = (size_t)(rowbase + tok) * 1024 + h * 64 + lc; \
    gr = *(const uint2*)(p.R + idx); gk = *(const uint2*)(p.Kx + idx); gv = *(const uint2*)(p.Vx + idx); ge = *(const uint2*)(E + idx); ga = *(const uint2*)(A + idx); } while (0)
#define RSTORE(cix, buf) do { const int ts = (cix) * 16 + lt; const int tok = dir ? T - 1 - ts : ts; \
    const float r_[4] = {bflo(gr.x), bfhi(gr.x), bflo(gr.y), bfhi(gr.y)}, k_[4] = {bflo(gk.x), bfhi(gk.x), bflo(gk.y), bfhi(gk.y)}; \
    const float e_[4] = {bflo(ge.x), bfhi(ge.x), bflo(ge.y), bfhi(ge.y)}, a_[4] = {bflo(ga.x), bfhi(ga.x), bflo(ga.y), bfhi(ga.y)}; \
    const float kc_[4] = {kkc.x, kkc.y, kkc.z, kkc.w}, ac_[4] = {kac.x, kac.y, kac.z, kac.w}, rc_[4] = {rkc.x, rkc.y, rkc.z, rkc.w}; \
    float kx[4], kd[4], ssq = 0.f, bsum = 0.f; \
    _Pragma("unroll") for (int j = 0; j < 4; ++j) { kx[j] = k_[j] * kc_[j]; ssq += kx[j] * kx[j]; kd[j] = k_[j] * (1.f + (a_[j] - 1.f) * ac_[j]); bsum += r_[j] * kd[j] * rc_[j]; } \
    ssq = hex_sum(ssq); bsum = hex_sum(bsum); const float rn = rsqrtf(fmaxf(ssq, 1e-24f)); \
    float* B = (float*)(smem + (buf) * 24576) + lt * 64 + lc; \
    *(float4*)(B) = make_float4(__expf(-e_[0]), __expf(-e_[1]), __expf(-e_[2]), __expf(-e_[3])); \
    *(float4*)(B + 1024) = make_float4(kx[0] * rn, kx[1] * rn, kx[2] * rn, kx[3] * rn); \
    *(float4*)(B + 2048) = make_float4(kx[0] * rn * a_[0], kx[1] * rn * a_[1], kx[2] * rn * a_[2], kx[3] * rn * a_[3]); \
    *(float4*)(B + 3072) = make_float4(kd[0], kd[1], kd[2], kd[3]); \
    *(float4*)(B + 4096) = make_float4(r_[0], r_[1], r_[2], r_[3]); \
    *(float4*)(B + 5120) = make_float4(bflo(gv.x), bfhi(gv.x), bflo(gv.y), bfhi(gv.y)); \
    if ((tid & 15) == 0 && wr) BSd[(size_t)(rowbase + tok) * 16 + h] = bsum; } while (0)
  RLOAD(0); RSTORE(0, 0); __syncthreads();
  for (int cix = 0; cix < nch; ++cix) {
    const int buf = cix & 1;
    if (cix + 1 < nch) RLOAD(cix + 1);
    const float* B = (const float*)(smem + buf * 24576);
    float* yb = ybuf + buf * 1024;
    float4 cw[2], ck[2], ca[2], cd[2], cr[2]; float cva, cvb;
#define RSTEP_LOAD(t_, w_, k_, a_, d_, r_, va_, vb_) do { const float* Bt = B + (t_) * 64 + k8 * 8; \
      w_[0] = *(const float4*)(Bt); w_[1] = *(const float4*)(Bt + 4); k_[0] = *(const float4*)(Bt + 1024); k_[1] = *(const float4*)(Bt + 1028); \
      a_[0] = *(const float4*)(Bt + 2048); a_[1] = *(const float4*)(Bt + 2052); d_[0] = *(const float4*)(Bt + 3072); d_[1] = *(const float4*)(Bt + 3076); \
      r_[0] = *(const float4*)(Bt + 4096); r_[1] = *(const float4*)(Bt + 4100); va_ = B[5120 + (t_) * 64 + vp]; vb_ = B[5120 + (t_) * 64 + vp + 32]; } while (0)
    RSTEP_LOAD(0, cw, ck, ca, cd, cr, cva, cvb);
#pragma unroll
    for (int t = 0; t < 16; ++t) {
      float4 nw[2], nk[2], na[2], nd[2], nr[2]; float nva = 0.f, nvb = 0.f;
      if (t + 1 < 16) RSTEP_LOAD(t + 1, nw, nk, na, nd, nr, nva, nvb);
      f32x2 w2[4], kk2[4];
#pragma unroll
      for (int q = 0; q < 2; ++q) {
        w2[2 * q] = (f32x2){cw[q].x, cw[q].y}; w2[2 * q + 1] = (f32x2){cw[q].z, cw[q].w};
        kk2[2 * q] = (f32x2){ck[q].x, ck[q].y}; kk2[2 * q + 1] = (f32x2){ck[q].z, ck[q].w};
      }
      const f32x2 sa_a = (Sa[0] * kk2[0] + Sa[1] * kk2[1]) + (Sa[2] * kk2[2] + Sa[3] * kk2[3]);
      const f32x2 sa_b = (Sb[0] * kk2[0] + Sb[1] * kk2[1]) + (Sb[2] * kk2[2] + Sb[3] * kk2[3]);
      const float saa = -oct_sum(sa_a.x + sa_a.y), sab = -oct_sum(sa_b.x + sa_b.y);
      const f32x2 saav = (f32x2){saa, saa}, sabv = (f32x2){sab, sab}, vav = (f32x2){cva, cva}, vbv = (f32x2){cvb, cvb};
      f32x2 ya = (f32x2){0.f, 0.f}, yb2 = (f32x2){0.f, 0.f};
#pragma unroll
      for (int q = 0; q < 2; ++q) {
        const f32x2 ka0 = (f32x2){ca[q].x, ca[q].y}, ka1 = (f32x2){ca[q].z, ca[q].w}, kd0 = (f32x2){cd[q].x, cd[q].y}, kd1 = (f32x2){cd[q].z, cd[q].w};
        const f32x2 r0 = (f32x2){cr[q].x, cr[q].y}, r1 = (f32x2){cr[q].z, cr[q].w};
        Sa[2 * q] = Sa[2 * q] * w2[2 * q] + (vav * kd0 + saav * ka0); Sa[2 * q + 1] = Sa[2 * q + 1] * w2[2 * q + 1] + (vav * kd1 + saav * ka1);
        Sb[2 * q] = Sb[2 * q] * w2[2 * q] + (vbv * kd0 + sabv * ka0); Sb[2 * q + 1] = Sb[2 * q + 1] * w2[2 * q + 1] + (vbv * kd1 + sabv * ka1);
        ya = Sa[2 * q] * r0 + ya; ya = Sa[2 * q + 1] * r1 + ya;
        yb2 = Sb[2 * q] * r0 + yb2; yb2 = Sb[2 * q + 1] * r1 + yb2;
      }
      const float y_a = oct_sum(ya.x + ya.y), y_b = oct_sum(yb2.x + yb2.y);
      if (k8 == 0) { yb[t * 64 + vp] = y_a; yb[t * 64 + vp + 32] = y_b; }
      if (t + 1 < 16) {
#pragma unroll
        for (int q = 0; q < 2; ++q) { cw[q] = nw[q]; ck[q] = nk[q]; ca[q] = na[q]; cd[q] = nd[q]; cr[q] = nr[q]; }
        cva = nva; cvb = nvb;
      }
    }
#undef RSTEP_LOAD
    if (cix + 1 < nch) RSTORE(cix + 1, buf ^ 1);
    __syncthreads();
    {
      const int ts = cix * 16 + lt; const int tok = dir ? T - 1 - ts : ts;
      const float4 yy = *(const float4*)(yb + lt * 64 + lc);
      if (wr) *(uint2*)(Y + (size_t)(rowbase + tok) * 1024 + h * 64 + lc) = make_uint2(pk_bf16(yy.x, yy.y), pk_bf16(yy.z, yy.w));
    }
  }
#undef RLOAD
#undef RSTORE
  __builtin_amdgcn_s_setprio(0);
  if (!grp && wr) {
    float* so = (dir ? p.out_rb : p.out_rf) + ((size_t)(b * 16 + h) * 64 + vp) * 64 + k8 * 8;
#pragma unroll
    for (int q = 0; q < 2; ++q) {
      *(float4*)(so + q * 4) = make_float4(Sa[2 * q].x, Sa[2 * q].y, Sa[2 * q + 1].x, Sa[2 * q + 1].y);
      *(float4*)(so + 2048 + q * 4) = make_float4(Sb[2 * q].x, Sb[2 * q].y, Sb[2 * q + 1].x, Sb[2 * q + 1].y);
    }
  }
}

__device__ __forceinline__ void rwkv_scan_phase(const Params& p, char* smem, bool dry = false) {
  const int G = gridDim.x;
  if (G >= 512) {
    if (blockIdx.x < 256) { const int a = blockIdx.x; rwkv_item(p, 1, a >> 5, (a >> 1) & 15, a & 1, smem, dry); }
    else for (int a = blockIdx.x - 256; a < 512; a += G - 256) { rwkv_item(p, 0, a >> 5, (a >> 1) & 15, a & 1, smem, dry); __syncthreads(); }
  } else {
    for (int it = blockIdx.x; it < 768; it += G) {
      const int grp = it < 256 ? 1 : 0, a = grp ? it : it - 256;
      rwkv_item(p, grp, a >> 5, (a >> 1) & 15, a & 1, smem, dry);
      __syncthreads();
    }
  }
}

__device__ __forceinline__ void blend_phase(const Params& p) {
  const int gid = blockIdx.x * NT + threadIdx.x, nth = gridDim.x * NT;
  for (int i = gid; i < NTOK * 128; i += nth) {
    const int row = i >> 7, k = (i & 127) * 8;
    ALoadShift a0{p.H, p.mix + 0 * 1024}, a2{p.H, p.mix + 2 * 1024}, a3{p.H, p.mix + 3 * 1024};
    const size_t o = (size_t)row * 1024 + k;
    *(uint4*)(p.E0 + o) = a0(row, k); *(uint4*)(p.E1 + o) = a2(row, k); *(uint4*)(p.A1 + o) = a3(row, k);
  }
}

__device__ __forceinline__ void rwkv_proj_phase(const Params& p, char* smem) {
  const int nunits = 96 * 27;
  for (int u = blockIdx.x; u < nunits; u += gridDim.x) {
    const int tm = u < 288 ? u / 3 : (u - 288) / 24, s = u < 288 ? 24 + u % 3 : (u - 288) % 24;
    if (s < 8) { EpiAct<0> ep{p.R, 1024, nullptr}; gemm_tile_glds(p.E0, 1024, p.wr_t, 1024, tm, s, ep, smem); }
    else if (s < 16) { EpiAct<0> ep{p.Kx, 1024, nullptr}; gemm_tile_glds(p.E1, 1024, p.wk_t, 1024, tm, s - 8, ep, smem); }
    else if (s < 24) { EpiAct<0> ep{p.Vx, 1024, nullptr}; gemm_tile_glds(p.A1, 1024, p.wv_t, 1024, tm, s - 16, ep, smem); }
    else if (s == 24) { ALoadShift al{p.H, p.mix + 1 * 1024}; EpiAct<2> ep{p.LW, 128, nullptr}; gemm_tile(al, p.w1cat_t, 1024, tm, 0, ep, smem); }
    else if (s == 25) { ALoadShift al{p.H, p.mix + 4 * 1024}; EpiAct<0> ep{p.LA, 128, nullptr}; gemm_tile(al, p.a1cat_t, 1024, tm, 0, ep, smem); }
    else { ALoadShift al{p.H, p.mix + 5 * 1024}; EpiAct<3> ep{p.LG, 128, nullptr}; gemm_tile(al, p.g1_t, 1024, tm, 0, ep, smem); }
  }
}
__device__ __forceinline__ void rwkv_lora2_phase(const Params& p, char* smem) {
  const int nunits = 96 * 32;
  for (int u = blockIdx.x; u < nunits; u += gridDim.x) {
    const int tm = u >> 5, s = u & 31, which = s >> 3, tn = s & 7;
    const int d = which & 1;
    if (which < 2) { ALoadPlain al{p.LW + d * 64, 128}; EpiAct<4> ep{d ? p.E1 : p.E0, 1024, p.w0 + d * 1024}; gemm_tile_glds(al.A, al.lda, p.w2_t + (size_t)d * 65536, 64, tm, tn, ep, smem); }
    else { ALoadPlain al{p.LA + d * 64, 128}; EpiAct<5> ep{d ? p.A1 : p.A0, 1024, p.a0 + d * 1024}; gemm_tile_glds(al.A, al.lda, p.a2_t + (size_t)d * 65536, 64, tm, tn, ep, smem); }
  }
}


#define XB_TMO      128
#define XB_XCNT(j)  (256  + 64 * (j))
#define XB_XSUB(j)  (1280 + 64 * (j))
#define XB_XGEN(j)  (2304 + 64 * (j))
#define XB_TOP      3328
#define XB_TOPGEN   3392
#define XCD_BAR_WORDS 3456
#define XB_SPIN_CAP (1u << 22)
#define LAS __attribute__((address_space(3)))
__device__ __forceinline__ unsigned xb_ld(unsigned* p)              { return __hip_atomic_load(p, __ATOMIC_RELAXED, __HIP_MEMORY_SCOPE_AGENT); }
__device__ __forceinline__ unsigned xb_add(unsigned* p, unsigned v) { return __hip_atomic_fetch_add(p, v, __ATOMIC_RELAXED, __HIP_MEMORY_SCOPE_AGENT); }
__device__ __forceinline__ unsigned xb_xcc_id() { return (unsigned)__builtin_amdgcn_s_getreg((3 << 11) | 20) & 0xFu; }
#define XB_SPIN(cond, bar) do { unsigned _sp = 0; while (cond) { __builtin_amdgcn_s_sleep(1); \
    if ((++_sp & 255u) == 0u) { if (xb_ld(&(bar)[XB_TMO])) break; if (_sp > XB_SPIN_CAP) { atomicAdd(&(bar)[XB_TMO], 1u); break; } } } } while (0)
struct XcdBarrier { unsigned* bar; unsigned x; volatile LAS unsigned* st; };
__device__ __forceinline__ XcdBarrier xcd_barrier_post(unsigned* bar, volatile LAS unsigned* st) {
    XcdBarrier b; b.bar = bar; b.x = xb_xcc_id(); b.st = st;
    if (threadIdx.x == 0) (void)xb_add(&bar[XB_XCNT(b.x)], 1u);
    return b;
}
__device__ __forceinline__ void xcd_barrier_complete(unsigned* bar, unsigned x, unsigned& nloc, unsigned& nx) {
    const unsigned G = gridDim.x * gridDim.y * gridDim.z;
    unsigned sum, cnt, mine, sp = 0u;
    for (;;) {
        sum = 0u; cnt = 0u; mine = 0u;
#pragma unroll
        for (unsigned j = 0; j < 16; ++j) { const unsigned c = xb_ld(&bar[XB_XCNT(j)]); sum += c; cnt += (c > 0u) ? 1u : 0u; mine = (j == x) ? c : mine; }
        if (sum == G) break;
        __builtin_amdgcn_s_sleep(1);
        if ((++sp & 255u) == 0u) { if (xb_ld(&bar[XB_TMO])) break; if (sp > XB_SPIN_CAP) { atomicAdd(&bar[XB_TMO], 1u); break; } }
    }
    nloc = mine > 0u ? mine : 1u; nx = cnt > 0u ? cnt : 1u;
}
__device__ __forceinline__ void xcd_barrier(const XcdBarrier& b) {
    asm volatile("s_waitcnt vmcnt(0)" ::: "memory");
    __syncthreads();
    if (threadIdx.x == 0) {
        unsigned* bar = b.bar;
        __builtin_amdgcn_s_waitcnt(0);
        unsigned nloc = b.st[0], nx = b.st[1];
        if (nloc == 0u) { xcd_barrier_complete(bar, b.x, nloc, nx); b.st[0] = nloc; b.st[1] = nx; }
        const unsigned old = xb_add(&bar[XB_XSUB(b.x)], 1u);
        const unsigned gen = old / nloc;
        if (old + 1u == (gen + 1u) * nloc) {
            __builtin_amdgcn_fence(__ATOMIC_RELEASE, "agent");
            asm volatile("s_waitcnt vmcnt(0)" ::: "memory");
            const unsigned og = xb_add(&bar[XB_TOP], 1u);
            const unsigned tg = og / nx;
            if (og + 1u == (tg + 1u) * nx) xb_add(&bar[XB_TOPGEN], 1u);
            else XB_SPIN(xb_ld(&bar[XB_TOPGEN]) == tg, bar);
            __builtin_amdgcn_fence(__ATOMIC_ACQUIRE, "agent");
            xb_add(&bar[XB_XGEN(b.x)], 1u);
            asm volatile("s_waitcnt vmcnt(0)" ::: "memory");
        } else {
            XB_SPIN(xb_ld(&bar[XB_XGEN(b.x)]) == gen, bar);
            __builtin_amdgcn_fence(__ATOMIC_ACQUIRE, "agent");
            asm volatile("s_waitcnt vmcnt(0)" ::: "memory");
        }
    }
    __syncthreads();
}

__device__ __forceinline__ void run_phase(const Params& p, int ph, char* smem, bool dry = false) {
  switch (ph) {
    case 0: if (ONLY_PHASE < 0 || ONLY_PHASE == 0) phase0(p, smem); break;
    case 1: if (ONLY_PHASE < 0 || ONLY_PHASE == 1) { prenorm_phase(p, 0, 0, true); mlp_bias_phase(p); } break;
    case 2: if (ONLY_PHASE < 0 || ONLY_PHASE == 2) { ALoadPlain al{p.H, 1024}; EpiWin ep{&p}; gemm_phase(al, p.w_in_t, 1024, 26, ep, smem); } break;
    case 3: if (ONLY_PHASE < 0 || ONLY_PHASE == 3) mix0_phase(p, smem); break;
    case 4: if (ONLY_PHASE < 0 || ONLY_PHASE == 4) hgrn_combine_phase(p); break;
    case 5: if (ONLY_PHASE < 0 || ONLY_PHASE == 5) { ALoadPlain al{p.AO, 1024}; EpiResid ep{&p, 0, 2, true, false, true}; gemm_phase(al, p.w_out_t, 1024, 8, ep, smem); } break;
    case 6: if (ONLY_PHASE < 0 || ONLY_PHASE == 6) prenorm_phase(p, 0, 1, false); break;
    case 7: if (ONLY_PHASE < 0 || ONLY_PHASE == 7) { ALoadPlain al{p.H, 1024}; EpiMlpUp ep{&p, 0}; gemm_phase(al, p.mlp1_t, 1024, 32, ep, smem); } break;
    case 8: if (ONLY_PHASE < 0 || ONLY_PHASE == 8) { ALoadPlain al{p.U, 4096}; EpiResid ep{&p, 0, 5, false, dry}; gemm_phase(al, p.mlp2_t, 4096, 8, ep, smem); } break;
    case 9: if (ONLY_PHASE < 0 || ONLY_PHASE == 9) prenorm_phase(p, 1, 0, false); break;
    case 10: if (ONLY_PHASE < 0 || ONLY_PHASE == 10) rwkv_proj_phase(p, smem); break;
    case 11: if (ONLY_PHASE < 0 || ONLY_PHASE == 11) rwkv_lora2_phase(p, smem); break;
    case 12: if (ONLY_PHASE < 0 || ONLY_PHASE == 12) rwkv_scan_phase(p, smem, dry); break;
    case 13: if (ONLY_PHASE < 0 || ONLY_PHASE == 13) { ALoadPlain al{p.LG, 128}; EpiRwkvOut ep{&p}; gemm_phase(al, p.g2_t, 128, 8, ep, smem); } break;
    case 14: if (ONLY_PHASE < 0 || ONLY_PHASE == 14) { ALoadPlain al{p.ZO, 1024}; EpiResid ep{&p, 1, 2, false, dry, true}; gemm_phase(al, p.wo_t, 1024, 8, ep, smem); } break;
    case 15: if (ONLY_PHASE < 0 || ONLY_PHASE == 15) prenorm_phase(p, 1, 1, false); break;
    case 16: if (ONLY_PHASE < 0 || ONLY_PHASE == 16) { ALoadPlain al{p.H, 1024}; EpiMlpUp ep{&p, 1}; gemm_phase(al, p.mlp1_t + (size_t)4096 * 1024, 1024, 32, ep, smem); } break;
    case 17: if (ONLY_PHASE < 0 || ONLY_PHASE == 17) { ALoadPlain al{p.U, 4096}; EpiResid ep{&p, 1, 5, false, dry}; gemm_phase(al, p.mlp2_t + (size_t)4096 * 1024, 4096, 8, ep, smem); } break;
    case 18: blend_phase(p); break;
    default: break;
  }
}

__global__ void __launch_bounds__(NT, 2) fwd_kernel(const Params p_unused, int ph_lo, int ph_hi) {
  const Params& p = *(const Params*)__builtin_amdgcn_kernarg_segment_ptr();
  __shared__ __attribute__((aligned(16))) char smem[65536];
  __shared__ uint4 xb_words;
  if (threadIdx.x == 0) xb_words = make_uint4(0u, 0u, 0u, 0u);
  __syncthreads();
  XcdBarrier xb = xcd_barrier_post(p.bar, (volatile LAS unsigned*)&xb_words);
  if (ph_hi < 0) cg::this_grid().sync();
#ifndef PROBE_MASK
#define PROBE_MASK 0
#endif
#ifndef PROBE_DRY
#define PROBE_DRY 0
#endif
#define PHASE(n, sync_) { if ((PROBE_MASK >> n) & 1) { run_phase(p, n, smem); xcd_barrier(xb); } if ((PROBE_DRY >> n) & 1) { run_phase(p, n, smem, true); xcd_barrier(xb); } run_phase(p, n, smem); if (sync_) xcd_barrier(xb); }
  PHASE(0, 1) PHASE(1, 1) PHASE(2, 1) PHASE(3, 1) PHASE(4, 1) PHASE(5, 1) PHASE(7, 1) PHASE(8, 1) PHASE(9, 1) PHASE(18, 1)
  PHASE(10, 1) PHASE(11, 1) PHASE(12, 1) PHASE(13, 1) PHASE(14, 1) PHASE(16, 1) PHASE(17, 0)
#undef PHASE
}

extern "C" void kernel_launch(void* const* d_in, const int* in_sizes, int n_in, void* d_out, int out_size, void* d_ws, size_t ws_size, hipStream_t stream) {
  Params p; memset(&p, 0, sizeof(p));
  auto F = [&](int i) { return (const float*)d_in[i]; };
  p.x_prompt = F(0); p.x_sample = F(1); p.cache_k = F(2); p.cache_v = F(3); p.hg_f0 = F(4); p.hg_b0 = F(5); p.rw_f0 = F(6); p.rw_b0 = F(7);
  p.c = F(8); p.c_ctx = F(9); p.ada_w = F(10); p.ada_b = F(11); p.norm1_w = F(12); p.norm2_w = F(13);
  p.q_norm = F(16); p.k_norm = F(17); p.hgrn_lb = F(18); p.g_norm = F(19); p.mix = F(20);
  p.w0 = F(25); p.a0 = F(28); p.k_k = F(33); p.k_a = F(34); p.r_k = F(35); p.ln_w = F(36); p.ln_b = F(37);
  float* out = (float*)d_out;
  p.X = out; p.out_k = out + 12582912; p.out_v = out + 13107200; p.out_hf = out + 13631488; p.out_hb = out + 14155776;
  p.out_rf = out + 14680064; p.out_rb = out + 15728640;
  char* ws = (char*)d_ws; size_t off = 16384;
  p.bar = (unsigned*)ws;
  auto alloc = [&](size_t bytes) { char* r = ws + off; off += (bytes + 255) & ~(size_t)255; return r; };
  const size_t M1 = (size_t)1024 * 1024;
  p.w_in_t = (bf16_t*)alloc((size_t)3328 * 1024 * 2); p.w_out_t = (bf16_t*)alloc(M1 * 2);
  p.wr_t = (bf16_t*)alloc(M1 * 2); p.wk_t = (bf16_t*)alloc(M1 * 2); p.wv_t = (bf16_t*)alloc(M1 * 2); p.wo_t = (bf16_t*)alloc(M1 * 2);
  p.w1cat_t = (bf16_t*)alloc(128 * 1024 * 2); p.a1cat_t = (bf16_t*)alloc(128 * 1024 * 2); p.g1_t = (bf16_t*)alloc(128 * 1024 * 2);
  p.w2_t = (bf16_t*)alloc(2 * 1024 * 64 * 2); p.a2_t = (bf16_t*)alloc(2 * 1024 * 64 * 2); p.g2_t = (bf16_t*)alloc(1024 * 128 * 2);
  p.mlp1_t = (bf16_t*)alloc(2 * 4 * M1 * 2); p.mlp2_t = (bf16_t*)alloc(2 * 4 * M1 * 2);
  p.MOD = (float*)alloc((size_t)2 * 9 * 6144 * 4);
  p.SSQ = (float*)alloc((size_t)2 * NTOK * 4); p.BM = (float*)alloc((size_t)2 * 9 * 4096 * 4);
  const size_t TOKD = (size_t)NTOK * 1024;
  p.H = (bf16_t*)alloc(TOKD * 2);
  const size_t regL = off;
  p.Qbuf = (bf16_t*)alloc((size_t)NTOK * 512 * 2);
  p.Kp = (bf16_t*)alloc((size_t)32 * 256 * 64 * 2); p.Ks = (bf16_t*)alloc((size_t)16 * 1280 * 64 * 2);
  p.Vtp = (bf16_t*)alloc((size_t)32 * 64 * 256 * 2); p.Vts = (bf16_t*)alloc((size_t)16 * 64 * 1280 * 2);
  p.HG = (bf16_t*)alloc((size_t)NTOK * 2560 * 2);
  p.OF = (float*)alloc((size_t)NTOK * 512 * 4); p.OB = (float*)alloc((size_t)NTOK * 512 * 4);
  p.AO = (bf16_t*)alloc(TOKD * 2);
  size_t end0 = off;
  off = regL; p.U = (bf16_t*)alloc((size_t)NTOK * 4096 * 2);
  size_t endU = off;
  off = regL;
  p.R = (bf16_t*)alloc(TOKD * 2); p.Kx = (bf16_t*)alloc(TOKD * 2); p.Vx = (bf16_t*)alloc(TOKD * 2);
  p.LW = (bf16_t*)alloc((size_t)NTOK * 128 * 2); p.LA = (bf16_t*)alloc((size_t)NTOK * 128 * 2); p.LG = (bf16_t*)alloc((size_t)NTOK * 128 * 2);
  p.E0 = (bf16_t*)alloc(TOKD * 2); p.E1 = (bf16_t*)alloc(TOKD * 2); p.A1 = (bf16_t*)alloc(TOKD * 2);
  p.BS = (float*)alloc((size_t)2 * NTOK * 16 * 4);
  p.A0 = p.H; p.ZO = p.R;
  size_t end1 = off;
  size_t need = end0 > end1 ? end0 : end1; if (endU > need) need = endU;
  if (need > ws_size) fprintf(stderr, "workspace too small: need %zu have %zu\n", need, ws_size);
  int nj = 0, tiles = 0;
  auto job = [&](const float* src, bf16_t* dst, int K, int N) { p.jobs[nj].src = src; p.jobs[nj].dst = dst; p.jobs[nj].K = K; p.jobs[nj].N = N; p.jobs[nj].tile0 = tiles; p.jobs[nj].pad = 0; tiles += (K / 64) * (N / 64); ++nj; };
  job(F(38), p.mlp1_t, 1024, 4096); job(F(38) + 4 * M1, p.mlp1_t + 4 * M1, 1024, 4096);
  job(F(39), p.mlp2_t, 4096, 1024); job(F(39) + 4 * M1, p.mlp2_t + 4 * M1, 4096, 1024);
  job(F(14), p.w_in_t, 1024, 3328); job(F(15), p.w_out_t, 1024, 1024);
  job(F(21), p.wr_t, 1024, 1024); job(F(22), p.wk_t, 1024, 1024); job(F(23), p.wv_t, 1024, 1024); job(F(24), p.wo_t, 1024, 1024);
  job(F(26), p.w1cat_t, 1024, 64); job(F(26) + 65536, p.w1cat_t + 65536, 1024, 64);
  job(F(29), p.a1cat_t, 1024, 64); job(F(29) + 65536, p.a1cat_t + 65536, 1024, 64);
  job(F(31), p.g1_t, 1024, 128);
  job(F(27), p.w2_t, 64, 1024); job(F(27) + 65536, p.w2_t + 65536, 64, 1024);
  job(F(30), p.a2_t, 64, 1024); job(F(30) + 65536, p.a2_t + 65536, 64, 1024);
  job(F(32), p.g2_t, 128, 1024);
  p.njobs = nj; p.ntiles = tiles;

  static int grid_blocks = 0;
  if (!grid_blocks) {
    int dev = 0, cus = 0, per_cu = 0;
    hipGetDevice(&dev);
    hipDeviceGetAttribute(&cus, hipDeviceAttributeMultiprocessorCount, dev);
    hipOccupancyMaxActiveBlocksPerMultiprocessor(&per_cu, fwd_kernel, NT, 0);
    if (per_cu > 2) per_cu = 2;
    if (per_cu < 1) per_cu = 1;
    grid_blocks = cus * per_cu;
  }
  hipMemsetAsync(d_ws, 0, 16384, stream);
  int lo = 0, hi = NPHASES;
  void* args[] = {(void*)&p, (void*)&lo, (void*)&hi};
  hipError_t e = hipLaunchCooperativeKernel((void*)fwd_kernel, dim3(grid_blocks), dim3(NT), args, 0, stream);
  if (e != hipSuccess) fprintf(stderr, "cooperative launch failed: %s (grid %d)\n", hipGetErrorString(e), grid_blocks);
}
```

```cpp
#include <hip/hip_runtime.h>
#include <hip/hip_cooperative_groups.h>
#include <stdint.h>
#include <string.h>
#include <stdio.h>
namespace cg = cooperative_groups;

typedef unsigned short bf16_t;
typedef short bf16x8 __attribute__((ext_vector_type(8)));
typedef float f32x4 __attribute__((ext_vector_type(4)));
typedef float f32x16 __attribute__((ext_vector_type(16)));
typedef float f32x2 __attribute__((ext_vector_type(2)));

#define NT 256
#define NTOK 12288
#define NP 4096
#define NPHASES 18
#ifndef ONLY_PHASE
#define ONLY_PHASE -1
#endif

struct TJob { const float* src; bf16_t* dst; int K, N, tile0, pad; };

struct Params {
  const float *x_prompt, *x_sample, *cache_k, *cache_v, *hg_f0, *hg_b0, *rw_f0, *rw_b0, *c, *c_ctx;
  const float *ada_w, *ada_b, *norm1_w, *norm2_w, *q_norm, *k_norm, *hgrn_lb, *g_norm;
  const float *mix, *w0, *a0, *k_k, *k_a, *r_k, *ln_w, *ln_b;
  float *X, *out_k, *out_v, *out_hf, *out_hb, *out_rf, *out_rb;
  bf16_t *w_in_t, *w_out_t, *wr_t, *wk_t, *wv_t, *wo_t, *w1cat_t, *a1cat_t, *g1_t, *w2_t, *a2_t, *g2_t, *mlp1_t, *mlp2_t;
  float* MOD;
  float *SSQ, *BM;
  bf16_t* H;
  bf16_t *Qbuf, *Kp, *Ks, *Vtp, *Vts, *HG, *AO, *U;
  float *OF, *OB;
  bf16_t *R, *Kx, *Vx, *LW, *LA, *LG, *E0, *E1, *A0, *A1, *ZO;
  float* BS;
  unsigned* bar;
  TJob jobs[20];
  int njobs, ntiles;
};

typedef float f32x2c __attribute__((ext_vector_type(2)));
typedef __bf16 bf16v2 __attribute__((ext_vector_type(2)));
__device__ __forceinline__ unsigned pk_bf16(float lo, float hi) { f32x2c v = {lo, hi}; bf16v2 b = __builtin_convertvector(v, bf16v2); return __builtin_bit_cast(unsigned, b); }
__device__ __forceinline__ bf16_t f2bf(float v) { return (bf16_t)(pk_bf16(v, 0.f) & 0xffffu); }
__device__ __forceinline__ float bf2f(bf16_t v) { return __uint_as_float(((unsigned)v) << 16); }
__device__ __forceinline__ float bflo(unsigned u) { return __uint_as_float(u << 16); }
__device__ __forceinline__ float bfhi(unsigned u) { return __uint_as_float(u & 0xffff0000u); }
__device__ __forceinline__ float sigmoidf_(float x) { return __builtin_amdgcn_rcpf(1.f + __expf(-x)); }
__device__ __forceinline__ float siluf_(float x) { return x * __builtin_amdgcn_rcpf(1.f + __expf(-x)); }
__device__ __forceinline__ float wave_sum(float v) {
#pragma unroll
  for (int o = 32; o >= 1; o >>= 1) v += __shfl_xor(v, o);
  return v;
}
__device__ __forceinline__ float quad_sum(float v) {
  v += __int_as_float(__builtin_amdgcn_update_dpp(0, __float_as_int(v), 0xB1, 0xF, 0xF, true));
  v += __int_as_float(__builtin_amdgcn_update_dpp(0, __float_as_int(v), 0x4E, 0xF, 0xF, true));
  return v;
}
__device__ __forceinline__ float oct_sum(float v) {
  v += __int_as_float(__builtin_amdgcn_update_dpp(0, __float_as_int(v), 0xB1, 0xF, 0xF, true));
  v += __int_as_float(__builtin_amdgcn_update_dpp(0, __float_as_int(v), 0x4E, 0xF, 0xF, true));
  v += __int_as_float(__builtin_amdgcn_update_dpp(0, __float_as_int(v), 0x141, 0xF, 0xF, true));
  return v;
}
__device__ __forceinline__ float hex_sum(float v) {
  v = oct_sum(v);
  v += __int_as_float(__builtin_amdgcn_update_dpp(0, __float_as_int(v), 0x140, 0xF, 0xF, true));
  return v;
}
__device__ __forceinline__ int mod_index(int row) { return row < NP ? 0 : 1 + ((row - NP) >> 10); }

__device__ __forceinline__ void ada_item(const Params& p, int it, char* smem) {
  const int tid = threadIdx.x;
  float* sil = (float*)smem;
  for (int i = tid; i < 9 * 1024; i += NT) {
    int n = i >> 10, k = i & 1023;
    float cv = n == 0 ? p.c_ctx[k] : p.c[(n - 1) * 1024 + k];
    sil[i] = siluf_(cv);
  }
  __syncthreads();
  const int gcol = it * 64, l = gcol / 6144, j = gcol % 6144;
  const int c4 = tid & 15, ks = tid >> 4;
  const float* wp = p.ada_w + (size_t)l * 1024 * 6144 + (size_t)(ks * 64) * 6144 + j + c4 * 4;
  float acc[9][4];
#pragma unroll
  for (int n = 0; n < 9; ++n) { acc[n][0] = 0.f; acc[n][1] = 0.f; acc[n][2] = 0.f; acc[n][3] = 0.f; }
#pragma unroll 4
  for (int k = 0; k < 64; ++k) {
    const f32x4 wv_ = __builtin_nontemporal_load((const f32x4*)(wp + (size_t)k * 6144));
    const float4 w = make_float4(wv_[0], wv_[1], wv_[2], wv_[3]);
#pragma unroll
    for (int n = 0; n < 9; ++n) {
      const float s = sil[n * 1024 + ks * 64 + k];
      acc[n][0] += s * w.x; acc[n][1] += s * w.y; acc[n][2] += s * w.z; acc[n][3] += s * w.w;
    }
  }
  __syncthreads();
  float* red = (float*)smem;
#pragma unroll
  for (int n = 0; n < 9; ++n)
#pragma unroll
    for (int q = 0; q < 4; ++q) red[(ks * 9 + n) * 64 + c4 * 4 + q] = acc[n][q];
  __syncthreads();
  for (int o = tid; o < 576; o += NT) {
    const int n = o >> 6, cc = o & 63;
    float s = 0.f;
#pragma unroll
    for (int k2 = 0; k2 < 16; ++k2) s += red[(k2 * 9 + n) * 64 + cc];
    s += p.ada_b[l * 6144 + j + cc];
    p.MOD[(size_t)(l * 9 + n) * 6144 + j + cc] = s;
  }
}

__device__ __forceinline__ void transpose_item(const Params& p, int tix, char* smem) {
  const int tid = threadIdx.x;
  int j = 0;
  while (j + 1 < p.njobs && tix >= p.jobs[j + 1].tile0) ++j;
  const float* src = p.jobs[j].src; bf16_t* dst = p.jobs[j].dst;
  const int K = p.jobs[j].K, N = p.jobs[j].N, lt = tix - p.jobs[j].tile0;
  const int ntn = N >> 6, tk = lt / ntn, tn = lt % ntn;
  float* tile = (float*)smem;
#pragma unroll
  for (int i = 0; i < 4; ++i) {
    const int r = (tid >> 4) + 16 * i, c4 = tid & 15;
    const f32x4 vv_ = __builtin_nontemporal_load((const f32x4*)(src + (size_t)(tk * 64 + r) * N + tn * 64 + c4 * 4));
    const float4 v = make_float4(vv_[0], vv_[1], vv_[2], vv_[3]);
    float* t = tile + r * 65 + c4 * 4;
    t[0] = v.x; t[1] = v.y; t[2] = v.z; t[3] = v.w;
  }
  __syncthreads();
  const int n = tid >> 2, kc = (tid & 3) * 16;
  unsigned w[8];
#pragma unroll
  for (int i = 0; i < 8; ++i) w[i] = pk_bf16(tile[(kc + 2 * i) * 65 + n], tile[(kc + 2 * i + 1) * 65 + n]);
  uint4* d = (uint4*)(dst + (size_t)(tn * 64 + n) * K + tk * 64 + kc);
  d[0] = make_uint4(w[0], w[1], w[2], w[3]);
  d[1] = make_uint4(w[4], w[5], w[6], w[7]);
}

__device__ __forceinline__ void cache_item(const Params& p, int ci) {
  const int tid = threadIdx.x;
  const int base = (ci & 31) * 8192;
  for (int e = tid; e < 8192; e += NT) {
    const int idx = base + e;
    const int d = idx & 63, kvh = (idx >> 6) & 1, pp = (idx >> 7) & 255, b = idx >> 15;
    if (ci < 32) p.Ks[((size_t)(b * 2 + kvh) * 1280 + 1024 + pp) * 64 + d] = f2bf(p.cache_k[idx]);
    else p.Vts[((size_t)(b * 2 + kvh) * 64 + d) * 1280 + 1024 + pp] = f2bf(p.cache_v[idx]);
  }
}

__device__ __forceinline__ void phase0(const Params& p, char* smem) {
  const int n_ada = 192, n_tr = p.ntiles, n_cc = 64;
  const int total = n_ada + n_tr + n_cc;
  for (int it = blockIdx.x; it < total; it += gridDim.x) {
    if (it < n_ada) ada_item(p, it, smem);
    else if (it < n_ada + n_tr) transpose_item(p, it - n_ada, smem);
    else cache_item(p, it - n_ada - n_tr);
    __syncthreads();
  }
}

__device__ __forceinline__ void prenorm_phase(const Params& p, int layer, int which, bool from_input) {
  const int wave = threadIdx.x >> 6, lane = threadIdx.x & 63;
  const float* nw = (which ? p.norm2_w : p.norm1_w) + layer * 1024;
  for (int row = blockIdx.x * 4 + wave; row < NTOK; row += gridDim.x * 4) {
    const float* xr = from_input ? (row < NP ? p.x_prompt + (size_t)row * 1024 : p.x_sample + (size_t)(row - NP) * 1024)
                                 : p.X + (size_t)row * 1024;
    float4 v[4]; float ss = 0.f;
#pragma unroll
    for (int i = 0; i < 4; ++i) { v[i] = *(const float4*)(xr + i * 256 + lane * 4); ss += v[i].x * v[i].x + v[i].y * v[i].y + v[i].z * v[i].z + v[i].w * v[i].w; }
    ss = wave_sum(ss);
    const float rstd = rsqrtf(ss * (1.f / 1024.f) + 1e-6f);
    const float* md = p.MOD + (size_t)(layer * 9 + mod_index(row)) * 6144;
    const float* sh = md + (which ? 3 : 0) * 1024; const float* sc = md + (which ? 4 : 1) * 1024;
#pragma unroll
    for (int i = 0; i < 4; ++i) {
      const int c = i * 256 + lane * 4;
      const float4 w4 = *(const float4*)(nw + c), s4 = *(const float4*)(sh + c), c4 = *(const float4*)(sc + c);
      const float h0 = v[i].x * rstd * w4.x * (1.f + c4.x) + s4.x, h1 = v[i].y * rstd * w4.y * (1.f + c4.y) + s4.y;
      const float h2 = v[i].z * rstd * w4.z * (1.f + c4.z) + s4.z, h3 = v[i].w * rstd * w4.w * (1.f + c4.w) + s4.w;
      *(uint2*)(p.H + (size_t)row * 1024 + c) = make_uint2(pk_bf16(h0, h1), pk_bf16(h2, h3));
    }
  }
}

__device__ __forceinline__ void mlp_bias_phase(const Params& p) {
  const int gid = blockIdx.x * NT + threadIdx.x, nth = gridDim.x * NT;
  for (int i = gid; i < 2 * NTOK; i += nth) p.SSQ[i] = 0.f;
  const int wave = threadIdx.x >> 6, lane = threadIdx.x & 63;
  for (int o = blockIdx.x * 4 + wave; o < 2 * 4096; o += gridDim.x * 4) {
    const int l = o >> 12, n = o & 4095;
    const bf16_t* wrow = p.mlp1_t + (size_t)l * 4096 * 1024 + (size_t)n * 1024 + lane * 16;
    const uint4 w0 = *(const uint4*)(wrow), w1 = *(const uint4*)(wrow + 8);
    const float wv[16] = {bflo(w0.x), bfhi(w0.x), bflo(w0.y), bfhi(w0.y), bflo(w0.z), bfhi(w0.z), bflo(w0.w), bfhi(w0.w),
                          bflo(w1.x), bfhi(w1.x), bflo(w1.y), bfhi(w1.y), bflo(w1.z), bfhi(w1.z), bflo(w1.w), bfhi(w1.w)};
#pragma unroll 1
    for (int m = 0; m < 9; ++m) {
      const float* sh = p.MOD + (size_t)(l * 9 + m) * 6144 + 3 * 1024 + lane * 16;
      float acc = 0.f;
#pragma unroll
      for (int q = 0; q < 4; ++q) { const float4 s4 = *(const float4*)(sh + q * 4); acc += s4.x * wv[q * 4] + s4.y * wv[q * 4 + 1] + s4.z * wv[q * 4 + 2] + s4.w * wv[q * 4 + 3]; }
      acc = wave_sum(acc);
      if (lane == 0) p.BM[(size_t)(l * 9 + m) * 4096 + n] = acc;
    }
  }
}

struct ALoadPlain {
  const bf16_t* A; int lda;
  __device__ __forceinline__ uint4 operator()(int row, int k) const { return *(const uint4*)(A + (size_t)row * lda + k); }
};
struct ALoadShift {
  const bf16_t* H; const float* mix;
  __device__ __forceinline__ uint4 operator()(int row, int k) const {
    const uint4 h = *(const uint4*)(H + (size_t)row * 1024 + k);
    int tl, T;
    if (row < NP) { tl = row & 255; T = 256; } else { tl = (row - NP) & 1023; T = 1024; }
    uint4 s = make_uint4(0, 0, 0, 0);
    if (k < 512) { if (tl > 0) s = *(const uint4*)(H + (size_t)(row - 1) * 1024 + k); }
    else { if (tl < T - 1) s = *(const uint4*)(H + (size_t)(row + 1) * 1024 + k); }
    const float4 m0 = *(const float4*)(mix + k), m1 = *(const float4*)(mix + k + 4);
    uint4 o;
    { float a = bflo(h.x), b = bfhi(h.x); o.x = pk_bf16(a + (bflo(s.x) - a) * m0.x, b + (bfhi(s.x) - b) * m0.y); }
    { float a = bflo(h.y), b = bfhi(h.y); o.y = pk_bf16(a + (bflo(s.y) - a) * m0.z, b + (bfhi(s.y) - b) * m0.w); }
    { float a = bflo(h.z), b = bfhi(h.z); o.z = pk_bf16(a + (bflo(s.z) - a) * m1.x, b + (bfhi(s.z) - b) * m1.y); }
    { float a = bflo(h.w), b = bfhi(h.w); o.w = pk_bf16(a + (bflo(s.w) - a) * m1.z, b + (bfhi(s.w) - b) * m1.w); }
    return o;
  }
};

template <class AL, class EP>
__device__ __forceinline__ void gemm_tile(const AL& al, const bf16_t* __restrict__ Bt, int K, int tm, int tn, const EP& ep, char* smem) {
  const int tid = threadIdx.x, lane = tid & 63, wid = tid >> 6, wm = wid >> 1, wn = wid & 1;
  const int fr = lane & 15, fq = lane >> 4;
  char* sA = smem; char* sB = smem + 32768;
  f32x4 acc[4][4];
#pragma unroll
  for (int a = 0; a < 4; ++a)
#pragma unroll
    for (int b = 0; b < 4; ++b) acc[a][b] = (f32x4){0.f, 0.f, 0.f, 0.f};
  uint4 pa[4], pb[4];
  const int nk = K >> 6;
  const int cr0 = tid >> 3, cc = tid & 7;
  const int soff = cr0 * 128 + ((cc ^ ((cr0 >> 1) & 7)) << 4);
  const bf16_t* bp = Bt + (size_t)(tn * 128 + cr0) * K + cc * 8;
#define GLOAD(kt) do { _Pragma("unroll") for (int i = 0; i < 4; ++i) { pa[i] = al(tm * 128 + cr0 + 32 * i, (kt) * 64 + cc * 8); pb[i] = *(const uint4*)(bp + (size_t)(32 * i) * K + (kt) * 64); } } while (0)
#define SSTORE(buf) do { _Pragma("unroll") for (int i = 0; i < 4; ++i) { *(uint4*)(sA + (buf) * 16384 + soff + i * 4096) = pa[i]; *(uint4*)(sB + (buf) * 16384 + soff + i * 4096) = pb[i]; } } while (0)
  GLOAD(0); SSTORE(0); __syncthreads();
  for (int kt = 0; kt < nk; ++kt) {
    const int buf = kt & 1;
    if (kt + 1 < nk) GLOAD(kt + 1);
#pragma unroll
    for (int kk = 0; kk < 2; ++kk) {
      bf16x8 af[4], bfr[4];
#pragma unroll
      for (int mi = 0; mi < 4; ++mi) { const int r = wm * 64 + mi * 16 + fr, c = kk * 4 + fq; af[mi] = *(const bf16x8*)(sA + buf * 16384 + r * 128 + ((c ^ ((r >> 1) & 7)) << 4)); }
#pragma unroll
      for (int ni = 0; ni < 4; ++ni) { const int r = wn * 64 + ni * 16 + fr, c = kk * 4 + fq; bfr[ni] = *(const bf16x8*)(sB + buf * 16384 + r * 128 + ((c ^ ((r >> 1) & 7)) << 4)); }
#pragma unroll
      for (int mi = 0; mi < 4; ++mi)
#pragma unroll
        for (int ni = 0; ni < 4; ++ni) acc[mi][ni] = __builtin_amdgcn_mfma_f32_16x16x32_bf16(bfr[ni], af[mi], acc[mi][ni], 0, 0, 0);
    }
    if (kt + 1 < nk) SSTORE(buf ^ 1);
    __syncthreads();
  }
#undef GLOAD
#undef SSTORE
  ep(acc, tm * 128 + wm * 64, tn * 128 + wn * 64, lane);
}

#define LAS3 __attribute__((address_space(3)))
template <int OFF>
__device__ __forceinline__ bf16x8 lds_rd128(unsigned addr) { bf16x8 v; asm volatile("ds_read_b128 %0, %1 offset:%2" : "=v"(v) : "v"(addr), "n"(OFF) : "memory"); return v; }
template <class EP>
__device__ __forceinline__ void gemm_tile_glds(const bf16_t* __restrict__ A, int lda, const bf16_t* __restrict__ Bt, int K, int tm, int tn, const EP& ep, char* smem) {
  const int tid = threadIdx.x, lane = tid & 63, wid = __builtin_amdgcn_readfirstlane(tid >> 6), wm = wid >> 1, wn = wid & 1;
  const int fr = lane & 15, fq = lane >> 4;
  f32x4 acc[4][4];
#pragma unroll
  for (int a = 0; a < 4; ++a)
#pragma unroll
    for (int b = 0; b < 4; ++b) acc[a][b] = (f32x4){0.f, 0.f, 0.f, 0.f};
  const int nk = K >> 6;
  const int lr = lane >> 3, c0 = (lane & 7) ^ (lr >> 1);
  const bf16_t* pa = A + (size_t)(tm * 128 + wid * 32 + lr) * lda;
  const bf16_t* pb = Bt + (size_t)(tn * 128 + wid * 32 + lr) * K;
  const unsigned lbase = (unsigned)(uintptr_t)(LAS3 char*)smem;
  const unsigned fsw = (unsigned)((fq ^ ((fr >> 1) & 7)) << 4);
  const unsigned aA0 = lbase + (unsigned)((wm * 64 + fr) * 128) + fsw, aA1 = lbase + (unsigned)((wm * 64 + fr) * 128) + (fsw ^ 64u);
  const unsigned aB0 = lbase + 32768u + (unsigned)((wn * 64 + fr) * 128) + fsw, aB1 = lbase + 32768u + (unsigned)((wn * 64 + fr) * 128) + (fsw ^ 64u);
#define GLDS(kt, buf) do { _Pragma("unroll") for (int i = 0; i < 4; ++i) { const int cc_ = (c0 ^ ((i & 1) << 2)) * 8 + (kt) * 64; \
    __builtin_amdgcn_global_load_lds((const unsigned*)(pa + (size_t)(i * 8) * lda + cc_), (LAS3 unsigned*)(smem + (buf) * 16384 + (wid * 4 + i) * 1024), 16, 0, 0); \
    __builtin_amdgcn_global_load_lds((const unsigned*)(pb + (size_t)(i * 8) * K + cc_), (LAS3 unsigned*)(smem + 32768 + (buf) * 16384 + (wid * 4 + i) * 1024), 16, 0, 0); } } while (0)
  GLDS(0, 0);
  asm volatile("s_waitcnt vmcnt(0)" ::: "memory");
  __builtin_amdgcn_s_barrier();
  for (int kt = 0; kt < nk; ++kt) {
    const int buf = kt & 1;
    if (kt + 1 < nk) GLDS(kt + 1, buf ^ 1);
    const unsigned bo = (unsigned)buf * 16384u;
    bf16x8 a0[4], b0[4], a1[4], b1[4];
    a0[0] = lds_rd128<0>(aA0 + bo); a0[1] = lds_rd128<2048>(aA0 + bo); a0[2] = lds_rd128<4096>(aA0 + bo); a0[3] = lds_rd128<6144>(aA0 + bo);
    b0[0] = lds_rd128<0>(aB0 + bo); b0[1] = lds_rd128<2048>(aB0 + bo); b0[2] = lds_rd128<4096>(aB0 + bo); b0[3] = lds_rd128<6144>(aB0 + bo);
    a1[0] = lds_rd128<0>(aA1 + bo); a1[1] = lds_rd128<2048>(aA1 + bo); a1[2] = lds_rd128<4096>(aA1 + bo); a1[3] = lds_rd128<6144>(aA1 + bo);
    b1[0] = lds_rd128<0>(aB1 + bo); b1[1] = lds_rd128<2048>(aB1 + bo); b1[2] = lds_rd128<4096>(aB1 + bo); b1[3] = lds_rd128<6144>(aB1 + bo);
    __builtin_amdgcn_sched_barrier(0);
    asm volatile("s_waitcnt lgkmcnt(8)" : "+v"(a0[0]), "+v"(a0[1]), "+v"(a0[2]), "+v"(a0[3]), "+v"(b0[0]), "+v"(b0[1]), "+v"(b0[2]), "+v"(b0[3]) :: "memory");
    __builtin_amdgcn_s_setprio(1);
#pragma unroll
    for (int mi = 0; mi < 4; ++mi)
#pragma unroll
      for (int ni = 0; ni < 4; ++ni) acc[mi][ni] = __builtin_amdgcn_mfma_f32_16x16x32_bf16(b0[ni], a0[mi], acc[mi][ni], 0, 0, 0);
    __builtin_amdgcn_sched_barrier(0);
    asm volatile("s_waitcnt lgkmcnt(0)" : "+v"(a1[0]), "+v"(a1[1]), "+v"(a1[2]), "+v"(a1[3]), "+v"(b1[0]), "+v"(b1[1]), "+v"(b1[2]), "+v"(b1[3]) :: "memory");
#pragma unroll
    for (int mi = 0; mi < 4; ++mi)
#pragma unroll
      for (int ni = 0; ni < 4; ++ni) acc[mi][ni] = __builtin_amdgcn_mfma_f32_16x16x32_bf16(b1[ni], a1[mi], acc[mi][ni], 0, 0, 0);
    __builtin_amdgcn_s_setprio(0);
    __builtin_amdgcn_sched_barrier(0);
    asm volatile("s_waitcnt vmcnt(0)" ::: "memory");
    __builtin_amdgcn_s_barrier();
    __builtin_amdgcn_sched_barrier(0);
  }
#undef GLDS
  ep(acc, tm * 128 + wm * 64, tn * 128 + wn * 64, lane);
}

struct EpiWin {
  const Params* pp;
  __device__ __forceinline__ void operator()(f32x4 (&acc)[4][4], int row0, int col0, int lane) const {
    const Params& p = *pp;
    const int fr = lane & 15, fq = lane >> 4;
    const bool sample = row0 >= NP;
    if (col0 < 640) {
      const bool isq = col0 < 512;
      const float* nw = isq ? p.q_norm : p.k_norm;
      float nwv[4][4];
#pragma unroll
      for (int ni = 0; ni < 4; ++ni)
#pragma unroll
        for (int j = 0; j < 4; ++j) nwv[ni][j] = nw[ni * 16 + fq * 4 + j];
#pragma unroll
      for (int mi = 0; mi < 4; ++mi) {
        const int row = row0 + mi * 16 + fr;
        float ss = 0.f;
#pragma unroll
        for (int ni = 0; ni < 4; ++ni)
#pragma unroll
          for (int j = 0; j < 4; ++j) ss += acc[mi][ni][j] * acc[mi][ni][j];
        ss += __shfl_xor(ss, 16); ss += __shfl_xor(ss, 32);
        const float rn = rsqrtf(ss * (1.f / 64.f) + 1e-6f);
        float y[4][4];
#pragma unroll
        for (int ni = 0; ni < 4; ++ni)
#pragma unroll
          for (int j = 0; j < 4; ++j) y[ni][j] = acc[mi][ni][j] * rn * nwv[ni][j];
        if (!sample && !isq) {
          const int kvh = (col0 - 512) >> 6;
#pragma unroll
          for (int ni = 0; ni < 4; ++ni) *(f32x4*)(p.out_k + (size_t)row * 128 + kvh * 64 + ni * 16 + fq * 4) = (f32x4){y[ni][0], y[ni][1], y[ni][2], y[ni][3]};
        }
        if (sample) {
          const int tl = (row - NP) & 1023;
          const float rp = (float)(tl >> 6), cp = (float)(tl & 63);
#pragma unroll
          for (int ni = 0; ni < 4; ++ni)
#pragma unroll
            for (int jp = 0; jp < 2; ++jp) {
              const int i = (ni * 16 + fq * 4 + jp * 2) >> 1;
              const float pos = i < 16 ? rp : cp;
              const float inv = exp2f(-(float)(i & 15) * 0.83048202372184058696f);
              const float ang = pos * inv;
              const float s = __sinf(ang), c = __cosf(ang);
              const float x0 = y[ni][2 * jp], x1 = y[ni][2 * jp + 1];
              y[ni][2 * jp] = x0 * c - x1 * s; y[ni][2 * jp + 1] = x0 * s + x1 * c;
            }
        }
        if (isq) {
          const float qs = 0.125f * 1.44269504088896f;
#pragma unroll
          for (int ni = 0; ni < 4; ++ni)
            *(uint2*)(p.Qbuf + (size_t)row * 512 + col0 + ni * 16 + fq * 4) = make_uint2(pk_bf16(y[ni][0] * qs, y[ni][1] * qs), pk_bf16(y[ni][2] * qs, y[ni][3] * qs));
        } else {
          const int kvh = (col0 - 512) >> 6;
          bf16_t* kd;
          if (!sample) kd = p.Kp + ((size_t)((row >> 8) * 2 + kvh) * 256 + (row & 255)) * 64;
          else kd = p.Ks + ((size_t)(((row - NP) >> 10) * 2 + kvh) * 1280 + ((row - NP) & 1023)) * 64;
#pragma unroll
          for (int ni = 0; ni < 4; ++ni)
            *(uint2*)(kd + ni * 16 + fq * 4) = make_uint2(pk_bf16(y[ni][0], y[ni][1]), pk_bf16(y[ni][2], y[ni][3]));
        }
      }
    } else if (col0 < 768) {
      const int kvh = (col0 - 640) >> 6;
#pragma unroll
      for (int mi = 0; mi < 4; ++mi) {
        const int row = row0 + mi * 16 + fr;
#pragma unroll
        for (int ni = 0; ni < 4; ++ni) {
          const int d0 = ni * 16 + fq * 4;
          if (!sample) {
            *(f32x4*)(p.out_v + (size_t)row * 128 + kvh * 64 + d0) = acc[mi][ni];
            bf16_t* vd = p.Vtp + ((size_t)((row >> 8) * 2 + kvh) * 64 + d0) * 256 + (row & 255);
#pragma unroll
            for (int j = 0; j < 4; ++j) vd[j * 256] = f2bf(acc[mi][ni][j]);
          } else {
            bf16_t* vd = p.Vts + ((size_t)(((row - NP) >> 10) * 2 + kvh) * 64 + d0) * 1280 + ((row - NP) & 1023);
#pragma unroll
            for (int j = 0; j < 4; ++j) vd[j * 1280] = f2bf(acc[mi][ni][j]);
          }
        }
      }
    } else {
      const int c0 = col0 - 768, seg = c0 >> 9;
      float oml[4][4];
      if (seg == 1 || seg == 2) {
#pragma unroll
        for (int ni = 0; ni < 4; ++ni)
#pragma unroll
          for (int j = 0; j < 4; ++j) { const int c = (c0 & 511) + ni * 16 + fq * 4 + j; oml[ni][j] = __builtin_amdgcn_rcpf(1.f + __expf(p.hgrn_lb[c] - p.hgrn_lb[512 + c])); }
      }
#pragma unroll
      for (int mi = 0; mi < 4; ++mi) {
        const int row = row0 + mi * 16 + fr;
#pragma unroll
        for (int ni = 0; ni < 4; ++ni) {
          float o[4];
#pragma unroll
          for (int j = 0; j < 4; ++j) {
            const float v = acc[mi][ni][j];
            if (seg == 0 || seg == 4) o[j] = siluf_(v);
            else if (seg == 3) o[j] = v;
            else o[j] = oml[ni][j] * sigmoidf_(-v);
          }
          *(uint2*)(p.HG + (size_t)row * 2560 + c0 + ni * 16 + fq * 4) = make_uint2(pk_bf16(o[0], o[1]), pk_bf16(o[2], o[3]));
        }
      }
    }
  }
};

struct EpiResid {
  const Params* pp; int layer, gidx; bool from_input; bool dry = false; bool fuse_norm2 = false;
  __device__ __forceinline__ void operator()(f32x4 (&acc)[4][4], int row0, int col0, int lane) const {
    const Params& p = *pp;
    if (dry && p.njobs >= 0) return;
    const int fr = lane & 15, fq = lane >> 4;
    const float* md = p.MOD + (size_t)(layer * 9 + mod_index(row0)) * 6144;
    const float* gt = md + gidx * 1024;
#pragma unroll
    for (int mi = 0; mi < 4; ++mi) {
      const int row = row0 + mi * 16 + fr;
      const float* base = from_input ? (row < NP ? p.x_prompt + (size_t)row * 1024 : p.x_sample + (size_t)(row - NP) * 1024) : p.X + (size_t)row * 1024;
      float ss = 0.f;
#pragma unroll
      for (int ni = 0; ni < 4; ++ni) {
        const int col = col0 + ni * 16 + fq * 4;
        const f32x4 b = *(const f32x4*)(base + col), g = *(const f32x4*)(gt + col);
        const f32x4 xn = b + g * acc[mi][ni];
        *(f32x4*)(p.X + (size_t)row * 1024 + col) = xn;
        if (fuse_norm2) {
          const f32x4 w2 = *(const f32x4*)(p.norm2_w + layer * 1024 + col), sc = *(const f32x4*)(md + 4 * 1024 + col);
          const f32x4 hv = xn * (w2 * (sc + 1.f));
          *(uint2*)(p.H + (size_t)row * 1024 + col) = make_uint2(pk_bf16(hv[0], hv[1]), pk_bf16(hv[2], hv[3]));
          ss += xn[0] * xn[0] + xn[1] * xn[1] + xn[2] * xn[2] + xn[3] * xn[3];
        }
      }
      if (fuse_norm2) {
        ss += __shfl_xor(ss, 16); ss += __shfl_xor(ss, 32);
        if (fq == 0) atomicAdd(p.SSQ + layer * NTOK + row, ss);
      }
    }
  }
};

struct EpiMlpUp {
  const Params* pp; int layer;
  __device__ __forceinline__ void operator()(f32x4 (&acc)[4][4], int row0, int col0, int lane) const {
    const Params& p = *pp;
    const int fr = lane & 15, fq = lane >> 4;
    const float* bm = p.BM + (size_t)(layer * 9 + mod_index(row0)) * 4096;
    float rs[4];
#pragma unroll
    for (int mi = 0; mi < 4; ++mi) rs[mi] = rsqrtf(p.SSQ[layer * NTOK + row0 + mi * 16 + fr] * (1.f / 1024.f) + 1e-6f);
#pragma unroll
    for (int ni = 0; ni < 4; ++ni) {
      const int col = col0 + ni * 16 + fq * 4;
      const f32x4 bv = *(const f32x4*)(bm + col);
#pragma unroll
      for (int mi = 0; mi < 4; ++mi) {
        const int row = row0 + mi * 16 + fr;
        float o[4];
#pragma unroll
        for (int j = 0; j < 4; ++j) { const float r = fmaxf(acc[mi][ni][j] * rs[mi] + bv[j], 0.f); o[j] = r * r; }
        *(uint2*)(p.U + (size_t)row * 4096 + col) = make_uint2(pk_bf16(o[0], o[1]), pk_bf16(o[2], o[3]));
      }
    }
  }
};

template <int ACT>
struct EpiAct {
  bf16_t* O; int ldo; const float* bias;
  __device__ __forceinline__ void operator()(f32x4 (&acc)[4][4], int row0, int col0, int lane) const {
    const int fr = lane & 15, fq = lane >> 4;
#pragma unroll
    for (int ni = 0; ni < 4; ++ni) {
      const int col = col0 + ni * 16 + fq * 4;
      f32x4 bv = (f32x4){0.f, 0.f, 0.f, 0.f};
      if (ACT >= 4) bv = *(const f32x4*)(bias + col);
#pragma unroll
      for (int mi = 0; mi < 4; ++mi) {
        const int row = row0 + mi * 16 + fr;
        float o[4];
#pragma unroll
        for (int j = 0; j < 4; ++j) {
          const float v = acc[mi][ni][j] + bv[j];
          if (ACT == 0) o[j] = v;
          else if (ACT == 1) { const float r = fmaxf(v, 0.f); o[j] = r * r; }
          else if (ACT == 2) o[j] = 1.f - 2.f * __builtin_amdgcn_rcpf(1.f + __expf(2.f * v));
          else if (ACT == 3 || ACT == 5) o[j] = sigmoidf_(v);
          else o[j] = 0.60653065971263342f * sigmoidf_(v);
        }
        *(uint2*)(O + (size_t)row * ldo + col) = make_uint2(pk_bf16(o[0], o[1]), pk_bf16(o[2], o[3]));
      }
    }
  }
};

struct EpiRwkvOut {
  const Params* pp;
  __device__ __forceinline__ void operator()(f32x4 (&acc)[4][4], int row0, int col0, int lane) const {
    const Params& p = *pp;
    const int fr = lane & 15, fq = lane >> 4, h = col0 >> 6;
#pragma unroll
    for (int mi = 0; mi < 4; ++mi) {
      const int row = row0 + mi * 16 + fr;
      float y[4][4]; float s = 0.f;
#pragma unroll
      for (int ni = 0; ni < 4; ++ni) {
        const size_t idx = (size_t)row * 1024 + col0 + ni * 16 + fq * 4;
        const uint2 a = *(const uint2*)(p.E0 + idx), b = *(const uint2*)(p.E1 + idx);
        y[ni][0] = bflo(a.x) + bflo(b.x); y[ni][1] = bfhi(a.x) + bfhi(b.x); y[ni][2] = bflo(a.y) + bflo(b.y); y[ni][3] = bfhi(a.y) + bfhi(b.y);
        s += (y[ni][0] + y[ni][1]) + (y[ni][2] + y[ni][3]);
      }
      s += __shfl_xor(s, 16); s += __shfl_xor(s, 32);
      const float mu = s * (1.f / 64.f);
      float q = 0.f;
#pragma unroll
      for (int ni = 0; ni < 4; ++ni)
#pragma unroll
        for (int j = 0; j < 4; ++j) { const float d = y[ni][j] - mu; q += d * d; }
      q += __shfl_xor(q, 16); q += __shfl_xor(q, 32);
      const float rs = rsqrtf(q * (1.f / 64.f) + 64e-5f);
      const float bs = p.BS[(size_t)row * 16 + h] + p.BS[(size_t)NTOK * 16 + (size_t)row * 16 + h];
#pragma unroll
      for (int ni = 0; ni < 4; ++ni) {
        const int col = col0 + ni * 16 + fq * 4;
        const size_t idx = (size_t)row * 1024 + col;
        const uint2 vv = *(const uint2*)(p.Vx + idx);
        const f32x4 lw = *(const f32x4*)(p.ln_w + col), lb = *(const f32x4*)(p.ln_b + col);
        const float v0 = bflo(vv.x), v1 = bfhi(vv.x), v2 = bflo(vv.y), v3 = bfhi(vv.y);
        const float o0 = ((y[ni][0] - mu) * rs * lw[0] + lb[0] + bs * v0) * acc[mi][ni][0];
        const float o1 = ((y[ni][1] - mu) * rs * lw[1] + lb[1] + bs * v1) * acc[mi][ni][1];
        const float o2 = ((y[ni][2] - mu) * rs * lw[2] + lb[2] + bs * v2) * acc[mi][ni][2];
        const float o3 = ((y[ni][3] - mu) * rs * lw[3] + lb[3] + bs * v3) * acc[mi][ni][3];
        *(uint2*)(p.ZO + idx) = make_uint2(pk_bf16(o0, o1), pk_bf16(o2, o3));
      }
    }
  }
};

template <class EP>
__device__ __forceinline__ void gemm_phase(const ALoadPlain& al, const bf16_t* Bt, int K, int ntn, const EP& ep, char* smem) {
  const int nunits = (NTOK / 128) * ntn;
  for (int u = blockIdx.x; u < nunits; u += gridDim.x) gemm_tile_glds(al.A, al.lda, Bt, K, u / ntn, u % ntn, ep, smem);
}

__device__ __forceinline__ void attn_item(const Params& p, int grp, int b, int h, int qb, char* smem) {
  const int tid = threadIdx.x, lane = tid & 63, wid = tid >> 6, qi = lane & 31, g = lane >> 5;
  const int Tk = grp ? 1280 : 256, kvh = h >> 2;
  const int rowbase = grp ? NP + b * 1024 + qb * 128 : b * 256 + qb * 128;
  const bf16_t* Kg = grp ? p.Ks + (size_t)(b * 2 + kvh) * 1280 * 64 : p.Kp + (size_t)(b * 2 + kvh) * 256 * 64;
  const bf16_t* Vg = grp ? p.Vts + (size_t)(b * 2 + kvh) * 64 * 1280 : p.Vtp + (size_t)(b * 2 + kvh) * 64 * 256;
  const int qrow = rowbase + wid * 32 + qi;
  bf16x8 Qf[4];
#pragma unroll
  for (int s = 0; s < 4; ++s) Qf[s] = *(const bf16x8*)(p.Qbuf + (size_t)qrow * 512 + h * 64 + s * 16 + g * 8);
  f32x16 O[2];
#pragma unroll
  for (int i = 0; i < 16; ++i) { O[0][i] = 0.f; O[1][i] = 0.f; }
  float m_run = -1e30f, l_run = 0.f;
  char* sK = smem; char* sV = smem + 16384;
  const int r0 = tid >> 3, c = tid & 7;
  uint4 pk[2], pv[2];
  const int ntile = Tk >> 6;
#define ALOAD(kt) do { _Pragma("unroll") for (int i = 0; i < 2; ++i) { const int r = r0 + 32 * i; pk[i] = *(const uint4*)(Kg + (size_t)((kt) * 64 + r) * 64 + c * 8); pv[i] = *(const uint4*)(Vg + (size_t)r * Tk + (kt) * 64 + c * 8); } } while (0)
#define ASTORE(buf) do { _Pragma("unroll") for (int i = 0; i < 2; ++i) { const int r = r0 + 32 * i; \
      *(uint4*)(sK + (buf) * 8192 + r * 128 + ((c ^ ((r >> 1) & 7)) << 4)) = pk[i]; \
      const int f = (r >> 1) & 15; \
      *(uint2*)(sV + (buf) * 8192 + r * 128 + (((2 * c) ^ f) << 3)) = make_uint2(pv[i].x, pv[i].y); \
      *(uint2*)(sV + (buf) * 8192 + r * 128 + (((2 * c + 1) ^ f) << 3)) = make_uint2(pv[i].z, pv[i].w); } } while (0)
  ALOAD(0); ASTORE(0); __syncthreads();
  for (int kt = 0; kt < ntile; ++kt) {
    const int buf = kt & 1;
    if (kt + 1 < ntile) ALOAD(kt + 1);
    f32x16 S[2];
#pragma unroll
    for (int t2 = 0; t2 < 2; ++t2) {
#pragma unroll
      for (int i = 0; i < 16; ++i) S[t2][i] = 0.f;
#pragma unroll
      for (int s = 0; s < 4; ++s) {
        const int r = t2 * 32 + qi, cc = 2 * s + g;
        const bf16x8 Kf = *(const bf16x8*)(sK + buf * 8192 + r * 128 + ((cc ^ ((r >> 1) & 7)) << 4));
        S[t2] = __builtin_amdgcn_mfma_f32_32x32x16_bf16(Kf, Qf[s], S[t2], 0, 0, 0);
      }
    }
    float mx = S[0][0];
#pragma unroll
    for (int i = 0; i < 16; ++i) { mx = fmaxf(mx, S[0][i]); mx = fmaxf(mx, S[1][i]); }
    mx = fmaxf(mx, __shfl_xor(mx, 32));
    const float m_new = fmaxf(m_run, mx);
    const float alpha = __builtin_amdgcn_exp2f(m_run - m_new);
    float ls = 0.f;
#pragma unroll
    for (int i = 0; i < 16; ++i) { S[0][i] = __builtin_amdgcn_exp2f(S[0][i] - m_new); S[1][i] = __builtin_amdgcn_exp2f(S[1][i] - m_new); ls += S[0][i] + S[1][i]; }
    l_run = l_run * alpha + ls; m_run = m_new;
#pragma unroll
    for (int i = 0; i < 16; ++i) { O[0][i] *= alpha; O[1][i] *= alpha; }
#pragma unroll
    for (int t2 = 0; t2 < 2; ++t2)
#pragma unroll
      for (int sp = 0; sp < 2; ++sp) {
        union { bf16x8 v; unsigned u[4]; } Pf;
#pragma unroll
        for (int e = 0; e < 4; ++e) Pf.u[e] = pk_bf16(S[t2][8 * sp + 2 * e], S[t2][8 * sp + 2 * e + 1]);
#pragma unroll
        for (int ds = 0; ds < 2; ++ds) {
          const int d = ds * 32 + qi, f = (d >> 1) & 15, u1 = 8 * t2 + 4 * sp + g;
          union { bf16x8 v; uint2 u[2]; } Vf;
          Vf.u[0] = *(const uint2*)(sV + buf * 8192 + d * 128 + ((u1 ^ f) << 3));
          Vf.u[1] = *(const uint2*)(sV + buf * 8192 + d * 128 + (((u1 + 2) ^ f) << 3));
          O[ds] = __builtin_amdgcn_mfma_f32_32x32x16_bf16(Vf.v, Pf.v, O[ds], 0, 0, 0);
        }
      }
    if (kt + 1 < ntile) ASTORE(buf ^ 1);
    __syncthreads();
  }
#undef ALOAD
#undef ASTORE
  const float l = l_run + __shfl_xor(l_run, 32);
  const float inv = 1.f / l;
#pragma unroll
  for (int ds = 0; ds < 2; ++ds)
#pragma unroll
    for (int bq = 0; bq < 4; ++bq) {
      const int d0 = ds * 32 + 8 * bq + 4 * g;
      *(uint2*)(p.AO + (size_t)qrow * 1024 + h * 64 + d0) =
          make_uint2(pk_bf16(O[ds][4 * bq] * inv, O[ds][4 * bq + 1] * inv), pk_bf16(O[ds][4 * bq + 2] * inv, O[ds][4 * bq + 3] * inv));
    }
}

__device__ __forceinline__ void hgrn_item(const Params& p, int grp, int b, int h, int dir, int half, char* smem) {
  const int tid = threadIdx.x, v = half * 32 + (tid >> 3), ks = tid & 7;
  const int T = grp ? 1024 : 256, rowbase = grp ? NP + b * 1024 : b * 256;
  if (grp) __builtin_amdgcn_s_setprio(3);
  f32x2 S2[4];
  if (grp) {
    const float* s0 = (dir ? p.hg_b0 : p.hg_f0) + (size_t)(b * 8 + h) * 4096;
#pragma unroll
    for (int i = 0; i < 4; ++i) S2[i] = (f32x2){s0[(ks * 8 + 2 * i) * 64 + v], s0[(ks * 8 + 2 * i + 1) * 64 + v]};
  } else {
#pragma unroll
    for (int i = 0; i < 4; ++i) S2[i] = (f32x2){0.f, 0.f};
  }
  float* obuf = (float*)(smem + 32768);
  const int lt = tid >> 4, lc = (tid & 15) * 4;
  const int kfseg = dir ? 1024 : 512;
  uint2 rq, rk, rv, rq2, rk2, rv2;
  const int nch = T >> 4;
#define HLOADX(cix, q_, k_, v_) do { const int ts = (cix) * 16 + lt; const int tok = dir ? T - 1 - ts : ts; const bf16_t* src = p.HG + (size_t)(rowbase + tok) * 2560 + h * 64 + lc; \
    q_ = *(const uint2*)(src); k_ = *(const uint2*)(src + kfseg); v_ = *(const uint2*)(src + 1536); } while (0)
#define HSTORE(buf) do { float* B = (float*)(smem + (buf) * 16384) + lt * 64 + lc; \
    const float k0 = bflo(rk.x), k1 = bfhi(rk.x), k2 = bflo(rk.y), k3 = bfhi(rk.y); \
    *(float4*)(B) = make_float4(1.f - k0, 1.f - k1, 1.f - k2, 1.f - k3); *(float4*)(B + 1024) = make_float4(k0, k1, k2, k3); \
    *(float4*)(B + 2048) = make_float4(bflo(rq.x), bfhi(rq.x), bflo(rq.y), bfhi(rq.y)); *(float4*)(B + 3072) = make_float4(bflo(rv.x), bfhi(rv.x), bflo(rv.y), bfhi(rv.y)); } while (0)
  HLOADX(0, rq, rk, rv); HSTORE(0);
  HLOADX(1, rq, rk, rv);
  __syncthreads();
  float* OD = dir ? p.OB : p.OF;
  for (int cix = 0; cix < nch; ++cix) {
    const int buf = cix & 1;
    if (cix + 2 < nch) HLOADX(cix + 2, rq2, rk2, rv2);
    const float* B = (const float*)(smem + buf * 16384);
    float* ob = obuf + buf * 512;
    float4 cf[2], ck[2], cq[2]; float cv;
#define HSTEP_LOAD(t_, f_, k_, q_, v_) do { const float* Bt = B + (t_) * 64 + ks * 8; \
      f_[0] = *(const float4*)(Bt); f_[1] = *(const float4*)(Bt + 4); k_[0] = *(const float4*)(Bt + 1024); k_[1] = *(const float4*)(Bt + 1028); \
      q_[0] = *(const float4*)(Bt + 2048); q_[1] = *(const float4*)(Bt + 2052); v_ = B[3072 + (t_) * 64 + v]; } while (0)
    HSTEP_LOAD(0, cf, ck, cq, cv);
#pragma unroll 1
    for (int g = 0; g < 4; ++g) {
      float op[4];
#pragma unroll
      for (int tt = 0; tt < 4; ++tt) {
        const int t = g * 4 + tt;
        float4 nf[2], nk[2], nq[2]; float nv;
        { const int tn_ = (t + 1) & 15; HSTEP_LOAD(tn_, nf, nk, nq, nv); }
        const f32x2 vvv = (f32x2){cv, cv};
        f32x2 o0, o1;
        S2[0] = S2[0] * (f32x2){cf[0].x, cf[0].y} + vvv * (f32x2){ck[0].x, ck[0].y};
        S2[1] = S2[1] * (f32x2){cf[0].z, cf[0].w} + vvv * (f32x2){ck[0].z, ck[0].w};
        S2[2] = S2[2] * (f32x2){cf[1].x, cf[1].y} + vvv * (f32x2){ck[1].x, ck[1].y};
        S2[3] = S2[3] * (f32x2){cf[1].z, cf[1].w} + vvv * (f32x2){ck[1].z, ck[1].w};
        o0 = S2[0] * (f32x2){cq[0].x, cq[0].y}; o1 = S2[1] * (f32x2){cq[0].z, cq[0].w};
        o0 = S2[2] * (f32x2){cq[1].x, cq[1].y} + o0; o1 = S2[3] * (f32x2){cq[1].z, cq[1].w} + o1;
        const f32x2 os = o0 + o1;
        op[tt] = os.x + os.y;
        cf[0] = nf[0]; cf[1] = nf[1]; ck[0] = nk[0]; ck[1] = nk[1]; cq[0] = nq[0]; cq[1] = nq[1]; cv = nv;
      }
      __builtin_amdgcn_sched_barrier(0);
#define DPPADD(x, ctrl) x += __int_as_float(__builtin_amdgcn_update_dpp(0, __float_as_int(x), ctrl, 0xF, 0xF, true))
      DPPADD(op[0], 0xB1); DPPADD(op[1], 0xB1); DPPADD(op[2], 0xB1); DPPADD(op[3], 0xB1);
      DPPADD(op[0], 0x4E); DPPADD(op[1], 0x4E); DPPADD(op[2], 0x4E); DPPADD(op[3], 0x4E);
      DPPADD(op[0], 0x141); DPPADD(op[1], 0x141); DPPADD(op[2], 0x141); DPPADD(op[3], 0x141);
#undef DPPADD
      if (ks == 0) {
#pragma unroll
        for (int tt = 0; tt < 4; ++tt) ob[(g * 4 + tt) * 32 + (tid >> 3)] = op[tt];
      }
      __builtin_amdgcn_sched_barrier(0);
    }
#undef HSTEP_LOAD
    if (cix + 1 < nch) HSTORE(buf ^ 1);
    rq = rq2; rk = rk2; rv = rv2;
    __syncthreads();
    if (tid < 128) {
      const int ft = tid >> 3, fc = (tid & 7) * 4;
      const int ts = cix * 16 + ft; const int tok = dir ? T - 1 - ts : ts;
      *(float4*)(OD + (size_t)(rowbase + tok) * 512 + h * 64 + half * 32 + fc) = *(const float4*)(ob + ft * 32 + fc);
    }
  }
#undef HLOADX
#undef HSTORE
  __builtin_amdgcn_s_setprio(0);
  if (!grp) {
    float* so = (dir ? p.out_hb : p.out_hf) + (size_t)(b * 8 + h) * 4096;
#pragma unroll
    for (int i = 0; i < 4; ++i) { so[(ks * 8 + 2 * i) * 64 + v] = S2[i].x; so[(ks * 8 + 2 * i + 1) * 64 + v] = S2[i].y; }
  }
}

__device__ __forceinline__ void mix0_phase(const Params& p, char* smem) {
  __shared__ int q_item;
  for (;;) {
    if (threadIdx.x == 0) q_item = (int)atomicAdd(&p.bar[0], 1u);
    __syncthreads();
    const int it = q_item;
    __syncthreads();
    if (it >= 1536) break;
    const bool is_h = it < 256 || (it >= 768 && it < 1280);
    if (is_h) {
      const int grp = it < 256 ? 1 : 0, a = grp ? it : it - 768;
      hgrn_item(p, grp, a >> 5, (a >> 2) & 7, (a >> 1) & 1, a & 1, smem);
    } else {
      const int grp = it < 768 ? 1 : 0, a = grp ? it - 256 : it - 1280;
      const int b = grp ? a >> 6 : a >> 4, h = grp ? (a >> 3) & 7 : (a >> 1) & 7, qb = grp ? a & 7 : a & 1;
      attn_item(p, grp, b, h, qb, smem);
    }
    __syncthreads();
  }
}

__device__ __forceinline__ void hgrn_combine_phase(const Params& p) {
  const int gid = blockIdx.x * NT + threadIdx.x, l16 = gid & 15;
  const int ngroups = NTOK * 8;
  for (int grp = gid >> 4; grp < ngroups; grp += (gridDim.x * NT) >> 4) {
    const int row = grp >> 3, h = grp & 7;
    const size_t o = (size_t)row * 512 + h * 64 + l16 * 4;
    const float4 a = *(const float4*)(p.OF + o), b = *(const float4*)(p.OB + o);
    const float y0 = a.x + b.x, y1 = a.y + b.y, y2 = a.z + b.z, y3 = a.w + b.w;
    float ss = y0 * y0 + y1 * y1 + y2 * y2 + y3 * y3;
    ss += __shfl_xor(ss, 1); ss += __shfl_xor(ss, 2); ss += __shfl_xor(ss, 4); ss += __shfl_xor(ss, 8);
    const float rn = rsqrtf(ss * (1.f / 64.f) + 1e-6f);
    const float4 gn = *(const float4*)(p.g_norm + l16 * 4);
    const uint2 gt = *(const uint2*)(p.HG + (size_t)row * 2560 + 2048 + h * 64 + l16 * 4);
    *(uint2*)(p.AO + (size_t)row * 1024 + 512 + h * 64 + l16 * 4) =
        make_uint2(pk_bf16(y0 * rn * gn.x * bflo(gt.x), y1 * rn * gn.y * bfhi(gt.x)), pk_bf16(y2 * rn * gn.z * bflo(gt.y), y3 * rn * gn.w * bfhi(gt.y)));
  }
}

__device__ __forceinline__ void rwkv_item(const Params& p, int grp, int b, int h, int dir, char* smem, bool dry = false) {
  const bool wr = !(dry && p.njobs >= 0);
  if (grp) __builtin_amdgcn_s_setprio(3);
  const int tid = threadIdx.x, lane = tid & 63, wid = tid >> 6, v = tid >> 2, ks = tid & 3;
  const int T = grp ? 1024 : 256, rowbase = grp ? NP + b * 1024 : b * 256;
  const int vp = tid >> 3, k8 = tid & 7;
  f32x2 Sa[4], Sb[4];
  if (grp) {
    const float* s0 = (dir ? p.rw_b0 : p.rw_f0) + ((size_t)(b * 16 + h) * 64 + vp) * 64 + k8 * 8;
#pragma unroll
    for (int q = 0; q < 2; ++q) {
      const float4 t = *(const float4*)(s0 + q * 4), u = *(const float4*)(s0 + 2048 + q * 4);
      Sa[2 * q] = (f32x2){t.x, t.y}; Sa[2 * q + 1] = (f32x2){t.z, t.w}; Sb[2 * q] = (f32x2){u.x, u.y}; Sb[2 * q + 1] = (f32x2){u.z, u.w};
    }
  } else {
#pragma unroll
    for (int i = 0; i < 4; ++i) { Sa[i] = (f32x2){0.f, 0.f}; Sb[i] = (f32x2){0.f, 0.f}; }
  }
  const bf16_t* E = dir ? p.E1 : p.E0; const bf16_t* A = dir ? p.A1 : p.A0; bf16_t* Y = dir ? p.E1 : p.E0;
  const int lt = tid >> 4, lc = (tid & 15) * 4;
  const float4 kkc = *(const float4*)(p.k_k + h * 64 + lc), kac = *(const float4*)(p.k_a + h * 64 + lc), rkc = *(const float4*)(p.r_k + h * 64 + lc);
  float* BSd = p.BS + (size_t)dir * NTOK * 16;
  float* ybuf = (float*)(smem + 49152);
  uint2 gr, gk, gv, ge, ga;
  const int nch = T >> 4;
#define RLOAD(cix) do { const int ts = (cix) * 16 + lt; const int tok = dir ? T - 1 - ts : ts; const size_t idx = (size_t)(rowbase + tok) * 1024 + h * 64 + lc; \
    gr = *(const uint2*)(p.R + idx); gk = *(const uint2*)(p.Kx + idx); gv = *(const uint2*)(p.Vx + idx); ge = *(const uint2*)(E + idx); ga = *(const uint2*)(A + idx); } while (0)
#define RSTORE(cix, buf) do { const int ts = (cix) * 16 + lt; const int tok = dir ? T - 1 - ts : ts; \
    const float r_[4] = {bflo(gr.x), bfhi(gr.x), bflo(gr.y), bfhi(gr.y)}, k_[4] = {bflo(gk.x), bfhi(gk.x), bflo(gk.y), bfhi(gk.y)}; \
    const float e_[4] = {bflo(ge.x), bfhi(ge.x), bflo(ge.y), bfhi(ge.y)}, a_[4] = {bflo(ga.x), bfhi(ga.x), bflo(ga.y), bfhi(ga.y)}; \
    const float kc_[4] = {kkc.x, kkc.y, kkc.z, kkc.w}, ac_[4] = {kac.x, kac.y, kac.z, kac.w}, rc_[4] = {rkc.x, rkc.y, rkc.z, rkc.w}; \
    float kx[4], kd[4], ssq = 0.f, bsum = 0.f; \
    _Pragma("unroll") for (int j = 0; j < 4; ++j) { kx[j] = k_[j] * kc_[j]; ssq += kx[j] * kx[j]; kd[j] = k_[j] * (1.f + (a_[j] - 1.f) * ac_[j]); bsum += r_[j] * kd[j] * rc_[j]; } \
    ssq = hex_sum(ssq); bsum = hex_sum(bsum); const float rn = rsqrtf(fmaxf(ssq, 1e-24f)); \
    float* B = (float*)(smem + (buf) * 24576) + lt * 64 + lc; \
    *(float4*)(B) = make_float4(__expf(-e_[0]), __expf(-e_[1]), __expf(-e_[2]), __expf(-e_[3])); \
    *(float4*)(B + 1024) = make_float4(kx[0] * rn, kx[1] * rn, kx[2] * rn, kx[3] * rn); \
    *(float4*)(B + 2048) = make_float4(kx[0] * rn * a_[0], kx[1] * rn * a_[1], kx[2] * rn * a_[2], kx[3] * rn * a_[3]); \
    *(float4*)(B + 3072) = make_float4(kd[0], kd[1], kd[2], kd[3]); \
    *(float4*)(B + 4096) = make_float4(r_[0], r_[1], r_[2], r_[3]); \
    *(float4*)(B + 5120) = make_float4(bflo(gv.x), bfhi(gv.x), bflo(gv.y), bfhi(gv.y)); \
    if ((tid & 15) == 0 && wr) BSd[(size_t)(rowbase + tok) * 16 + h] = bsum; } while (0)
  RLOAD(0); RSTORE(0, 0); __syncthreads();
  for (int cix = 0; cix < nch; ++cix) {
    const int buf = cix & 1;
    if (cix + 1 < nch) RLOAD(cix + 1);
    const float* B = (const float*)(smem + buf * 24576);
    float* yb = ybuf + buf * 1024;
    float4 cw[2], ck[2], ca[2], cd[2], cr[2]; float cva, cvb;
#define RSTEP_LOAD(t_, w_, k_, a_, d_, r_, va_, vb_) do { const float* Bt = B + (t_) * 64 + k8 * 8; \
      w_[0] = *(const float4*)(Bt); w_[1] = *(const float4*)(Bt + 4); k_[0] = *(const float4*)(Bt + 1024); k_[1] = *(const float4*)(Bt + 1028); \
      a_[0] = *(const float4*)(Bt + 2048); a_[1] = *(const float4*)(Bt + 2052); d_[0] = *(const float4*)(Bt + 3072); d_[1] = *(const float4*)(Bt + 3076); \
      r_[0] = *(const float4*)(Bt + 4096); r_[1] = *(const float4*)(Bt + 4100); va_ = B[5120 + (t_) * 64 + vp]; vb_ = B[5120 + (t_) * 64 + vp + 32]; } while (0)
    RSTEP_LOAD(0, cw, ck, ca, cd, cr, cva, cvb);
#pragma unroll
    for (int t = 0; t < 16; ++t) {
      float4 nw[2], nk[2], na[2], nd[2], nr[2]; float nva = 0.f, nvb = 0.f;
      if (t + 1 < 16) RSTEP_LOAD(t + 1, nw, nk, na, nd, nr, nva, nvb);
      f32x2 w2[4], kk2[4];
#pragma unroll
      for (int q = 0; q < 2; ++q) {
        w2[2 * q] = (f32x2){cw[q].x, cw[q].y}; w2[2 * q + 1] = (f32x2){cw[q].z, cw[q].w};
        kk2[2 * q] = (f32x2){ck[q].x, ck[q].y}; kk2[2 * q + 1] = (f32x2){ck[q].z, ck[q].w};
      }
      const f32x2 sa_a = (Sa[0] * kk2[0] + Sa[1] * kk2[1]) + (Sa[2] * kk2[2] + Sa[3] * kk2[3]);
      const f32x2 sa_b = (Sb[0] * kk2[0] + Sb[1] * kk2[1]) + (Sb[2] * kk2[2] + Sb[3] * kk2[3]);
      const float saa = -oct_sum(sa_a.x + sa_a.y), sab = -oct_sum(sa_b.x + sa_b.y);
      const f32x2 saav = (f32x2){saa, saa}, sabv = (f32x2){sab, sab}, vav = (f32x2){cva, cva}, vbv = (f32x2){cvb, cvb};
      f32x2 ya = (f32x2){0.f, 0.f}, yb2 = (f32x2){0.f, 0.f};
#pragma unroll
      for (int q = 0; q < 2; ++q) {
        const f32x2 ka0 = (f32x2){ca[q].x, ca[q].y}, ka1 = (f32x2){ca[q].z, ca[q].w}, kd0 = (f32x2){cd[q].x, cd[q].y}, kd1 = (f32x2){cd[q].z, cd[q].w};
        const f32x2 r0 = (f32x2){cr[q].x, cr[q].y}, r1 = (f32x2){cr[q].z, cr[q].w};
        Sa[2 * q] = Sa[2 * q] * w2[2 * q] + (vav * kd0 + saav * ka0); Sa[2 * q + 1] = Sa[2 * q + 1] * w2[2 * q + 1] + (vav * kd1 + saav * ka1);
        Sb[2 * q] = Sb[2 * q] * w2[2 * q] + (vbv * kd0 + sabv * ka0); Sb[2 * q + 1] = Sb[2 * q + 1] * w2[2 * q + 1] + (vbv * kd1 + sabv * ka1);
        ya = Sa[2 * q] * r0 + ya; ya = Sa[2 * q + 1] * r1 + ya;
        yb2 = Sb[2 * q] * r0 + yb2; yb2 = Sb[2 * q + 1] * r1 + yb2;
      }
      const float y_a = oct_sum(ya.x + ya.y), y_b = oct_sum(yb2.x + yb2.y);
      if (k8 == 0) { yb[t * 64 + vp] = y_a; yb[t * 64 + vp + 32] = y_b; }
      if (t + 1 < 16) {
#pragma unroll
        for (int q = 0; q < 2; ++q) { cw[q] = nw[q]; ck[q] = nk[q]; ca[q] = na[q]; cd[q] = nd[q]; cr[q] = nr[q]; }
        cva = nva; cvb = nvb;
      }
    }
#undef RSTEP_LOAD
    if (cix + 1 < nch) RSTORE(cix + 1, buf ^ 1);
    __syncthreads();
    {
      const int ts = cix * 16 + lt; const int tok = dir ? T - 1 - ts : ts;
      const float4 yy = *(const float4*)(yb + lt * 64 + lc);
      if (wr) *(uint2*)(Y + (size_t)(rowbase + tok) * 1024 + h * 64 + lc) = make_uint2(pk_bf16(yy.x, yy.y), pk_bf16(yy.z, yy.w));
    }
  }
#undef RLOAD
#undef RSTORE
  __builtin_amdgcn_s_setprio(0);
  if (!grp && wr) {
    float* so = (dir ? p.out_rb : p.out_rf) + ((size_t)(b * 16 + h) * 64 + vp) * 64 + k8 * 8;
#pragma unroll
    for (int q = 0; q < 2; ++q) {
      *(float4*)(so + q * 4) = make_float4(Sa[2 * q].x, Sa[2 * q].y, Sa[2 * q + 1].x, Sa[2 * q + 1].y);
      *(float4*)(so + 2048 + q * 4) = make_float4(Sb[2 * q].x, Sb[2 * q].y, Sb[2 * q + 1].x, Sb[2 * q + 1].y);
    }
  }
}

__device__ __forceinline__ void rwkv_scan_phase(const Params& p, char* smem, bool dry = false) {
  const int G = gridDim.x;
  if (G >= 512) {
    if (blockIdx.x < 256) { const int a = blockIdx.x; rwkv_item(p, 1, a >> 5, (a >> 1) & 15, a & 1, smem, dry); }
    else for (int a = blockIdx.x - 256; a < 512; a += G - 256) { rwkv_item(p, 0, a >> 5, (a >> 1) & 15, a & 1, smem, dry); __syncthreads(); }
  } else {
    for (int it = blockIdx.x; it < 768; it += G) {
      const int grp = it < 256 ? 1 : 0, a = grp ? it : it - 256;
      rwkv_item(p, grp, a >> 5, (a >> 1) & 15, a & 1, smem, dry);
      __syncthreads();
    }
  }
}

__device__ __forceinline__ void blend_phase(const Params& p) {
  const int gid = blockIdx.x * NT + threadIdx.x, nth = gridDim.x * NT;
  for (int i = gid; i < NTOK * 128; i += nth) {
    const int row = i >> 7, k = (i & 127) * 8;
    ALoadShift a0{p.H, p.mix + 0 * 1024}, a2{p.H, p.mix + 2 * 1024}, a3{p.H, p.mix + 3 * 1024};
    const size_t o = (size_t)row * 1024 + k;
    *(uint4*)(p.E0 + o) = a0(row, k); *(uint4*)(p.E1 + o) = a2(row, k); *(uint4*)(p.A1 + o) = a3(row, k);
  }
}

__device__ __forceinline__ void rwkv_proj_phase(const Params& p, char* smem) {
  const int nunits = 96 * 27;
  for (int u = blockIdx.x; u < nunits; u += gridDim.x) {
    const int tm = u < 288 ? u / 3 : (u - 288) / 24, s = u < 288 ? 24 + u % 3 : (u - 288) % 24;
    if (s < 8) { EpiAct<0> ep{p.R, 1024, nullptr}; gemm_tile_glds(p.E0, 1024, p.wr_t, 1024, tm, s, ep, smem); }
    else if (s < 16) { EpiAct<0> ep{p.Kx, 1024, nullptr}; gemm_tile_glds(p.E1, 1024, p.wk_t, 1024, tm, s - 8, ep, smem); }
    else if (s < 24) { EpiAct<0> ep{p.Vx, 1024, nullptr}; gemm_tile_glds(p.A1, 1024, p.wv_t, 1024, tm, s - 16, ep, smem); }
    else if (s == 24) { ALoadShift al{p.H, p.mix + 1 * 1024}; EpiAct<2> ep{p.LW, 128, nullptr}; gemm_tile(al, p.w1cat_t, 1024, tm, 0, ep, smem); }
    else if (s == 25) { ALoadShift al{p.H, p.mix + 4 * 1024}; EpiAct<0> ep{p.LA, 128, nullptr}; gemm_tile(al, p.a1cat_t, 1024, tm, 0, ep, smem); }
    else { ALoadShift al{p.H, p.mix + 5 * 1024}; EpiAct<3> ep{p.LG, 128, nullptr}; gemm_tile(al, p.g1_t, 1024, tm, 0, ep, smem); }
  }
}
__device__ __forceinline__ void rwkv_lora2_phase(const Params& p, char* smem) {
  const int nunits = 96 * 32;
  for (int u = blockIdx.x; u < nunits; u += gridDim.x) {
    const int tm = u >> 5, s = u & 31, which = s >> 3, tn = s & 7;
    const int d = which & 1;
    if (which < 2) { ALoadPlain al{p.LW + d * 64, 128}; EpiAct<4> ep{d ? p.E1 : p.E0, 1024, p.w0 + d * 1024}; gemm_tile_glds(al.A, al.lda, p.w2_t + (size_t)d * 65536, 64, tm, tn, ep, smem); }
    else { ALoadPlain al{p.LA + d * 64, 128}; EpiAct<5> ep{d ? p.A1 : p.A0, 1024, p.a0 + d * 1024}; gemm_tile_glds(al.A, al.lda, p.a2_t + (size_t)d * 65536, 64, tm, tn, ep, smem); }
  }
}


#define XB_TMO      128
#define XB_XCNT(j)  (256  + 64 * (j))
#define XB_XSUB(j)  (1280 + 64 * (j))
#define XB_XGEN(j)  (2304 + 64 * (j))
#define XB_TOP      3328
#define XB_TOPGEN   3392
#define XCD_BAR_WORDS 3456
#define XB_SPIN_CAP (1u << 22)
#define LAS __attribute__((address_space(3)))
__device__ __forceinline__ unsigned xb_ld(unsigned* p)              { return __hip_atomic_load(p, __ATOMIC_RELAXED, __HIP_MEMORY_SCOPE_AGENT); }
__device__ __forceinline__ unsigned xb_add(unsigned* p, unsigned v) { return __hip_atomic_fetch_add(p, v, __ATOMIC_RELAXED, __HIP_MEMORY_SCOPE_AGENT); }
__device__ __forceinline__ unsigned xb_xcc_id() { return (unsigned)__builtin_amdgcn_s_getreg((3 << 11) | 20) & 0xFu; }
#define XB_SPIN(cond, bar) do { unsigned _sp = 0; while (cond) { __builtin_amdgcn_s_sleep(1); \
    if ((++_sp & 255u) == 0u) { if (xb_ld(&(bar)[XB_TMO])) break; if (_sp > XB_SPIN_CAP) { atomicAdd(&(bar)[XB_TMO], 1u); break; } } } } while (0)
struct XcdBarrier { unsigned* bar; unsigned x; volatile LAS unsigned* st; };
__device__ __forceinline__ XcdBarrier xcd_barrier_post(unsigned* bar, volatile LAS unsigned* st) {
    XcdBarrier b; b.bar = bar; b.x = xb_xcc_id(); b.st = st;
    if (threadIdx.x == 0) (void)xb_add(&bar[XB_XCNT(b.x)], 1u);
    return b;
}
__device__ __forceinline__ void xcd_barrier_complete(unsigned* bar, unsigned x, unsigned& nloc, unsigned& nx) {
    const unsigned G = gridDim.x * gridDim.y * gridDim.z;
    unsigned sum, cnt, mine, sp = 0u;
    for (;;) {
        sum = 0u; cnt = 0u; mine = 0u;
#pragma unroll
        for (unsigned j = 0; j < 16; ++j) { const unsigned c = xb_ld(&bar[XB_XCNT(j)]); sum += c; cnt += (c > 0u) ? 1u : 0u; mine = (j == x) ? c : mine; }
        if (sum == G) break;
        __builtin_amdgcn_s_sleep(1);
        if ((++sp & 255u) == 0u) { if (xb_ld(&bar[XB_TMO])) break; if (sp > XB_SPIN_CAP) { atomicAdd(&bar[XB_TMO], 1u); break; } }
    }
    nloc = mine > 0u ? mine : 1u; nx = cnt > 0u ? cnt : 1u;
}
__device__ __forceinline__ void xcd_barrier(const XcdBarrier& b) {
    asm volatile("s_waitcnt vmcnt(0)" ::: "memory");
    __syncthreads();
    if (threadIdx.x == 0) {
        unsigned* bar = b.bar;
        __builtin_amdgcn_s_waitcnt(0);
        unsigned nloc = b.st[0], nx = b.st[1];
        if (nloc == 0u) { xcd_barrier_complete(bar, b.x, nloc, nx); b.st[0] = nloc; b.st[1] = nx; }
        const unsigned old = xb_add(&bar[XB_XSUB(b.x)], 1u);
        const unsigned gen = old / nloc;
        if (old + 1u == (gen + 1u) * nloc) {
            __builtin_amdgcn_fence(__ATOMIC_RELEASE, "agent");
            asm volatile("s_waitcnt vmcnt(0)" ::: "memory");
            const unsigned og = xb_add(&bar[XB_TOP], 1u);
            const unsigned tg = og / nx;
            if (og + 1u == (tg + 1u) * nx) xb_add(&bar[XB_TOPGEN], 1u);
            else XB_SPIN(xb_ld(&bar[XB_TOPGEN]) == tg, bar);
            __builtin_amdgcn_fence(__ATOMIC_ACQUIRE, "agent");
            xb_add(&bar[XB_XGEN(b.x)], 1u);
            asm volatile("s_waitcnt vmcnt(0)" ::: "memory");
        } else {
            XB_SPIN(xb_ld(&bar[XB_XGEN(b.x)]) == gen, bar);
            __builtin_amdgcn_fence(__ATOMIC_ACQUIRE, "agent");
            asm volatile("s_waitcnt vmcnt(0)" ::: "memory");
        }
    }
    __syncthreads();
}

__device__ __forceinline__ void run_phase(const Params& p, int ph, char* smem, bool dry = false) {
  switch (ph) {
    case 0: if (ONLY_PHASE < 0 || ONLY_PHASE == 0) phase0(p, smem); break;
    case 1: if (ONLY_PHASE < 0 || ONLY_PHASE == 1) { prenorm_phase(p, 0, 0, true); mlp_bias_phase(p); } break;
    case 2: if (ONLY_PHASE < 0 || ONLY_PHASE == 2) { ALoadPlain al{p.H, 1024}; EpiWin ep{&p}; gemm_phase(al, p.w_in_t, 1024, 26, ep, smem); } break;
    case 3: if (ONLY_PHASE < 0 || ONLY_PHASE == 3) mix0_phase(p, smem); break;
    case 4: if (ONLY_PHASE < 0 || ONLY_PHASE == 4) hgrn_combine_phase(p); break;
    case 5: if (ONLY_PHASE < 0 || ONLY_PHASE == 5) { ALoadPlain al{p.AO, 1024}; EpiResid ep{&p, 0, 2, true, false, true}; gemm_phase(al, p.w_out_t, 1024, 8, ep, smem); } break;
    case 6: if (ONLY_PHASE < 0 || ONLY_PHASE == 6) prenorm_phase(p, 0, 1, false); break;
    case 7: if (ONLY_PHASE < 0 || ONLY_PHASE == 7) { ALoadPlain al{p.H, 1024}; EpiMlpUp ep{&p, 0}; gemm_phase(al, p.mlp1_t, 1024, 32, ep, smem); } break;
    case 8: if (ONLY_PHASE < 0 || ONLY_PHASE == 8) { ALoadPlain al{p.U, 4096}; EpiResid ep{&p, 0, 5, false, dry}; gemm_phase(al, p.mlp2_t, 4096, 8, ep, smem); } break;
    case 9: if (ONLY_PHASE < 0 || ONLY_PHASE == 9) prenorm_phase(p, 1, 0, false); break;
    case 10: if (ONLY_PHASE < 0 || ONLY_PHASE == 10) rwkv_proj_phase(p, smem); break;
    case 11: if (ONLY_PHASE < 0 || ONLY_PHASE == 11) rwkv_lora2_phase(p, smem); break;
    case 12: if (ONLY_PHASE < 0 || ONLY_PHASE == 12) rwkv_scan_phase(p, smem, dry); break;
    case 13: if (ONLY_PHASE < 0 || ONLY_PHASE == 13) { ALoadPlain al{p.LG, 128}; EpiRwkvOut ep{&p}; gemm_phase(al, p.g2_t, 128, 8, ep, smem); } break;
    case 14: if (ONLY_PHASE < 0 || ONLY_PHASE == 14) { ALoadPlain al{p.ZO, 1024}; EpiResid ep{&p, 1, 2, false, dry, true}; gemm_phase(al, p.wo_t, 1024, 8, ep, smem); } break;
    case 15: if (ONLY_PHASE < 0 || ONLY_PHASE == 15) prenorm_phase(p, 1, 1, false); break;
    case 16: if (ONLY_PHASE < 0 || ONLY_PHASE == 16) { ALoadPlain al{p.H, 1024}; EpiMlpUp ep{&p, 1}; gemm_phase(al, p.mlp1_t + (size_t)4096 * 1024, 1024, 32, ep, smem); } break;
    case 17: if (ONLY_PHASE < 0 || ONLY_PHASE == 17) { ALoadPlain al{p.U, 4096}; EpiResid ep{&p, 1, 5, false, dry}; gemm_phase(al, p.mlp2_t + (size_t)4096 * 1024, 4096, 8, ep, smem); } break;
    case 18: blend_phase(p); break;
    default: break;
  }
}

__global__ void __launch_bounds__(NT, 2) fwd_kernel(const Params p_unused, int ph_lo, int ph_hi) {
  const Params& p = *(const Params*)__builtin_amdgcn_kernarg_segment_ptr();
  __shared__ __attribute__((aligned(16))) char smem[65536];
  __shared__ uint4 xb_words;
  if (threadIdx.x == 0) xb_words = make_uint4(0u, 0u, 0u, 0u);
  __syncthreads();
  XcdBarrier xb = xcd_barrier_post(p.bar, (volatile LAS unsigned*)&xb_words);
  if (ph_hi < 0) cg::this_grid().sync();
#ifndef PROBE_MASK
#define PROBE_MASK 0
#endif
#ifndef PROBE_DRY
#define PROBE_DRY 0
#endif
#define PHASE(n, sync_) { if ((PROBE_MASK >> n) & 1) { run_phase(p, n, smem); xcd_barrier(xb); } if ((PROBE_DRY >> n) & 1) { run_phase(p, n, smem, true); xcd_barrier(xb); } run_phase(p, n, smem); if (sync_) xcd_barrier(xb); }
  PHASE(0, 1) PHASE(1, 1) PHASE(2, 1) PHASE(3, 1) PHASE(4, 1) PHASE(5, 1) PHASE(7, 1) PHASE(8, 1) PHASE(9, 1) PHASE(18, 1)
  PHASE(10, 1) PHASE(11, 1) PHASE(12, 1) PHASE(13, 1) PHASE(14, 1) PHASE(16, 1) PHASE(17, 0)
#undef PHASE
}

extern "C" void kernel_launch(void* const* d_in, const int* in_sizes, int n_in, void* d_out, int out_size, void* d_ws, size_t ws_size, hipStream_t stream) {
  Params p; memset(&p, 0, sizeof(p));
  auto F = [&](int i) { return (const float*)d_in[i]; };
  p.x_prompt = F(0); p.x_sample = F(1); p.cache_k = F(2); p.cache_v = F(3); p.hg_f0 = F(4); p.hg_b0 = F(5); p.rw_f0 = F(6); p.rw_b0 = F(7);
  p.c = F(8); p.c_ctx = F(9); p.ada_w = F(10); p.ada_b = F(11); p.norm1_w = F(12); p.norm2_w = F(13);
  p.q_norm = F(16); p.k_norm = F(17); p.hgrn_lb = F(18); p.g_norm = F(19); p.mix = F(20);
  p.w0 = F(25); p.a0 = F(28); p.k_k = F(33); p.k_a = F(34); p.r_k = F(35); p.ln_w = F(36); p.ln_b = F(37);
  float* out = (float*)d_out;
  p.X = out; p.out_k = out + 12582912; p.out_v = out + 13107200; p.out_hf = out + 13631488; p.out_hb = out + 14155776;
  p.out_rf = out + 14680064; p.out_rb = out + 15728640;
  char* ws = (char*)d_ws; size_t off = 16384;
  p.bar = (unsigned*)ws;
  auto alloc = [&](size_t bytes) { char* r = ws + off; off += (bytes + 255) & ~(size_t)255; return r; };
  const size_t M1 = (size_t)1024 * 1024;
  p.w_in_t = (bf16_t*)alloc((size_t)3328 * 1024 * 2); p.w_out_t = (bf16_t*)alloc(M1 * 2);
  p.wr_t = (bf16_t*)alloc(M1 * 2); p.wk_t = (bf16_t*)alloc(M1 * 2); p.wv_t = (bf16_t*)alloc(M1 * 2); p.wo_t = (bf16_t*)alloc(M1 * 2);
  p.w1cat_t = (bf16_t*)alloc(128 * 1024 * 2); p.a1cat_t = (bf16_t*)alloc(128 * 1024 * 2); p.g1_t = (bf16_t*)alloc(128 * 1024 * 2);
  p.w2_t = (bf16_t*)alloc(2 * 1024 * 64 * 2); p.a2_t = (bf16_t*)alloc(2 * 1024 * 64 * 2); p.g2_t = (bf16_t*)alloc(1024 * 128 * 2);
  p.mlp1_t = (bf16_t*)alloc(2 * 4 * M1 * 2); p.mlp2_t = (bf16_t*)alloc(2 * 4 * M1 * 2);
  p.MOD = (float*)alloc((size_t)2 * 9 * 6144 * 4);
  p.SSQ = (float*)alloc((size_t)2 * NTOK * 4); p.BM = (float*)alloc((size_t)2 * 9 * 4096 * 4);
  const size_t TOKD = (size_t)NTOK * 1024;
  p.H = (bf16_t*)alloc(TOKD * 2);
  const size_t regL = off;
  p.Qbuf = (bf16_t*)alloc((size_t)NTOK * 512 * 2);
  p.Kp = (bf16_t*)alloc((size_t)32 * 256 * 64 * 2); p.Ks = (bf16_t*)alloc((size_t)16 * 1280 * 64 * 2);
  p.Vtp = (bf16_t*)alloc((size_t)32 * 64 * 256 * 2); p.Vts = (bf16_t*)alloc((size_t)16 * 64 * 1280 * 2);
  p.HG = (bf16_t*)alloc((size_t)NTOK * 2560 * 2);
  p.OF = (float*)alloc((size_t)NTOK * 512 * 4); p.OB = (float*)alloc((size_t)NTOK * 512 * 4);
  p.AO = (bf16_t*)alloc(TOKD * 2);
  size_t end0 = off;
  off = regL; p.U = (bf16_t*)alloc((size_t)NTOK * 4096 * 2);
  size_t endU = off;
  off = regL;
  p.R = (bf16_t*)alloc(TOKD * 2); p.Kx = (bf16_t*)alloc(TOKD * 2); p.Vx = (bf16_t*)alloc(TOKD * 2);
  p.LW = (bf16_t*)alloc((size_t)NTOK * 128 * 2); p.LA = (bf16_t*)alloc((size_t)NTOK * 128 * 2); p.LG = (bf16_t*)alloc((size_t)NTOK * 128 * 2);
  p.E0 = (bf16_t*)alloc(TOKD * 2); p.E1 = (bf16_t*)alloc(TOKD * 2); p.A1 = (bf16_t*)alloc(TOKD * 2);
  p.BS = (float*)alloc((size_t)2 * NTOK * 16 * 4);
  p.A0 = p.H; p.ZO = p.R;
  size_t end1 = off;
  size_t need = end0 > end1 ? end0 : end1; if (endU > need) need = endU;
  if (need > ws_size) fprintf(stderr, "workspace too small: need %zu have %zu\n", need, ws_size);
  int nj = 0, tiles = 0;
  auto job = [&](const float* src, bf16_t* dst, int K, int N) { p.jobs[nj].src = src; p.jobs[nj].dst = dst; p.jobs[nj].K = K; p.jobs[nj].N = N; p.jobs[nj].tile0 = tiles; p.jobs[nj].pad = 0; tiles += (K / 64) * (N / 64); ++nj; };
  job(F(38), p.mlp1_t, 1024, 4096); job(F(38) + 4 * M1, p.mlp1_t + 4 * M1, 1024, 4096);
  job(F(39), p.mlp2_t, 4096, 1024); job(F(39) + 4 * M1, p.mlp2_t + 4 * M1, 4096, 1024);
  job(F(14), p.w_in_t, 1024, 3328); job(F(15), p.w_out_t, 1024, 1024);
  job(F(21), p.wr_t, 1024, 1024); job(F(22), p.wk_t, 1024, 1024); job(F(23), p.wv_t, 1024, 1024); job(F(24), p.wo_t, 1024, 1024);
  job(F(26), p.w1cat_t, 1024, 64); job(F(26) + 65536, p.w1cat_t + 65536, 1024, 64);
  job(F(29), p.a1cat_t, 1024, 64); job(F(29) + 65536, p.a1cat_t + 65536, 1024, 64);
  job(F(31), p.g1_t, 1024, 128);
  job(F(27), p.w2_t, 64, 1024); job(F(27) + 65536, p.w2_t + 65536, 64, 1024);
  job(F(30), p.a2_t, 64, 1024); job(F(30) + 65536, p.a2_t + 65536, 64, 1024);
  job(F(32), p.g2_t, 128, 1024);
  p.njobs = nj; p.ntiles = tiles;

  static int grid_blocks = 0;
  if (!grid_blocks) {
    int dev = 0, cus = 0, per_cu = 0;
    hipGetDevice(&dev);
    hipDeviceGetAttribute(&cus, hipDeviceAttributeMultiprocessorCount, dev);
    hipOccupancyMaxActiveBlocksPerMultiprocessor(&per_cu, fwd_kernel, NT, 0);
    if (per_cu > 2) per_cu = 2;
    if (per_cu < 1) per_cu = 1;
    grid_blocks = cus * per_cu;
  }
  hipMemsetAsync(d_ws, 0, 16384, stream);
  int lo = 0, hi = NPHASES;
  void* args[] = {(void*)&p, (void*)&lo, (void*)&hi};
  hipError_t e = hipLaunchCooperativeKernel((void*)fwd_kernel, dim3(grid_blocks), dim3(NT), args, 0, stream);
  if (e != hipSuccess) fprintf(stderr, "cooperative launch failed: %s (grid %d)\n", hipGetErrorString(e), grid_blocks);
}
```
